# Optimizing an MI355X kernel written in HIP

```python
import math
import jax
import jax.numpy as jnp
from jax import lax
import numpy as np

D_MODEL = 1024
BATCH = 8
SEQ = 2048
DEPTH = 1

EPS = 1e-6
GDN_HEADS = 4
GDN_DK = 128
GDN_DV = 128
GDN_CONV = 4
GDN_CHUNK = 64
RET_HEADS = 4
RET_DK = 128
RET_DV = 256
RET_CHUNK = 128
ROPE_BASE = 10000.0
N_GROUPS = 4
EXPERTS_PER_GROUP = 8
N_EXPERTS = N_GROUPS * EXPERTS_PER_GROUP
TOP_K = 2
D_EXPERT = 512

GDN_QK = GDN_HEADS * GDN_DK
GDN_V = GDN_HEADS * GDN_DV
GDN_CONV_DIM = 2 * GDN_QK + GDN_V
RET_QK = RET_HEADS * RET_DK
RET_V = RET_HEADS * RET_DV
SPLITS = (GDN_QK, GDN_QK, GDN_V, GDN_HEADS, GDN_HEADS, GDN_V, RET_QK, RET_QK, RET_V, RET_V, D_MODEL, D_MODEL)
D_IN = sum(SPLITS)

kernel_name = "hybrid_gdn_retention_hmoe"


def rms_norm(x, w=None):
    xf = x.astype(jnp.float32)
    y = xf * lax.rsqrt(jnp.mean(xf * xf, axis=-1, keepdims=True) + EPS)
    if w is not None:
        y = y * w.astype(jnp.float32)
    return y.astype(x.dtype)


def l2_norm(x):
    return x * lax.rsqrt(jnp.sum(x * x, axis=-1, keepdims=True) + EPS)


def to_chunks(a, chunk):
    b, t, h = a.shape[:3]
    a = a.reshape((b, t // chunk, chunk, h) + a.shape[3:])
    return jnp.moveaxis(a, (1, 3), (0, 2))


def from_chunks(a):
    n, b, h, c, d = a.shape
    return jnp.moveaxis(a, (0, 2), (1, 3)).reshape(b, n * c, h, d)


def causal_depthwise_conv(x, w):
    k, c = w.shape
    return lax.conv_general_dilated(
        x, w[:, None, :].astype(x.dtype), window_strides=(1,), padding=[(k - 1, 0)],
        dimension_numbers=("NWC", "WIO", "NWC"), feature_group_count=c)


def gated_delta_rule(q, k, v, g, beta):
    bsz, t, h, dk = q.shape
    dv = v.shape[-1]
    c = GDN_CHUNK
    q = to_chunks(q, c) * (dk ** -0.5)
    k = to_chunks(k, c)
    v = to_chunks(v, c)
    g = to_chunks(g, c)
    beta = to_chunks(beta, c)
    gc = jnp.cumsum(g, axis=-1)
    causal = jnp.tril(jnp.ones((c, c), dtype=bool))
    strict = jnp.tril(jnp.ones((c, c), dtype=bool), -1)
    diff = gc[..., :, None] - gc[..., None, :]
    decay = jnp.where(causal, jnp.exp(jnp.where(causal, diff, 0.0)), 0.0)
    kb = k * beta[..., None]
    lower = jnp.where(strict, jnp.einsum('nbhid,nbhjd->nbhij', kb, k) * decay, 0.0)
    rhs = jnp.concatenate([v * beta[..., None], kb * jnp.exp(gc)[..., None]], axis=-1)
    sol = lax.linalg.triangular_solve(lower, rhs, left_side=True, lower=True, unit_diagonal=True)
    u, w = sol[..., :dv], sol[..., dv:]
    attn = jnp.where(causal, jnp.einsum('nbhid,nbhjd->nbhij', q, k) * decay, 0.0)
    qg = q * jnp.exp(gc)[..., None]
    kd = k * jnp.exp(gc[..., -1:] - gc)[..., None]
    glast = jnp.exp(gc[..., -1])

    def step(state, inp):
        qg_i, w_i, u_i, attn_i, kd_i, gl_i = inp
        v_new = u_i - jnp.einsum('bhck,bhkv->bhcv', w_i, state)
        o = jnp.einsum('bhck,bhkv->bhcv', qg_i, state) + jnp.einsum('bhij,bhjv->bhiv', attn_i, v_new)
        state = state * gl_i[..., None, None] + jnp.einsum('bhck,bhcv->bhkv', kd_i, v_new)
        return state, o

    s0 = jnp.zeros((bsz, h, dk, dv), jnp.float32)
    _, o = lax.scan(step, s0, (qg, w, u, attn, kd, glast))
    return from_chunks(o)


def gdn_branch(q, k, v, a, b, z, conv_w, A_log, dt_bias, norm_w):
    bsz, t, _ = q.shape
    f32 = jnp.float32
    qkv = jax.nn.silu(causal_depthwise_conv(jnp.concatenate([q, k, v], axis=-1), conv_w)).astype(f32)
    q, k, v = jnp.split(qkv, [GDN_QK, 2 * GDN_QK], axis=-1)
    q = l2_norm(q.reshape(bsz, t, GDN_HEADS, GDN_DK))
    k = l2_norm(k.reshape(bsz, t, GDN_HEADS, GDN_DK))
    v = v.reshape(bsz, t, GDN_HEADS, GDN_DV)
    beta = jax.nn.sigmoid(b.astype(f32))
    g = -jnp.exp(A_log.astype(f32)) * jax.nn.softplus(a.astype(f32) + dt_bias.astype(f32))
    o = gated_delta_rule(q, k, v, g, beta)
    o = rms_norm(o, norm_w) * jax.nn.silu(z.astype(f32).reshape(bsz, t, GDN_HEADS, GDN_DV))
    return o.reshape(bsz, t, GDN_V)


def xpos_rotate(x):
    t, d = x.shape[1], x.shape[-1]
    inv_freq = 1.0 / (ROPE_BASE ** jnp.linspace(0.0, 1.0, d // 2, dtype=jnp.float32))
    ang = jnp.arange(t, dtype=jnp.float32)[:, None] * inv_freq[None, :]
    sin = jnp.repeat(jnp.sin(ang), 2, axis=-1)[None, :, None, :]
    cos = jnp.repeat(jnp.cos(ang), 2, axis=-1)[None, :, None, :]
    rot = jnp.stack([-x[..., 1::2], x[..., 0::2]], axis=-1).reshape(x.shape)
    return x * cos + rot * sin


def retention_chunkwise(q, k, v):
    bsz, t, h, dk = q.shape
    dv = v.shape[-1]
    c = RET_CHUNK
    log_gamma = jnp.log(1.0 - 2.0 ** (-5.0 - jnp.arange(h, dtype=jnp.float32)))
    q, k, v = to_chunks(q, c), to_chunks(k, c), to_chunks(v, c)
    idx = jnp.arange(c, dtype=jnp.float32)
    causal = jnp.tril(jnp.ones((c, c), dtype=bool))
    rel = jnp.where(causal, idx[:, None] - idx[None, :], 0.0)
    inner_decay = jnp.where(causal, jnp.exp(rel[None] * log_gamma[:, None, None]), 0.0)
    scores = jnp.einsum('nbhid,nbhjd->nbhij', q, k) * inner_decay
    o_intra = jnp.einsum('nbhij,nbhjv->nbhiv', scores, v)
    k_decay = jnp.exp(log_gamma[:, None] * (c - 1.0 - idx)[None, :])
    q_decay = jnp.exp(log_gamma[:, None] * (idx + 1.0)[None, :])
    kv = jnp.einsum('nbhck,hc,nbhcv->nbhkv', k, k_decay, v)
    chunk_decay = jnp.exp(log_gamma * c)

    def step(state, kv_n):
        return state * chunk_decay[:, None, None] + kv_n, state

    _, state_prev = lax.scan(step, jnp.zeros((bsz, h, dk, dv), jnp.float32), kv)
    o_inter = jnp.einsum('nbhck,hc,nbhkv->nbhcv', q, q_decay, state_prev)
    return from_chunks(o_intra + o_inter)


def retention_branch(q, k, v, gate):
    bsz, t, _ = q.shape
    f32 = jnp.float32
    q = xpos_rotate(q.astype(f32).reshape(bsz, t, RET_HEADS, RET_DK))
    k = xpos_rotate(k.astype(f32).reshape(bsz, t, RET_HEADS, RET_DK)) * (RET_DK ** -0.5)
    v = v.astype(f32).reshape(bsz, t, RET_HEADS, RET_DV)
    o = rms_norm(retention_chunkwise(q, k, v))
    o = o * jax.nn.silu(gate.astype(f32).reshape(bsz, t, RET_HEADS, RET_DV))
    return o.reshape(bsz, t, RET_V)


def hier_moe(x, w_group, b_group, w_expert, b_expert, w_gate, w_up, w_down):
    bsz, t, d = x.shape
    f32 = jnp.float32
    xt = x.reshape(-1, d)
    g_logits = (xt @ w_group).astype(f32) + b_group.astype(f32)
    g_w, g_idx = lax.top_k(jax.nn.softmax(g_logits, axis=-1), 1)
    e_logits = ((xt @ w_expert).astype(f32) + b_expert.astype(f32)).reshape(-1, N_GROUPS, EXPERTS_PER_GROUP)
    e_logits = jnp.take_along_axis(e_logits, g_idx[:, :, None], axis=1)[:, 0]
    e_val, e_idx = lax.top_k(e_logits, TOP_K)
    e_w = jax.nn.softmax(e_val, axis=-1) * g_w
    e_global = g_idx * EXPERTS_PER_GROUP + e_idx
    combine = jnp.sum(jax.nn.one_hot(e_global, N_EXPERTS, dtype=f32) * e_w[..., None], axis=1)
    y = jnp.zeros(xt.shape, f32)
    for e in range(N_EXPERTS):
        hid = jax.nn.silu(xt @ w_gate[e]) * (xt @ w_up[e])
        y = y + combine[:, e:e + 1] * (hid @ w_down[e]).astype(f32)
    return y.astype(x.dtype).reshape(bsz, t, d)


def setup_inputs(seed: int = 0) -> dict:
    key = jax.random.key(seed)
    ks = jax.random.split(key, 20)
    f32 = jnp.float32
    L = DEPTH

    def nrm(k, shape, scale):
        return jax.random.normal(k, shape, f32) * scale

    x = jax.random.normal(ks[0], (BATCH, SEQ, D_MODEL), f32)
    norm_mix_w = 1.0 + nrm(ks[1], (L, D_MODEL), 0.02)
    w_in = nrm(ks[2], (L, D_MODEL, D_IN), D_MODEL ** -0.5)
    conv_w = nrm(ks[3], (L, GDN_CONV, GDN_CONV_DIM), GDN_CONV ** -0.5)
    A_log = jnp.log(jax.random.uniform(ks[4], (L, GDN_HEADS), f32, 1.0, 16.0))
    dt = jnp.exp(jax.random.uniform(ks[5], (L, GDN_HEADS), f32, math.log(1e-3), math.log(1e-1)))
    dt_bias = dt + jnp.log(-jnp.expm1(-dt))
    gdn_norm_w = 1.0 + nrm(ks[6], (L, GDN_DV), 0.02)
    w_up_gdn = nrm(ks[7], (L, GDN_V, D_MODEL), GDN_V ** -0.5)
    w_up_ret = nrm(ks[8], (L, RET_V, D_MODEL), RET_V ** -0.5)
    w_out = nrm(ks[9], (L, D_MODEL, D_MODEL), D_MODEL ** -0.5)
    norm_ffn_w = 1.0 + nrm(ks[10], (L, D_MODEL), 0.02)
    w_group = nrm(ks[11], (L, D_MODEL, N_GROUPS), D_MODEL ** -0.5)
    b_group = nrm(ks[12], (L, N_GROUPS), 0.01)
    w_expert = nrm(ks[13], (L, D_MODEL, N_EXPERTS), D_MODEL ** -0.5)
    b_expert = nrm(ks[14], (L, N_EXPERTS), 0.01)
    w_gate = nrm(ks[15], (L, N_EXPERTS, D_MODEL, D_EXPERT), D_MODEL ** -0.5)
    w_up = nrm(ks[16], (L, N_EXPERTS, D_MODEL, D_EXPERT), D_MODEL ** -0.5)
    w_down = nrm(ks[17], (L, N_EXPERTS, D_EXPERT, D_MODEL), D_EXPERT ** -0.5)
    norm_final_w = 1.0 + nrm(ks[18], (D_MODEL,), 0.02)
    return {"x": x, "norm_mix_w": norm_mix_w, "w_in": w_in, "conv_w": conv_w, "A_log": A_log,
            "dt_bias": dt_bias, "gdn_norm_w": gdn_norm_w, "w_up_gdn": w_up_gdn, "w_up_ret": w_up_ret,
            "w_out": w_out, "norm_ffn_w": norm_ffn_w, "w_group": w_group, "b_group": b_group,
            "w_expert": w_expert, "b_expert": b_expert, "w_gate": w_gate, "w_up": w_up,
            "w_down": w_down, "norm_final_w": norm_final_w}


def reference(x, norm_mix_w, w_in, conv_w, A_log, dt_bias, gdn_norm_w, w_up_gdn, w_up_ret, w_out,
              norm_ffn_w, w_group, b_group, w_expert, b_expert, w_gate, w_up, w_down, norm_final_w):
    dt = x.dtype
    split_points = np.cumsum(np.array(SPLITS))[:-1].tolist()
    h = x
    for l in range(DEPTH):
        u = rms_norm(h, norm_mix_w[l])
        proj = jnp.einsum('btd,de->bte', u, w_in[l])
        (gq, gk, gv, ga, gb, gz, rq, rk, rv, rg, m_a, m_b) = jnp.split(proj, split_points, axis=-1)
        y_a = gdn_branch(gq, gk, gv, ga, gb, gz, conv_w[l], A_log[l], dt_bias[l], gdn_norm_w[l]).astype(dt)
        y_b = retention_branch(rq, rk, rv, rg).astype(dt)
        merged = (jax.nn.sigmoid(m_a) * jnp.einsum('bte,ed->btd', y_a, w_up_gdn[l])
                  + jax.nn.sigmoid(m_b) * jnp.einsum('bte,ed->btd', y_b, w_up_ret[l]))
        h = h + jnp.einsum('btd,de->bte', merged, w_out[l])
        h = h + hier_moe(rms_norm(h, norm_ffn_w[l]), w_group[l], b_group[l], w_expert[l], b_expert[l],
                         w_gate[l], w_up[l], w_down[l])
    return rms_norm(h, norm_final_w)
```

```cpp
#include <hip/hip_runtime.h>
#include <cstdio>
#include <cstdint>

#ifndef MK_N_LAUNCHES
#define MK_N_LAUNCHES 0
#endif

#define LAS __attribute__((address_space(3)))
#define GAS __attribute__((address_space(1)))
typedef unsigned short bf16_t;
typedef short bf16x8 __attribute__((ext_vector_type(8)));
typedef short bf16x4 __attribute__((ext_vector_type(4)));
typedef float f32x4 __attribute__((ext_vector_type(4)));
typedef float f32x2 __attribute__((ext_vector_type(2)));
typedef unsigned u32x4 __attribute__((ext_vector_type(4)));
typedef unsigned u32x2 __attribute__((ext_vector_type(2)));

constexpr int BATCH = 8, SEQ = 2048, DM = 1024, M = BATCH * SEQ;
constexpr int D_IN = 7176, NP = 7168;
constexpr int NE = 32, DE = 512;
constexpr float EPS = 1e-6f;
constexpr int NWAVES = 8, NTHR = 512;
constexpr int NPH = 11;

constexpr size_t MiB = 1u << 20;
constexpr size_t WS_CTL = 0, CTL_ZERO_BYTES = 1 * MiB;
constexpr size_t WS_LTOK = 1 * MiB, WS_LDST = 3 * MiB, WS_LW = 5 * MiB;
constexpr size_t WS_ROPE = 7 * MiB;
constexpr size_t WS_G = 8 * MiB, WS_BETA = 8 * MiB + 256 * 1024;
constexpr size_t WS_WUPA = 9 * MiB, WS_WUPR = 10 * MiB, WS_WOUT = 12 * MiB;
constexpr size_t WS_WRT = 14 * MiB;
constexpr size_t WS_SSQ = 15 * MiB;
constexpr size_t WS_GQKV = 18 * MiB;
constexpr size_t WS_OGDN = 18 * MiB;
constexpr size_t WS_XN = 18 * MiB;
constexpr size_t WS_Y2 = 18 * MiB;
constexpr size_t WS_GZ = 66 * MiB;
constexpr size_t WS_RQK = 82 * MiB;
constexpr size_t WS_RV = 114 * MiB;
constexpr size_t WS_TMP = 82 * MiB;
constexpr size_t WS_WGU = 82 * MiB;
constexpr size_t WS_RG = 146 * MiB;
constexpr size_t WS_WD = 146 * MiB;
constexpr size_t WS_MAB = 178 * MiB;
constexpr size_t WS_HID = 178 * MiB;
constexpr size_t WS_U = 242 * MiB;
constexpr size_t WS_KV = 242 * MiB;
constexpr size_t WS_MERGED = 242 * MiB;
constexpr size_t WS_WINT = 274 * MiB;
constexpr size_t WS_ATTN = 274 * MiB;
constexpr size_t WS_END = 288 * MiB;
constexpr size_t DO_WNEG = 0, DO_QG = 16 * MiB, DO_KDT = 32 * MiB, DO_UT = 48 * MiB;
constexpr size_t DO_YA = 0, DO_YB = 16 * MiB;

constexpr int CW_TMO = 0;
constexpr int CW_CNT = 64;
constexpr int CW_BAR = 4096;

constexpr int RING_BYTES = 131072;
constexpr int MISC_OFF = RING_BYTES;
constexpr int LDS_BYTES = 147456;

#define LDS_WAIT() asm volatile("s_waitcnt lgkmcnt(0)" ::: "memory")
#define VM_WAIT() asm volatile("s_waitcnt vmcnt(0)" ::: "memory")
__device__ __forceinline__ unsigned f2bf(float f) { unsigned u = __builtin_bit_cast(unsigned, f); return (u + 0x7fffu + ((u >> 16) & 1u)) >> 16; }
__device__ __forceinline__ unsigned pk2(float lo, float hi) { return f2bf(lo) | (f2bf(hi) << 16); }
__device__ __forceinline__ float bf2f(unsigned short h) { return __builtin_bit_cast(float, (unsigned)h << 16); }
__device__ __forceinline__ float bflo(unsigned w) { return __builtin_bit_cast(float, w << 16); }
__device__ __forceinline__ float bfhi(unsigned w) { return __builtin_bit_cast(float, w & 0xffff0000u); }
__device__ __forceinline__ float wave_sum(float v) {
#pragma unroll
    for (int o = 1; o < 64; o <<= 1) v += __shfl_xor(v, o);
    return v;
}
__device__ __forceinline__ float sigmoidf_(float x) { return 1.0f / (1.0f + __expf(-x)); }
__device__ __forceinline__ float siluf_(float x) { return x / (1.0f + __expf(-x)); }

#define XB_TMO      128
#define XB_XCNT(j)  (256  + 64 * (j))
#define XB_XSUB(j)  (1280 + 64 * (j))
#define XB_XGEN(j)  (2304 + 64 * (j))
#define XB_TOP      3328
#define XB_TOPGEN   3392
#define XCD_BAR_WORDS 3456
#define XB_SPIN_CAP (1u << 18)
__device__ __forceinline__ unsigned xb_ld(unsigned* p)              { return __hip_atomic_load(p, __ATOMIC_RELAXED, __HIP_MEMORY_SCOPE_AGENT); }
__device__ __forceinline__ unsigned xb_add(unsigned* p, unsigned v) { return __hip_atomic_fetch_add(p, v, __ATOMIC_RELAXED, __HIP_MEMORY_SCOPE_AGENT); }
__device__ __forceinline__ unsigned xb_xcc_id() { return (unsigned)__builtin_amdgcn_s_getreg((3 << 11) | 20) & 0xFu; }
#define XB_SPIN(cond, bar) do { unsigned _sp = 0; while (cond) { __builtin_amdgcn_s_sleep(1); \
    if ((++_sp & 255u) == 0u) { if (xb_ld(&(bar)[XB_TMO])) break; if (_sp > XB_SPIN_CAP) { atomicAdd(&(bar)[XB_TMO], 1u); break; } } } } while (0)
struct XcdBarrier { unsigned* bar; unsigned x; volatile LAS unsigned* st; };
__device__ __forceinline__ XcdBarrier xcd_barrier_post(unsigned* bar, volatile LAS unsigned* st) {
    XcdBarrier b; b.bar = bar; b.x = xb_xcc_id(); b.st = st;
    if (threadIdx.x == 0) (void)xb_add(&bar[XB_XCNT(b.x)], 1u);
    return b;
}
__device__ __forceinline__ void xcd_barrier_complete(unsigned* bar, unsigned x, unsigned& nloc, unsigned& nx) {
    const unsigned G = gridDim.x * gridDim.y * gridDim.z;
    unsigned sum, cnt, mine, sp = 0u;
    for (;;) {
        sum = 0u; cnt = 0u; mine = 0u;
#pragma unroll
        for (unsigned j = 0; j < 16; ++j) { const unsigned c = xb_ld(&bar[XB_XCNT(j)]); sum += c; cnt += (c > 0u) ? 1u : 0u; mine = (j == x) ? c : mine; }
        if (sum == G) break;
        __builtin_amdgcn_s_sleep(1);
        if ((++sp & 255u) == 0u) { if (xb_ld(&bar[XB_TMO])) break; if (sp > XB_SPIN_CAP) { atomicAdd(&bar[XB_TMO], 1u); break; } }
    }
    nloc = mine > 0u ? mine : 1u; nx = cnt > 0u ? cnt : 1u;
}
__device__ __forceinline__ void xcd_barrier(const XcdBarrier& b) {
    asm volatile("s_waitcnt vmcnt(0)" ::: "memory");
    __syncthreads();
    if (threadIdx.x == 0) {
        unsigned* bar = b.bar;
        __builtin_amdgcn_s_waitcnt(0);
        unsigned nloc = b.st[0], nx = b.st[1];
        if (nloc == 0u) { xcd_barrier_complete(bar, b.x, nloc, nx); b.st[0] = nloc; b.st[1] = nx; }
        const unsigned old = xb_add(&bar[XB_XSUB(b.x)], 1u);
        const unsigned gen = old / nloc;
        if (old + 1u == (gen + 1u) * nloc) {
            __builtin_amdgcn_fence(__ATOMIC_RELEASE, "agent");
            asm volatile("s_waitcnt vmcnt(0)" ::: "memory");
            const unsigned og = xb_add(&bar[XB_TOP], 1u);
            const unsigned tg = og / nx;
            if (og + 1u == (tg + 1u) * nx) xb_add(&bar[XB_TOPGEN], 1u);
            else XB_SPIN(xb_ld(&bar[XB_TOPGEN]) == tg, bar);
            __builtin_amdgcn_fence(__ATOMIC_ACQUIRE, "agent");
            xb_add(&bar[XB_XGEN(b.x)], 1u);
            asm volatile("s_waitcnt vmcnt(0)" ::: "memory");
        } else {
            XB_SPIN(xb_ld(&bar[XB_XGEN(b.x)]) == gen, bar);
            __builtin_amdgcn_fence(__ATOMIC_ACQUIRE, "agent");
            asm volatile("s_waitcnt vmcnt(0)" ::: "memory");
        }
    }
    __syncthreads();
}

namespace pg8 {
constexpr int BM = 256, BK = 64, HALF = 128, HTB = HALF * BK * 2, STAGE_BYTES = 8 * HTB, NXCD = 8, WGM = 8;
__host__ __device__ __forceinline__ int lds_byte(int r, int c) { const int st = (r >> 4) * 2 + (c >> 5), rr = r & 15, cc = c & 31, ob = rr * 64 + cc * 2; return st * 1024 + (ob ^ (((ob >> 9) & 1) << 5)); }
__host__ __device__ __forceinline__ void stage_rc(int b, int& R, int& C) { const int st = b / 1024, sb = b % 1024, swz = sb ^ (((sb >> 9) & 1) << 5); R = (st >> 1) * 16 + swz / 64; C = (st & 1) * 32 + (swz % 64) / 2; }
__host__ __device__ __forceinline__ int perm32(int rho) { const int n = rho >> 4, i = rho & 15; return 8 * (i >> 2) + 4 * n + (i & 3); }

struct Unit { int pm, pn, e, rows, base; };

__device__ __forceinline__ unsigned cvt_pk_bf16(float lo, float hi) { unsigned r; asm volatile("v_cvt_pk_bf16_f32 %0, %1, %2" : "=v"(r) : "v"(lo), "v"(hi)); return r; }

struct Dense {
    const bf16_t* A; const bf16_t* Bt; int K; int nM, nN, nwg, G, c;
    __device__ void init(const bf16_t* A_, const bf16_t* Bt_, int M_, int N_, int K_, int G_, int c_) { A = A_; Bt = Bt_; K = K_; nM = M_ / BM; nN = N_ / BM; nwg = nM * nN; G = G_; c = c_; }
    __device__ __forceinline__ bool next(int i, Unit& u) const {
        const long L = (long)i * G + c; if (L >= nwg) return false;
        int wgid = (int)L; { const int q = nwg / NXCD, r = nwg % NXCD, xcd = wgid % NXCD, off = wgid / NXCD; wgid = (xcd < r ? xcd * (q + 1) : r * (q + 1) + (xcd - r) * q) + off; }
        const int nig = WGM * nN, gid = wgid / nig, fm = gid * WGM, gsz = (nM - fm) < WGM ? (nM - fm) : WGM;
        u.pm = fm + ((wgid % nig) % gsz); u.pn = (wgid % nig) / gsz; u.e = 0; u.rows = 256; u.base = 0; return true;
    }
    __device__ __forceinline__ const char* a_ptr(const Unit& u) const { return (const char*)A + (size_t)u.pm * (size_t)(2 * HALF) * K * 2; }
    __device__ __forceinline__ const char* b_ptr(const Unit& u) const { return (const char*)Bt + (size_t)u.pn * (size_t)(2 * HALF) * K * 2; }
};

template <class Epi, class Prob, bool GATHER, bool ALIGN_EPI, bool SP2>
__device__ __forceinline__ void gemm_phase(LAS unsigned char* lds, const Prob& S, const Epi& E) {
    const int tid = threadIdx.x, wid = __builtin_amdgcn_readfirstlane(tid >> 6), lane = tid & 63, wr = wid >> 2, wc = wid & 3, fr = lane & 15, fq = lane >> 4;
    const int K = S.K, nt = K / BK;
    unsigned voffB[2]; int RA[2], CA[2];
    unsigned cvo[2][2], nvo[2][2];
#pragma unroll
    for (int i = 0; i < 2; ++i) { int R, C; stage_rc(tid * 16 + i * 8192, R, C); const int Rb = Epi::PERM ? ((R & ~31) + perm32(R & 31)) : R;
        RA[i] = R; CA[i] = C; voffB[i] = (unsigned)(Rb * K + C) * 2u; }
    const size_t kstep = (size_t)(BK * 2);
    const size_t hstep = (size_t)HALF * K * 2;
    const unsigned ldsw = (unsigned)wid * 1024u;
    const int aoff = lds_byte(wr * 64 + fr, fq * 8), boff = lds_byte(wc * 32 + fr, fq * 8);
#define PG8_SA(b, h) (((b) * 2 + (h)) * HTB)
#define PG8_SB(b, h) ((4 + (b) * 2 + (h)) * HTB)
#define PG8_STAGE(bufoff, gbase, voff) do { _Pragma("unroll") for (int _i = 0; _i < 2; ++_i) \
        __builtin_amdgcn_global_load_lds((const unsigned*)((const char*)(gbase) + (voff)[_i]), (LAS unsigned*)(lds + (bufoff) + ldsw + _i * 8192), 16, 0, 0); } while (0)
#define PG8_LDA(dst, b, h) do { _Pragma("unroll") for (int m = 0; m < 4; ++m) _Pragma("unroll") for (int k = 0; k < 2; ++k) dst[m][k] = *(const LAS bf16x8*)(lds + PG8_SA(b, h) + aoff + m * 2048 + k * 1024); } while (0)
#define PG8_LDB(dst, b, h) do { _Pragma("unroll") for (int n = 0; n < 2; ++n) _Pragma("unroll") for (int k = 0; k < 2; ++k) dst[n][k] = *(const LAS bf16x8*)(lds + PG8_SB(b, h) + boff + n * 2048 + k * 1024); } while (0)
#define PG8_MMA(ai, bj, At, Bt) do { __builtin_amdgcn_s_setprio(1); _Pragma("unroll") for (int m = 0; m < 4; ++m) _Pragma("unroll") for (int n = 0; n < 2; ++n) _Pragma("unroll") for (int k = 0; k < 2; ++k) \
        acc[ai][bj][m][n] = __builtin_amdgcn_mfma_f32_16x16x32_bf16(Bt[n][k], At[m][k], acc[ai][bj][m][n], 0, 0, 0); __builtin_amdgcn_s_setprio(0); } while (0)
#define PG8_WAIT_V(n) asm volatile("s_waitcnt vmcnt(" #n ")" ::: "memory")
#define PG8_WAIT_L(n) asm volatile("s_waitcnt lgkmcnt(" #n ")" ::: "memory")
#define PG8_BAR __builtin_amdgcn_s_barrier()
#define PG8_SCHED __builtin_amdgcn_sched_barrier(0)
    Unit cur, nxt; int ui = 0;
    if (!S.next(0, cur)) return;
    f32x4 acc[2][2][4][2];
#pragma unroll
    for (int a = 0; a < 2; ++a)
#pragma unroll
        for (int b = 0; b < 2; ++b)
#pragma unroll
            for (int m = 0; m < 4; ++m)
#pragma unroll
                for (int n = 0; n < 2; ++n) acc[a][b][m][n] = (f32x4){0.f, 0.f, 0.f, 0.f};
    bf16x8 At[4][2], B0[2][2], B1[2][2];
    const char* cA = S.a_ptr(cur); const char* cB = S.b_ptr(cur);
#pragma unroll
    for (int h = 0; h < 2; ++h)
#pragma unroll
        for (int i = 0; i < 2; ++i) {
            if constexpr (GATHER) cvo[h][i] = (unsigned)(((size_t)S.a_row(cur, h * HALF + RA[i]) * K + CA[i]) * 2u);
            else cvo[h][i] = (unsigned)((RA[i] * K + CA[i]) * 2u + h * hstep);
            nvo[h][i] = cvo[h][i];
        }
    if constexpr (SP2) {
        PG8_STAGE(PG8_SB(0, 0), cB, voffB); PG8_STAGE(PG8_SB(0, 1), cB + hstep, voffB); PG8_STAGE(PG8_SA(0, 0), cA, cvo[0]); PG8_STAGE(PG8_SA(0, 1), cA, cvo[1]);
        if (wr == 1) PG8_BAR;
        PG8_WAIT_V(2); PG8_BAR;
        PG8_STAGE(PG8_SB(1, 0), cB + kstep, voffB); PG8_STAGE(PG8_SA(1, 0), cA + kstep, cvo[0]); PG8_STAGE(PG8_SB(1, 1), cB + hstep + kstep, voffB);
        PG8_WAIT_V(6); PG8_BAR;
    } else {
        PG8_STAGE(PG8_SB(0, 0), cB, voffB); PG8_STAGE(PG8_SA(0, 0), cA, cvo[0]); PG8_STAGE(PG8_SB(0, 1), cB + hstep, voffB); PG8_STAGE(PG8_SA(0, 1), cA, cvo[1]);
        if (wr == 1) PG8_BAR;
        PG8_WAIT_V(4); PG8_BAR;
        PG8_STAGE(PG8_SB(1, 0), cB + kstep, voffB); PG8_STAGE(PG8_SA(1, 0), cA + kstep, cvo[0]); PG8_STAGE(PG8_SB(1, 1), cB + hstep + kstep, voffB);
        PG8_WAIT_V(6); PG8_BAR;
    }
    for (;;) {
        const bool has_next = S.next(ui + 1, nxt);
        const char* nA = has_next ? S.a_ptr(nxt) : cA; const char* nB = has_next ? S.b_ptr(nxt) : cB;
        if constexpr (GATHER) {
#pragma unroll
            for (int h = 0; h < 2; ++h)
#pragma unroll
                for (int i = 0; i < 2; ++i) nvo[h][i] = has_next ? (unsigned)(((size_t)S.a_row(nxt, h * HALF + RA[i]) * K + CA[i]) * 2u) : cvo[h][i];
        }
        for (int t = 0; t < nt; t += 2) {
            const bool last = (t == nt - 2);
            const char* a1 = cA + (size_t)(t + 1) * kstep;
            const char* a2 = last ? nA : cA + (size_t)(t + 2) * kstep; const char* b2 = last ? nB : cB + (size_t)(t + 2) * kstep;
            const char* a3 = a2 + kstep; const char* b3 = b2 + kstep;
            unsigned v2[2][2];
#pragma unroll
            for (int h = 0; h < 2; ++h)
#pragma unroll
                for (int i = 0; i < 2; ++i) v2[h][i] = (GATHER && last) ? nvo[h][i] : cvo[h][i];
            if constexpr (SP2) {
            PG8_LDB(B0, 0, 0); PG8_LDB(B1, 0, 1); PG8_SCHED; PG8_LDA(At, 0, 0); PG8_STAGE(PG8_SA(1, 1), a1, cvo[1]);
            PG8_WAIT_V(8); PG8_WAIT_L(0); PG8_BAR; PG8_MMA(0, 0, At, B0); PG8_MMA(0, 1, At, B1); PG8_BAR; PG8_SCHED;
            PG8_LDA(At, 0, 1); PG8_STAGE(PG8_SB(0, 0), b2, voffB); PG8_STAGE(PG8_SB(0, 1), b2 + hstep, voffB); PG8_STAGE(PG8_SA(0, 0), a2, v2[0]);
            PG8_WAIT_V(8); PG8_WAIT_L(0); PG8_BAR; PG8_MMA(1, 0, At, B0); PG8_MMA(1, 1, At, B1); PG8_BAR; PG8_SCHED;
            PG8_LDB(B0, 1, 0); PG8_LDB(B1, 1, 1); PG8_SCHED; PG8_LDA(At, 1, 0); PG8_STAGE(PG8_SA(0, 1), a2, v2[1]);
            PG8_WAIT_V(8); PG8_WAIT_L(0); PG8_BAR; PG8_MMA(0, 0, At, B0); PG8_MMA(0, 1, At, B1); PG8_BAR; PG8_SCHED;
            PG8_LDA(At, 1, 1); PG8_STAGE(PG8_SB(1, 0), b3, voffB); PG8_STAGE(PG8_SB(1, 1), b3 + hstep, voffB); PG8_STAGE(PG8_SA(1, 0), a3, v2[0]);
            PG8_WAIT_V(8); PG8_WAIT_L(0); PG8_BAR; PG8_MMA(1, 0, At, B0); PG8_MMA(1, 1, At, B1); PG8_BAR; PG8_SCHED;
            } else {
            PG8_LDB(B0, 0, 0); PG8_SCHED; PG8_LDA(At, 0, 0); PG8_STAGE(PG8_SA(1, 1), a1, cvo[1]);
            PG8_WAIT_L(8); PG8_BAR; PG8_WAIT_L(0); PG8_MMA(0, 0, At, B0); PG8_BAR; PG8_SCHED;
            PG8_LDB(B1, 0, 1); PG8_STAGE(PG8_SB(0, 0), b2, voffB);
            PG8_BAR; PG8_WAIT_L(0); PG8_MMA(0, 1, At, B1); PG8_BAR;
            PG8_LDA(At, 0, 1); PG8_STAGE(PG8_SA(0, 0), a2, v2[0]);
            PG8_BAR; PG8_WAIT_L(0); PG8_MMA(1, 0, At, B0); PG8_BAR; PG8_SCHED;
            PG8_STAGE(PG8_SB(0, 1), b2 + hstep, voffB);
            PG8_WAIT_V(6); PG8_BAR; PG8_MMA(1, 1, At, B1); PG8_BAR;
            PG8_LDB(B0, 1, 0); PG8_SCHED; PG8_LDA(At, 1, 0); PG8_STAGE(PG8_SA(0, 1), a2, v2[1]);
            PG8_WAIT_L(8); PG8_BAR; PG8_WAIT_L(0); PG8_MMA(0, 0, At, B0); PG8_BAR; PG8_SCHED;
            PG8_LDB(B1, 1, 1); PG8_STAGE(PG8_SB(1, 0), b3, voffB);
            PG8_BAR; PG8_WAIT_L(0); PG8_MMA(0, 1, At, B1); PG8_BAR;
            PG8_LDA(At, 1, 1); PG8_STAGE(PG8_SA(1, 0), a3, v2[0]);
            PG8_BAR; PG8_WAIT_L(0); PG8_MMA(1, 0, At, B0); PG8_BAR; PG8_SCHED;
            PG8_STAGE(PG8_SB(1, 1), b3 + hstep, voffB);
            PG8_WAIT_V(6); PG8_BAR; PG8_MMA(1, 1, At, B1); PG8_BAR;
            }
        }
        if constexpr (ALIGN_EPI) { if (wr == 0) PG8_BAR; }
        E(acc, cur, wr, wc, fr, fq);
        if (!has_next) break;
#pragma unroll
        for (int a = 0; a < 2; ++a)
#pragma unroll
            for (int b = 0; b < 2; ++b)
#pragma unroll
                for (int m = 0; m < 4; ++m)
#pragma unroll
                    for (int n = 0; n < 2; ++n) acc[a][b][m][n] = (f32x4){0.f, 0.f, 0.f, 0.f};
        cur = nxt; cA = nA; cB = nB; ++ui;
#pragma unroll
        for (int h = 0; h < 2; ++h)
#pragma unroll
            for (int i = 0; i < 2; ++i) cvo[h][i] = nvo[h][i];
        if constexpr (ALIGN_EPI) { if (wr == 1) PG8_BAR; }
    }
    PG8_WAIT_V(0);
    if constexpr (!ALIGN_EPI) { if (wr == 0) PG8_BAR; }
    PG8_BAR;
#undef PG8_SA
#undef PG8_SB
#undef PG8_STAGE
#undef PG8_LDA
#undef PG8_LDB
#undef PG8_MMA
#undef PG8_WAIT_V
#undef PG8_WAIT_L
#undef PG8_BAR
#undef PG8_SCHED
}
}

struct Frame {
    LAS unsigned char* lds;
    volatile LAS unsigned* MISC;
    GAS unsigned* ctl;
    int tid, lane, wave;
    int vcu, G;
    const float* in[19];
    float* out; unsigned char* ws;
};
enum { I_X = 0, I_NMW, I_WIN, I_CONVW, I_ALOG, I_DTB, I_GNW, I_WUPG, I_WUPR, I_WOUT, I_NFW, I_WGRP, I_BGRP, I_WEXP, I_BEXP, I_WGATE, I_WUP, I_WDOWN, I_NFINW };

__device__ __forceinline__ void transpose_item(const float* W, int ldw, int col0, bf16_t* WT, int K, int row0, int k0, LAS float* scr, int lane) {
#pragma unroll 8
    for (int i = 0; i < 32; ++i) { const int kk = 2 * i + (lane >> 5); scr[kk * 33 + (lane & 31)] = W[(size_t)(k0 + kk) * ldw + col0 + (lane & 31)]; }
    LDS_WAIT(); asm volatile("" ::: "memory");
    const int c = lane & 7;
#pragma unroll
    for (int j = 0; j < 4; ++j) { const int n = (lane >> 3) + 8 * j; const LAS float* s = scr + (8 * c) * 33 + n;
        u32x4 o; o.x = pk2(s[0 * 33], s[1 * 33]); o.y = pk2(s[2 * 33], s[3 * 33]); o.z = pk2(s[4 * 33], s[5 * 33]); o.w = pk2(s[6 * 33], s[7 * 33]);
        *(GAS u32x4*)(WT + (size_t)(row0 + n) * K + k0 + 8 * c) = o; }
    LDS_WAIT(); asm volatile("" ::: "memory");
}

__device__ __forceinline__ void p0_prologue(Frame& F) {
    LAS float* scr = (LAS float*)(F.lds + F.wave * 16384);
    const int gw = F.vcu * NWAVES + F.wave, NGW = F.G * NWAVES;
    unsigned char* ws = F.ws;
    {
        constexpr int I_IN = (DM / 64) * (NP / 32);
        constexpr int I_UA = (512 / 64) * (DM / 32);
        constexpr int I_UR = (1024 / 64) * (DM / 32);
        constexpr int I_WO = (1024 / 64) * (DM / 32);
        constexpr int NIT = I_IN + I_UA + I_UR + I_WO;
        for (int it = gw; it < NIT; it += NGW) {
            int r = it;
            if (r < I_IN) { const int nb = r % (NP / 32), kb = r / (NP / 32); const int n0 = nb * 32; const int src = n0 + (n0 >= 1536 ? 8 : 0);
                transpose_item(F.in[I_WIN], D_IN, src, (bf16_t*)(ws + WS_WINT), DM, n0, kb * 64, scr, F.lane); continue; } r -= I_IN;
            if (r < I_UA) { const int nb = r % 32, kb = r / 32; transpose_item(F.in[I_WUPG], DM, nb * 32, (bf16_t*)(ws + WS_WUPA), 512, nb * 32, kb * 64, scr, F.lane); continue; } r -= I_UA;
            if (r < I_UR) { const int nb = r % 32, kb = r / 32; transpose_item(F.in[I_WUPR], DM, nb * 32, (bf16_t*)(ws + WS_WUPR), 1024, nb * 32, kb * 64, scr, F.lane); continue; } r -= I_UR;
            { const int nb = r % 32, kb = r / 32; transpose_item(F.in[I_WOUT], DM, nb * 32, (bf16_t*)(ws + WS_WOUT), 1024, nb * 32, kb * 64, scr, F.lane); }
        }
    }
    {
        GAS f32x2* tab = (GAS f32x2*)(ws + WS_ROPE);
        const int gt = (F.vcu * NTHR + F.tid), NGT = F.G * NTHR;
        for (int i = gt; i < SEQ * 64; i += NGT) {
            const int t = i >> 6, p = i & 63;
            const float invf = 1.0f / powf(10000.0f, (float)p * (1.0f / 63.0f));
            const float ang = (float)t * invf;
            float s, c; sincosf(ang, &s, &c);
            tab[i] = (f32x2){c, s};
        }
    }
    {
        GAS float* wrt = (GAS float*)(ws + WS_WRT);
        const int gt = (F.vcu * NTHR + F.tid), NGT = F.G * NTHR;
        for (int i = gt; i < 36 * DM; i += NGT) {
            const int j = i / DM, k = i % DM;
            wrt[i] = j < 4 ? F.in[I_WGRP][k * 4 + j] : F.in[I_WEXP][k * 32 + (j - 4)];
        }
    }
    {
        __syncthreads();
        LAS float* wab2 = (LAS float*)F.lds;
        for (int idx = F.tid; idx < 8192; idx += NTHR) { const int k = idx >> 3, q = idx & 7; const int j = k >> 8, l_ = (k & 255) >> 2, e = k & 3;
            wab2[((j * 4 + e) * 64 + l_) * 8 + q] = F.in[I_WIN][(size_t)k * D_IN + 1536 + q]; }
        __syncthreads();
        const float* nw = F.in[I_NMW];
        f32x4 wv[4];
#pragma unroll
        for (int j = 0; j < 4; ++j) wv[j] = *(const f32x4*)(nw + 4 * F.lane + 256 * j);
        float alog = 0.f, dtb = 0.f;
        if (F.lane < 4) { alog = F.in[I_ALOG][F.lane]; dtb = F.in[I_DTB][F.lane]; }
        for (int m = gw; m < M; m += NGW) {
            const GAS f32x4* xr = (const GAS f32x4*)(F.in[I_X] + (size_t)m * DM) + F.lane;
            f32x4 v[4]; float s = 0.f;
#pragma unroll
            for (int j = 0; j < 4; ++j) { v[j] = xr[64 * j]; s += (v[j].x * v[j].x + v[j].y * v[j].y) + (v[j].z * v[j].z + v[j].w * v[j].w); }
            const float rstd = 1.0f / sqrtf(wave_sum(s) * (1.f / DM) + EPS);
            float ab[8];
#pragma unroll
            for (int q = 0; q < 8; ++q) ab[q] = 0.f;
            GAS unsigned long long* o8 = (GAS unsigned long long*)((bf16_t*)(ws + WS_U) + (size_t)m * DM) + F.lane;
#pragma unroll
            for (int j = 0; j < 4; ++j) {
                v[j] = v[j] * rstd * wv[j];
                o8[64 * j] = (unsigned long long)pk2(v[j].x, v[j].y) | ((unsigned long long)pk2(v[j].z, v[j].w) << 32);
#pragma unroll
                for (int e = 0; e < 4; ++e) {
                    const LAS f32x4* wp = (const LAS f32x4*)(wab2 + ((j * 4 + e) * 64 + F.lane) * 8);
                    const f32x4 w0 = wp[0], w1 = wp[1];
                    const float xv = v[j][e];
                    ab[0] += xv * w0.x; ab[1] += xv * w0.y; ab[2] += xv * w0.z; ab[3] += xv * w0.w;
                    ab[4] += xv * w1.x; ab[5] += xv * w1.y; ab[6] += xv * w1.z; ab[7] += xv * w1.w;
                }
            }
#pragma unroll
            for (int q = 0; q < 8; ++q) ab[q] = wave_sum(ab[q]);
            if (F.lane < 4) {
                const float a = F.lane == 0 ? ab[0] : F.lane == 1 ? ab[1] : F.lane == 2 ? ab[2] : ab[3];
                const float b = F.lane == 0 ? ab[4] : F.lane == 1 ? ab[5] : F.lane == 2 ? ab[6] : ab[7];
                const float z = a + dtb;
                const float sp = z > 20.f ? z : log1pf(__expf(z));
                ((GAS float*)(ws + WS_G))[(size_t)m * 4 + F.lane] = -__expf(alog) * sp;
                ((GAS float*)(ws + WS_BETA))[(size_t)m * 4 + F.lane] = 1.0f / (1.0f + __expf(-b));
            }
        }
    }
}

struct EpiProj {
    static constexpr bool PERM = true;
    unsigned char* ws;
    __device__ __forceinline__ void operator()(const f32x4 (&acc)[2][2][4][2], const pg8::Unit& u, int wr, int wc, int fr, int fq) const {
        const int pn = u.pn; bf16_t* base; int ldc, colt, mode = 0;
        if (pn < 6) { base = (bf16_t*)(ws + WS_GQKV); ldc = 1536; colt = 256 * pn; }
        else if (pn < 8) { base = (bf16_t*)(ws + WS_GZ); ldc = 512; colt = 256 * (pn - 6); }
        else if (pn < 12) { base = (bf16_t*)(ws + WS_RQK); ldc = 1024; colt = 256 * (pn - 8); mode = pn < 10 ? 1 : 2; }
        else if (pn < 16) { base = (bf16_t*)(ws + WS_RV); ldc = 1024; colt = 256 * (pn - 12); }
        else if (pn < 20) { base = (bf16_t*)(ws + WS_RG); ldc = 1024; colt = 256 * (pn - 16); }
        else { base = (bf16_t*)(ws + WS_MAB); ldc = 2048; colt = 256 * (pn - 20); }
        const int row0 = u.pm * 256 + wr * 64 + fr, col0 = colt + wc * 32 + 8 * fq;
        const float sc = mode == 2 ? 0.08838834764831845f : 1.0f;
        const GAS f32x4* tab = (const GAS f32x4*)(ws + WS_ROPE);
#pragma unroll
        for (int ai = 0; ai < 2; ++ai)
#pragma unroll
            for (int m = 0; m < 4; ++m) {
                const int row = row0 + ai * 128 + m * 16;
                bf16_t* rowp = base + (size_t)row * ldc + col0;
                f32x4 cs0 = {1.f, 0.f, 1.f, 0.f}, cs1 = cs0;
                if (mode) { const GAS f32x4* tp = tab + ((size_t)(row & (SEQ - 1)) * 64 + wc * 16 + 4 * fq) / 2; cs0 = tp[0]; cs1 = tp[1]; }
#pragma unroll
                for (int bj = 0; bj < 2; ++bj) {
                    f32x4 v0 = acc[ai][bj][m][0], v1 = acc[ai][bj][m][1];
                    if (mode) {
                        f32x4 r0, r1;
                        r0[0] = v0[0] * cs0[0] - v0[1] * cs0[1]; r0[1] = v0[1] * cs0[0] + v0[0] * cs0[1];
                        r0[2] = v0[2] * cs0[2] - v0[3] * cs0[3]; r0[3] = v0[3] * cs0[2] + v0[2] * cs0[3];
                        r1[0] = v1[0] * cs1[0] - v1[1] * cs1[1]; r1[1] = v1[1] * cs1[0] + v1[0] * cs1[1];
                        r1[2] = v1[2] * cs1[2] - v1[3] * cs1[3]; r1[3] = v1[3] * cs1[2] + v1[2] * cs1[3];
                        v0 = r0 * sc; v1 = r1 * sc;
                    }
                    u32x4 w; w.x = pg8::cvt_pk_bf16(v0[0], v0[1]); w.y = pg8::cvt_pk_bf16(v0[2], v0[3]); w.z = pg8::cvt_pk_bf16(v1[0], v1[1]); w.w = pg8::cvt_pk_bf16(v1[2], v1[3]);
                    *(u32x4*)(rowp + bj * 128) = w;
                }
            }
    }
};

__device__ __forceinline__ f32x4 mma16(bf16x8 x, bf16x8 y, f32x4 c) { return __builtin_amdgcn_mfma_f32_16x16x32_bf16(x, y, c, 0, 0, 0); }
__device__ __forceinline__ bf16x8 lfrag(const LAS bf16_t* base, int ld, int row0, int k0, int fr, int fq) { return *(const LAS bf16x8*)(base + (row0 + fr) * ld + k0 + 8 * fq); }
__device__ __forceinline__ bf16x8 gfrag(const bf16_t* base, int ld, int row0, int k0, int fr, int fq) { return *(const bf16x8*)(base + (size_t)(row0 + fr) * ld + k0 + 8 * fq); }
__device__ __forceinline__ bf16x8 tfrag(const LAS bf16_t* base, int ld, int k0, int n0, int lane) {
    const int g = lane >> 4, q = (lane & 15) >> 2, p = lane & 3;
    const LAS bf16_t* a = base + (k0 + 8 * g + q) * ld + n0 + 4 * p;
    const bf16x4 v0 = __builtin_amdgcn_ds_read_tr16_b64_v4i16((LAS bf16x4*)a);
    const bf16x4 v1 = __builtin_amdgcn_ds_read_tr16_b64_v4i16((LAS bf16x4*)(a + 4 * ld));
    return (bf16x8){v0[0], v0[1], v0[2], v0[3], v1[0], v1[1], v1[2], v1[3]};
}
__device__ __forceinline__ bf16x8 pack_acc(f32x4 a, f32x4 b) {
    u32x4 w; w.x = pk2(a[0], a[1]); w.y = pk2(a[2], a[3]); w.z = pk2(b[0], b[1]); w.w = pk2(b[2], b[3]);
    return __builtin_bit_cast(bf16x8, w);
}
__device__ __forceinline__ int ppos(int kap) { return 8 * ((kap & 15) >> 2) + 4 * (kap >> 4) + (kap & 3); }

constexpr size_t WS_GL = 8 * MiB + 512 * 1024;

__device__ __forceinline__ void gdn_prep_item(Frame& F, int idx) {
    const int bh = idx >> 5, n = idx & 31, b = bh >> 2, h = bh & 3;
    const int tok0 = b * SEQ + n * 64;
    LAS bf16_t* QN = (LAS bf16_t*)(F.lds);
    LAS bf16_t* KN = (LAS bf16_t*)(F.lds + 17408);
    LAS bf16_t* KT = (LAS bf16_t*)(F.lds + 34816);
    LAS bf16_t* VT = (LAS bf16_t*)(F.lds + 53248);
    LAS float*  LM = (LAS float*)(F.lds + 71680);
    LAS bf16_t* T1 = (LAS bf16_t*)(F.lds + 89088);
    LAS bf16_t* T2 = (LAS bf16_t*)(F.lds + 98304);
    LAS float*  SC = (LAS float*)(F.lds + 107520);
    LAS float*  SSQ = (LAS float*)(F.lds + 108544);
    const int tid = F.tid, lane = F.lane, fr = lane & 15, fq = lane >> 4, wave = F.wave;
    const bf16_t* GQKV = (const bf16_t*)(F.ws + WS_GQKV);
#pragma unroll 1
    for (int task = tid; task < 768; task += NTHR) {
        const int cg = task % 48, tr = task / 48, part = cg >> 4, cl = (cg & 15) * 8;
        const int gcol = part * 512 + h * 128 + cl;
        u32x4 xw[7];
#pragma unroll
        for (int r = 0; r < 7; ++r) {
            const int tt = tr * 4 - 3 + r;
            xw[r] = (u32x4){0u, 0u, 0u, 0u};
            if (n * 64 + tt >= 0) xw[r] = *(const u32x4*)(GQKV + (size_t)(tok0 + tt) * 1536 + gcol);
        }
        unsigned nat[4][4];
        float ssq[4];
#pragma unroll
        for (int t = 0; t < 4; ++t) ssq[t] = 0.f;
#pragma unroll
        for (int e2 = 0; e2 < 4; ++e2) {
            float c0[4], c1[4];
#pragma unroll
            for (int k = 0; k < 4; ++k) { const f32x2 cc = *(const f32x2*)(F.in[I_CONVW] + k * 1536 + gcol + 2 * e2); c0[k] = cc.x; c1[k] = cc.y; }
            float xa[7], xb[7];
#pragma unroll
            for (int r = 0; r < 7; ++r) { const unsigned w = xw[r][e2]; xa[r] = bflo(w); xb[r] = bfhi(w); }
            float ya[4], yb[4];
#pragma unroll
            for (int t = 0; t < 4; ++t) {
                ya[t] = siluf_(c0[0] * xa[t] + c0[1] * xa[t + 1] + c0[2] * xa[t + 2] + c0[3] * xa[t + 3]);
                yb[t] = siluf_(c1[0] * xb[t] + c1[1] * xb[t + 1] + c1[2] * xb[t + 2] + c1[3] * xb[t + 3]);
                ssq[t] += ya[t] * ya[t] + yb[t] * yb[t];
                nat[t][e2] = pk2(ya[t], yb[t]);
            }
            if (part >= 1) {
                LAS bf16_t* Tt = part == 1 ? KT : VT;
                u32x2 w; w.x = pk2(ya[0], ya[1]); w.y = pk2(ya[2], ya[3]);
                *(LAS u32x2*)(Tt + (cl + 2 * e2) * 72 + tr * 4) = w;
                w.x = pk2(yb[0], yb[1]); w.y = pk2(yb[2], yb[3]);
                *(LAS u32x2*)(Tt + (cl + 2 * e2 + 1) * 72 + tr * 4) = w;
            }
        }
        if (part < 2) {
            LAS bf16_t* N = part == 0 ? QN : KN;
#pragma unroll
            for (int t = 0; t < 4; ++t) {
                SSQ[(part * 64 + tr * 4 + t) * 16 + (cg & 15)] = ssq[t];
                *(LAS u32x4*)(N + (tr * 4 + t) * 136 + cl) = (u32x4){nat[t][0], nat[t][1], nat[t][2], nat[t][3]};
            }
        }
    }
    __syncthreads();
    if (wave == 0) {
        const int c = lane;
        float sq = 0.f, sk = 0.f;
#pragma unroll
        for (int j = 0; j < 16; ++j) { sq += SSQ[c * 16 + j]; sk += SSQ[(64 + c) * 16 + j]; }
        const float rq = 1.0f / sqrtf(sq + EPS), rk = 1.0f / sqrtf(sk + EPS);
        const float g = ((const float*)(F.ws + WS_G))[(size_t)(tok0 + c) * 4 + h];
        const float be = ((const float*)(F.ws + WS_BETA))[(size_t)(tok0 + c) * 4 + h];
        float gc = g;
#pragma unroll
        for (int o = 1; o < 64; o <<= 1) { const float t = __shfl_up(gc, o); if (lane >= o) gc += t; }
        SC[c] = rq; SC[64 + c] = rk; SC[128 + c] = gc; SC[192 + c] = be;
        if (c == 63) ((float*)(F.ws + WS_GL))[idx] = gc;
    }
    __syncthreads();
    {
        bf16_t* ATT = (bf16_t*)(F.ws + WS_ATTN) + (size_t)idx * 4096;
#pragma unroll 1
        for (int job = wave * 4; job < wave * 4 + 4; ++job) {
            const int which = job >> 4, it = (job >> 2) & 3, jt = job & 3;
            f32x4 acc = {0.f, 0.f, 0.f, 0.f};
            const LAS bf16_t* Y = which ? QN : KN;
#pragma unroll
            for (int ks = 0; ks < 4; ++ks) acc = mma16(lfrag(KN, 136, jt * 16, ks * 32, fr, fq), lfrag(Y, 136, it * 16, ks * 32, fr, fq), acc);
            const int i = it * 16 + fr, j0 = jt * 16 + 4 * fq;
            const float gci = SC[128 + i];
            if (which == 0) {
                const float fi = SC[192 + i] * SC[64 + i];
                f32x4 o;
#pragma unroll
                for (int r = 0; r < 4; ++r) { const int j = j0 + r; o[r] = (j < i) ? fi * SC[64 + j] * acc[r] * __expf(gci - SC[128 + j]) : 0.f; }
                *(LAS f32x4*)(LM + i * 68 + j0) = o;
            } else {
                const float fi = SC[i] * 0.08838834764831845f;
                float o[4];
#pragma unroll
                for (int r = 0; r < 4; ++r) { const int j = j0 + r; o[r] = (j <= i) ? fi * SC[64 + j] * acc[r] * __expf(gci - SC[128 + j]) : 0.f; }
                u32x2 w; w.x = pk2(o[0], o[1]); w.y = pk2(o[2], o[3]);
                *(u32x2*)(ATT + i * 64 + (j0 & 32) + ppos(j0 & 31)) = w;
            }
        }
    }
    __syncthreads();
    if (wave == 0) {
        const int c = lane;
        int zero = 0; asm volatile("v_mov_b32 %0, 0" : "=v"(zero));
        const LAS float* LMv = LM + zero;
        const float b1 = SC[192 + c], b2 = b1 * SC[64 + c] * __expf(SC[128 + c]);
        unsigned t1a = (unsigned)(uintptr_t)(T1 + c), t2a = (unsigned)(uintptr_t)(T2 + c);
        asm volatile("" : "+v"(t1a), "+v"(t2a));
        LAS bf16_t* T1v = (LAS bf16_t*)(uintptr_t)t1a; LAS bf16_t* T2v = (LAS bf16_t*)(uintptr_t)t2a;
        float t[64];
#pragma unroll
        for (int i = 0; i < 64; ++i) {
            float s = (i == c) ? 1.f : 0.f;
#pragma unroll
            for (int j4 = 0; j4 < (i + 3) / 4; ++j4) {
                const f32x4 l = *(const LAS f32x4*)(LMv + i * 68 + 4 * j4);
#pragma unroll
                for (int e = 0; e < 4; ++e) if (4 * j4 + e < i) s -= l[e] * t[4 * j4 + e];
            }
            t[i] = s;
            T1v[i * 72] = (bf16_t)f2bf(s * b1); T2v[i * 72] = (bf16_t)f2bf(s * b2);
            asm volatile("" ::: "memory");
        }
    } else {
        bf16_t* QGo = (bf16_t*)((unsigned char*)F.out + DO_QG) + (size_t)idx * 8192;
        bf16_t* KDo = (bf16_t*)((unsigned char*)F.out + DO_KDT) + (size_t)idx * 8192;
        const float gl = SC[128 + 63];
        for (int task = tid - 64; task < 2048; task += 448) {
            if (task < 1024) {
                const int c = task >> 4, d0 = (task & 15) * 8;
                const float f = SC[c] * 0.08838834764831845f * __expf(SC[128 + c]);
                const u32x4 w = *(const LAS u32x4*)(QN + c * 136 + d0);
                u32x2 o0, o1; o0.x = pk2(bflo(w.x) * f, bfhi(w.x) * f); o0.y = pk2(bflo(w.y) * f, bfhi(w.y) * f); o1.x = pk2(bflo(w.z) * f, bfhi(w.z) * f); o1.y = pk2(bflo(w.w) * f, bfhi(w.w) * f);
                bf16_t* dst = QGo + c * 128 + (d0 & ~31);
                *(u32x2*)(dst + ppos(d0 & 31)) = o0; *(u32x2*)(dst + ppos((d0 & 31) + 4)) = o1;
            } else {
                const int tk = task - 1024, d = tk >> 3, c0 = (tk & 7) * 8;
                const u32x4 w = *(const LAS u32x4*)(KT + d * 72 + c0);
                float f[8];
#pragma unroll
                for (int e = 0; e < 8; ++e) f[e] = SC[64 + c0 + e] * __expf(gl - SC[128 + c0 + e]);
                u32x2 o0, o1; o0.x = pk2(bflo(w.x) * f[0], bfhi(w.x) * f[1]); o0.y = pk2(bflo(w.y) * f[2], bfhi(w.y) * f[3]); o1.x = pk2(bflo(w.z) * f[4], bfhi(w.z) * f[5]); o1.y = pk2(bflo(w.w) * f[6], bfhi(w.w) * f[7]);
                bf16_t* dst = KDo + d * 64 + (c0 & ~31);
                *(u32x2*)(dst + ppos(c0 & 31)) = o0; *(u32x2*)(dst + ppos((c0 & 31) + 4)) = o1;
            }
        }
    }
    __syncthreads();
    {
        bf16_t* UTo = (bf16_t*)((unsigned char*)F.out + DO_UT) + (size_t)idx * 8192;
        bf16_t* WNo = (bf16_t*)((unsigned char*)F.out + DO_WNEG) + (size_t)idx * 8192;
#pragma unroll 1
        for (int job = wave * 8; job < wave * 8 + 8; ++job) {
            f32x4 acc = {0.f, 0.f, 0.f, 0.f};
            if (job < 32) {
                const int it = job >> 3, dvt = job & 7;
#pragma unroll
                for (int ks = 0; ks < 2; ++ks) acc = mma16(lfrag(T1, 72, it * 16, ks * 32, fr, fq), lfrag(VT, 72, dvt * 16, ks * 32, fr, fq), acc);
                u32x2 w; w.x = pk2(acc[0], acc[1]); w.y = pk2(acc[2], acc[3]);
                *(u32x2*)(UTo + (dvt * 16 + fr) * 64 + it * 16 + 4 * fq) = w;
            } else {
                const int dkt = (job - 32) >> 2, it = (job - 32) & 3;
#pragma unroll
                for (int ks = 0; ks < 2; ++ks) acc = mma16(lfrag(KT, 72, dkt * 16, ks * 32, fr, fq), lfrag(T2, 72, it * 16, ks * 32, fr, fq), acc);
                u32x2 w; w.x = pk2(-acc[0], -acc[1]); w.y = pk2(-acc[2], -acc[3]);
                const int d0 = dkt * 16 + 4 * fq;
                *(u32x2*)(WNo + (it * 16 + fr) * 128 + (d0 & ~31) + ppos(d0 & 31)) = w;
            }
        }
    }
    __syncthreads();
}

__device__ __forceinline__ float ret_log2_gamma(int h) { return log2f(1.0f - exp2f(-5.0f - (float)h)); }
__device__ __forceinline__ void ret_kv_item(Frame& F, int idx2) {
    const int bh = idx2 >> 4, n = idx2 & 15, b = bh >> 2, h = bh & 3;
    const int tok0 = b * SEQ + n * 128;
    LAS bf16_t* KS = (LAS bf16_t*)(F.lds);
    LAS bf16_t* VN = (LAS bf16_t*)(F.lds + 34816);
    const int tid = F.tid, lane = F.lane, fr = lane & 15, fq = lane >> 4, wave = F.wave;
    const float l2g = ret_log2_gamma(h);
    const bf16_t* RQK = (const bf16_t*)(F.ws + WS_RQK); const bf16_t* RV = (const bf16_t*)(F.ws + WS_RV);
#pragma unroll
    for (int i = 0; i < 4; ++i) { const int p = tid + i * 512, c = p >> 4, d0 = (p & 15) * 8;
        const u32x4 w = *(const u32x4*)(RQK + (size_t)(tok0 + c) * 1024 + 512 + h * 128 + d0);
        const float f = exp2f(l2g * (float)(127 - c));
        u32x4 o; o.x = pk2(bflo(w.x) * f, bfhi(w.x) * f); o.y = pk2(bflo(w.y) * f, bfhi(w.y) * f); o.z = pk2(bflo(w.z) * f, bfhi(w.z) * f); o.w = pk2(bflo(w.w) * f, bfhi(w.w) * f);
        *(LAS u32x4*)(KS + c * 136 + d0) = o; }
#pragma unroll
    for (int i = 0; i < 8; ++i) { const int p = tid + i * 512, c = p >> 5, d0 = (p & 31) * 8;
        *(LAS u32x4*)(VN + c * 264 + d0) = *(const u32x4*)(RV + (size_t)(tok0 + c) * 1024 + h * 256 + d0); }
    __syncthreads();
    f32x4 acc[8][2];
#pragma unroll
    for (int a = 0; a < 8; ++a) { acc[a][0] = (f32x4){0.f, 0.f, 0.f, 0.f}; acc[a][1] = acc[a][0]; }
#pragma unroll
    for (int ks = 0; ks < 4; ++ks) {
        const bf16x8 y0 = tfrag(VN, 264, ks * 32, (2 * wave) * 16, lane), y1 = tfrag(VN, 264, ks * 32, (2 * wave + 1) * 16, lane);
#pragma unroll
        for (int dkt = 0; dkt < 8; ++dkt) { const bf16x8 x = tfrag(KS, 136, ks * 32, dkt * 16, lane); acc[dkt][0] = mma16(x, y0, acc[dkt][0]); acc[dkt][1] = mma16(x, y1, acc[dkt][1]); }
    }
    bf16_t* KVo = (bf16_t*)(F.ws + WS_KV) + (size_t)idx2 * 32768;
#pragma unroll
    for (int dkt = 0; dkt < 8; ++dkt)
#pragma unroll
        for (int q = 0; q < 2; ++q) { u32x2 w; w.x = pk2(acc[dkt][q][0], acc[dkt][q][1]); w.y = pk2(acc[dkt][q][2], acc[dkt][q][3]);
            *(u32x2*)(KVo + ((2 * wave + q) * 16 + fr) * 128 + dkt * 16 + 4 * fq) = w; }
    __syncthreads();
}

__device__ __forceinline__ void gdn_scan_chain(Frame& F, int chain) {
    const int bh = chain >> 3, sl = chain & 7, b = bh >> 2, h = bh & 3;
    const int lane = F.lane, fr = lane & 15, fq = lane >> 4;
    const bf16_t* WNEG = (const bf16_t*)((unsigned char*)F.out + DO_WNEG); const bf16_t* QG = (const bf16_t*)((unsigned char*)F.out + DO_QG);
    const bf16_t* KDT = (const bf16_t*)((unsigned char*)F.out + DO_KDT); const bf16_t* UT = (const bf16_t*)((unsigned char*)F.out + DO_UT);
    const bf16_t* ATT = (const bf16_t*)(F.ws + WS_ATTN);
    float* OG = (float*)(F.ws + WS_OGDN); float* SSQ = (float*)(F.ws + WS_SSQ);
    f32x4 S[8];
#pragma unroll
    for (int d = 0; d < 8; ++d) S[d] = (f32x4){0.f, 0.f, 0.f, 0.f};
#pragma unroll 1
    for (int n = 0; n < 32; ++n) {
        const int idx = bh * 32 + n;
        const bf16_t* W = WNEG + (size_t)idx * 8192; const bf16_t* Q = QG + (size_t)idx * 8192; const bf16_t* KD = KDT + (size_t)idx * 8192;
        const bf16_t* U = UT + (size_t)idx * 8192; const bf16_t* A = ATT + (size_t)idx * 4096;
        const float egl = __expf(((const float*)(F.ws + WS_GL))[idx]);
        bf16x8 Sf[4];
#pragma unroll
        for (int ks = 0; ks < 4; ++ks) Sf[ks] = pack_acc(S[2 * ks], S[2 * ks + 1]);
        f32x4 av[4], ao[4];
#pragma unroll
        for (int ct = 0; ct < 4; ++ct) {
            const u32x2 w = *(const u32x2*)(U + (sl * 16 + fr) * 64 + ct * 16 + 4 * fq);
            av[ct] = (f32x4){bflo(w.x), bfhi(w.x), bflo(w.y), bfhi(w.y)};
            ao[ct] = (f32x4){0.f, 0.f, 0.f, 0.f};
        }
#pragma unroll
        for (int ct = 0; ct < 4; ++ct)
#pragma unroll
            for (int ks = 0; ks < 4; ++ks) av[ct] = mma16(gfrag(W, 128, ct * 16, ks * 32, fr, fq), Sf[ks], av[ct]);
#pragma unroll
        for (int ct = 0; ct < 4; ++ct)
#pragma unroll
            for (int ks = 0; ks < 4; ++ks) ao[ct] = mma16(gfrag(Q, 128, ct * 16, ks * 32, fr, fq), Sf[ks], ao[ct]);
        bf16x8 Vf[2];
        Vf[0] = pack_acc(av[0], av[1]); Vf[1] = pack_acc(av[2], av[3]);
#pragma unroll
        for (int ct = 0; ct < 4; ++ct)
#pragma unroll
            for (int k2 = 0; k2 < 2; ++k2) ao[ct] = mma16(gfrag(A, 64, ct * 16, k2 * 32, fr, fq), Vf[k2], ao[ct]);
#pragma unroll
        for (int dt = 0; dt < 8; ++dt) {
            S[dt] = S[dt] * egl;
#pragma unroll
            for (int k2 = 0; k2 < 2; ++k2) S[dt] = mma16(gfrag(KD, 64, dt * 16, k2 * 32, fr, fq), Vf[k2], S[dt]);
        }
        const int tok0 = b * SEQ + n * 64;
#pragma unroll
        for (int ct = 0; ct < 4; ++ct)
#pragma unroll
            for (int r = 0; r < 4; ++r) {
                const int c = ct * 16 + 4 * fq + r; const float v = ao[ct][r];
                OG[(size_t)(tok0 + c) * 512 + h * 128 + sl * 16 + fr] = v;
                float s = v * v;
                s += __shfl_xor(s, 1); s += __shfl_xor(s, 2); s += __shfl_xor(s, 4); s += __shfl_xor(s, 8);
                if (fr == 0) SSQ[(size_t)(tok0 + c) * 32 + h * 8 + sl] = s;
            }
    }
}

__device__ __forceinline__ void ret_prefix_task(Frame& F, int task) {
    const int bh = task >> 6, part = task & 63, h = bh & 3;
    const float cd = exp2f(ret_log2_gamma(h) * 128.0f);
    bf16_t* base = (bf16_t*)(F.ws + WS_KV) + (size_t)bh * 16 * 32768 + part * 512 + F.lane * 8;
    float st[8];
#pragma unroll
    for (int e = 0; e < 8; ++e) st[e] = 0.f;
#pragma unroll 4
    for (int n = 0; n < 16; ++n) {
        u32x4* p = (u32x4*)(base + (size_t)n * 32768);
        const u32x4 w = *p;
        u32x4 o; o.x = pk2(st[0], st[1]); o.y = pk2(st[2], st[3]); o.z = pk2(st[4], st[5]); o.w = pk2(st[6], st[7]);
        *p = o;
        st[0] = st[0] * cd + bflo(w.x); st[1] = st[1] * cd + bfhi(w.x); st[2] = st[2] * cd + bflo(w.y); st[3] = st[3] * cd + bfhi(w.y);
        st[4] = st[4] * cd + bflo(w.z); st[5] = st[5] * cd + bfhi(w.z); st[6] = st[6] * cd + bflo(w.w); st[7] = st[7] * cd + bfhi(w.w);
    }
}

__device__ __forceinline__ void ret_out_item(Frame& F, int idx2) {
    const int bh = idx2 >> 4, n = idx2 & 15, b = bh >> 2, h = bh & 3;
    const int tok0 = b * SEQ + n * 128;
    LAS bf16_t* QN = (LAS bf16_t*)(F.lds);
    LAS bf16_t* KN = (LAS bf16_t*)(F.lds + 34816);
    LAS bf16_t* VN = (LAS bf16_t*)(F.lds);
    LAS bf16_t* PM = (LAS bf16_t*)(F.lds + 69632);
    LAS float*  NS = (LAS float*)(F.lds + 104448);
    const int tid = F.tid, lane = F.lane, fr = lane & 15, fq = lane >> 4, wave = F.wave;
    const float l2g = ret_log2_gamma(h);
    const bf16_t* RQK = (const bf16_t*)(F.ws + WS_RQK); const bf16_t* RV = (const bf16_t*)(F.ws + WS_RV);
#pragma unroll
    for (int i = 0; i < 4; ++i) { const int p = tid + i * 512, c = p >> 4, d0 = (p & 15) * 8;
        *(LAS u32x4*)(QN + c * 136 + d0) = *(const u32x4*)(RQK + (size_t)(tok0 + c) * 1024 + h * 128 + d0);
        *(LAS u32x4*)(KN + c * 136 + d0) = *(const u32x4*)(RQK + (size_t)(tok0 + c) * 1024 + 512 + h * 128 + d0); }
    __syncthreads();
    {
        bf16x8 yq[4];
#pragma unroll
        for (int ks = 0; ks < 4; ++ks) yq[ks] = lfrag(QN, 136, wave * 16, ks * 32, fr, fq);
        const int i = wave * 16 + fr;
#pragma unroll
        for (int jt = 0; jt < 8; ++jt) {
            f32x4 acc = {0.f, 0.f, 0.f, 0.f};
#pragma unroll
            for (int ks = 0; ks < 4; ++ks) acc = mma16(lfrag(KN, 136, jt * 16, ks * 32, fr, fq), yq[ks], acc);
            float o[4];
#pragma unroll
            for (int r = 0; r < 4; ++r) { const int j = jt * 16 + 4 * fq + r; o[r] = (j <= i) ? acc[r] * exp2f(l2g * (float)(i - j)) : 0.f; }
            u32x2 w; w.x = pk2(o[0], o[1]); w.y = pk2(o[2], o[3]);
            *(LAS u32x2*)(PM + i * 136 + jt * 16 + 4 * fq) = w;
        }
    }
    __syncthreads();
#pragma unroll
    for (int i = 0; i < 8; ++i) { const int p = tid + i * 512, c = p >> 5, d0 = (p & 31) * 8;
        *(LAS u32x4*)(VN + c * 264 + d0) = *(const u32x4*)(RV + (size_t)(tok0 + c) * 1024 + h * 256 + d0); }
    __syncthreads();
    const int wi = wave >> 1, wd = wave & 1;
    f32x4 a1[8][2];
#pragma unroll
    for (int d = 0; d < 8; ++d) { a1[d][0] = (f32x4){0.f, 0.f, 0.f, 0.f}; a1[d][1] = a1[d][0]; }
    const bf16_t* SP = (const bf16_t*)(F.ws + WS_KV) + (size_t)idx2 * 32768;
    const float qd0 = exp2f(l2g * (float)((2 * wi) * 16 + fr + 1)), qd1 = exp2f(l2g * (float)((2 * wi + 1) * 16 + fr + 1));
#pragma unroll
    for (int ks = 0; ks < 4; ++ks) {
        const bf16x8 p0 = lfrag(PM, 136, (2 * wi) * 16, ks * 32, fr, fq), p1 = lfrag(PM, 136, (2 * wi + 1) * 16, ks * 32, fr, fq);
        bf16x8 q0 = gfrag(RQK + (size_t)tok0 * 1024 + h * 128, 1024, (2 * wi) * 16, ks * 32, fr, fq), q1 = gfrag(RQK + (size_t)tok0 * 1024 + h * 128, 1024, (2 * wi + 1) * 16, ks * 32, fr, fq);
        { u32x4 w = __builtin_bit_cast(u32x4, q0); w.x = pk2(bflo(w.x) * qd0, bfhi(w.x) * qd0); w.y = pk2(bflo(w.y) * qd0, bfhi(w.y) * qd0); w.z = pk2(bflo(w.z) * qd0, bfhi(w.z) * qd0); w.w = pk2(bflo(w.w) * qd0, bfhi(w.w) * qd0); q0 = __builtin_bit_cast(bf16x8, w); }
        { u32x4 w = __builtin_bit_cast(u32x4, q1); w.x = pk2(bflo(w.x) * qd1, bfhi(w.x) * qd1); w.y = pk2(bflo(w.y) * qd1, bfhi(w.y) * qd1); w.z = pk2(bflo(w.z) * qd1, bfhi(w.z) * qd1); w.w = pk2(bflo(w.w) * qd1, bfhi(w.w) * qd1); q1 = __builtin_bit_cast(bf16x8, w); }
#pragma unroll
        for (int d = 0; d < 8; ++d) {
            const bf16x8 xv = tfrag(VN, 264, ks * 32, (wd * 8 + d) * 16, lane);
            a1[d][0] = mma16(xv, p0, a1[d][0]); a1[d][1] = mma16(xv, p1, a1[d][1]);
            const bf16x8 xs = gfrag(SP, 128, (wd * 8 + d) * 16, ks * 32, fr, fq);
            a1[d][0] = mma16(xs, q0, a1[d][0]); a1[d][1] = mma16(xs, q1, a1[d][1]);
        }
    }
#pragma unroll
    for (int t = 0; t < 2; ++t) {
        const int i = (2 * wi + t) * 16 + fr;
        float s = 0.f;
#pragma unroll
        for (int d = 0; d < 8; ++d) { const f32x4 v = a1[d][t]; s += (v[0] * v[0] + v[1] * v[1]) + (v[2] * v[2] + v[3] * v[3]); }
        s += __shfl_xor(s, 16); s += __shfl_xor(s, 32);
        if (fq == 0) NS[i * 2 + wd] = s;
    }
    __syncthreads();
    const bf16_t* RG = (const bf16_t*)(F.ws + WS_RG);
    bf16_t* YB = (bf16_t*)((unsigned char*)F.out + DO_YB);
#pragma unroll
    for (int t = 0; t < 2; ++t) {
        const int i = (2 * wi + t) * 16 + fr;
        const float rstd = 1.0f / sqrtf((NS[i * 2] + NS[i * 2 + 1]) * (1.0f / 256.0f) + EPS);
#pragma unroll
        for (int d = 0; d < 8; ++d) {
            const int dv = (wd * 8 + d) * 16 + 4 * fq;
            const u32x2 g = *(const u32x2*)(RG + (size_t)(tok0 + i) * 1024 + h * 256 + dv);
            const f32x4 v = a1[d][t] * rstd;
            u32x2 w; w.x = pk2(v[0] * siluf_(bflo(g.x)), v[1] * siluf_(bfhi(g.x))); w.y = pk2(v[2] * siluf_(bflo(g.y)), v[3] * siluf_(bfhi(g.y)));
            *(u32x2*)(YB + (size_t)(tok0 + i) * 1024 + h * 256 + dv) = w;
        }
    }
    __syncthreads();
}

__device__ __forceinline__ void gdn_normgate_row(Frame& F, int m) {
    const int lane = F.lane, hd = lane >> 4;
    const float* OG = (const float*)(F.ws + WS_OGDN) + (size_t)m * 512 + lane * 8;
    const f32x4 o0 = *(const f32x4*)OG, o1 = *(const f32x4*)(OG + 4);
    const float* sp = (const float*)(F.ws + WS_SSQ) + (size_t)m * 32 + hd * 8;
    const f32x4 s0 = *(const f32x4*)sp, s1 = *(const f32x4*)(sp + 4);
    const float ssum = ((s0[0] + s0[1]) + (s0[2] + s0[3])) + ((s1[0] + s1[1]) + (s1[2] + s1[3]));
    const float rstd = 1.0f / sqrtf(ssum * (1.0f / 128.0f) + EPS);
    const float* nw = F.in[I_GNW] + (lane & 15) * 8;
    const f32x4 w0 = *(const f32x4*)nw, w1 = *(const f32x4*)(nw + 4);
    const u32x4 z = *(const u32x4*)((const bf16_t*)(F.ws + WS_GZ) + (size_t)m * 512 + lane * 8);
    u32x4 y;
    y.x = pk2(o0[0] * rstd * w0[0] * siluf_(bflo(z.x)), o0[1] * rstd * w0[1] * siluf_(bfhi(z.x)));
    y.y = pk2(o0[2] * rstd * w0[2] * siluf_(bflo(z.y)), o0[3] * rstd * w0[3] * siluf_(bfhi(z.y)));
    y.z = pk2(o1[0] * rstd * w1[0] * siluf_(bflo(z.z)), o1[1] * rstd * w1[1] * siluf_(bfhi(z.z)));
    y.w = pk2(o1[2] * rstd * w1[2] * siluf_(bflo(z.w)), o1[3] * rstd * w1[3] * siluf_(bfhi(z.w)));
    *(u32x4*)((bf16_t*)((unsigned char*)F.out + DO_YA) + (size_t)m * 512 + lane * 8) = y;
}

struct EpiUp1 {
    static constexpr bool PERM = true;
    unsigned char* ws;
    __device__ __forceinline__ void operator()(const f32x4 (&acc)[2][2][4][2], const pg8::Unit& u, int wr, int wc, int fr, int fq) const {
        const int row0 = u.pm * 256 + wr * 64 + fr, col0 = u.pn * 256 + wc * 32 + 8 * fq;
        const bf16_t* MAB = (const bf16_t*)(ws + WS_MAB); float* TMP = (float*)(ws + WS_TMP);
#pragma unroll
        for (int ai = 0; ai < 2; ++ai)
#pragma unroll
            for (int m = 0; m < 4; ++m) { const int row = row0 + ai * 128 + m * 16;
#pragma unroll
                for (int bj = 0; bj < 2; ++bj) {
                    const int col = col0 + bj * 128;
                    const u32x4 g = *(const u32x4*)(MAB + (size_t)row * 2048 + col);
                    const f32x4 v0 = acc[ai][bj][m][0], v1 = acc[ai][bj][m][1];
                    f32x4 o0, o1;
                    o0[0] = v0[0] * sigmoidf_(bflo(g.x)); o0[1] = v0[1] * sigmoidf_(bfhi(g.x)); o0[2] = v0[2] * sigmoidf_(bflo(g.y)); o0[3] = v0[3] * sigmoidf_(bfhi(g.y));
                    o1[0] = v1[0] * sigmoidf_(bflo(g.z)); o1[1] = v1[1] * sigmoidf_(bfhi(g.z)); o1[2] = v1[2] * sigmoidf_(bflo(g.w)); o1[3] = v1[3] * sigmoidf_(bfhi(g.w));
                    float* p = TMP + (size_t)row * 1024 + col;
                    *(f32x4*)p = o0; *(f32x4*)(p + 4) = o1;
                } }
    }
};
struct EpiUp2 {
    static constexpr bool PERM = true;
    unsigned char* ws;
    __device__ __forceinline__ void operator()(const f32x4 (&acc)[2][2][4][2], const pg8::Unit& u, int wr, int wc, int fr, int fq) const {
        const int row0 = u.pm * 256 + wr * 64 + fr, col0 = u.pn * 256 + wc * 32 + 8 * fq;
        const bf16_t* MAB = (const bf16_t*)(ws + WS_MAB); const float* TMP = (const float*)(ws + WS_TMP); bf16_t* MG = (bf16_t*)(ws + WS_MERGED);
#pragma unroll
        for (int ai = 0; ai < 2; ++ai)
#pragma unroll
            for (int m = 0; m < 4; ++m) { const int row = row0 + ai * 128 + m * 16;
#pragma unroll
                for (int bj = 0; bj < 2; ++bj) {
                    const int col = col0 + bj * 128;
                    const u32x4 g = *(const u32x4*)(MAB + (size_t)row * 2048 + 1024 + col);
                    const float* p = TMP + (size_t)row * 1024 + col;
                    const f32x4 t0 = *(const f32x4*)p, t1 = *(const f32x4*)(p + 4);
                    const f32x4 v0 = acc[ai][bj][m][0], v1 = acc[ai][bj][m][1];
                    u32x4 w;
                    w.x = pk2(t0[0] + v0[0] * sigmoidf_(bflo(g.x)), t0[1] + v0[1] * sigmoidf_(bfhi(g.x)));
                    w.y = pk2(t0[2] + v0[2] * sigmoidf_(bflo(g.y)), t0[3] + v0[3] * sigmoidf_(bfhi(g.y)));
                    w.z = pk2(t1[0] + v1[0] * sigmoidf_(bflo(g.z)), t1[1] + v1[1] * sigmoidf_(bfhi(g.z)));
                    w.w = pk2(t1[2] + v1[2] * sigmoidf_(bflo(g.w)), t1[3] + v1[3] * sigmoidf_(bfhi(g.w)));
                    *(u32x4*)(MG + (size_t)row * 1024 + col) = w;
                } }
    }
};
struct EpiOut {
    static constexpr bool PERM = false;
    const float* x; float* h;
    __device__ __forceinline__ void operator()(const f32x4 (&acc)[2][2][4][2], const pg8::Unit& u, int wr, int wc, int fr, int fq) const {
        const int row0 = u.pm * 256 + wr * 64 + fr, col0 = u.pn * 256 + wc * 32 + 4 * fq;
#pragma unroll
        for (int ai = 0; ai < 2; ++ai)
#pragma unroll
            for (int m = 0; m < 4; ++m) { const size_t off = (size_t)(row0 + ai * 128 + m * 16) * 1024 + col0;
#pragma unroll
                for (int bj = 0; bj < 2; ++bj)
#pragma unroll
                    for (int n = 0; n < 2; ++n) *(f32x4*)(h + off + bj * 128 + n * 16) = *(const f32x4*)(x + off + bj * 128 + n * 16) + acc[ai][bj][m][n]; }
    }
};

__device__ __forceinline__ void router_rows8(Frame& F, int m0) {
    const int lane = F.lane;
    const float* h = (const float*)F.out;
    f32x4 v[8][4];
    f32x4 wv[4];
#pragma unroll
    for (int j = 0; j < 4; ++j) wv[j] = *(const f32x4*)(F.in[I_NFW] + 4 * lane + 256 * j);
#pragma unroll
    for (int r = 0; r < 8; ++r) {
        const f32x4* xr = (const f32x4*)(h + (size_t)(m0 + r) * DM) + lane;
        float s = 0.f;
#pragma unroll
        for (int j = 0; j < 4; ++j) { v[r][j] = xr[64 * j]; s += (v[r][j].x * v[r][j].x + v[r][j].y * v[r][j].y) + (v[r][j].z * v[r][j].z + v[r][j].w * v[r][j].w); }
        const float rstd = 1.0f / sqrtf(wave_sum(s) * (1.f / DM) + EPS);
        unsigned long long* o8 = (unsigned long long*)((bf16_t*)(F.ws + WS_XN) + (size_t)(m0 + r) * DM) + lane;
#pragma unroll
        for (int j = 0; j < 4; ++j) { v[r][j] = v[r][j] * rstd * wv[j];
            o8[64 * j] = (unsigned long long)pk2(v[r][j].x, v[r][j].y) | ((unsigned long long)pk2(v[r][j].z, v[r][j].w) << 32); }
    }
    float lg[8];
#pragma unroll
    for (int r = 0; r < 8; ++r) lg[r] = 0.f;
    const float* wrt = (const float*)(F.ws + WS_WRT);
#pragma unroll 1
    for (int o = 0; o < 36; ++o) {
        f32x4 w[4];
#pragma unroll
        for (int j = 0; j < 4; ++j) w[j] = *(const f32x4*)(wrt + o * DM + 4 * lane + 256 * j);
#pragma unroll
        for (int r = 0; r < 8; ++r) {
            float s = 0.f;
#pragma unroll
            for (int j = 0; j < 4; ++j) s += (v[r][j].x * w[j].x + v[r][j].y * w[j].y) + (v[r][j].z * w[j].z + v[r][j].w * w[j].w);
            s = wave_sum(s);
            if (lane == o) lg[r] = s;
        }
    }
    const float bias = lane < 4 ? F.in[I_BGRP][lane] : (lane < 36 ? F.in[I_BEXP][lane - 4] : 0.f);
    int* LTOK = (int*)(F.ws + WS_LTOK); int* LDST = (int*)(F.ws + WS_LDST); float* LW = (float*)(F.ws + WS_LW);
    unsigned* cnt = (unsigned*)(F.ws + WS_CTL) + CW_CNT;
#pragma unroll
    for (int r = 0; r < 8; ++r) {
        const float l = lg[r] + bias;
        const float g0 = __shfl(l, 0), g1 = __shfl(l, 1), g2 = __shfl(l, 2), g3 = __shfl(l, 3);
        int gi = 0; float gm = g0;
        if (g1 > gm) { gm = g1; gi = 1; } if (g2 > gm) { gm = g2; gi = 2; } if (g3 > gm) { gm = g3; gi = 3; }
        const float gp = 1.0f / (__expf(g0 - gm) + __expf(g1 - gm) + __expf(g2 - gm) + __expf(g3 - gm));
        float ev[8];
#pragma unroll
        for (int i = 0; i < 8; ++i) ev[i] = __shfl(l, 4 + gi * 8 + i);
        int i0 = 0; float v0 = ev[0];
#pragma unroll
        for (int i = 1; i < 8; ++i) if (ev[i] > v0) { v0 = ev[i]; i0 = i; }
        int i1 = -1; float v1 = -3.0e38f;
#pragma unroll
        for (int i = 0; i < 8; ++i) if (i != i0 && ev[i] > v1) { v1 = ev[i]; i1 = i; }
        const float w0 = gp / (1.0f + __expf(v1 - v0)), w1 = gp / (1.0f + __expf(v0 - v1));
        if (lane < 2) {
            const int e = gi * 8 + (lane == 0 ? i0 : i1);
            const unsigned pos = __hip_atomic_fetch_add(cnt + e, 1u, __ATOMIC_RELAXED, __HIP_MEMORY_SCOPE_AGENT);
            LTOK[e * 16384 + pos] = m0 + r; LDST[e * 16384 + pos] = 2 * (m0 + r) + lane; LW[e * 16384 + pos] = lane == 0 ? w0 : w1;
        }
    }
}
__device__ __forceinline__ void p7_router(Frame& F) {
    const int gw = F.vcu * NWAVES + F.wave, NGW = F.G * NWAVES;
    for (int t = gw; t < M / 8; t += NGW) router_rows8(F, t * 8);
    LAS float* scr = (LAS float*)(F.lds + F.wave * 16384);
    constexpr int IG = 16 * 16, ID = 8 * 32, IPE = 2 * IG + ID;
    for (int it = gw; it < NE * IPE; it += NGW) {
        const int e = it / IPE; int r = it % IPE;
        if (r < 2 * IG) { const int up = r >= IG; if (up) r -= IG; const int nb = r % 16, kb = r / 16, n0 = nb * 32;
            const float* W = (up ? F.in[I_WUP] : F.in[I_WGATE]) + (size_t)e * 1024 * 512;
            transpose_item(W, 512, n0, (bf16_t*)(F.ws + WS_WGU) + (size_t)e * 1024 * 1024, 1024, (n0 >> 7) * 256 + (up ? 128 : 0) + (n0 & 127), kb * 64, scr, F.lane);
        } else { r -= 2 * IG; const int nb = r % 32, kb = r / 32;
            transpose_item(F.in[I_WDOWN] + (size_t)e * 512 * 1024, 1024, nb * 32, (bf16_t*)(F.ws + WS_WD) + (size_t)e * 1024 * 512, 512, nb * 32, kb * 64, scr, F.lane); }
    }
}

constexpr int TOFF_OFF = MISC_OFF + 512;
struct MoeProb {
    const LAS int* toff; const unsigned* cnt; const int* ltok;
    const bf16_t* A; const bf16_t* Bt; int K; int G, c; int total;
    __device__ __forceinline__ bool next(int i, pg8::Unit& u) const {
        const int L = i * G + c; if (L >= total) return false;
        const int tile = L >> 2; int e = 0;
#pragma unroll 1
        for (int s = 16; s > 0; s >>= 1) if (toff[e + s] <= tile) e += s;
        u.e = e; u.pm = tile - toff[e]; u.pn = L & 3; u.base = tile * 256;
        const int c_e = (int)cnt[e]; const int rem = c_e - u.pm * 256; u.rows = rem < 256 ? rem : 256;
        return true;
    }
    __device__ __forceinline__ int a_row(const pg8::Unit& u, int r) const { return ltok[u.e * 16384 + u.pm * 256 + (r < u.rows ? r : 0)]; }
    __device__ __forceinline__ const char* a_ptr(const pg8::Unit& u) const { return (const char*)A; }
    __device__ __forceinline__ const char* a_ptr_rows(const pg8::Unit& u) const { return (const char*)A + (size_t)u.base * K * 2; }
    __device__ __forceinline__ const char* b_ptr(const pg8::Unit& u) const { return (const char*)Bt + ((size_t)u.e * 1024 + u.pn * 256) * K * 2; }
};
struct MoeProbD : MoeProb { __device__ __forceinline__ const char* a_ptr(const pg8::Unit& u) const { return a_ptr_rows(u); } };
struct EpiGU {
    static constexpr bool PERM = true;
    bf16_t* hid;
    __device__ __forceinline__ void operator()(const f32x4 (&acc)[2][2][4][2], const pg8::Unit& u, int wr, int wc, int fr, int fq) const {
        const int col0 = u.pn * 128 + wc * 32 + 8 * fq;
#pragma unroll
        for (int ai = 0; ai < 2; ++ai)
#pragma unroll
            for (int m = 0; m < 4; ++m) { const int r = ai * 128 + wr * 64 + m * 16 + fr;
                const f32x4 g0 = acc[ai][0][m][0], g1 = acc[ai][0][m][1], u0 = acc[ai][1][m][0], u1 = acc[ai][1][m][1];
                u32x4 w;
                w.x = pk2(siluf_(g0[0]) * u0[0], siluf_(g0[1]) * u0[1]); w.y = pk2(siluf_(g0[2]) * u0[2], siluf_(g0[3]) * u0[3]);
                w.z = pk2(siluf_(g1[0]) * u1[0], siluf_(g1[1]) * u1[1]); w.w = pk2(siluf_(g1[2]) * u1[2], siluf_(g1[3]) * u1[3]);
                *(u32x4*)(hid + (size_t)(u.base + r) * 512 + col0) = w; }
    }
};
struct EpiDown {
    static constexpr bool PERM = true;
    bf16_t* y2; const int* ldst; const float* lw;
    __device__ __forceinline__ void operator()(const f32x4 (&acc)[2][2][4][2], const pg8::Unit& u, int wr, int wc, int fr, int fq) const {
        const int col0 = u.pn * 256 + wc * 32 + 8 * fq;
#pragma unroll
        for (int ai = 0; ai < 2; ++ai)
#pragma unroll
            for (int m = 0; m < 4; ++m) { const int r = ai * 128 + wr * 64 + m * 16 + fr;
                if (r < u.rows) {
                    const int li = u.e * 16384 + u.pm * 256 + r; const int dst = ldst[li]; const float cw = lw[li];
#pragma unroll
                    for (int bj = 0; bj < 2; ++bj) { const f32x4 v0 = acc[ai][bj][m][0] * cw, v1 = acc[ai][bj][m][1] * cw;
                        u32x4 w; w.x = pk2(v0[0], v0[1]); w.y = pk2(v0[2], v0[3]); w.z = pk2(v1[0], v1[1]); w.w = pk2(v1[2], v1[3]);
                        *(u32x4*)(y2 + (size_t)dst * 1024 + col0 + bj * 128) = w; }
                } }
    }
};
__device__ __forceinline__ void moe_toff(Frame& F) {
    LAS int* toff = (LAS int*)(F.lds + TOFF_OFF);
    __syncthreads();
    if (F.tid == 0) { const unsigned* cnt = (const unsigned*)(F.ws + WS_CTL) + CW_CNT; int a = 0;
        for (int e = 0; e < NE; ++e) { toff[e] = a; a += ((int)cnt[e] + 255) >> 8; } toff[NE] = a; }
    __syncthreads();
}

__device__ __forceinline__ void final_row(Frame& F, int m) {
    const int lane = F.lane;
    float* hr = F.out + (size_t)m * DM;
    const bf16_t* y0 = (const bf16_t*)(F.ws + WS_Y2) + (size_t)(2 * m) * DM; const bf16_t* y1 = y0 + DM;
    f32x4 v[4]; float s = 0.f;
#pragma unroll
    for (int j = 0; j < 4; ++j) {
        v[j] = *(const f32x4*)(hr + 4 * lane + 256 * j);
        const u32x2 a = *(const u32x2*)(y0 + 4 * lane + 256 * j), b = *(const u32x2*)(y1 + 4 * lane + 256 * j);
        v[j][0] += bflo(a.x) + bflo(b.x); v[j][1] += bfhi(a.x) + bfhi(b.x); v[j][2] += bflo(a.y) + bflo(b.y); v[j][3] += bfhi(a.y) + bfhi(b.y);
        s += (v[j].x * v[j].x + v[j].y * v[j].y) + (v[j].z * v[j].z + v[j].w * v[j].w);
    }
    const float rstd = 1.0f / sqrtf(wave_sum(s) * (1.f / DM) + EPS);
#pragma unroll
    for (int j = 0; j < 4; ++j) { const f32x4 w = *(const f32x4*)(F.in[I_NFINW] + 4 * lane + 256 * j); *(f32x4*)(hr + 4 * lane + 256 * j) = v[j] * rstd * w; }
}

struct Args { const float* in[19]; float* out; unsigned char* ws; int ph_lo, ph_hi; };
__global__ void __launch_bounds__(NTHR, 2) hgrh_fwd(Args args) {
    extern __shared__ __attribute__((aligned(16))) unsigned char lds_raw[];
    Frame F;
    F.lds = (LAS unsigned char*)lds_raw;
    F.MISC = (volatile LAS unsigned*)(F.lds + MISC_OFF);
    F.tid = threadIdx.x; F.lane = F.tid & 63; F.wave = __builtin_amdgcn_readfirstlane(F.tid >> 6);
    F.G = gridDim.x; { const int bx = blockIdx.x; F.vcu = (F.G % 8 == 0) ? (bx % 8) * (F.G / 8) + bx / 8 : bx; }
#pragma unroll
    for (int i = 0; i < 19; ++i) F.in[i] = args.in[i];
    F.out = args.out; F.ws = args.ws;
    F.ctl = (GAS unsigned*)(args.ws + WS_CTL);
    for (int u = F.tid; u < (LDS_BYTES - MISC_OFF) / 4; u += NTHR) ((LAS unsigned*)(F.lds + MISC_OFF))[u] = 0u;
    __syncthreads();
    const int lo = args.ph_lo, hi = args.ph_hi;
    XcdBarrier bar; bar.bar = (unsigned*)(args.ws + WS_CTL) + CW_BAR; bar.x = 0; bar.st = nullptr;
    if (hi - lo > 1) bar = xcd_barrier_post((unsigned*)(args.ws + WS_CTL) + CW_BAR, F.MISC + 8);
#ifndef PH_MASK
#define PH_MASK 0xFFFF
#endif
#define IN(k) (((PH_MASK >> (k)) & 1) && lo <= (k) && (k) < hi)
#define SEAM(k) do { if (IN(k) && IN((k) + 1)) xcd_barrier(bar); } while (0)
    const int gw = F.vcu * NWAVES + F.wave, NGW = F.G * NWAVES;

    if (IN(0)) { p0_prologue(F); }
    SEAM(0);
    if (IN(1)) {
        pg8::Dense P; P.init((const bf16_t*)(F.ws + WS_U), (const bf16_t*)(F.ws + WS_WINT), M, NP, DM, F.G, (int)blockIdx.x);
        EpiProj E{F.ws};
        pg8::gemm_phase<EpiProj, pg8::Dense, false, true, true>(F.lds, P, E);
    }
    SEAM(1);
    if (IN(2)) {
        for (int it = F.vcu; it < 1024 + 512; it += F.G) { if (it < 1024) gdn_prep_item(F, it); else ret_kv_item(F, it - 1024); }
    }
    SEAM(2);
    if (IN(3)) {
        if (F.wave == 0) { for (int ch = F.vcu; ch < 256; ch += F.G) gdn_scan_chain(F, ch); }
        else { for (int t = F.vcu * 7 + (F.wave - 1); t < 2048; t += F.G * 7) ret_prefix_task(F, t); }
    }
    SEAM(3);
    if (IN(4)) {
        for (int it = F.vcu; it < 512; it += F.G) ret_out_item(F, it);
        for (int m = gw; m < M; m += NGW) gdn_normgate_row(F, m);
    }
    SEAM(4);
    if (IN(5)) {
        { pg8::Dense P; P.init((const bf16_t*)((unsigned char*)F.out + DO_YA), (const bf16_t*)(F.ws + WS_WUPA), M, DM, 512, F.G, (int)blockIdx.x);
          EpiUp1 E{F.ws}; pg8::gemm_phase<EpiUp1, pg8::Dense, false, false, true>(F.lds, P, E); }
        { pg8::Dense P; P.init((const bf16_t*)((unsigned char*)F.out + DO_YB), (const bf16_t*)(F.ws + WS_WUPR), M, DM, 1024, F.G, (int)blockIdx.x);
          EpiUp2 E{F.ws}; pg8::gemm_phase<EpiUp2, pg8::Dense, false, false, true>(F.lds, P, E); }
    }
    SEAM(5);
    if (IN(6)) {
        pg8::Dense P; P.init((const bf16_t*)(F.ws + WS_MERGED), (const bf16_t*)(F.ws + WS_WOUT), M, DM, DM, F.G, (int)blockIdx.x);
        EpiOut E{F.in[I_X], F.out}; pg8::gemm_phase<EpiOut, pg8::Dense, false, false, true>(F.lds, P, E);
    }
    SEAM(6);
    if (IN(7)) { p7_router(F); }
    SEAM(7);
    if (IN(8)) {
        moe_toff(F);
        MoeProb P; P.toff = (const LAS int*)(F.lds + TOFF_OFF); P.cnt = (const unsigned*)(F.ws + WS_CTL) + CW_CNT; P.ltok = (const int*)(F.ws + WS_LTOK);
        P.A = (const bf16_t*)(F.ws + WS_XN); P.Bt = (const bf16_t*)(F.ws + WS_WGU); P.K = 1024; P.G = F.G; P.c = F.vcu; P.total = 4 * P.toff[NE];
        EpiGU E{(bf16_t*)(F.ws + WS_HID)};
        pg8::gemm_phase<EpiGU, MoeProb, true, true, true>(F.lds, P, E);
    }
    SEAM(8);
    if (IN(9)) {
        moe_toff(F);
        MoeProbD P; P.toff = (const LAS int*)(F.lds + TOFF_OFF); P.cnt = (const unsigned*)(F.ws + WS_CTL) + CW_CNT; P.ltok = (const int*)(F.ws + WS_LTOK);
        P.A = (const bf16_t*)(F.ws + WS_HID); P.Bt = (const bf16_t*)(F.ws + WS_WD); P.K = 512; P.G = F.G; P.c = F.vcu; P.total = 4 * P.toff[NE];
        EpiDown E{(bf16_t*)(F.ws + WS_Y2), (const int*)(F.ws + WS_LDST), (const float*)(F.ws + WS_LW)};
        pg8::gemm_phase<EpiDown, MoeProbD, false, true, true>(F.lds, P, E);
    }
    SEAM(9);
    if (IN(10)) { for (int m = gw; m < M; m += NGW) final_row(F, m); }
#undef IN
#undef SEAM
}

extern "C" void kernel_launch(void* const* d_in, const int* in_sizes, int n_in, void* d_out, int out_size, void* d_ws, size_t ws_size, hipStream_t stream) {
    static int grid = 0;
    if (grid == 0) {
        if (n_in != 19 || in_sizes[0] != M * DM || out_size != M * DM || ws_size < WS_END) {
            fprintf(stderr, "kernel_launch: unexpected problem (n_in %d, in0 %d, out %d, ws %zu < %zu); nothing launched\n", n_in, n_in > 0 ? in_sizes[0] : -1, out_size, ws_size, (size_t)WS_END); grid = -1; return; }
        int dev = 0, cus = 0;
        if (hipGetDevice(&dev) != hipSuccess || hipDeviceGetAttribute(&cus, hipDeviceAttributeMultiprocessorCount, dev) != hipSuccess) { grid = -1; return; }
        if (hipFuncSetAttribute((const void*)hgrh_fwd, hipFuncAttributeMaxDynamicSharedMemorySize, LDS_BYTES) != hipSuccess) { fprintf(stderr, "kernel_launch: hipFuncSetAttribute failed\n"); grid = -1; return; }
        int per_cu = 0;
        if (hipOccupancyMaxActiveBlocksPerMultiprocessor(&per_cu, (const void*)hgrh_fwd, NTHR, LDS_BYTES) != hipSuccess || per_cu < 1)
            fprintf(stderr, "kernel_launch: occupancy query reports %d workgroups per CU\n", per_cu);
        (void)hipGetLastError();
        grid = cus;
    }
    if (grid < 0) return;
    (void)hipMemsetAsync((char*)d_ws + WS_CTL, 0, CTL_ZERO_BYTES, stream);
    Args a{};
    for (int i = 0; i < 19; ++i) a.in[i] = (const float*)d_in[i];
    a.out = (float*)d_out; a.ws = (unsigned char*)d_ws;
#if MK_N_LAUNCHES == 1
    a.ph_lo = 0; a.ph_hi = NPH;
    hipLaunchKernelGGL(hgrh_fwd, dim3(grid), dim3(NTHR), LDS_BYTES, stream, a);
#else
    for (int p = 0; p < NPH; ++p) { a.ph_lo = p; a.ph_hi = p + 1; hipLaunchKernelGGL(hgrh_fwd, dim3(grid), dim3(NTHR), LDS_BYTES, stream, a); }
#endif
}
```

```cpp
#include <hip/hip_runtime.h>
#include <cstdio>
#include <cstdint>

#ifndef MK_N_LAUNCHES
#define MK_N_LAUNCHES 1
#endif

#define LAS __attribute__((address_space(3)))
#define GAS __attribute__((address_space(1)))
typedef unsigned short bf16_t;
typedef short bf16x8 __attribute__((ext_vector_type(8)));
typedef short bf16x4 __attribute__((ext_vector_type(4)));
typedef float f32x4 __attribute__((ext_vector_type(4)));
typedef float f32x2 __attribute__((ext_vector_type(2)));
typedef unsigned u32x4 __attribute__((ext_vector_type(4)));
typedef unsigned u32x2 __attribute__((ext_vector_type(2)));

constexpr int BATCH = 8, SEQ = 2048, DM = 1024, M = BATCH * SEQ;
constexpr int D_IN = 7176, NP = 7168;
constexpr int NE = 32, DE = 512;
constexpr float EPS = 1e-6f;
constexpr int NWAVES = 8, NTHR = 512;
constexpr int NPH = 11;

constexpr size_t MiB = 1u << 20;
constexpr size_t WS_CTL = 0, CTL_ZERO_BYTES = 1 * MiB;
constexpr size_t WS_LTOK = 1 * MiB, WS_LDST = 3 * MiB, WS_LW = 5 * MiB;
constexpr size_t WS_ROPE = 7 * MiB;
constexpr size_t WS_G = 8 * MiB, WS_BETA = 8 * MiB + 256 * 1024;
constexpr size_t WS_WUPA = 9 * MiB, WS_WUPR = 10 * MiB, WS_WOUT = 12 * MiB;
constexpr size_t WS_WRT = 14 * MiB;
constexpr size_t WS_SSQ = 15 * MiB;
constexpr size_t WS_GQKV = 18 * MiB;
constexpr size_t WS_OGDN = 18 * MiB;
constexpr size_t WS_XN = 18 * MiB;
constexpr size_t WS_Y2 = 18 * MiB;
constexpr size_t WS_GZ = 66 * MiB;
constexpr size_t WS_RQK = 82 * MiB;
constexpr size_t WS_RV = 114 * MiB;
constexpr size_t WS_TMP = 82 * MiB;
constexpr size_t WS_WGU = 82 * MiB;
constexpr size_t WS_RG = 146 * MiB;
constexpr size_t WS_WD = 146 * MiB;
constexpr size_t WS_MAB = 178 * MiB;
constexpr size_t WS_HID = 178 * MiB;
constexpr size_t WS_U = 242 * MiB;
constexpr size_t WS_KV = 242 * MiB;
constexpr size_t WS_MERGED = 242 * MiB;
constexpr size_t WS_WINT = 274 * MiB;
constexpr size_t WS_ATTN = 274 * MiB;
constexpr size_t WS_END = 288 * MiB;
constexpr size_t DO_WNEG = 0, DO_QG = 16 * MiB, DO_KDT = 32 * MiB, DO_UT = 48 * MiB;
constexpr size_t DO_YA = 0, DO_YB = 16 * MiB;

constexpr int CW_TMO = 0;
constexpr int CW_CNT = 64;
constexpr int CW_BAR = 4096;

constexpr int RING_BYTES = 131072;
constexpr int MISC_OFF = RING_BYTES;
constexpr int LDS_BYTES = 147456;

#define LDS_WAIT() asm volatile("s_waitcnt lgkmcnt(0)" ::: "memory")
#define VM_WAIT() asm volatile("s_waitcnt vmcnt(0)" ::: "memory")
__device__ __forceinline__ unsigned f2bf(float f) { unsigned u = __builtin_bit_cast(unsigned, f); return (u + 0x7fffu + ((u >> 16) & 1u)) >> 16; }
__device__ __forceinline__ unsigned pk2(float lo, float hi) { return f2bf(lo) | (f2bf(hi) << 16); }
__device__ __forceinline__ float bf2f(unsigned short h) { return __builtin_bit_cast(float, (unsigned)h << 16); }
__device__ __forceinline__ float bflo(unsigned w) { return __builtin_bit_cast(float, w << 16); }
__device__ __forceinline__ float bfhi(unsigned w) { return __builtin_bit_cast(float, w & 0xffff0000u); }
__device__ __forceinline__ float wave_sum(float v) {
#pragma unroll
    for (int o = 1; o < 64; o <<= 1) v += __shfl_xor(v, o);
    return v;
}
__device__ __forceinline__ float sigmoidf_(float x) { return 1.0f / (1.0f + __expf(-x)); }
__device__ __forceinline__ float siluf_(float x) { return x / (1.0f + __expf(-x)); }

#define XB_TMO      128
#define XB_XCNT(j)  (256  + 64 * (j))
#define XB_XSUB(j)  (1280 + 64 * (j))
#define XB_XGEN(j)  (2304 + 64 * (j))
#define XB_TOP      3328
#define XB_TOPGEN   3392
#define XCD_BAR_WORDS 3456
#define XB_SPIN_CAP (1u << 18)
__device__ __forceinline__ unsigned xb_ld(unsigned* p)              { return __hip_atomic_load(p, __ATOMIC_RELAXED, __HIP_MEMORY_SCOPE_AGENT); }
__device__ __forceinline__ unsigned xb_add(unsigned* p, unsigned v) { return __hip_atomic_fetch_add(p, v, __ATOMIC_RELAXED, __HIP_MEMORY_SCOPE_AGENT); }
__device__ __forceinline__ unsigned xb_xcc_id() { return (unsigned)__builtin_amdgcn_s_getreg((3 << 11) | 20) & 0xFu; }
#define XB_SPIN(cond, bar) do { unsigned _sp = 0; while (cond) { __builtin_amdgcn_s_sleep(1); \
    if ((++_sp & 255u) == 0u) { if (xb_ld(&(bar)[XB_TMO])) break; if (_sp > XB_SPIN_CAP) { atomicAdd(&(bar)[XB_TMO], 1u); break; } } } } while (0)
struct XcdBarrier { unsigned* bar; unsigned x; volatile LAS unsigned* st; };
__device__ __forceinline__ XcdBarrier xcd_barrier_post(unsigned* bar, volatile LAS unsigned* st) {
    XcdBarrier b; b.bar = bar; b.x = xb_xcc_id(); b.st = st;
    if (threadIdx.x == 0) (void)xb_add(&bar[XB_XCNT(b.x)], 1u);
    return b;
}
__device__ __forceinline__ void xcd_barrier_complete(unsigned* bar, unsigned x, unsigned& nloc, unsigned& nx) {
    const unsigned G = gridDim.x * gridDim.y * gridDim.z;
    unsigned sum, cnt, mine, sp = 0u;
    for (;;) {
        sum = 0u; cnt = 0u; mine = 0u;
#pragma unroll
        for (unsigned j = 0; j < 16; ++j) { const unsigned c = xb_ld(&bar[XB_XCNT(j)]); sum += c; cnt += (c > 0u) ? 1u : 0u; mine = (j == x) ? c : mine; }
        if (sum == G) break;
        __builtin_amdgcn_s_sleep(1);
        if ((++sp & 255u) == 0u) { if (xb_ld(&bar[XB_TMO])) break; if (sp > XB_SPIN_CAP) { atomicAdd(&bar[XB_TMO], 1u); break; } }
    }
    nloc = mine > 0u ? mine : 1u; nx = cnt > 0u ? cnt : 1u;
}
__device__ __forceinline__ void xcd_barrier(const XcdBarrier& b) {
    asm volatile("s_waitcnt vmcnt(0)" ::: "memory");
    __syncthreads();
    if (threadIdx.x == 0) {
        unsigned* bar = b.bar;
        __builtin_amdgcn_s_waitcnt(0);
        unsigned nloc = b.st[0], nx = b.st[1];
        if (nloc == 0u) { xcd_barrier_complete(bar, b.x, nloc, nx); b.st[0] = nloc; b.st[1] = nx; }
        const unsigned old = xb_add(&bar[XB_XSUB(b.x)], 1u);
        const unsigned gen = old / nloc;
        if (old + 1u == (gen + 1u) * nloc) {
            __builtin_amdgcn_fence(__ATOMIC_RELEASE, "agent");
            asm volatile("s_waitcnt vmcnt(0)" ::: "memory");
            const unsigned og = xb_add(&bar[XB_TOP], 1u);
            const unsigned tg = og / nx;
            if (og + 1u == (tg + 1u) * nx) xb_add(&bar[XB_TOPGEN], 1u);
            else XB_SPIN(xb_ld(&bar[XB_TOPGEN]) == tg, bar);
            __builtin_amdgcn_fence(__ATOMIC_ACQUIRE, "agent");
            xb_add(&bar[XB_XGEN(b.x)], 1u);
            asm volatile("s_waitcnt vmcnt(0)" ::: "memory");
        } else {
            XB_SPIN(xb_ld(&bar[XB_XGEN(b.x)]) == gen, bar);
            __builtin_amdgcn_fence(__ATOMIC_ACQUIRE, "agent");
            asm volatile("s_waitcnt vmcnt(0)" ::: "memory");
        }
    }
    __syncthreads();
}

namespace pg8 {
constexpr int BM = 256, BK = 64, HALF = 128, HTB = HALF * BK * 2, STAGE_BYTES = 8 * HTB, NXCD = 8, WGM = 8;
__host__ __device__ __forceinline__ int lds_byte(int r, int c) { const int st = (r >> 4) * 2 + (c >> 5), rr = r & 15, cc = c & 31, ob = rr * 64 + cc * 2; return st * 1024 + (ob ^ (((ob >> 9) & 1) << 5)); }
__host__ __device__ __forceinline__ void stage_rc(int b, int& R, int& C) { const int st = b / 1024, sb = b % 1024, swz = sb ^ (((sb >> 9) & 1) << 5); R = (st >> 1) * 16 + swz / 64; C = (st & 1) * 32 + (swz % 64) / 2; }
__host__ __device__ __forceinline__ int perm32(int rho) { const int n = rho >> 4, i = rho & 15; return 8 * (i >> 2) + 4 * n + (i & 3); }

struct Unit { int pm, pn, e, rows, base; };

__device__ __forceinline__ unsigned cvt_pk_bf16(float lo, float hi) { unsigned r; asm volatile("v_cvt_pk_bf16_f32 %0, %1, %2" : "=v"(r) : "v"(lo), "v"(hi)); return r; }

struct Dense {
    const bf16_t* A; const bf16_t* Bt; int K; int nM, nN, nwg, G, c;
    __device__ void init(const bf16_t* A_, const bf16_t* Bt_, int M_, int N_, int K_, int G_, int c_) { A = A_; Bt = Bt_; K = K_; nM = M_ / BM; nN = N_ / BM; nwg = nM * nN; G = G_; c = c_; }
    __device__ __forceinline__ bool next(int i, Unit& u) const {
        const long L = (long)i * G + c; if (L >= nwg) return false;
        int wgid = (int)L; { const int q = nwg / NXCD, r = nwg % NXCD, xcd = wgid % NXCD, off = wgid / NXCD; wgid = (xcd < r ? xcd * (q + 1) : r * (q + 1) + (xcd - r) * q) + off; }
        const int nig = WGM * nN, gid = wgid / nig, fm = gid * WGM, gsz = (nM - fm) < WGM ? (nM - fm) : WGM;
        u.pm = fm + ((wgid % nig) % gsz); u.pn = (wgid % nig) / gsz; u.e = 0; u.rows = 256; u.base = 0; return true;
    }
    __device__ __forceinline__ const char* a_ptr(const Unit& u) const { return (const char*)A + (size_t)u.pm * (size_t)(2 * HALF) * K * 2; }
    __device__ __forceinline__ const char* b_ptr(const Unit& u) const { return (const char*)Bt + (size_t)u.pn * (size_t)(2 * HALF) * K * 2; }
};

template <class Epi, class Prob, bool GATHER, bool ALIGN_EPI, bool SP2>
__device__ __forceinline__ void gemm_phase(LAS unsigned char* lds, const Prob& S, const Epi& E) {
    const int tid = threadIdx.x, wid = __builtin_amdgcn_readfirstlane(tid >> 6), lane = tid & 63, wr = wid >> 2, wc = wid & 3, fr = lane & 15, fq = lane >> 4;
    const int K = S.K, nt = K / BK;
    unsigned voffB[2]; int RA[2], CA[2];
    unsigned cvo[2][2], nvo[2][2];
#pragma unroll
    for (int i = 0; i < 2; ++i) { int R, C; stage_rc(tid * 16 + i * 8192, R, C); const int Rb = Epi::PERM ? ((R & ~31) + perm32(R & 31)) : R;
        RA[i] = R; CA[i] = C; voffB[i] = (unsigned)(Rb * K + C) * 2u; }
    const size_t kstep = (size_t)(BK * 2);
    const size_t hstep = (size_t)HALF * K * 2;
    const unsigned ldsw = (unsigned)wid * 1024u;
    const int aoff = lds_byte(wr * 64 + fr, fq * 8), boff = lds_byte(wc * 32 + fr, fq * 8);
#define PG8_SA(b, h) (((b) * 2 + (h)) * HTB)
#define PG8_SB(b, h) ((4 + (b) * 2 + (h)) * HTB)
#define PG8_STAGE(bufoff, gbase, voff) do { _Pragma("unroll") for (int _i = 0; _i < 2; ++_i) \
        __builtin_amdgcn_global_load_lds((const unsigned*)((const char*)(gbase) + (voff)[_i]), (LAS unsigned*)(lds + (bufoff) + ldsw + _i * 8192), 16, 0, 0); } while (0)
#define PG8_LDA(dst, b, h) do { _Pragma("unroll") for (int m = 0; m < 4; ++m) _Pragma("unroll") for (int k = 0; k < 2; ++k) dst[m][k] = *(const LAS bf16x8*)(lds + PG8_SA(b, h) + aoff + m * 2048 + k * 1024); } while (0)
#define PG8_LDB(dst, b, h) do { _Pragma("unroll") for (int n = 0; n < 2; ++n) _Pragma("unroll") for (int k = 0; k < 2; ++k) dst[n][k] = *(const LAS bf16x8*)(lds + PG8_SB(b, h) + boff + n * 2048 + k * 1024); } while (0)
#define PG8_MMA(ai, bj, At, Bt) do { __builtin_amdgcn_s_setprio(1); _Pragma("unroll") for (int m = 0; m < 4; ++m) _Pragma("unroll") for (int n = 0; n < 2; ++n) _Pragma("unroll") for (int k = 0; k < 2; ++k) \
        acc[ai][bj][m][n] = __builtin_amdgcn_mfma_f32_16x16x32_bf16(Bt[n][k], At[m][k], acc[ai][bj][m][n], 0, 0, 0); __builtin_amdgcn_s_setprio(0); } while (0)
#define PG8_WAIT_V(n) asm volatile("s_waitcnt vmcnt(" #n ")" ::: "memory")
#define PG8_WAIT_L(n) asm volatile("s_waitcnt lgkmcnt(" #n ")" ::: "memory")
#define PG8_BAR __builtin_amdgcn_s_barrier()
#define PG8_SCHED __builtin_amdgcn_sched_barrier(0)
    Unit cur, nxt; int ui = 0;
    if (!S.next(0, cur)) return;
    f32x4 acc[2][2][4][2];
#pragma unroll
    for (int a = 0; a < 2; ++a)
#pragma unroll
        for (int b = 0; b < 2; ++b)
#pragma unroll
            for (int m = 0; m < 4; ++m)
#pragma unroll
                for (int n = 0; n < 2; ++n) acc[a][b][m][n] = (f32x4){0.f, 0.f, 0.f, 0.f};
    bf16x8 At[4][2], B0[2][2], B1[2][2];
    const char* cA = S.a_ptr(cur); const char* cB = S.b_ptr(cur);
#pragma unroll
    for (int h = 0; h < 2; ++h)
#pragma unroll
        for (int i = 0; i < 2; ++i) {
            if constexpr (GATHER) cvo[h][i] = (unsigned)(((size_t)S.a_row(cur, h * HALF + RA[i]) * K + CA[i]) * 2u);
            else cvo[h][i] = (unsigned)((RA[i] * K + CA[i]) * 2u + h * hstep);
            nvo[h][i] = cvo[h][i];
        }
    if constexpr (SP2) {
        PG8_STAGE(PG8_SB(0, 0), cB, voffB); PG8_STAGE(PG8_SB(0, 1), cB + hstep, voffB); PG8_STAGE(PG8_SA(0, 0), cA, cvo[0]); PG8_STAGE(PG8_SA(0, 1), cA, cvo[1]);
        if (wr == 1) PG8_BAR;
        PG8_WAIT_V(2); PG8_BAR;
        PG8_STAGE(PG8_SB(1, 0), cB + kstep, voffB); PG8_STAGE(PG8_SA(1, 0), cA + kstep, cvo[0]); PG8_STAGE(PG8_SB(1, 1), cB + hstep + kstep, voffB);
        PG8_WAIT_V(6); PG8_BAR;
    } else {
        PG8_STAGE(PG8_SB(0, 0), cB, voffB); PG8_STAGE(PG8_SA(0, 0), cA, cvo[0]); PG8_STAGE(PG8_SB(0, 1), cB + hstep, voffB); PG8_STAGE(PG8_SA(0, 1), cA, cvo[1]);
        if (wr == 1) PG8_BAR;
        PG8_WAIT_V(4); PG8_BAR;
        PG8_STAGE(PG8_SB(1, 0), cB + kstep, voffB); PG8_STAGE(PG8_SA(1, 0), cA + kstep, cvo[0]); PG8_STAGE(PG8_SB(1, 1), cB + hstep + kstep, voffB);
        PG8_WAIT_V(6); PG8_BAR;
    }
    for (;;) {
        const bool has_next = S.next(ui + 1, nxt);
        const char* nA = has_next ? S.a_ptr(nxt) : cA; const char* nB = has_next ? S.b_ptr(nxt) : cB;
        if constexpr (GATHER) {
#pragma unroll
            for (int h = 0; h < 2; ++h)
#pragma unroll
                for (int i = 0; i < 2; ++i) nvo[h][i] = has_next ? (unsigned)(((size_t)S.a_row(nxt, h * HALF + RA[i]) * K + CA[i]) * 2u) : cvo[h][i];
        }
        for (int t = 0; t < nt; t += 2) {
            const bool last = (t == nt - 2);
            const char* a1 = cA + (size_t)(t + 1) * kstep;
            const char* a2 = last ? nA : cA + (size_t)(t + 2) * kstep; const char* b2 = last ? nB : cB + (size_t)(t + 2) * kstep;
            const char* a3 = a2 + kstep; const char* b3 = b2 + kstep;
            unsigned v2[2][2];
#pragma unroll
            for (int h = 0; h < 2; ++h)
#pragma unroll
                for (int i = 0; i < 2; ++i) v2[h][i] = (GATHER && last) ? nvo[h][i] : cvo[h][i];
            if constexpr (SP2) {
            PG8_LDB(B0, 0, 0); PG8_LDB(B1, 0, 1); PG8_SCHED; PG8_LDA(At, 0, 0); PG8_STAGE(PG8_SA(1, 1), a1, cvo[1]);
            PG8_WAIT_V(8); PG8_WAIT_L(0); PG8_BAR; PG8_MMA(0, 0, At, B0); PG8_MMA(0, 1, At, B1); PG8_BAR; PG8_SCHED;
            PG8_LDA(At, 0, 1); PG8_STAGE(PG8_SB(0, 0), b2, voffB); PG8_STAGE(PG8_SB(0, 1), b2 + hstep, voffB); PG8_STAGE(PG8_SA(0, 0), a2, v2[0]);
            PG8_WAIT_V(8); PG8_WAIT_L(0); PG8_BAR; PG8_MMA(1, 0, At, B0); PG8_MMA(1, 1, At, B1); PG8_BAR; PG8_SCHED;
            PG8_LDB(B0, 1, 0); PG8_LDB(B1, 1, 1); PG8_SCHED; PG8_LDA(At, 1, 0); PG8_STAGE(PG8_SA(0, 1), a2, v2[1]);
            PG8_WAIT_V(8); PG8_WAIT_L(0); PG8_BAR; PG8_MMA(0, 0, At, B0); PG8_MMA(0, 1, At, B1); PG8_BAR; PG8_SCHED;
            PG8_LDA(At, 1, 1); PG8_STAGE(PG8_SB(1, 0), b3, voffB); PG8_STAGE(PG8_SB(1, 1), b3 + hstep, voffB); PG8_STAGE(PG8_SA(1, 0), a3, v2[0]);
            PG8_WAIT_V(8); PG8_WAIT_L(0); PG8_BAR; PG8_MMA(1, 0, At, B0); PG8_MMA(1, 1, At, B1); PG8_BAR; PG8_SCHED;
            } else {
            PG8_LDB(B0, 0, 0); PG8_SCHED; PG8_LDA(At, 0, 0); PG8_STAGE(PG8_SA(1, 1), a1, cvo[1]);
            PG8_WAIT_L(8); PG8_BAR; PG8_WAIT_L(0); PG8_MMA(0, 0, At, B0); PG8_BAR; PG8_SCHED;
            PG8_LDB(B1, 0, 1); PG8_STAGE(PG8_SB(0, 0), b2, voffB);
            PG8_BAR; PG8_WAIT_L(0); PG8_MMA(0, 1, At, B1); PG8_BAR;
            PG8_LDA(At, 0, 1); PG8_STAGE(PG8_SA(0, 0), a2, v2[0]);
            PG8_BAR; PG8_WAIT_L(0); PG8_MMA(1, 0, At, B0); PG8_BAR; PG8_SCHED;
            PG8_STAGE(PG8_SB(0, 1), b2 + hstep, voffB);
            PG8_WAIT_V(6); PG8_BAR; PG8_MMA(1, 1, At, B1); PG8_BAR;
            PG8_LDB(B0, 1, 0); PG8_SCHED; PG8_LDA(At, 1, 0); PG8_STAGE(PG8_SA(0, 1), a2, v2[1]);
            PG8_WAIT_L(8); PG8_BAR; PG8_WAIT_L(0); PG8_MMA(0, 0, At, B0); PG8_BAR; PG8_SCHED;
            PG8_LDB(B1, 1, 1); PG8_STAGE(PG8_SB(1, 0), b3, voffB);
            PG8_BAR; PG8_WAIT_L(0); PG8_MMA(0, 1, At, B1); PG8_BAR;
            PG8_LDA(At, 1, 1); PG8_STAGE(PG8_SA(1, 0), a3, v2[0]);
            PG8_BAR; PG8_WAIT_L(0); PG8_MMA(1, 0, At, B0); PG8_BAR; PG8_SCHED;
            PG8_STAGE(PG8_SB(1, 1), b3 + hstep, voffB);
            PG8_WAIT_V(6); PG8_BAR; PG8_MMA(1, 1, At, B1); PG8_BAR;
            }
        }
        if constexpr (ALIGN_EPI) { if (wr == 0) PG8_BAR; }
        E(acc, cur, wr, wc, fr, fq);
        if (!has_next) break;
#pragma unroll
        for (int a = 0; a < 2; ++a)
#pragma unroll
            for (int b = 0; b < 2; ++b)
#pragma unroll
                for (int m = 0; m < 4; ++m)
#pragma unroll
                    for (int n = 0; n < 2; ++n) acc[a][b][m][n] = (f32x4){0.f, 0.f, 0.f, 0.f};
        cur = nxt; cA = nA; cB = nB; ++ui;
#pragma unroll
        for (int h = 0; h < 2; ++h)
#pragma unroll
            for (int i = 0; i < 2; ++i) cvo[h][i] = nvo[h][i];
        if constexpr (ALIGN_EPI) { if (wr == 1) PG8_BAR; }
    }
    PG8_WAIT_V(0);
    if constexpr (!ALIGN_EPI) { if (wr == 0) PG8_BAR; }
    PG8_BAR;
#undef PG8_SA
#undef PG8_SB
#undef PG8_STAGE
#undef PG8_LDA
#undef PG8_LDB
#undef PG8_MMA
#undef PG8_WAIT_V
#undef PG8_WAIT_L
#undef PG8_BAR
#undef PG8_SCHED
}
}

struct Frame {
    LAS unsigned char* lds;
    volatile LAS unsigned* MISC;
    GAS unsigned* ctl;
    int tid, lane, wave;
    int vcu, G;
    const float* in[19];
    float* out; unsigned char* ws;
};
enum { I_X = 0, I_NMW, I_WIN, I_CONVW, I_ALOG, I_DTB, I_GNW, I_WUPG, I_WUPR, I_WOUT, I_NFW, I_WGRP, I_BGRP, I_WEXP, I_BEXP, I_WGATE, I_WUP, I_WDOWN, I_NFINW };

__device__ __forceinline__ void transpose_item(const float* W, int ldw, int col0, bf16_t* WT, int K, int row0, int k0, LAS float* scr, int lane) {
#pragma unroll 8
    for (int i = 0; i < 32; ++i) { const int kk = 2 * i + (lane >> 5); scr[kk * 33 + (lane & 31)] = W[(size_t)(k0 + kk) * ldw + col0 + (lane & 31)]; }
    LDS_WAIT(); asm volatile("" ::: "memory");
    const int c = lane & 7;
#pragma unroll
    for (int j = 0; j < 4; ++j) { const int n = (lane >> 3) + 8 * j; const LAS float* s = scr + (8 * c) * 33 + n;
        u32x4 o; o.x = pk2(s[0 * 33], s[1 * 33]); o.y = pk2(s[2 * 33], s[3 * 33]); o.z = pk2(s[4 * 33], s[5 * 33]); o.w = pk2(s[6 * 33], s[7 * 33]);
        *(GAS u32x4*)(WT + (size_t)(row0 + n) * K + k0 + 8 * c) = o; }
    LDS_WAIT(); asm volatile("" ::: "memory");
}

__device__ __forceinline__ void p0_prologue(Frame& F) {
    LAS float* scr = (LAS float*)(F.lds + F.wave * 16384);
    const int gw = F.vcu * NWAVES + F.wave, NGW = F.G * NWAVES;
    unsigned char* ws = F.ws;
    {
        constexpr int I_IN = (DM / 64) * (NP / 32);
        constexpr int I_UA = (512 / 64) * (DM / 32);
        constexpr int I_UR = (1024 / 64) * (DM / 32);
        constexpr int I_WO = (1024 / 64) * (DM / 32);
        constexpr int NIT = I_IN + I_UA + I_UR + I_WO;
        for (int it = gw; it < NIT; it += NGW) {
            int r = it;
            if (r < I_IN) { const int nb = r % (NP / 32), kb = r / (NP / 32); const int n0 = nb * 32; const int src = n0 + (n0 >= 1536 ? 8 : 0);
                transpose_item(F.in[I_WIN], D_IN, src, (bf16_t*)(ws + WS_WINT), DM, n0, kb * 64, scr, F.lane); continue; } r -= I_IN;
            if (r < I_UA) { const int nb = r % 32, kb = r / 32; transpose_item(F.in[I_WUPG], DM, nb * 32, (bf16_t*)(ws + WS_WUPA), 512, nb * 32, kb * 64, scr, F.lane); continue; } r -= I_UA;
            if (r < I_UR) { const int nb = r % 32, kb = r / 32; transpose_item(F.in[I_WUPR], DM, nb * 32, (bf16_t*)(ws + WS_WUPR), 1024, nb * 32, kb * 64, scr, F.lane); continue; } r -= I_UR;
            { const int nb = r % 32, kb = r / 32; transpose_item(F.in[I_WOUT], DM, nb * 32, (bf16_t*)(ws + WS_WOUT), 1024, nb * 32, kb * 64, scr, F.lane); }
        }
    }
    {
        GAS f32x2* tab = (GAS f32x2*)(ws + WS_ROPE);
        const int gt = (F.vcu * NTHR + F.tid), NGT = F.G * NTHR;
        for (int i = gt; i < SEQ * 64; i += NGT) {
            const int t = i >> 6, p = i & 63;
            const float invf = 1.0f / powf(10000.0f, (float)p * (1.0f / 63.0f));
            const float ang = (float)t * invf;
            float s, c; sincosf(ang, &s, &c);
            tab[i] = (f32x2){c, s};
        }
    }
    {
        GAS float* wrt = (GAS float*)(ws + WS_WRT);
        const int gt = (F.vcu * NTHR + F.tid), NGT = F.G * NTHR;
        for (int i = gt; i < 36 * DM; i += NGT) {
            const int j = i / DM, k = i % DM;
            wrt[i] = j < 4 ? F.in[I_WGRP][k * 4 + j] : F.in[I_WEXP][k * 32 + (j - 4)];
        }
    }
    {
        __syncthreads();
        LAS float* wab2 = (LAS float*)F.lds;
        for (int idx = F.tid; idx < 8192; idx += NTHR) { const int k = idx >> 3, q = idx & 7; const int j = k >> 8, l_ = (k & 255) >> 2, e = k & 3;
            wab2[((j * 4 + e) * 64 + l_) * 8 + q] = F.in[I_WIN][(size_t)k * D_IN + 1536 + q]; }
        __syncthreads();
        const float* nw = F.in[I_NMW];
        f32x4 wv[4];
#pragma unroll
        for (int j = 0; j < 4; ++j) wv[j] = *(const f32x4*)(nw + 4 * F.lane + 256 * j);
        float alog = 0.f, dtb = 0.f;
        if (F.lane < 4) { alog = F.in[I_ALOG][F.lane]; dtb = F.in[I_DTB][F.lane]; }
        for (int m = gw; m < M; m += NGW) {
            const GAS f32x4* xr = (const GAS f32x4*)(F.in[I_X] + (size_t)m * DM) + F.lane;
            f32x4 v[4]; float s = 0.f;
#pragma unroll
            for (int j = 0; j < 4; ++j) { v[j] = xr[64 * j]; s += (v[j].x * v[j].x + v[j].y * v[j].y) + (v[j].z * v[j].z + v[j].w * v[j].w); }
            const float rstd = 1.0f / sqrtf(wave_sum(s) * (1.f / DM) + EPS);
            float ab[8];
#pragma unroll
            for (int q = 0; q < 8; ++q) ab[q] = 0.f;
            GAS unsigned long long* o8 = (GAS unsigned long long*)((bf16_t*)(ws + WS_U) + (size_t)m * DM) + F.lane;
#pragma unroll
            for (int j = 0; j < 4; ++j) {
                v[j] = v[j] * rstd * wv[j];
                o8[64 * j] = (unsigned long long)pk2(v[j].x, v[j].y) | ((unsigned long long)pk2(v[j].z, v[j].w) << 32);
#pragma unroll
                for (int e = 0; e < 4; ++e) {
                    const LAS f32x4* wp = (const LAS f32x4*)(wab2 + ((j * 4 + e) * 64 + F.lane) * 8);
                    const f32x4 w0 = wp[0], w1 = wp[1];
                    const float xv = v[j][e];
                    ab[0] += xv * w0.x; ab[1] += xv * w0.y; ab[2] += xv * w0.z; ab[3] += xv * w0.w;
                    ab[4] += xv * w1.x; ab[5] += xv * w1.y; ab[6] += xv * w1.z; ab[7] += xv * w1.w;
                }
            }
#pragma unroll
            for (int q = 0; q < 8; ++q) ab[q] = wave_sum(ab[q]);
            if (F.lane < 4) {
                const float a = F.lane == 0 ? ab[0] : F.lane == 1 ? ab[1] : F.lane == 2 ? ab[2] : ab[3];
                const float b = F.lane == 0 ? ab[4] : F.lane == 1 ? ab[5] : F.lane == 2 ? ab[6] : ab[7];
                const float z = a + dtb;
                const float sp = z > 20.f ? z : log1pf(__expf(z));
                ((GAS float*)(ws + WS_G))[(size_t)m * 4 + F.lane] = -__expf(alog) * sp;
                ((GAS float*)(ws + WS_BETA))[(size_t)m * 4 + F.lane] = 1.0f / (1.0f + __expf(-b));
            }
        }
    }
}

struct EpiProj {
    static constexpr bool PERM = true;
    unsigned char* ws;
    __device__ __forceinline__ void operator()(const f32x4 (&acc)[2][2][4][2], const pg8::Unit& u, int wr, int wc, int fr, int fq) const {
        const int pn = u.pn; bf16_t* base; int ldc, colt, mode = 0;
        if (pn < 6) { base = (bf16_t*)(ws + WS_GQKV); ldc = 1536; colt = 256 * pn; }
        else if (pn < 8) { base = (bf16_t*)(ws + WS_GZ); ldc = 512; colt = 256 * (pn - 6); }
        else if (pn < 12) { base = (bf16_t*)(ws + WS_RQK); ldc = 1024; colt = 256 * (pn - 8); mode = pn < 10 ? 1 : 2; }
        else if (pn < 16) { base = (bf16_t*)(ws + WS_RV); ldc = 1024; colt = 256 * (pn - 12); }
        else if (pn < 20) { base = (bf16_t*)(ws + WS_RG); ldc = 1024; colt = 256 * (pn - 16); }
        else { base = (bf16_t*)(ws + WS_MAB); ldc = 2048; colt = 256 * (pn - 20); }
        const int row0 = u.pm * 256 + wr * 64 + fr, col0 = colt + wc * 32 + 8 * fq;
        const float sc = mode == 2 ? 0.08838834764831845f : 1.0f;
        const GAS f32x4* tab = (const GAS f32x4*)(ws + WS_ROPE);
#pragma unroll
        for (int ai = 0; ai < 2; ++ai)
#pragma unroll
            for (int m = 0; m < 4; ++m) {
                const int row = row0 + ai * 128 + m * 16;
                bf16_t* rowp = base + (size_t)row * ldc + col0;
                f32x4 cs0 = {1.f, 0.f, 1.f, 0.f}, cs1 = cs0;
                if (mode) { const GAS f32x4* tp = tab + ((size_t)(row & (SEQ - 1)) * 64 + wc * 16 + 4 * fq) / 2; cs0 = tp[0]; cs1 = tp[1]; }
#pragma unroll
                for (int bj = 0; bj < 2; ++bj) {
                    f32x4 v0 = acc[ai][bj][m][0], v1 = acc[ai][bj][m][1];
                    if (mode) {
                        f32x4 r0, r1;
                        r0[0] = v0[0] * cs0[0] - v0[1] * cs0[1]; r0[1] = v0[1] * cs0[0] + v0[0] * cs0[1];
                        r0[2] = v0[2] * cs0[2] - v0[3] * cs0[3]; r0[3] = v0[3] * cs0[2] + v0[2] * cs0[3];
                        r1[0] = v1[0] * cs1[0] - v1[1] * cs1[1]; r1[1] = v1[1] * cs1[0] + v1[0] * cs1[1];
                        r1[2] = v1[2] * cs1[2] - v1[3] * cs1[3]; r1[3] = v1[3] * cs1[2] + v1[2] * cs1[3];
                        v0 = r0 * sc; v1 = r1 * sc;
                    }
                    u32x4 w; w.x = pg8::cvt_pk_bf16(v0[0], v0[1]); w.y = pg8::cvt_pk_bf16(v0[2], v0[3]); w.z = pg8::cvt_pk_bf16(v1[0], v1[1]); w.w = pg8::cvt_pk_bf16(v1[2], v1[3]);
                    *(u32x4*)(rowp + bj * 128) = w;
                }
            }
    }
};

__device__ __forceinline__ f32x4 mma16(bf16x8 x, bf16x8 y, f32x4 c) { return __builtin_amdgcn_mfma_f32_16x16x32_bf16(x, y, c, 0, 0, 0); }
__device__ __forceinline__ bf16x8 lfrag(const LAS bf16_t* base, int ld, int row0, int k0, int fr, int fq) { return *(const LAS bf16x8*)(base + (row0 + fr) * ld + k0 + 8 * fq); }
__device__ __forceinline__ bf16x8 gfrag(const bf16_t* base, int ld, int row0, int k0, int fr, int fq) { return *(const bf16x8*)(base + (size_t)(row0 + fr) * ld + k0 + 8 * fq); }
__device__ __forceinline__ bf16x8 tfrag(const LAS bf16_t* base, int ld, int k0, int n0, int lane) {
    const int g = lane >> 4, q = (lane & 15) >> 2, p = lane & 3;
    const LAS bf16_t* a = base + (k0 + 8 * g + q) * ld + n0 + 4 * p;
    const bf16x4 v0 = __builtin_amdgcn_ds_read_tr16_b64_v4i16((LAS bf16x4*)a);
    const bf16x4 v1 = __builtin_amdgcn_ds_read_tr16_b64_v4i16((LAS bf16x4*)(a + 4 * ld));
    return (bf16x8){v0[0], v0[1], v0[2], v0[3], v1[0], v1[1], v1[2], v1[3]};
}
__device__ __forceinline__ bf16x8 pack_acc(f32x4 a, f32x4 b) {
    u32x4 w; w.x = pk2(a[0], a[1]); w.y = pk2(a[2], a[3]); w.z = pk2(b[0], b[1]); w.w = pk2(b[2], b[3]);
    return __builtin_bit_cast(bf16x8, w);
}
__device__ __forceinline__ int ppos(int kap) { return 8 * ((kap & 15) >> 2) + 4 * (kap >> 4) + (kap & 3); }

constexpr size_t WS_GL = 8 * MiB + 512 * 1024;

__device__ __forceinline__ void gdn_prep_item(Frame& F, int idx) {
    const int bh = idx >> 5, n = idx & 31, b = bh >> 2, h = bh & 3;
    const int tok0 = b * SEQ + n * 64;
    LAS bf16_t* QN = (LAS bf16_t*)(F.lds);
    LAS bf16_t* KN = (LAS bf16_t*)(F.lds + 17408);
    LAS bf16_t* KT = (LAS bf16_t*)(F.lds + 34816);
    LAS bf16_t* VT = (LAS bf16_t*)(F.lds + 53248);
    LAS float*  LM = (LAS float*)(F.lds + 71680);
    LAS bf16_t* T1 = (LAS bf16_t*)(F.lds + 89088);
    LAS bf16_t* T2 = (LAS bf16_t*)(F.lds + 98304);
    LAS float*  SC = (LAS float*)(F.lds + 107520);
    LAS float*  SSQ = (LAS float*)(F.lds + 108544);
    const int tid = F.tid, lane = F.lane, fr = lane & 15, fq = lane >> 4, wave = F.wave;
    const bf16_t* GQKV = (const bf16_t*)(F.ws + WS_GQKV);
#pragma unroll 1
    for (int task = tid; task < 768; task += NTHR) {
        const int cg = task % 48, tr = task / 48, part = cg >> 4, cl = (cg & 15) * 8;
        const int gcol = part * 512 + h * 128 + cl;
        u32x4 xw[7];
#pragma unroll
        for (int r = 0; r < 7; ++r) {
            const int tt = tr * 4 - 3 + r;
            xw[r] = (u32x4){0u, 0u, 0u, 0u};
            if (n * 64 + tt >= 0) xw[r] = *(const u32x4*)(GQKV + (size_t)(tok0 + tt) * 1536 + gcol);
        }
        unsigned nat[4][4];
        float ssq[4];
#pragma unroll
        for (int t = 0; t < 4; ++t) ssq[t] = 0.f;
#pragma unroll
        for (int e2 = 0; e2 < 4; ++e2) {
            float c0[4], c1[4];
#pragma unroll
            for (int k = 0; k < 4; ++k) { const f32x2 cc = *(const f32x2*)(F.in[I_CONVW] + k * 1536 + gcol + 2 * e2); c0[k] = cc.x; c1[k] = cc.y; }
            float xa[7], xb[7];
#pragma unroll
            for (int r = 0; r < 7; ++r) { const unsigned w = xw[r][e2]; xa[r] = bflo(w); xb[r] = bfhi(w); }
            float ya[4], yb[4];
#pragma unroll
            for (int t = 0; t < 4; ++t) {
                ya[t] = siluf_(c0[0] * xa[t] + c0[1] * xa[t + 1] + c0[2] * xa[t + 2] + c0[3] * xa[t + 3]);
                yb[t] = siluf_(c1[0] * xb[t] + c1[1] * xb[t + 1] + c1[2] * xb[t + 2] + c1[3] * xb[t + 3]);
                ssq[t] += ya[t] * ya[t] + yb[t] * yb[t];
                nat[t][e2] = pk2(ya[t], yb[t]);
            }
            if (part >= 1) {
                LAS bf16_t* Tt = part == 1 ? KT : VT;
                u32x2 w; w.x = pk2(ya[0], ya[1]); w.y = pk2(ya[2], ya[3]);
                *(LAS u32x2*)(Tt + (cl + 2 * e2) * 72 + tr * 4) = w;
                w.x = pk2(yb[0], yb[1]); w.y = pk2(yb[2], yb[3]);
                *(LAS u32x2*)(Tt + (cl + 2 * e2 + 1) * 72 + tr * 4) = w;
            }
        }
        if (part < 2) {
            LAS bf16_t* N = part == 0 ? QN : KN;
#pragma unroll
            for (int t = 0; t < 4; ++t) {
                SSQ[(part * 64 + tr * 4 + t) * 16 + (cg & 15)] = ssq[t];
                *(LAS u32x4*)(N + (tr * 4 + t) * 136 + cl) = (u32x4){nat[t][0], nat[t][1], nat[t][2], nat[t][3]};
            }
        }
    }
    __syncthreads();
    if (wave == 0) {
        const int c = lane;
        float sq = 0.f, sk = 0.f;
#pragma unroll
        for (int j = 0; j < 16; ++j) { sq += SSQ[c * 16 + j]; sk += SSQ[(64 + c) * 16 + j]; }
        const float rq = 1.0f / sqrtf(sq + EPS), rk = 1.0f / sqrtf(sk + EPS);
        const float g = ((const float*)(F.ws + WS_G))[(size_t)(tok0 + c) * 4 + h];
        const float be = ((const float*)(F.ws + WS_BETA))[(size_t)(tok0 + c) * 4 + h];
        float gc = g;
#pragma unroll
        for (int o = 1; o < 64; o <<= 1) { const float t = __shfl_up(gc, o); if (lane >= o) gc += t; }
        SC[c] = rq; SC[64 + c] = rk; SC[128 + c] = gc; SC[192 + c] = be;
        if (c == 63) ((float*)(F.ws + WS_GL))[idx] = gc;
    }
    __syncthreads();
    {
        bf16_t* ATT = (bf16_t*)(F.ws + WS_ATTN) + (size_t)idx * 4096;
#pragma unroll 1
        for (int job = wave * 4; job < wave * 4 + 4; ++job) {
            const int which = job >> 4, it = (job >> 2) & 3, jt = job & 3;
            f32x4 acc = {0.f, 0.f, 0.f, 0.f};
            const LAS bf16_t* Y = which ? QN : KN;
#pragma unroll
            for (int ks = 0; ks < 4; ++ks) acc = mma16(lfrag(KN, 136, jt * 16, ks * 32, fr, fq), lfrag(Y, 136, it * 16, ks * 32, fr, fq), acc);
            const int i = it * 16 + fr, j0 = jt * 16 + 4 * fq;
            const float gci = SC[128 + i];
            if (which == 0) {
                const float fi = SC[192 + i] * SC[64 + i];
                f32x4 o;
#pragma unroll
                for (int r = 0; r < 4; ++r) { const int j = j0 + r; o[r] = (j < i) ? fi * SC[64 + j] * acc[r] * __expf(gci - SC[128 + j]) : 0.f; }
                *(LAS f32x4*)(LM + i * 68 + j0) = o;
            } else {
                const float fi = SC[i] * 0.08838834764831845f;
                float o[4];
#pragma unroll
                for (int r = 0; r < 4; ++r) { const int j = j0 + r; o[r] = (j <= i) ? fi * SC[64 + j] * acc[r] * __expf(gci - SC[128 + j]) : 0.f; }
                u32x2 w; w.x = pk2(o[0], o[1]); w.y = pk2(o[2], o[3]);
                *(u32x2*)(ATT + i * 64 + (j0 & 32) + ppos(j0 & 31)) = w;
            }
        }
    }
    __syncthreads();
    if (wave == 0) {
        const int c = lane;
        int zero = 0; asm volatile("v_mov_b32 %0, 0" : "=v"(zero));
        const LAS float* LMv = LM + zero;
        const float b1 = SC[192 + c], b2 = b1 * SC[64 + c] * __expf(SC[128 + c]);
        unsigned t1a = (unsigned)(uintptr_t)(T1 + c), t2a = (unsigned)(uintptr_t)(T2 + c);
        asm volatile("" : "+v"(t1a), "+v"(t2a));
        LAS bf16_t* T1v = (LAS bf16_t*)(uintptr_t)t1a; LAS bf16_t* T2v = (LAS bf16_t*)(uintptr_t)t2a;
        float t[64];
#pragma unroll
        for (int i = 0; i < 64; ++i) {
            float s = (i == c) ? 1.f : 0.f;
#pragma unroll
            for (int j4 = 0; j4 < (i + 3) / 4; ++j4) {
                const f32x4 l = *(const LAS f32x4*)(LMv + i * 68 + 4 * j4);
#pragma unroll
                for (int e = 0; e < 4; ++e) if (4 * j4 + e < i) s -= l[e] * t[4 * j4 + e];
            }
            t[i] = s;
            T1v[i * 72] = (bf16_t)f2bf(s * b1); T2v[i * 72] = (bf16_t)f2bf(s * b2);
            asm volatile("" ::: "memory");
        }
    } else {
        bf16_t* QGo = (bf16_t*)((unsigned char*)F.out + DO_QG) + (size_t)idx * 8192;
        bf16_t* KDo = (bf16_t*)((unsigned char*)F.out + DO_KDT) + (size_t)idx * 8192;
        const float gl = SC[128 + 63];
        for (int task = tid - 64; task < 2048; task += 448) {
            if (task < 1024) {
                const int c = task >> 4, d0 = (task & 15) * 8;
                const float f = SC[c] * 0.08838834764831845f * __expf(SC[128 + c]);
                const u32x4 w = *(const LAS u32x4*)(QN + c * 136 + d0);
                u32x2 o0, o1; o0.x = pk2(bflo(w.x) * f, bfhi(w.x) * f); o0.y = pk2(bflo(w.y) * f, bfhi(w.y) * f); o1.x = pk2(bflo(w.z) * f, bfhi(w.z) * f); o1.y = pk2(bflo(w.w) * f, bfhi(w.w) * f);
                bf16_t* dst = QGo + c * 128 + (d0 & ~31);
                *(u32x2*)(dst + ppos(d0 & 31)) = o0; *(u32x2*)(dst + ppos((d0 & 31) + 4)) = o1;
            } else {
                const int tk = task - 1024, d = tk >> 3, c0 = (tk & 7) * 8;
                const u32x4 w = *(const LAS u32x4*)(KT + d * 72 + c0);
                float f[8];
#pragma unroll
                for (int e = 0; e < 8; ++e) f[e] = SC[64 + c0 + e] * __expf(gl - SC[128 + c0 + e]);
                u32x2 o0, o1; o0.x = pk2(bflo(w.x) * f[0], bfhi(w.x) * f[1]); o0.y = pk2(bflo(w.y) * f[2], bfhi(w.y) * f[3]); o1.x = pk2(bflo(w.z) * f[4], bfhi(w.z) * f[5]); o1.y = pk2(bflo(w.w) * f[6], bfhi(w.w) * f[7]);
                bf16_t* dst = KDo + d * 64 + (c0 & ~31);
                *(u32x2*)(dst + ppos(c0 & 31)) = o0; *(u32x2*)(dst + ppos((c0 & 31) + 4)) = o1;
            }
        }
    }
    __syncthreads();
    {
        bf16_t* UTo = (bf16_t*)((unsigned char*)F.out + DO_UT) + (size_t)idx * 8192;
        bf16_t* WNo = (bf16_t*)((unsigned char*)F.out + DO_WNEG) + (size_t)idx * 8192;
#pragma unroll 1
        for (int job = wave * 8; job < wave * 8 + 8; ++job) {
            f32x4 acc = {0.f, 0.f, 0.f, 0.f};
            if (job < 32) {
                const int it = job >> 3, dvt = job & 7;
#pragma unroll
                for (int ks = 0; ks < 2; ++ks) acc = mma16(lfrag(T1, 72, it * 16, ks * 32, fr, fq), lfrag(VT, 72, dvt * 16, ks * 32, fr, fq), acc);
                u32x2 w; w.x = pk2(acc[0], acc[1]); w.y = pk2(acc[2], acc[3]);
                *(u32x2*)(UTo + (dvt * 16 + fr) * 64 + it * 16 + 4 * fq) = w;
            } else {
                const int dkt = (job - 32) >> 2, it = (job - 32) & 3;
#pragma unroll
                for (int ks = 0; ks < 2; ++ks) acc = mma16(lfrag(KT, 72, dkt * 16, ks * 32, fr, fq), lfrag(T2, 72, it * 16, ks * 32, fr, fq), acc);
                u32x2 w; w.x = pk2(-acc[0], -acc[1]); w.y = pk2(-acc[2], -acc[3]);
                const int d0 = dkt * 16 + 4 * fq;
                *(u32x2*)(WNo + (it * 16 + fr) * 128 + (d0 & ~31) + ppos(d0 & 31)) = w;
            }
        }
    }
    __syncthreads();
}

__device__ __forceinline__ float ret_log2_gamma(int h) { return log2f(1.0f - exp2f(-5.0f - (float)h)); }
__device__ __forceinline__ void ret_kv_item(Frame& F, int idx2) {
    const int bh = idx2 >> 4, n = idx2 & 15, b = bh >> 2, h = bh & 3;
    const int tok0 = b * SEQ + n * 128;
    LAS bf16_t* KS = (LAS bf16_t*)(F.lds);
    LAS bf16_t* VN = (LAS bf16_t*)(F.lds + 34816);
    const int tid = F.tid, lane = F.lane, fr = lane & 15, fq = lane >> 4, wave = F.wave;
    const float l2g = ret_log2_gamma(h);
    const bf16_t* RQK = (const bf16_t*)(F.ws + WS_RQK); const bf16_t* RV = (const bf16_t*)(F.ws + WS_RV);
#pragma unroll
    for (int i = 0; i < 4; ++i) { const int p = tid + i * 512, c = p >> 4, d0 = (p & 15) * 8;
        const u32x4 w = *(const u32x4*)(RQK + (size_t)(tok0 + c) * 1024 + 512 + h * 128 + d0);
        const float f = exp2f(l2g * (float)(127 - c));
        u32x4 o; o.x = pk2(bflo(w.x) * f, bfhi(w.x) * f); o.y = pk2(bflo(w.y) * f, bfhi(w.y) * f); o.z = pk2(bflo(w.z) * f, bfhi(w.z) * f); o.w = pk2(bflo(w.w) * f, bfhi(w.w) * f);
        *(LAS u32x4*)(KS + c * 136 + d0) = o; }
#pragma unroll
    for (int i = 0; i < 8; ++i) { const int p = tid + i * 512, c = p >> 5, d0 = (p & 31) * 8;
        *(LAS u32x4*)(VN + c * 264 + d0) = *(const u32x4*)(RV + (size_t)(tok0 + c) * 1024 + h * 256 + d0); }
    __syncthreads();
    f32x4 acc[8][2];
#pragma unroll
    for (int a = 0; a < 8; ++a) { acc[a][0] = (f32x4){0.f, 0.f, 0.f, 0.f}; acc[a][1] = acc[a][0]; }
#pragma unroll
    for (int ks = 0; ks < 4; ++ks) {
        const bf16x8 y0 = tfrag(VN, 264, ks * 32, (2 * wave) * 16, lane), y1 = tfrag(VN, 264, ks * 32, (2 * wave + 1) * 16, lane);
#pragma unroll
        for (int dkt = 0; dkt < 8; ++dkt) { const bf16x8 x = tfrag(KS, 136, ks * 32, dkt * 16, lane); acc[dkt][0] = mma16(x, y0, acc[dkt][0]); acc[dkt][1] = mma16(x, y1, acc[dkt][1]); }
    }
    bf16_t* KVo = (bf16_t*)(F.ws + WS_KV) + (size_t)idx2 * 32768;
#pragma unroll
    for (int dkt = 0; dkt < 8; ++dkt)
#pragma unroll
        for (int q = 0; q < 2; ++q) { u32x2 w; w.x = pk2(acc[dkt][q][0], acc[dkt][q][1]); w.y = pk2(acc[dkt][q][2], acc[dkt][q][3]);
            *(u32x2*)(KVo + ((2 * wave + q) * 16 + fr) * 128 + dkt * 16 + 4 * fq) = w; }
    __syncthreads();
}

__device__ __forceinline__ void gdn_scan_chain(Frame& F, int chain) {
    const int bh = chain >> 3, sl = chain & 7, b = bh >> 2, h = bh & 3;
    const int lane = F.lane, fr = lane & 15, fq = lane >> 4;
    const bf16_t* WNEG = (const bf16_t*)((unsigned char*)F.out + DO_WNEG); const bf16_t* QG = (const bf16_t*)((unsigned char*)F.out + DO_QG);
    const bf16_t* KDT = (const bf16_t*)((unsigned char*)F.out + DO_KDT); const bf16_t* UT = (const bf16_t*)((unsigned char*)F.out + DO_UT);
    const bf16_t* ATT = (const bf16_t*)(F.ws + WS_ATTN);
    float* OG = (float*)(F.ws + WS_OGDN); float* SSQ = (float*)(F.ws + WS_SSQ);
    f32x4 S[8];
#pragma unroll
    for (int d = 0; d < 8; ++d) S[d] = (f32x4){0.f, 0.f, 0.f, 0.f};
#pragma unroll 1
    for (int n = 0; n < 32; ++n) {
        const int idx = bh * 32 + n;
        const bf16_t* W = WNEG + (size_t)idx * 8192; const bf16_t* Q = QG + (size_t)idx * 8192; const bf16_t* KD = KDT + (size_t)idx * 8192;
        const bf16_t* U = UT + (size_t)idx * 8192; const bf16_t* A = ATT + (size_t)idx * 4096;
        const float egl = __expf(((const float*)(F.ws + WS_GL))[idx]);
        bf16x8 Sf[4];
#pragma unroll
        for (int ks = 0; ks < 4; ++ks) Sf[ks] = pack_acc(S[2 * ks], S[2 * ks + 1]);
        f32x4 av[4], ao[4];
#pragma unroll
        for (int ct = 0; ct < 4; ++ct) {
            const u32x2 w = *(const u32x2*)(U + (sl * 16 + fr) * 64 + ct * 16 + 4 * fq);
            av[ct] = (f32x4){bflo(w.x), bfhi(w.x), bflo(w.y), bfhi(w.y)};
            ao[ct] = (f32x4){0.f, 0.f, 0.f, 0.f};
        }
#pragma unroll
        for (int ct = 0; ct < 4; ++ct)
#pragma unroll
            for (int ks = 0; ks < 4; ++ks) av[ct] = mma16(gfrag(W, 128, ct * 16, ks * 32, fr, fq), Sf[ks], av[ct]);
#pragma unroll
        for (int ct = 0; ct < 4; ++ct)
#pragma unroll
            for (int ks = 0; ks < 4; ++ks) ao[ct] = mma16(gfrag(Q, 128, ct * 16, ks * 32, fr, fq), Sf[ks], ao[ct]);
        bf16x8 Vf[2];
        Vf[0] = pack_acc(av[0], av[1]); Vf[1] = pack_acc(av[2], av[3]);
#pragma unroll
        for (int ct = 0; ct < 4; ++ct)
#pragma unroll
            for (int k2 = 0; k2 < 2; ++k2) ao[ct] = mma16(gfrag(A, 64, ct * 16, k2 * 32, fr, fq), Vf[k2], ao[ct]);
#pragma unroll
        for (int dt = 0; dt < 8; ++dt) {
            S[dt] = S[dt] * egl;
#pragma unroll
            for (int k2 = 0; k2 < 2; ++k2) S[dt] = mma16(gfrag(KD, 64, dt * 16, k2 * 32, fr, fq), Vf[k2], S[dt]);
        }
        const int tok0 = b * SEQ + n * 64;
#pragma unroll
        for (int ct = 0; ct < 4; ++ct)
#pragma unroll
            for (int r = 0; r < 4; ++r) {
                const int c = ct * 16 + 4 * fq + r; const float v = ao[ct][r];
                OG[(size_t)(tok0 + c) * 512 + h * 128 + sl * 16 + fr] = v;
                float s = v * v;
                s += __shfl_xor(s, 1); s += __shfl_xor(s, 2); s += __shfl_xor(s, 4); s += __shfl_xor(s, 8);
                if (fr == 0) SSQ[(size_t)(tok0 + c) * 32 + h * 8 + sl] = s;
            }
    }
}

__device__ __forceinline__ void ret_prefix_task(Frame& F, int task) {
    const int bh = task >> 6, part = task & 63, h = bh & 3;
    const float cd = exp2f(ret_log2_gamma(h) * 128.0f);
    bf16_t* base = (bf16_t*)(F.ws + WS_KV) + (size_t)bh * 16 * 32768 + part * 512 + F.lane * 8;
    float st[8];
#pragma unroll
    for (int e = 0; e < 8; ++e) st[e] = 0.f;
#pragma unroll 4
    for (int n = 0; n < 16; ++n) {
        u32x4* p = (u32x4*)(base + (size_t)n * 32768);
        const u32x4 w = *p;
        u32x4 o; o.x = pk2(st[0], st[1]); o.y = pk2(st[2], st[3]); o.z = pk2(st[4], st[5]); o.w = pk2(st[6], st[7]);
        *p = o;
        st[0] = st[0] * cd + bflo(w.x); st[1] = st[1] * cd + bfhi(w.x); st[2] = st[2] * cd + bflo(w.y); st[3] = st[3] * cd + bfhi(w.y);
        st[4] = st[4] * cd + bflo(w.z); st[5] = st[5] * cd + bfhi(w.z); st[6] = st[6] * cd + bflo(w.w); st[7] = st[7] * cd + bfhi(w.w);
    }
}

__device__ __forceinline__ void ret_out_item(Frame& F, int idx2) {
    const int bh = idx2 >> 4, n = idx2 & 15, b = bh >> 2, h = bh & 3;
    const int tok0 = b * SEQ + n * 128;
    LAS bf16_t* QN = (LAS bf16_t*)(F.lds);
    LAS bf16_t* KN = (LAS bf16_t*)(F.lds + 34816);
    LAS bf16_t* VN = (LAS bf16_t*)(F.lds);
    LAS bf16_t* PM = (LAS bf16_t*)(F.lds + 69632);
    LAS float*  NS = (LAS float*)(F.lds + 104448);
    const int tid = F.tid, lane = F.lane, fr = lane & 15, fq = lane >> 4, wave = F.wave;
    const float l2g = ret_log2_gamma(h);
    const bf16_t* RQK = (const bf16_t*)(F.ws + WS_RQK); const bf16_t* RV = (const bf16_t*)(F.ws + WS_RV);
#pragma unroll
    for (int i = 0; i < 4; ++i) { const int p = tid + i * 512, c = p >> 4, d0 = (p & 15) * 8;
        *(LAS u32x4*)(QN + c * 136 + d0) = *(const u32x4*)(RQK + (size_t)(tok0 + c) * 1024 + h * 128 + d0);
        *(LAS u32x4*)(KN + c * 136 + d0) = *(const u32x4*)(RQK + (size_t)(tok0 + c) * 1024 + 512 + h * 128 + d0); }
    __syncthreads();
    {
        bf16x8 yq[4];
#pragma unroll
        for (int ks = 0; ks < 4; ++ks) yq[ks] = lfrag(QN, 136, wave * 16, ks * 32, fr, fq);
        const int i = wave * 16 + fr;
#pragma unroll
        for (int jt = 0; jt < 8; ++jt) {
            f32x4 acc = {0.f, 0.f, 0.f, 0.f};
#pragma unroll
            for (int ks = 0; ks < 4; ++ks) acc = mma16(lfrag(KN, 136, jt * 16, ks * 32, fr, fq), yq[ks], acc);
            float o[4];
#pragma unroll
            for (int r = 0; r < 4; ++r) { const int j = jt * 16 + 4 * fq + r; o[r] = (j <= i) ? acc[r] * exp2f(l2g * (float)(i - j)) : 0.f; }
            u32x2 w; w.x = pk2(o[0], o[1]); w.y = pk2(o[2], o[3]);
            *(LAS u32x2*)(PM + i * 136 + jt * 16 + 4 * fq) = w;
        }
    }
    __syncthreads();
#pragma unroll
    for (int i = 0; i < 8; ++i) { const int p = tid + i * 512, c = p >> 5, d0 = (p & 31) * 8;
        *(LAS u32x4*)(VN + c * 264 + d0) = *(const u32x4*)(RV + (size_t)(tok0 + c) * 1024 + h * 256 + d0); }
    __syncthreads();
    const int wi = wave >> 1, wd = wave & 1;
    f32x4 a1[8][2];
#pragma unroll
    for (int d = 0; d < 8; ++d) { a1[d][0] = (f32x4){0.f, 0.f, 0.f, 0.f}; a1[d][1] = a1[d][0]; }
    const bf16_t* SP = (const bf16_t*)(F.ws + WS_KV) + (size_t)idx2 * 32768;
    const float qd0 = exp2f(l2g * (float)((2 * wi) * 16 + fr + 1)), qd1 = exp2f(l2g * (float)((2 * wi + 1) * 16 + fr + 1));
#pragma unroll
    for (int ks = 0; ks < 4; ++ks) {
        const bf16x8 p0 = lfrag(PM, 136, (2 * wi) * 16, ks * 32, fr, fq), p1 = lfrag(PM, 136, (2 * wi + 1) * 16, ks * 32, fr, fq);
        bf16x8 q0 = gfrag(RQK + (size_t)tok0 * 1024 + h * 128, 1024, (2 * wi) * 16, ks * 32, fr, fq), q1 = gfrag(RQK + (size_t)tok0 * 1024 + h * 128, 1024, (2 * wi + 1) * 16, ks * 32, fr, fq);
        { u32x4 w = __builtin_bit_cast(u32x4, q0); w.x = pk2(bflo(w.x) * qd0, bfhi(w.x) * qd0); w.y = pk2(bflo(w.y) * qd0, bfhi(w.y) * qd0); w.z = pk2(bflo(w.z) * qd0, bfhi(w.z) * qd0); w.w = pk2(bflo(w.w) * qd0, bfhi(w.w) * qd0); q0 = __builtin_bit_cast(bf16x8, w); }
        { u32x4 w = __builtin_bit_cast(u32x4, q1); w.x = pk2(bflo(w.x) * qd1, bfhi(w.x) * qd1); w.y = pk2(bflo(w.y) * qd1, bfhi(w.y) * qd1); w.z = pk2(bflo(w.z) * qd1, bfhi(w.z) * qd1); w.w = pk2(bflo(w.w) * qd1, bfhi(w.w) * qd1); q1 = __builtin_bit_cast(bf16x8, w); }
#pragma unroll
        for (int d = 0; d < 8; ++d) {
            const bf16x8 xv = tfrag(VN, 264, ks * 32, (wd * 8 + d) * 16, lane);
            a1[d][0] = mma16(xv, p0, a1[d][0]); a1[d][1] = mma16(xv, p1, a1[d][1]);
            const bf16x8 xs = gfrag(SP, 128, (wd * 8 + d) * 16, ks * 32, fr, fq);
            a1[d][0] = mma16(xs, q0, a1[d][0]); a1[d][1] = mma16(xs, q1, a1[d][1]);
        }
    }
#pragma unroll
    for (int t = 0; t < 2; ++t) {
        const int i = (2 * wi + t) * 16 + fr;
        float s = 0.f;
#pragma unroll
        for (int d = 0; d < 8; ++d) { const f32x4 v = a1[d][t]; s += (v[0] * v[0] + v[1] * v[1]) + (v[2] * v[2] + v[3] * v[3]); }
        s += __shfl_xor(s, 16); s += __shfl_xor(s, 32);
        if (fq == 0) NS[i * 2 + wd] = s;
    }
    __syncthreads();
    const bf16_t* RG = (const bf16_t*)(F.ws + WS_RG);
    bf16_t* YB = (bf16_t*)((unsigned char*)F.out + DO_YB);
#pragma unroll
    for (int t = 0; t < 2; ++t) {
        const int i = (2 * wi + t) * 16 + fr;
        const float rstd = 1.0f / sqrtf((NS[i * 2] + NS[i * 2 + 1]) * (1.0f / 256.0f) + EPS);
#pragma unroll
        for (int d = 0; d < 8; ++d) {
            const int dv = (wd * 8 + d) * 16 + 4 * fq;
            const u32x2 g = *(const u32x2*)(RG + (size_t)(tok0 + i) * 1024 + h * 256 + dv);
            const f32x4 v = a1[d][t] * rstd;
            u32x2 w; w.x = pk2(v[0] * siluf_(bflo(g.x)), v[1] * siluf_(bfhi(g.x))); w.y = pk2(v[2] * siluf_(bflo(g.y)), v[3] * siluf_(bfhi(g.y)));
            *(u32x2*)(YB + (size_t)(tok0 + i) * 1024 + h * 256 + dv) = w;
        }
    }
    __syncthreads();
}

__device__ __forceinline__ void gdn_normgate_row(Frame& F, int m) {
    const int lane = F.lane, hd = lane >> 4;
    const float* OG = (const float*)(F.ws + WS_OGDN) + (size_t)m * 512 + lane * 8;
    const f32x4 o0 = *(const f32x4*)OG, o1 = *(const f32x4*)(OG + 4);
    const float* sp = (const float*)(F.ws + WS_SSQ) + (size_t)m * 32 + hd * 8;
    const f32x4 s0 = *(const f32x4*)sp, s1 = *(const f32x4*)(sp + 4);
    const float ssum = ((s0[0] + s0[1]) + (s0[2] + s0[3])) + ((s1[0] + s1[1]) + (s1[2] + s1[3]));
    const float rstd = 1.0f / sqrtf(ssum * (1.0f / 128.0f) + EPS);
    const float* nw = F.in[I_GNW] + (lane & 15) * 8;
    const f32x4 w0 = *(const f32x4*)nw, w1 = *(const f32x4*)(nw + 4);
    const u32x4 z = *(const u32x4*)((const bf16_t*)(F.ws + WS_GZ) + (size_t)m * 512 + lane * 8);
    u32x4 y;
    y.x = pk2(o0[0] * rstd * w0[0] * siluf_(bflo(z.x)), o0[1] * rstd * w0[1] * siluf_(bfhi(z.x)));
    y.y = pk2(o0[2] * rstd * w0[2] * siluf_(bflo(z.y)), o0[3] * rstd * w0[3] * siluf_(bfhi(z.y)));
    y.z = pk2(o1[0] * rstd * w1[0] * siluf_(bflo(z.z)), o1[1] * rstd * w1[1] * siluf_(bfhi(z.z)));
    y.w = pk2(o1[2] * rstd * w1[2] * siluf_(bflo(z.w)), o1[3] * rstd * w1[3] * siluf_(bfhi(z.w)));
    *(u32x4*)((bf16_t*)((unsigned char*)F.out + DO_YA) + (size_t)m * 512 + lane * 8) = y;
}

struct EpiUp1 {
    static constexpr bool PERM = true;
    unsigned char* ws;
    __device__ __forceinline__ void operator()(const f32x4 (&acc)[2][2][4][2], const pg8::Unit& u, int wr, int wc, int fr, int fq) const {
        const int row0 = u.pm * 256 + wr * 64 + fr, col0 = u.pn * 256 + wc * 32 + 8 * fq;
        const bf16_t* MAB = (const bf16_t*)(ws + WS_MAB); float* TMP = (float*)(ws + WS_TMP);
#pragma unroll
        for (int ai = 0; ai < 2; ++ai)
#pragma unroll
            for (int m = 0; m < 4; ++m) { const int row = row0 + ai * 128 + m * 16;
#pragma unroll
                for (int bj = 0; bj < 2; ++bj) {
                    const int col = col0 + bj * 128;
                    const u32x4 g = *(const u32x4*)(MAB + (size_t)row * 2048 + col);
                    const f32x4 v0 = acc[ai][bj][m][0], v1 = acc[ai][bj][m][1];
                    f32x4 o0, o1;
                    o0[0] = v0[0] * sigmoidf_(bflo(g.x)); o0[1] = v0[1] * sigmoidf_(bfhi(g.x)); o0[2] = v0[2] * sigmoidf_(bflo(g.y)); o0[3] = v0[3] * sigmoidf_(bfhi(g.y));
                    o1[0] = v1[0] * sigmoidf_(bflo(g.z)); o1[1] = v1[1] * sigmoidf_(bfhi(g.z)); o1[2] = v1[2] * sigmoidf_(bflo(g.w)); o1[3] = v1[3] * sigmoidf_(bfhi(g.w));
                    float* p = TMP + (size_t)row * 1024 + col;
                    *(f32x4*)p = o0; *(f32x4*)(p + 4) = o1;
                } }
    }
};
struct EpiUp2 {
    static constexpr bool PERM = true;
    unsigned char* ws;
    __device__ __forceinline__ void operator()(const f32x4 (&acc)[2][2][4][2], const pg8::Unit& u, int wr, int wc, int fr, int fq) const {
        const int row0 = u.pm * 256 + wr * 64 + fr, col0 = u.pn * 256 + wc * 32 + 8 * fq;
        const bf16_t* MAB = (const bf16_t*)(ws + WS_MAB); const float* TMP = (const float*)(ws + WS_TMP); bf16_t* MG = (bf16_t*)(ws + WS_MERGED);
#pragma unroll
        for (int ai = 0; ai < 2; ++ai)
#pragma unroll
            for (int m = 0; m < 4; ++m) { const int row = row0 + ai * 128 + m * 16;
#pragma unroll
                for (int bj = 0; bj < 2; ++bj) {
                    const int col = col0 + bj * 128;
                    const u32x4 g = *(const u32x4*)(MAB + (size_t)row * 2048 + 1024 + col);
                    const float* p = TMP + (size_t)row * 1024 + col;
                    const f32x4 t0 = *(const f32x4*)p, t1 = *(const f32x4*)(p + 4);
                    const f32x4 v0 = acc[ai][bj][m][0], v1 = acc[ai][bj][m][1];
                    u32x4 w;
                    w.x = pk2(t0[0] + v0[0] * sigmoidf_(bflo(g.x)), t0[1] + v0[1] * sigmoidf_(bfhi(g.x)));
                    w.y = pk2(t0[2] + v0[2] * sigmoidf_(bflo(g.y)), t0[3] + v0[3] * sigmoidf_(bfhi(g.y)));
                    w.z = pk2(t1[0] + v1[0] * sigmoidf_(bflo(g.z)), t1[1] + v1[1] * sigmoidf_(bfhi(g.z)));
                    w.w = pk2(t1[2] + v1[2] * sigmoidf_(bflo(g.w)), t1[3] + v1[3] * sigmoidf_(bfhi(g.w)));
                    *(u32x4*)(MG + (size_t)row * 1024 + col) = w;
                } }
    }
};
struct EpiOut {
    static constexpr bool PERM = false;
    const float* x; float* h;
    __device__ __forceinline__ void operator()(const f32x4 (&acc)[2][2][4][2], const pg8::Unit& u, int wr, int wc, int fr, int fq) const {
        const int row0 = u.pm * 256 + wr * 64 + fr, col0 = u.pn * 256 + wc * 32 + 4 * fq;
#pragma unroll
        for (int ai = 0; ai < 2; ++ai)
#pragma unroll
            for (int m = 0; m < 4; ++m) { const size_t off = (size_t)(row0 + ai * 128 + m * 16) * 1024 + col0;
#pragma unroll
                for (int bj = 0; bj < 2; ++bj)
#pragma unroll
                    for (int n = 0; n < 2; ++n) *(f32x4*)(h + off + bj * 128 + n * 16) = *(const f32x4*)(x + off + bj * 128 + n * 16) + acc[ai][bj][m][n]; }
    }
};

__device__ __forceinline__ void router_rows8(Frame& F, int m0) {
    const int lane = F.lane;
    const float* h = (const float*)F.out;
    f32x4 v[8][4];
    f32x4 wv[4];
#pragma unroll
    for (int j = 0; j < 4; ++j) wv[j] = *(const f32x4*)(F.in[I_NFW] + 4 * lane + 256 * j);
#pragma unroll
    for (int r = 0; r < 8; ++r) {
        const f32x4* xr = (const f32x4*)(h + (size_t)(m0 + r) * DM) + lane;
        float s = 0.f;
#pragma unroll
        for (int j = 0; j < 4; ++j) { v[r][j] = xr[64 * j]; s += (v[r][j].x * v[r][j].x + v[r][j].y * v[r][j].y) + (v[r][j].z * v[r][j].z + v[r][j].w * v[r][j].w); }
        const float rstd = 1.0f / sqrtf(wave_sum(s) * (1.f / DM) + EPS);
        unsigned long long* o8 = (unsigned long long*)((bf16_t*)(F.ws + WS_XN) + (size_t)(m0 + r) * DM) + lane;
#pragma unroll
        for (int j = 0; j < 4; ++j) { v[r][j] = v[r][j] * rstd * wv[j];
            o8[64 * j] = (unsigned long long)pk2(v[r][j].x, v[r][j].y) | ((unsigned long long)pk2(v[r][j].z, v[r][j].w) << 32); }
    }
    float lg[8];
#pragma unroll
    for (int r = 0; r < 8; ++r) lg[r] = 0.f;
    const float* wrt = (const float*)(F.ws + WS_WRT);
#pragma unroll 1
    for (int o = 0; o < 36; ++o) {
        f32x4 w[4];
#pragma unroll
        for (int j = 0; j < 4; ++j) w[j] = *(const f32x4*)(wrt + o * DM + 4 * lane + 256 * j);
#pragma unroll
        for (int r = 0; r < 8; ++r) {
            float s = 0.f;
#pragma unroll
            for (int j = 0; j < 4; ++j) s += (v[r][j].x * w[j].x + v[r][j].y * w[j].y) + (v[r][j].z * w[j].z + v[r][j].w * w[j].w);
            s = wave_sum(s);
            if (lane == o) lg[r] = s;
        }
    }
    const float bias = lane < 4 ? F.in[I_BGRP][lane] : (lane < 36 ? F.in[I_BEXP][lane - 4] : 0.f);
    int* LTOK = (int*)(F.ws + WS_LTOK); int* LDST = (int*)(F.ws + WS_LDST); float* LW = (float*)(F.ws + WS_LW);
    unsigned* cnt = (unsigned*)(F.ws + WS_CTL) + CW_CNT;
#pragma unroll
    for (int r = 0; r < 8; ++r) {
        const float l = lg[r] + bias;
        const float g0 = __shfl(l, 0), g1 = __shfl(l, 1), g2 = __shfl(l, 2), g3 = __shfl(l, 3);
        int gi = 0; float gm = g0;
        if (g1 > gm) { gm = g1; gi = 1; } if (g2 > gm) { gm = g2; gi = 2; } if (g3 > gm) { gm = g3; gi = 3; }
        const float gp = 1.0f / (__expf(g0 - gm) + __expf(g1 - gm) + __expf(g2 - gm) + __expf(g3 - gm));
        float ev[8];
#pragma unroll
        for (int i = 0; i < 8; ++i) ev[i] = __shfl(l, 4 + gi * 8 + i);
        int i0 = 0; float v0 = ev[0];
#pragma unroll
        for (int i = 1; i < 8; ++i) if (ev[i] > v0) { v0 = ev[i]; i0 = i; }
        int i1 = -1; float v1 = -3.0e38f;
#pragma unroll
        for (int i = 0; i < 8; ++i) if (i != i0 && ev[i] > v1) { v1 = ev[i]; i1 = i; }
        const float w0 = gp / (1.0f + __expf(v1 - v0)), w1 = gp / (1.0f + __expf(v0 - v1));
        if (lane < 2) {
            const int e = gi * 8 + (lane == 0 ? i0 : i1);
            const unsigned pos = __hip_atomic_fetch_add(cnt + e, 1u, __ATOMIC_RELAXED, __HIP_MEMORY_SCOPE_AGENT);
            LTOK[e * 16384 + pos] = m0 + r; LDST[e * 16384 + pos] = 2 * (m0 + r) + lane; LW[e * 16384 + pos] = lane == 0 ? w0 : w1;
        }
    }
}
__device__ __forceinline__ void p7_router(Frame& F) {
    const int gw = F.vcu * NWAVES + F.wave, NGW = F.G * NWAVES;
    for (int t = gw; t < M / 8; t += NGW) router_rows8(F, t * 8);
    LAS float* scr = (LAS float*)(F.lds + F.wave * 16384);
    constexpr int IG = 16 * 16, ID = 8 * 32, IPE = 2 * IG + ID;
    for (int it = gw; it < NE * IPE; it += NGW) {
        const int e = it / IPE; int r = it % IPE;
        if (r < 2 * IG) { const int up = r >= IG; if (up) r -= IG; const int nb = r % 16, kb = r / 16, n0 = nb * 32;
            const float* W = (up ? F.in[I_WUP] : F.in[I_WGATE]) + (size_t)e * 1024 * 512;
            transpose_item(W, 512, n0, (bf16_t*)(F.ws + WS_WGU) + (size_t)e * 1024 * 1024, 1024, (n0 >> 7) * 256 + (up ? 128 : 0) + (n0 & 127), kb * 64, scr, F.lane);
        } else { r -= 2 * IG; const int nb = r % 32, kb = r / 32;
            transpose_item(F.in[I_WDOWN] + (size_t)e * 512 * 1024, 1024, nb * 32, (bf16_t*)(F.ws + WS_WD) + (size_t)e * 1024 * 512, 512, nb * 32, kb * 64, scr, F.lane); }
    }
}

constexpr int TOFF_OFF = MISC_OFF + 512;
struct MoeProb {
    const LAS int* toff; const unsigned* cnt; const int* ltok;
    const bf16_t* A; const bf16_t* Bt; int K; int G, c; int total;
    __device__ __forceinline__ bool next(int i, pg8::Unit& u) const {
        const int L = i * G + c; if (L >= total) return false;
        const int tile = L >> 2; int e = 0;
#pragma unroll 1
        for (int s = 16; s > 0; s >>= 1) if (toff[e + s] <= tile) e += s;
        u.e = e; u.pm = tile - toff[e]; u.pn = L & 3; u.base = tile * 256;
        const int c_e = (int)cnt[e]; const int rem = c_e - u.pm * 256; u.rows = rem < 256 ? rem : 256;
        return true;
    }
    __device__ __forceinline__ int a_row(const pg8::Unit& u, int r) const { return ltok[u.e * 16384 + u.pm * 256 + (r < u.rows ? r : 0)]; }
    __device__ __forceinline__ const char* a_ptr(const pg8::Unit& u) const { return (const char*)A; }
    __device__ __forceinline__ const char* a_ptr_rows(const pg8::Unit& u) const { return (const char*)A + (size_t)u.base * K * 2; }
    __device__ __forceinline__ const char* b_ptr(const pg8::Unit& u) const { return (const char*)Bt + ((size_t)u.e * 1024 + u.pn * 256) * K * 2; }
};
struct MoeProbD : MoeProb { __device__ __forceinline__ const char* a_ptr(const pg8::Unit& u) const { return a_ptr_rows(u); } };
struct EpiGU {
    static constexpr bool PERM = true;
    bf16_t* hid;
    __device__ __forceinline__ void operator()(const f32x4 (&acc)[2][2][4][2], const pg8::Unit& u, int wr, int wc, int fr, int fq) const {
        const int col0 = u.pn * 128 + wc * 32 + 8 * fq;
#pragma unroll
        for (int ai = 0; ai < 2; ++ai)
#pragma unroll
            for (int m = 0; m < 4; ++m) { const int r = ai * 128 + wr * 64 + m * 16 + fr;
                const f32x4 g0 = acc[ai][0][m][0], g1 = acc[ai][0][m][1], u0 = acc[ai][1][m][0], u1 = acc[ai][1][m][1];
                u32x4 w;
                w.x = pk2(siluf_(g0[0]) * u0[0], siluf_(g0[1]) * u0[1]); w.y = pk2(siluf_(g0[2]) * u0[2], siluf_(g0[3]) * u0[3]);
                w.z = pk2(siluf_(g1[0]) * u1[0], siluf_(g1[1]) * u1[1]); w.w = pk2(siluf_(g1[2]) * u1[2], siluf_(g1[3]) * u1[3]);
                *(u32x4*)(hid + (size_t)(u.base + r) * 512 + col0) = w; }
    }
};
struct EpiDown {
    static constexpr bool PERM = true;
    bf16_t* y2; const int* ldst; const float* lw;
    __device__ __forceinline__ void operator()(const f32x4 (&acc)[2][2][4][2], const pg8::Unit& u, int wr, int wc, int fr, int fq) const {
        const int col0 = u.pn * 256 + wc * 32 + 8 * fq;
#pragma unroll
        for (int ai = 0; ai < 2; ++ai)
#pragma unroll
            for (int m = 0; m < 4; ++m) { const int r = ai * 128 + wr * 64 + m * 16 + fr;
                if (r < u.rows) {
                    const int li = u.e * 16384 + u.pm * 256 + r; const int dst = ldst[li]; const float cw = lw[li];
#pragma unroll
                    for (int bj = 0; bj < 2; ++bj) { const f32x4 v0 = acc[ai][bj][m][0] * cw, v1 = acc[ai][bj][m][1] * cw;
                        u32x4 w; w.x = pk2(v0[0], v0[1]); w.y = pk2(v0[2], v0[3]); w.z = pk2(v1[0], v1[1]); w.w = pk2(v1[2], v1[3]);
                        *(u32x4*)(y2 + (size_t)dst * 1024 + col0 + bj * 128) = w; }
                } }
    }
};
__device__ __forceinline__ void moe_toff(Frame& F) {
    LAS int* toff = (LAS int*)(F.lds + TOFF_OFF);
    __syncthreads();
    if (F.tid == 0) { const unsigned* cnt = (const unsigned*)(F.ws + WS_CTL) + CW_CNT; int a = 0;
        for (int e = 0; e < NE; ++e) { toff[e] = a; a += ((int)cnt[e] + 255) >> 8; } toff[NE] = a; }
    __syncthreads();
}

__device__ __forceinline__ void final_row(Frame& F, int m) {
    const int lane = F.lane;
    float* hr = F.out + (size_t)m * DM;
    const bf16_t* y0 = (const bf16_t*)(F.ws + WS_Y2) + (size_t)(2 * m) * DM; const bf16_t* y1 = y0 + DM;
    f32x4 v[4]; float s = 0.f;
#pragma unroll
    for (int j = 0; j < 4; ++j) {
        v[j] = *(const f32x4*)(hr + 4 * lane + 256 * j);
        const u32x2 a = *(const u32x2*)(y0 + 4 * lane + 256 * j), b = *(const u32x2*)(y1 + 4 * lane + 256 * j);
        v[j][0] += bflo(a.x) + bflo(b.x); v[j][1] += bfhi(a.x) + bfhi(b.x); v[j][2] += bflo(a.y) + bflo(b.y); v[j][3] += bfhi(a.y) + bfhi(b.y);
        s += (v[j].x * v[j].x + v[j].y * v[j].y) + (v[j].z * v[j].z + v[j].w * v[j].w);
    }
    const float rstd = 1.0f / sqrtf(wave_sum(s) * (1.f / DM) + EPS);
#pragma unroll
    for (int j = 0; j < 4; ++j) { const f32x4 w = *(const f32x4*)(F.in[I_NFINW] + 4 * lane + 256 * j); *(f32x4*)(hr + 4 * lane + 256 * j) = v[j] * rstd * w; }
}

struct Args { const float* in[19]; float* out; unsigned char* ws; int ph_lo, ph_hi; };
__global__ void __launch_bounds__(NTHR, 2) hgrh_fwd(Args args) {
    extern __shared__ __attribute__((aligned(16))) unsigned char lds_raw[];
    Frame F;
    F.lds = (LAS unsigned char*)lds_raw;
    F.MISC = (volatile LAS unsigned*)(F.lds + MISC_OFF);
    F.tid = threadIdx.x; F.lane = F.tid & 63; F.wave = __builtin_amdgcn_readfirstlane(F.tid >> 6);
    F.G = gridDim.x; { const int bx = blockIdx.x; F.vcu = (F.G % 8 == 0) ? (bx % 8) * (F.G / 8) + bx / 8 : bx; }
#pragma unroll
    for (int i = 0; i < 19; ++i) F.in[i] = args.in[i];
    F.out = args.out; F.ws = args.ws;
    F.ctl = (GAS unsigned*)(args.ws + WS_CTL);
    for (int u = F.tid; u < (LDS_BYTES - MISC_OFF) / 4; u += NTHR) ((LAS unsigned*)(F.lds + MISC_OFF))[u] = 0u;
    __syncthreads();
    const int lo = args.ph_lo, hi = args.ph_hi;
    XcdBarrier bar; bar.bar = (unsigned*)(args.ws + WS_CTL) + CW_BAR; bar.x = 0; bar.st = nullptr;
    if (hi - lo > 1) bar = xcd_barrier_post((unsigned*)(args.ws + WS_CTL) + CW_BAR, F.MISC + 8);
#ifndef PH_MASK
#define PH_MASK 0xFFFF
#endif
#define IN(k) (((PH_MASK >> (k)) & 1) && lo <= (k) && (k) < hi)
#define SEAM(k) do { if (IN(k) && IN((k) + 1)) xcd_barrier(bar); } while (0)
    const int gw = F.vcu * NWAVES + F.wave, NGW = F.G * NWAVES;

    if (IN(0)) { p0_prologue(F); }
    SEAM(0);
    if (IN(1)) {
        pg8::Dense P; P.init((const bf16_t*)(F.ws + WS_U), (const bf16_t*)(F.ws + WS_WINT), M, NP, DM, F.G, (int)blockIdx.x);
        EpiProj E{F.ws};
        pg8::gemm_phase<EpiProj, pg8::Dense, false, true, true>(F.lds, P, E);
    }
    SEAM(1);
    if (IN(2)) {
        for (int it = F.vcu; it < 1024 + 512; it += F.G) { if (it < 1024) gdn_prep_item(F, it); else ret_kv_item(F, it - 1024); }
    }
    SEAM(2);
    if (IN(3)) {
        if (F.wave == 0) { for (int ch = F.vcu; ch < 256; ch += F.G) gdn_scan_chain(F, ch); }
        else { for (int t = F.vcu * 7 + (F.wave - 1); t < 2048; t += F.G * 7) ret_prefix_task(F, t); }
    }
    SEAM(3);
    if (IN(4)) {
        for (int it = F.vcu; it < 512; it += F.G) ret_out_item(F, it);
        for (int m = gw; m < M; m += NGW) gdn_normgate_row(F, m);
    }
    SEAM(4);
    if (IN(5)) {
        { pg8::Dense P; P.init((const bf16_t*)((unsigned char*)F.out + DO_YA), (const bf16_t*)(F.ws + WS_WUPA), M, DM, 512, F.G, (int)blockIdx.x);
          EpiUp1 E{F.ws}; pg8::gemm_phase<EpiUp1, pg8::Dense, false, false, true>(F.lds, P, E); }
        { pg8::Dense P; P.init((const bf16_t*)((unsigned char*)F.out + DO_YB), (const bf16_t*)(F.ws + WS_WUPR), M, DM, 1024, F.G, (int)blockIdx.x);
          EpiUp2 E{F.ws}; pg8::gemm_phase<EpiUp2, pg8::Dense, false, false, true>(F.lds, P, E); }
    }
    SEAM(5);
    if (IN(6)) {
        pg8::Dense P; P.init((const bf16_t*)(F.ws + WS_MERGED), (const bf16_t*)(F.ws + WS_WOUT), M, DM, DM, F.G, (int)blockIdx.x);
        EpiOut E{F.in[I_X], F.out}; pg8::gemm_phase<EpiOut, pg8::Dense, false, false, true>(F.lds, P, E);
    }
    SEAM(6);
    if (IN(7)) { p7_router(F); }
    SEAM(7);
    if (IN(8)) {
        moe_toff(F);
        MoeProb P; P.toff = (const LAS int*)(F.lds + TOFF_OFF); P.cnt = (const unsigned*)(F.ws + WS_CTL) + CW_CNT; P.ltok = (const int*)(F.ws + WS_LTOK);
        P.A = (const bf16_t*)(F.ws + WS_XN); P.Bt = (const bf16_t*)(F.ws + WS_WGU); P.K = 1024; P.G = F.G; P.c = F.vcu; P.total = 4 * P.toff[NE];
        EpiGU E{(bf16_t*)(F.ws + WS_HID)};
        pg8::gemm_phase<EpiGU, MoeProb, true, true, true>(F.lds, P, E);
    }
    SEAM(8);
    if (IN(9)) {
        moe_toff(F);
        MoeProbD P; P.toff = (const LAS int*)(F.lds + TOFF_OFF); P.cnt = (const unsigned*)(F.ws + WS_CTL) + CW_CNT; P.ltok = (const int*)(F.ws + WS_LTOK);
        P.A = (const bf16_t*)(F.ws + WS_HID); P.Bt = (const bf16_t*)(F.ws + WS_WD); P.K = 512; P.G = F.G; P.c = F.vcu; P.total = 4 * P.toff[NE];
        EpiDown E{(bf16_t*)(F.ws + WS_Y2), (const int*)(F.ws + WS_LDST), (const float*)(F.ws + WS_LW)};
        pg8::gemm_phase<EpiDown, MoeProbD, false, true, true>(F.lds, P, E);
    }
    SEAM(9);
    if (IN(10)) { for (int m = gw; m < M; m += NGW) final_row(F, m); }
#undef IN
#undef SEAM
}

extern "C" void kernel_launch(void* const* d_in, const int* in_sizes, int n_in, void* d_out, int out_size, void* d_ws, size_t ws_size, hipStream_t stream) {
    static int grid = 0;
    if (grid == 0) {
        if (n_in != 19 || in_sizes[0] != M * DM || out_size != M * DM || ws_size < WS_END) {
            fprintf(stderr, "kernel_launch: unexpected problem (n_in %d, in0 %d, out %d, ws %zu < %zu); nothing launched\n", n_in, n_in > 0 ? in_sizes[0] : -1, out_size, ws_size, (size_t)WS_END); grid = -1; return; }
        int dev = 0, cus = 0;
        if (hipGetDevice(&dev) != hipSuccess || hipDeviceGetAttribute(&cus, hipDeviceAttributeMultiprocessorCount, dev) != hipSuccess) { grid = -1; return; }
        if (hipFuncSetAttribute((const void*)hgrh_fwd, hipFuncAttributeMaxDynamicSharedMemorySize, LDS_BYTES) != hipSuccess) { fprintf(stderr, "kernel_launch: hipFuncSetAttribute failed\n"); grid = -1; return; }
        int per_cu = 0;
        if (hipOccupancyMaxActiveBlocksPerMultiprocessor(&per_cu, (const void*)hgrh_fwd, NTHR, LDS_BYTES) != hipSuccess || per_cu < 1)
            fprintf(stderr, "kernel_launch: occupancy query reports %d workgroups per CU\n", per_cu);
        (void)hipGetLastError();
        grid = cus;
    }
    if (grid < 0) return;
    (void)hipMemsetAsync((char*)d_ws + WS_CTL, 0, CTL_ZERO_BYTES, stream);
    Args a{};
    for (int i = 0; i < 19; ++i) a.in[i] = (const float*)d_in[i];
    a.out = (float*)d_out; a.ws = (unsigned char*)d_ws;
#if MK_N_LAUNCHES == 1
    a.ph_lo = 0; a.ph_hi = NPH;
    hipLaunchKernelGGL(hgrh_fwd, dim3(grid), dim3(NTHR), LDS_BYTES, stream, a);
#else
    for (int p = 0; p < NPH; ++p) { a.ph_lo = p; a.ph_hi = p + 1; hipLaunchKernelGGL(hgrh_fwd, dim3(grid), dim3(NTHR), LDS_BYTES, stream, a); }
#endif
}
```

```cpp
#include <hip/hip_runtime.h>
#include <cstdio>
#include <cstdint>

#ifndef MK_N_LAUNCHES
#define MK_N_LAUNCHES 1
#endif

#ifndef REP_MASK
#define REP_MASK 0
#endif
#define REPS(k) (((REP_MASK >> (k)) & 1) ? 2 : 1)
#define LAS __attribute__((address_space(3)))
#define GAS __attribute__((address_space(1)))
typedef unsigned short bf16_t;
typedef short bf16x8 __attribute__((ext_vector_type(8)));
typedef short bf16x4 __attribute__((ext_vector_type(4)));
typedef float f32x4 __attribute__((ext_vector_type(4)));
typedef float f32x2 __attribute__((ext_vector_type(2)));
typedef unsigned u32x4 __attribute__((ext_vector_type(4)));
typedef unsigned u32x2 __attribute__((ext_vector_type(2)));

constexpr int BATCH = 8, SEQ = 2048, DM = 1024, M = BATCH * SEQ;
constexpr int D_IN = 7176, NP = 7168;
constexpr int NE = 32, DE = 512;
constexpr float EPS = 1e-6f;
constexpr int NWAVES = 8, NTHR = 512;
constexpr int NPH = 11;

constexpr size_t MiB = 1u << 20;
constexpr size_t WS_CTL = 0, CTL_ZERO_BYTES = 1 * MiB;
constexpr size_t WS_LTOK = 1 * MiB, WS_LDST = 3 * MiB, WS_LW = 5 * MiB;
constexpr size_t WS_ROPE = 7 * MiB;
constexpr size_t WS_G = 8 * MiB, WS_BETA = 8 * MiB + 256 * 1024;
constexpr size_t WS_WUPA = 9 * MiB, WS_WUPR = 10 * MiB, WS_WOUT = 12 * MiB;
constexpr size_t WS_WRT = 14 * MiB;
constexpr size_t WS_SSQ = 15 * MiB;
constexpr size_t WS_GQKV = 18 * MiB;
constexpr size_t WS_OGDN = 18 * MiB;
constexpr size_t WS_YB = 34 * MiB;
constexpr size_t WS_YA = 274 * MiB;
constexpr size_t WS_XN = 18 * MiB;
constexpr size_t WS_Y2 = 18 * MiB;
constexpr size_t WS_GZ = 66 * MiB;
constexpr size_t WS_RQK = 82 * MiB;
constexpr size_t WS_RV = 114 * MiB;
constexpr size_t WS_TMP = 82 * MiB;
constexpr size_t WS_WGU = 82 * MiB;
constexpr size_t WS_RG = 146 * MiB;
constexpr size_t WS_WD = 146 * MiB;
constexpr size_t WS_MAB = 178 * MiB;
constexpr size_t WS_HID = 178 * MiB;
constexpr size_t WS_U = 242 * MiB;
constexpr size_t WS_KV = 242 * MiB;
constexpr size_t WS_MERGED = 242 * MiB;
constexpr size_t WS_WINT = 274 * MiB;
constexpr size_t WS_UT = 274 * MiB;
constexpr size_t WS_END = 290 * MiB;
constexpr size_t GP_BYTES = 57344;
constexpr int GP_W = 0, GP_Q = 8192, GP_K = 16384, GP_A = 24576;
constexpr size_t DO_YA = 0, DO_YB = 16 * MiB;

constexpr int CW_TMO = 0;
constexpr int CW_CNT = 64;
constexpr int CW_PFX = 256;
constexpr int CW_BAR = 4096;

constexpr int RING_BYTES = 131072;
constexpr int MISC_OFF = RING_BYTES;
constexpr int LDS_BYTES = 147456;

#define LDS_WAIT() asm volatile("s_waitcnt lgkmcnt(0)" ::: "memory")
#define VM_WAIT() asm volatile("s_waitcnt vmcnt(0)" ::: "memory")
#define LBAR() do { asm volatile("s_waitcnt lgkmcnt(0)" ::: "memory"); __builtin_amdgcn_s_barrier(); asm volatile("" ::: "memory"); } while (0)
__device__ __forceinline__ unsigned f2bf(float f) { unsigned u = __builtin_bit_cast(unsigned, f); return (u + 0x7fffu + ((u >> 16) & 1u)) >> 16; }
typedef __bf16 bf16v2_t __attribute__((ext_vector_type(2)));
__device__ __forceinline__ unsigned pk2(float lo, float hi) { return __builtin_bit_cast(unsigned, __builtin_convertvector((f32x2){lo, hi}, bf16v2_t)); }
__device__ __forceinline__ float bf2f(unsigned short h) { return __builtin_bit_cast(float, (unsigned)h << 16); }
__device__ __forceinline__ float bflo(unsigned w) { return __builtin_bit_cast(float, w << 16); }
__device__ __forceinline__ float bfhi(unsigned w) { return __builtin_bit_cast(float, w & 0xffff0000u); }
template <int CTRL> __device__ __forceinline__ float dpp_f(float v) { return __builtin_bit_cast(float, __builtin_amdgcn_update_dpp(0, __builtin_bit_cast(int, v), CTRL, 0xf, 0xf, true)); }
__device__ __forceinline__ float row16_sum(float v) {
    v += dpp_f<0xB1>(v);
    v += dpp_f<0x4E>(v);
    v += dpp_f<0x141>(v);
    v += dpp_f<0x140>(v);
    return v;
}
__device__ __forceinline__ float rdlane(float v, int l) { return __builtin_bit_cast(float, __builtin_amdgcn_readlane(__builtin_bit_cast(int, v), l)); }
__device__ __forceinline__ float wave_sum(float v) {
    v = row16_sum(v);
    return (rdlane(v, 0) + rdlane(v, 16)) + (rdlane(v, 32) + rdlane(v, 48));
}
__device__ __forceinline__ float sigmoidf_(float x) { return __builtin_amdgcn_rcpf(1.0f + __builtin_amdgcn_exp2f(-1.4426950408889634f * x)); }
__device__ __forceinline__ float siluf_(float x) { return x * sigmoidf_(x); }
__device__ __forceinline__ float rsqrtf_(float x) { return __builtin_amdgcn_rsqf(x); }

#define XB_TMO      128
#define XB_XCNT(j)  (256  + 64 * (j))
#define XB_XSUB(j)  (1280 + 64 * (j))
#define XB_XGEN(j)  (2304 + 64 * (j))
#define XB_TOP      3328
#define XB_TOPGEN   3392
#define XCD_BAR_WORDS 3456
#define XB_SPIN_CAP (1u << 18)
__device__ __forceinline__ unsigned xb_ld(unsigned* p)              { return __hip_atomic_load(p, __ATOMIC_RELAXED, __HIP_MEMORY_SCOPE_AGENT); }
__device__ __forceinline__ unsigned xb_add(unsigned* p, unsigned v) { return __hip_atomic_fetch_add(p, v, __ATOMIC_RELAXED, __HIP_MEMORY_SCOPE_AGENT); }
__device__ __forceinline__ unsigned xb_xcc_id() { return (unsigned)__builtin_amdgcn_s_getreg((3 << 11) | 20) & 0xFu; }
#define XB_SPIN(cond, bar) do { unsigned _sp = 0; while (cond) { __builtin_amdgcn_s_sleep(1); \
    if ((++_sp & 255u) == 0u) { if (xb_ld(&(bar)[XB_TMO])) break; if (_sp > XB_SPIN_CAP) { atomicAdd(&(bar)[XB_TMO], 1u); break; } } } } while (0)
struct XcdBarrier { unsigned* bar; unsigned x; volatile LAS unsigned* st; };
__device__ __forceinline__ XcdBarrier xcd_barrier_post(unsigned* bar, volatile LAS unsigned* st) {
    XcdBarrier b; b.bar = bar; b.x = xb_xcc_id(); b.st = st;
    if (threadIdx.x == 0) (void)xb_add(&bar[XB_XCNT(b.x)], 1u);
    return b;
}
__device__ __forceinline__ void xcd_barrier_complete(unsigned* bar, unsigned x, unsigned& nloc, unsigned& nx) {
    const unsigned G = gridDim.x * gridDim.y * gridDim.z;
    unsigned sum, cnt, mine, sp = 0u;
    for (;;) {
        sum = 0u; cnt = 0u; mine = 0u;
#pragma unroll
        for (unsigned j = 0; j < 16; ++j) { const unsigned c = xb_ld(&bar[XB_XCNT(j)]); sum += c; cnt += (c > 0u) ? 1u : 0u; mine = (j == x) ? c : mine; }
        if (sum == G) break;
        __builtin_amdgcn_s_sleep(1);
        if ((++sp & 255u) == 0u) { if (xb_ld(&bar[XB_TMO])) break; if (sp > XB_SPIN_CAP) { atomicAdd(&bar[XB_TMO], 1u); break; } }
    }
    nloc = mine > 0u ? mine : 1u; nx = cnt > 0u ? cnt : 1u;
}
__device__ __forceinline__ void xcd_barrier(const XcdBarrier& b) {
    asm volatile("s_waitcnt vmcnt(0)" ::: "memory");
    __syncthreads();
    if (threadIdx.x == 0) {
        unsigned* bar = b.bar;
        __builtin_amdgcn_s_waitcnt(0);
        unsigned nloc = b.st[0], nx = b.st[1];
        if (nloc == 0u) { xcd_barrier_complete(bar, b.x, nloc, nx); b.st[0] = nloc; b.st[1] = nx; }
        const unsigned old = xb_add(&bar[XB_XSUB(b.x)], 1u);
        const unsigned gen = old / nloc;
        if (old + 1u == (gen + 1u) * nloc) {
            __builtin_amdgcn_fence(__ATOMIC_RELEASE, "agent");
            asm volatile("s_waitcnt vmcnt(0)" ::: "memory");
            const unsigned og = xb_add(&bar[XB_TOP], 1u);
            const unsigned tg = og / nx;
            if (og + 1u == (tg + 1u) * nx) xb_add(&bar[XB_TOPGEN], 1u);
            else XB_SPIN(xb_ld(&bar[XB_TOPGEN]) == tg, bar);
            __builtin_amdgcn_fence(__ATOMIC_ACQUIRE, "agent");
            xb_add(&bar[XB_XGEN(b.x)], 1u);
            asm volatile("s_waitcnt vmcnt(0)" ::: "memory");
        } else {
            XB_SPIN(xb_ld(&bar[XB_XGEN(b.x)]) == gen, bar);
            __builtin_amdgcn_fence(__ATOMIC_ACQUIRE, "agent");
            asm volatile("s_waitcnt vmcnt(0)" ::: "memory");
        }
    }
    __syncthreads();
}

namespace pg8 {
constexpr int BM = 256, BK = 64, HALF = 128, HTB = HALF * BK * 2, STAGE_BYTES = 8 * HTB, NXCD = 8, WGM = 8;
__host__ __device__ __forceinline__ int lds_byte(int r, int c) { const int st = (r >> 4) * 2 + (c >> 5), rr = r & 15, cc = c & 31, ob = rr * 64 + cc * 2; return st * 1024 + (ob ^ (((ob >> 9) & 1) << 5)); }
__host__ __device__ __forceinline__ void stage_rc(int b, int& R, int& C) { const int st = b / 1024, sb = b % 1024, swz = sb ^ (((sb >> 9) & 1) << 5); R = (st >> 1) * 16 + swz / 64; C = (st & 1) * 32 + (swz % 64) / 2; }
__host__ __device__ __forceinline__ int perm32(int rho) { const int n = rho >> 4, i = rho & 15; return 8 * (i >> 2) + 4 * n + (i & 3); }

struct Unit { int pm, pn, e, rows, base; };

__device__ __forceinline__ unsigned cvt_pk_bf16(float lo, float hi) { return pk2(lo, hi); }

struct Dense {
    const bf16_t* A; const bf16_t* Bt; int K; int nM, nN, nwg, G, c;
    __device__ void init(const bf16_t* A_, const bf16_t* Bt_, int M_, int N_, int K_, int G_, int c_) { A = A_; Bt = Bt_; K = K_; nM = M_ / BM; nN = N_ / BM; nwg = nM * nN; G = G_; c = c_; }
    __device__ __forceinline__ bool next(int i, Unit& u) const {
        const long L = (long)i * G + c; if (L >= nwg) return false;
        int wgid = (int)L; { const int q = nwg / NXCD, r = nwg % NXCD, xcd = wgid % NXCD, off = wgid / NXCD; wgid = (xcd < r ? xcd * (q + 1) : r * (q + 1) + (xcd - r) * q) + off; }
        const int nig = WGM * nN, gid = wgid / nig, fm = gid * WGM, gsz = (nM - fm) < WGM ? (nM - fm) : WGM;
        u.pm = fm + ((wgid % nig) % gsz); u.pn = (wgid % nig) / gsz; u.e = 0; u.rows = 256; u.base = 0; return true;
    }
    __device__ __forceinline__ const char* a_ptr(const Unit& u) const { return (const char*)A + (size_t)u.pm * (size_t)(2 * HALF) * K * 2; }
    __device__ __forceinline__ const char* b_ptr(const Unit& u) const { return (const char*)Bt + (size_t)u.pn * (size_t)(2 * HALF) * K * 2; }
};

template <class Epi, class Prob, bool GATHER, bool ALIGN_EPI, bool SP2, int ACCMODE = 0>
__device__ __forceinline__ void gemm_phase(LAS unsigned char* lds, const Prob& S, const Epi& E, f32x4 (*xacc)[2][4][2] = nullptr) {
    const int tid = threadIdx.x, wid = __builtin_amdgcn_readfirstlane(tid >> 6), lane = tid & 63, wr = wid >> 2, wc = wid & 3, fr = lane & 15, fq = lane >> 4;
    const int K = S.K, nt = K / BK;
    unsigned voffB[2]; int RA[2], CA[2];
    unsigned cvo[2][2], nvo[2][2];
#pragma unroll
    for (int i = 0; i < 2; ++i) { int R, C; stage_rc(tid * 16 + i * 8192, R, C); const int Rb = Epi::PERM ? ((R & ~31) + perm32(R & 31)) : R;
        RA[i] = R; CA[i] = C; voffB[i] = (unsigned)(Rb * K + C) * 2u; }
    const size_t kstep = (size_t)(BK * 2);
    const size_t hstep = (size_t)HALF * K * 2;
    const unsigned ldsw = (unsigned)wid * 1024u;
    const int aoff = lds_byte(wr * 64 + fr, fq * 8), boff = lds_byte(wc * 32 + fr, fq * 8);
#define PG8_SA(b, h) (((b) * 2 + (h)) * HTB)
#define PG8_SB(b, h) ((4 + (b) * 2 + (h)) * HTB)
#define PG8_STAGE(bufoff, gbase, voff) do { _Pragma("unroll") for (int _i = 0; _i < 2; ++_i) \
        __builtin_amdgcn_global_load_lds((const unsigned*)((const char*)(gbase) + (voff)[_i]), (LAS unsigned*)(lds + (bufoff) + ldsw + _i * 8192), 16, 0, 0); } while (0)
#define PG8_LDA(dst, b, h) do { _Pragma("unroll") for (int m = 0; m < 4; ++m) _Pragma("unroll") for (int k = 0; k < 2; ++k) dst[m][k] = *(const LAS bf16x8*)(lds + PG8_SA(b, h) + aoff + m * 2048 + k * 1024); } while (0)
#define PG8_LDB(dst, b, h) do { _Pragma("unroll") for (int n = 0; n < 2; ++n) _Pragma("unroll") for (int k = 0; k < 2; ++k) dst[n][k] = *(const LAS bf16x8*)(lds + PG8_SB(b, h) + boff + n * 2048 + k * 1024); } while (0)
#define PG8_MMA(ai, bj, At, Bt) do { __builtin_amdgcn_s_setprio(1); _Pragma("unroll") for (int m = 0; m < 4; ++m) _Pragma("unroll") for (int n = 0; n < 2; ++n) _Pragma("unroll") for (int k = 0; k < 2; ++k) \
        acc[ai][bj][m][n] = __builtin_amdgcn_mfma_f32_16x16x32_bf16(Bt[n][k], At[m][k], acc[ai][bj][m][n], 0, 0, 0); __builtin_amdgcn_s_setprio(0); } while (0)
#define PG8_WAIT_V(n) asm volatile("s_waitcnt vmcnt(" #n ")" ::: "memory")
#define PG8_WAIT_L(n) asm volatile("s_waitcnt lgkmcnt(" #n ")" ::: "memory")
#define PG8_BAR __builtin_amdgcn_s_barrier()
#define PG8_SCHED __builtin_amdgcn_sched_barrier(0)
    Unit cur, nxt; int ui = 0;
    if (!S.next(0, cur)) return;
    f32x4 acc_local[2][2][4][2];
    f32x4 (&acc)[2][2][4][2] = (ACCMODE == 0) ? acc_local : *(f32x4 (*)[2][2][4][2])xacc;
    if constexpr (ACCMODE != 2) {
#pragma unroll
    for (int a = 0; a < 2; ++a)
#pragma unroll
        for (int b = 0; b < 2; ++b)
#pragma unroll
            for (int m = 0; m < 4; ++m)
#pragma unroll
                for (int n = 0; n < 2; ++n) acc[a][b][m][n] = (f32x4){0.f, 0.f, 0.f, 0.f};
    }
    bf16x8 At[4][2], B0[2][2], B1[2][2];
    const char* cA = S.a_ptr(cur); const char* cB = S.b_ptr(cur);
#pragma unroll
    for (int h = 0; h < 2; ++h)
#pragma unroll
        for (int i = 0; i < 2; ++i) {
            if constexpr (GATHER) cvo[h][i] = (unsigned)(((size_t)S.a_row(cur, h * HALF + RA[i]) * K + CA[i]) * 2u);
            else cvo[h][i] = (unsigned)((RA[i] * K + CA[i]) * 2u + h * hstep);
            nvo[h][i] = cvo[h][i];
        }
    if constexpr (SP2) {
        PG8_STAGE(PG8_SB(0, 0), cB, voffB); PG8_STAGE(PG8_SB(0, 1), cB + hstep, voffB); PG8_STAGE(PG8_SA(0, 0), cA, cvo[0]); PG8_STAGE(PG8_SA(0, 1), cA, cvo[1]);
        if (wr == 1) PG8_BAR;
        PG8_WAIT_V(2); PG8_BAR;
        PG8_STAGE(PG8_SB(1, 0), cB + kstep, voffB); PG8_STAGE(PG8_SA(1, 0), cA + kstep, cvo[0]); PG8_STAGE(PG8_SB(1, 1), cB + hstep + kstep, voffB);
        PG8_WAIT_V(6); PG8_BAR;
    } else {
        PG8_STAGE(PG8_SB(0, 0), cB, voffB); PG8_STAGE(PG8_SA(0, 0), cA, cvo[0]); PG8_STAGE(PG8_SB(0, 1), cB + hstep, voffB); PG8_STAGE(PG8_SA(0, 1), cA, cvo[1]);
        if (wr == 1) PG8_BAR;
        PG8_WAIT_V(4); PG8_BAR;
        PG8_STAGE(PG8_SB(1, 0), cB + kstep, voffB); PG8_STAGE(PG8_SA(1, 0), cA + kstep, cvo[0]); PG8_STAGE(PG8_SB(1, 1), cB + hstep + kstep, voffB);
        PG8_WAIT_V(6); PG8_BAR;
    }
    for (;;) {
        const bool has_next = (ACCMODE == 0) ? S.next(ui + 1, nxt) : false;
        const char* nA = has_next ? S.a_ptr(nxt) : cA; const char* nB = has_next ? S.b_ptr(nxt) : cB;
        if constexpr (GATHER) {
#pragma unroll
            for (int h = 0; h < 2; ++h)
#pragma unroll
                for (int i = 0; i < 2; ++i) nvo[h][i] = has_next ? (unsigned)(((size_t)S.a_row(nxt, h * HALF + RA[i]) * K + CA[i]) * 2u) : cvo[h][i];
        }
        for (int t = 0; t < nt; t += 2) {
            const bool last = (t == nt - 2);
            const char* a1 = cA + (size_t)(t + 1) * kstep;
            const char* a2 = last ? nA : cA + (size_t)(t + 2) * kstep; const char* b2 = last ? nB : cB + (size_t)(t + 2) * kstep;
            const char* a3 = a2 + kstep; const char* b3 = b2 + kstep;
            unsigned v2[2][2];
#pragma unroll
            for (int h = 0; h < 2; ++h)
#pragma unroll
                for (int i = 0; i < 2; ++i) v2[h][i] = (GATHER && last) ? nvo[h][i] : cvo[h][i];
            if constexpr (SP2) {
            PG8_LDB(B0, 0, 0); PG8_LDB(B1, 0, 1); PG8_SCHED; PG8_LDA(At, 0, 0); PG8_STAGE(PG8_SA(1, 1), a1, cvo[1]);
            PG8_WAIT_V(8); PG8_WAIT_L(0); PG8_BAR; PG8_MMA(0, 0, At, B0); PG8_MMA(0, 1, At, B1); PG8_BAR; PG8_SCHED;
            PG8_LDA(At, 0, 1); PG8_STAGE(PG8_SB(0, 0), b2, voffB); PG8_STAGE(PG8_SB(0, 1), b2 + hstep, voffB); PG8_STAGE(PG8_SA(0, 0), a2, v2[0]);
            PG8_WAIT_V(8); PG8_WAIT_L(0); PG8_BAR; PG8_MMA(1, 0, At, B0); PG8_MMA(1, 1, At, B1); PG8_BAR; PG8_SCHED;
            PG8_LDB(B0, 1, 0); PG8_LDB(B1, 1, 1); PG8_SCHED; PG8_LDA(At, 1, 0); PG8_STAGE(PG8_SA(0, 1), a2, v2[1]);
            PG8_WAIT_V(8); PG8_WAIT_L(0); PG8_BAR; PG8_MMA(0, 0, At, B0); PG8_MMA(0, 1, At, B1); PG8_BAR; PG8_SCHED;
            PG8_LDA(At, 1, 1); PG8_STAGE(PG8_SB(1, 0), b3, voffB); PG8_STAGE(PG8_SB(1, 1), b3 + hstep, voffB); PG8_STAGE(PG8_SA(1, 0), a3, v2[0]);
            PG8_WAIT_V(8); PG8_WAIT_L(0); PG8_BAR; PG8_MMA(1, 0, At, B0); PG8_MMA(1, 1, At, B1); PG8_BAR; PG8_SCHED;
            } else {
            PG8_LDB(B0, 0, 0); PG8_SCHED; PG8_LDA(At, 0, 0); PG8_STAGE(PG8_SA(1, 1), a1, cvo[1]);
            PG8_WAIT_L(8); PG8_BAR; PG8_WAIT_L(0); PG8_MMA(0, 0, At, B0); PG8_BAR; PG8_SCHED;
            PG8_LDB(B1, 0, 1); PG8_STAGE(PG8_SB(0, 0), b2, voffB);
            PG8_BAR; PG8_WAIT_L(0); PG8_MMA(0, 1, At, B1); PG8_BAR;
            PG8_LDA(At, 0, 1); PG8_STAGE(PG8_SA(0, 0), a2, v2[0]);
            PG8_BAR; PG8_WAIT_L(0); PG8_MMA(1, 0, At, B0); PG8_BAR; PG8_SCHED;
            PG8_STAGE(PG8_SB(0, 1), b2 + hstep, voffB);
            PG8_WAIT_V(6); PG8_BAR; PG8_MMA(1, 1, At, B1); PG8_BAR;
            PG8_LDB(B0, 1, 0); PG8_SCHED; PG8_LDA(At, 1, 0); PG8_STAGE(PG8_SA(0, 1), a2, v2[1]);
            PG8_WAIT_L(8); PG8_BAR; PG8_WAIT_L(0); PG8_MMA(0, 0, At, B0); PG8_BAR; PG8_SCHED;
            PG8_LDB(B1, 1, 1); PG8_STAGE(PG8_SB(1, 0), b3, voffB);
            PG8_BAR; PG8_WAIT_L(0); PG8_MMA(0, 1, At, B1); PG8_BAR;
            PG8_LDA(At, 1, 1); PG8_STAGE(PG8_SA(1, 0), a3, v2[0]);
            PG8_BAR; PG8_WAIT_L(0); PG8_MMA(1, 0, At, B0); PG8_BAR; PG8_SCHED;
            PG8_STAGE(PG8_SB(1, 1), b3 + hstep, voffB);
            PG8_WAIT_V(6); PG8_BAR; PG8_MMA(1, 1, At, B1); PG8_BAR;
            }
        }
        if constexpr (ALIGN_EPI) { if (wr == 0) PG8_BAR; }
        E(acc, cur, wr, wc, fr, fq);
        if (!has_next) break;
#pragma unroll
        for (int a = 0; a < 2; ++a)
#pragma unroll
            for (int b = 0; b < 2; ++b)
#pragma unroll
                for (int m = 0; m < 4; ++m)
#pragma unroll
                    for (int n = 0; n < 2; ++n) acc[a][b][m][n] = (f32x4){0.f, 0.f, 0.f, 0.f};
        cur = nxt; cA = nA; cB = nB; ++ui;
#pragma unroll
        for (int h = 0; h < 2; ++h)
#pragma unroll
            for (int i = 0; i < 2; ++i) cvo[h][i] = nvo[h][i];
        if constexpr (ALIGN_EPI) { if (wr == 1) PG8_BAR; }
    }
    PG8_WAIT_V(0);
    if constexpr (!ALIGN_EPI) { if (wr == 0) PG8_BAR; }
    PG8_BAR;
#undef PG8_SA
#undef PG8_SB
#undef PG8_STAGE
#undef PG8_LDA
#undef PG8_LDB
#undef PG8_MMA
#undef PG8_WAIT_V
#undef PG8_WAIT_L
#undef PG8_BAR
#undef PG8_SCHED
}
}

struct Frame {
    LAS unsigned char* lds;
    volatile LAS unsigned* MISC;
    GAS unsigned* ctl;
    int tid, lane, wave;
    int vcu, G;
    const float* in[19];
    float* out; unsigned char* ws;
};
enum { I_X = 0, I_NMW, I_WIN, I_CONVW, I_ALOG, I_DTB, I_GNW, I_WUPG, I_WUPR, I_WOUT, I_NFW, I_WGRP, I_BGRP, I_WEXP, I_BEXP, I_WGATE, I_WUP, I_WDOWN, I_NFINW };

struct TrItem { const float* W; bf16_t* WT; int ldw, col0, K, row0, k0; };
__device__ __forceinline__ void tr_load(const TrItem& t, int lane, f32x4 (&ld)[8]) {
#pragma unroll
    for (int i = 0; i < 8; ++i) ld[i] = *(const f32x4*)(t.W + (size_t)(t.k0 + i * 8 + (lane >> 3)) * t.ldw + t.col0 + (lane & 7) * 4);
}
__device__ __forceinline__ void tr_store(const TrItem& t, int lane, const f32x4 (&ld)[8], LAS float* scr) {
#pragma unroll
    for (int i = 0; i < 8; ++i) { LAS float* d = scr + (i * 8 + (lane >> 3)) * 33 + (lane & 7) * 4; d[0] = ld[i].x; d[1] = ld[i].y; d[2] = ld[i].z; d[3] = ld[i].w; }
    LDS_WAIT(); asm volatile("" ::: "memory");
    const int c = lane & 7;
#pragma unroll
    for (int j = 0; j < 4; ++j) { const int n = (lane >> 3) + 8 * j; const LAS float* sp = scr + (8 * c) * 33 + n;
        u32x4 o; o.x = pk2(sp[0 * 33], sp[1 * 33]); o.y = pk2(sp[2 * 33], sp[3 * 33]); o.z = pk2(sp[4 * 33], sp[5 * 33]); o.w = pk2(sp[6 * 33], sp[7 * 33]);
        *(GAS u32x4*)(t.WT + (size_t)(t.row0 + n) * t.K + t.k0 + 8 * c) = o; }
    LDS_WAIT(); asm volatile("" ::: "memory");
}
template <class Dec> __device__ __forceinline__ void tr_run(const Dec& dec, int first, int count, int stride, int lane, LAS float* scr) {
    if (first >= count) return;
    f32x4 la[8], lb[8];
    TrItem ta = dec(first), tb = ta;
    tr_load(ta, lane, la);
    for (int it = first; it < count; it += 2 * stride) {
        const bool hb = it + stride < count;
        if (hb) { tb = dec(it + stride); tr_load(tb, lane, lb); }
        tr_store(ta, lane, la, scr);
        const bool ha = it + 2 * stride < count;
        if (ha) { ta = dec(it + 2 * stride); tr_load(ta, lane, la); }
        if (hb) tr_store(tb, lane, lb, scr);
    }
}

__device__ __forceinline__ void p0_prologue(Frame& F) {
    LAS float* scr = (LAS float*)(F.lds + F.wave * 16384);
    const int gw = F.vcu * NWAVES + F.wave, NGW = F.G * NWAVES;
    unsigned char* ws = F.ws;
    {
        constexpr int I_IN = (DM / 64) * (NP / 32);
        constexpr int I_UA = (512 / 64) * (DM / 32);
        constexpr int I_UR = (1024 / 64) * (DM / 32);
        constexpr int I_WO = (1024 / 64) * (DM / 32);
        constexpr int NIT = I_IN + I_UA + I_UR + I_WO;
        const float* win = F.in[I_WIN]; const float* wua = F.in[I_WUPG]; const float* wur = F.in[I_WUPR]; const float* wo = F.in[I_WOUT];
        auto dec = [=](int it) -> TrItem {
            int r = it; TrItem t;
            if (r < I_IN) { const int nb = r % (NP / 32), kb = r / (NP / 32); const int n0 = nb * 32;
                t.W = win; t.ldw = D_IN; t.col0 = n0 + (n0 >= 1536 ? 8 : 0); t.WT = (bf16_t*)(ws + WS_WINT); t.K = DM; t.row0 = n0; t.k0 = kb * 64; return t; }
            r -= I_IN;
            if (r < I_UA) { const int nb = r % 32, kb = r / 32; t.W = wua; t.ldw = DM; t.col0 = nb * 32; t.WT = (bf16_t*)(ws + WS_WUPA); t.K = 512; t.row0 = nb * 32; t.k0 = kb * 64; return t; }
            r -= I_UA;
            if (r < I_UR) { const int nb = r % 32, kb = r / 32; t.W = wur; t.ldw = DM; t.col0 = nb * 32; t.WT = (bf16_t*)(ws + WS_WUPR); t.K = 1024; t.row0 = nb * 32; t.k0 = kb * 64; return t; }
            r -= I_UR;
            { const int nb = r % 32, kb = r / 32; t.W = wo; t.ldw = DM; t.col0 = nb * 32; t.WT = (bf16_t*)(ws + WS_WOUT); t.K = 1024; t.row0 = nb * 32; t.k0 = kb * 64; return t; }
        };
        tr_run(dec, gw, NIT, NGW, F.lane, scr);
    }
    {
        GAS f32x2* tab = (GAS f32x2*)(ws + WS_ROPE);
        const int gt = (F.vcu * NTHR + F.tid), NGT = F.G * NTHR;
        for (int i = gt; i < SEQ * 64; i += NGT) {
            const int t = i >> 6, p = i & 63;
            const float invf = 1.0f / powf(10000.0f, (float)p * (1.0f / 63.0f));
            const float ang = (float)t * invf;
            float s, c; sincosf(ang, &s, &c);
            tab[i] = (f32x2){c, s};
        }
    }
    {
        GAS float* wrt = (GAS float*)(ws + WS_WRT);
        const int gt = (F.vcu * NTHR + F.tid), NGT = F.G * NTHR;
        for (int i = gt; i < 48 * DM; i += NGT) {
            const int j = i / DM, k = i % DM;
            const float nf = F.in[I_NFW][k];
            wrt[i] = j < 4 ? F.in[I_WGRP][k * 4 + j] * nf : (j < 36 ? F.in[I_WEXP][k * 32 + (j - 4)] * nf : 0.f);
        }
    }
    {
        __syncthreads();
        LAS float* wab2 = (LAS float*)F.lds;
        for (int idx = F.tid; idx < 8192; idx += NTHR) { const int k = idx >> 3, q = idx & 7; const int j = k >> 8, l_ = (k & 255) >> 2, e = k & 3;
            wab2[((j * 4 + e) * 64 + l_) * 8 + q] = F.in[I_WIN][(size_t)k * D_IN + 1536 + q]; }
        __syncthreads();
        const float* nw = F.in[I_NMW];
        f32x4 wv[4];
#pragma unroll
        for (int j = 0; j < 4; ++j) wv[j] = *(const f32x4*)(nw + 4 * F.lane + 256 * j);
        float alog = 0.f, dtb = 0.f;
        if (F.lane < 4) { alog = F.in[I_ALOG][F.lane]; dtb = F.in[I_DTB][F.lane]; }
        for (int m = gw; m < M; m += NGW) {
            const GAS f32x4* xr = (const GAS f32x4*)(F.in[I_X] + (size_t)m * DM) + F.lane;
            f32x4 v[4]; float s = 0.f;
#pragma unroll
            for (int j = 0; j < 4; ++j) { v[j] = xr[64 * j]; s += (v[j].x * v[j].x + v[j].y * v[j].y) + (v[j].z * v[j].z + v[j].w * v[j].w); }
            const float rstd = 1.0f / sqrtf(wave_sum(s) * (1.f / DM) + EPS);
            float ab[8];
#pragma unroll
            for (int q = 0; q < 8; ++q) ab[q] = 0.f;
            GAS unsigned long long* o8 = (GAS unsigned long long*)((bf16_t*)(ws + WS_U) + (size_t)m * DM) + F.lane;
#pragma unroll
            for (int j = 0; j < 4; ++j) {
                v[j] = v[j] * rstd * wv[j];
                o8[64 * j] = (unsigned long long)pk2(v[j].x, v[j].y) | ((unsigned long long)pk2(v[j].z, v[j].w) << 32);
#pragma unroll
                for (int e = 0; e < 4; ++e) {
                    const LAS f32x4* wp = (const LAS f32x4*)(wab2 + ((j * 4 + e) * 64 + F.lane) * 8);
                    const f32x4 w0 = wp[0], w1 = wp[1];
                    const float xv = v[j][e];
                    ab[0] += xv * w0.x; ab[1] += xv * w0.y; ab[2] += xv * w0.z; ab[3] += xv * w0.w;
                    ab[4] += xv * w1.x; ab[5] += xv * w1.y; ab[6] += xv * w1.z; ab[7] += xv * w1.w;
                }
            }
#pragma unroll
            for (int q = 0; q < 8; ++q) ab[q] = wave_sum(ab[q]);
            if (F.lane < 4) {
                const float a = F.lane == 0 ? ab[0] : F.lane == 1 ? ab[1] : F.lane == 2 ? ab[2] : ab[3];
                const float b = F.lane == 0 ? ab[4] : F.lane == 1 ? ab[5] : F.lane == 2 ? ab[6] : ab[7];
                const float z = a + dtb;
                const float sp = z > 20.f ? z : log1pf(__expf(z));
                ((GAS float*)(ws + WS_G))[(size_t)m * 4 + F.lane] = -__expf(alog) * sp;
                ((GAS float*)(ws + WS_BETA))[(size_t)m * 4 + F.lane] = 1.0f / (1.0f + __expf(-b));
            }
        }
    }
}

struct EpiProj {
    static constexpr bool PERM = true;
    unsigned char* ws;
    __device__ __forceinline__ void operator()(const f32x4 (&acc)[2][2][4][2], const pg8::Unit& u, int wr, int wc, int fr, int fq) const {
        const int pn = u.pn; bf16_t* base; int ldc, colt, mode = 0;
        if (pn < 6) { base = (bf16_t*)(ws + WS_GQKV); ldc = 1536; colt = 256 * pn; }
        else if (pn < 8) { base = (bf16_t*)(ws + WS_GZ); ldc = 512; colt = 256 * (pn - 6); }
        else if (pn < 12) { base = (bf16_t*)(ws + WS_RQK); ldc = 1024; colt = 256 * (pn - 8); mode = pn < 10 ? 1 : 2; }
        else if (pn < 16) { base = (bf16_t*)(ws + WS_RV); ldc = 1024; colt = 256 * (pn - 12); }
        else if (pn < 20) { base = (bf16_t*)(ws + WS_RG); ldc = 1024; colt = 256 * (pn - 16); }
        else { base = (bf16_t*)(ws + WS_MAB); ldc = 2048; colt = 256 * (pn - 20); }
        const int row0 = u.pm * 256 + wr * 64 + fr, col0 = colt + wc * 32 + 8 * fq;
        const float sc = mode == 2 ? 0.08838834764831845f : 1.0f;
        const GAS f32x4* tab = (const GAS f32x4*)(ws + WS_ROPE);
#pragma unroll
        for (int ai = 0; ai < 2; ++ai)
#pragma unroll
            for (int m = 0; m < 4; ++m) {
                const int row = row0 + ai * 128 + m * 16;
                bf16_t* rowp = base + (size_t)row * ldc + col0;
                f32x4 cs0 = {1.f, 0.f, 1.f, 0.f}, cs1 = cs0;
                if (mode) { const GAS f32x4* tp = tab + ((size_t)(row & (SEQ - 1)) * 64 + wc * 16 + 4 * fq) / 2; cs0 = tp[0]; cs1 = tp[1]; }
#pragma unroll
                for (int bj = 0; bj < 2; ++bj) {
                    f32x4 v0 = acc[ai][bj][m][0], v1 = acc[ai][bj][m][1];
                    if (mode) {
                        f32x4 r0, r1;
                        r0[0] = v0[0] * cs0[0] - v0[1] * cs0[1]; r0[1] = v0[1] * cs0[0] + v0[0] * cs0[1];
                        r0[2] = v0[2] * cs0[2] - v0[3] * cs0[3]; r0[3] = v0[3] * cs0[2] + v0[2] * cs0[3];
                        r1[0] = v1[0] * cs1[0] - v1[1] * cs1[1]; r1[1] = v1[1] * cs1[0] + v1[0] * cs1[1];
                        r1[2] = v1[2] * cs1[2] - v1[3] * cs1[3]; r1[3] = v1[3] * cs1[2] + v1[2] * cs1[3];
                        v0 = r0 * sc; v1 = r1 * sc;
                    }
                    u32x4 w; w.x = pg8::cvt_pk_bf16(v0[0], v0[1]); w.y = pg8::cvt_pk_bf16(v0[2], v0[3]); w.z = pg8::cvt_pk_bf16(v1[0], v1[1]); w.w = pg8::cvt_pk_bf16(v1[2], v1[3]);
                    *(u32x4*)(rowp + bj * 128) = w;
                }
            }
    }
};

__device__ __forceinline__ f32x4 mma16(bf16x8 x, bf16x8 y, f32x4 c) { return __builtin_amdgcn_mfma_f32_16x16x32_bf16(x, y, c, 0, 0, 0); }
__device__ __forceinline__ bf16x8 lfrag(const LAS bf16_t* base, int ld, int row0, int k0, int fr, int fq) { return *(const LAS bf16x8*)(base + (row0 + fr) * ld + k0 + 8 * fq); }
__device__ __forceinline__ bf16x8 gfrag(const bf16_t* base, int ld, int row0, int k0, int fr, int fq) { return *(const bf16x8*)(base + (size_t)(row0 + fr) * ld + k0 + 8 * fq); }
__device__ __forceinline__ bf16x8 tfrag(const LAS bf16_t* base, int ld, int k0, int n0, int lane) {
    const int g = lane >> 4, q = (lane & 15) >> 2, p = lane & 3;
    const LAS bf16_t* a = base + (k0 + 8 * g + q) * ld + n0 + 4 * p;
    const bf16x4 v0 = __builtin_amdgcn_ds_read_tr16_b64_v4i16((LAS bf16x4*)a);
    const bf16x4 v1 = __builtin_amdgcn_ds_read_tr16_b64_v4i16((LAS bf16x4*)(a + 4 * ld));
    return (bf16x8){v0[0], v0[1], v0[2], v0[3], v1[0], v1[1], v1[2], v1[3]};
}
__device__ __forceinline__ bf16x8 pack_acc(f32x4 a, f32x4 b) {
    u32x4 w; w.x = pk2(a[0], a[1]); w.y = pk2(a[2], a[3]); w.z = pk2(b[0], b[1]); w.w = pk2(b[2], b[3]);
    return __builtin_bit_cast(bf16x8, w);
}
__device__ __forceinline__ int ppos(int kap) { return 8 * ((kap & 15) >> 2) + 4 * (kap >> 4) + (kap & 3); }
__device__ __forceinline__ int foff(int row, int col, int kc32) { const int p = ppos(col & 31); return ((row >> 4) * kc32 + (col >> 5)) * 512 + ((row & 15) + 16 * (p >> 3)) * 8 + (p & 7); }

constexpr size_t WS_GL = 8 * MiB + 512 * 1024;

__device__ __forceinline__ void gdn_prep_item(Frame& F, int idx) {
    const int bh = idx >> 5, n = idx & 31, b = bh >> 2, h = bh & 3;
    const int tok0 = b * SEQ + n * 64;
    LAS bf16_t* QN = (LAS bf16_t*)(F.lds);
    LAS bf16_t* KN = (LAS bf16_t*)(F.lds + 17408);
    LAS bf16_t* KT = (LAS bf16_t*)(F.lds + 34816);
    LAS bf16_t* VT = (LAS bf16_t*)(F.lds + 53248);
    LAS float*  LM = (LAS float*)(F.lds + 71680);
    LAS bf16_t* T1 = (LAS bf16_t*)(F.lds + 89088);
    LAS bf16_t* T2 = (LAS bf16_t*)(F.lds + 98304);
    LAS float*  SC = (LAS float*)(F.lds + 107520);
    LAS float*  SSQ = (LAS float*)(F.lds + 108544);
    const int tid = F.tid, lane = F.lane, fr = lane & 15, fq = lane >> 4, wave = F.wave;
    const bf16_t* GQKV = (const bf16_t*)(F.ws + WS_GQKV);
    float gpre = 0.f, bpre = 0.f;
    if (wave == 0) { gpre = ((const float*)(F.ws + WS_G))[(size_t)(tok0 + lane) * 4 + h]; bpre = ((const float*)(F.ws + WS_BETA))[(size_t)(tok0 + lane) * 4 + h]; }
    {
        u32x4 xw[2][7];
#pragma unroll
        for (int q = 0; q < 2; ++q) {
            const int task = tid + q * NTHR;
            const int cg = task % 48, tr = task / 48, part = cg >> 4, cl = (cg & 15) * 8, gcol = part * 512 + h * 128 + cl;
#pragma unroll
            for (int r = 0; r < 7; ++r) {
                const int tt = tr * 4 - 3 + r;
                xw[q][r] = (u32x4){0u, 0u, 0u, 0u};
                if (task < 768 && n * 64 + tt >= 0) xw[q][r] = *(const u32x4*)((const unsigned char*)GQKV + (unsigned)(((tok0 + tt) * 1536 + gcol) * 2));
            }
        }
#pragma unroll
        for (int q = 0; q < 2; ++q) {
            const int task = tid + q * NTHR;
            if (task < 768) {
                const int cg = task % 48, tr = task / 48, part = cg >> 4, cl = (cg & 15) * 8, gcol = part * 512 + h * 128 + cl;
                unsigned nat[4][4];
                float ssq[4];
#pragma unroll
                for (int t = 0; t < 4; ++t) ssq[t] = 0.f;
#pragma unroll
                for (int e2 = 0; e2 < 4; ++e2) {
                    float c0[4], c1[4];
#pragma unroll
                    for (int k = 0; k < 4; ++k) { const f32x2 cc = *(const f32x2*)(F.in[I_CONVW] + k * 1536 + gcol + 2 * e2); c0[k] = cc.x; c1[k] = cc.y; }
                    float xa[7], xb[7];
#pragma unroll
                    for (int r = 0; r < 7; ++r) { const unsigned w = xw[q][r][e2]; xa[r] = bflo(w); xb[r] = bfhi(w); }
                    float ya[4], yb[4];
#pragma unroll
                    for (int t = 0; t < 4; ++t) {
                        ya[t] = siluf_(c0[0] * xa[t] + c0[1] * xa[t + 1] + c0[2] * xa[t + 2] + c0[3] * xa[t + 3]);
                        yb[t] = siluf_(c1[0] * xb[t] + c1[1] * xb[t + 1] + c1[2] * xb[t + 2] + c1[3] * xb[t + 3]);
                        ssq[t] += ya[t] * ya[t] + yb[t] * yb[t];
                        nat[t][e2] = pk2(ya[t], yb[t]);
                    }
                    if (part >= 1) {
                        LAS bf16_t* Tt = part == 1 ? KT : VT;
                        u32x2 w; w.x = pk2(ya[0], ya[1]); w.y = pk2(ya[2], ya[3]);
                        *(LAS u32x2*)(Tt + (cl + 2 * e2) * 72 + tr * 4) = w;
                        w.x = pk2(yb[0], yb[1]); w.y = pk2(yb[2], yb[3]);
                        *(LAS u32x2*)(Tt + (cl + 2 * e2 + 1) * 72 + tr * 4) = w;
                    }
                }
                if (part < 2) {
                    LAS bf16_t* N = part == 0 ? QN : KN;
#pragma unroll
                    for (int t = 0; t < 4; ++t) {
                        SSQ[(part * 64 + tr * 4 + t) * 16 + (cg & 15)] = ssq[t];
                        *(LAS u32x4*)(N + (tr * 4 + t) * 136 + cl) = (u32x4){nat[t][0], nat[t][1], nat[t][2], nat[t][3]};
                    }
                }
            }
        }
    }
    LBAR();
    if (wave == 0) {
        const int c = lane;
        float sq = 0.f, sk = 0.f;
#pragma unroll
        for (int j = 0; j < 16; ++j) { sq += SSQ[c * 16 + j]; sk += SSQ[(64 + c) * 16 + j]; }
        const float rq = 1.0f / sqrtf(sq + EPS), rk = 1.0f / sqrtf(sk + EPS);
        const float g = gpre, be = bpre;
        float gc = g;
#pragma unroll
        for (int o = 1; o < 64; o <<= 1) { const float t = __shfl_up(gc, o); if (lane >= o) gc += t; }
        SC[c] = rq; SC[64 + c] = rk; SC[128 + c] = gc; SC[192 + c] = be;
        if (c == 63) ((float*)(F.ws + WS_GL))[idx] = gc;
    }
    LBAR();
    {
        bf16_t* ATT = (bf16_t*)((unsigned char*)F.out + (size_t)idx * GP_BYTES) + GP_A;
#pragma unroll 1
        for (int job = wave * 4; job < wave * 4 + 4; ++job) {
            const int which = job >> 4, it = (job >> 2) & 3, jt = job & 3;
            f32x4 acc = {0.f, 0.f, 0.f, 0.f};
            const LAS bf16_t* Y = which ? QN : KN;
#pragma unroll
            for (int ks = 0; ks < 4; ++ks) acc = mma16(lfrag(KN, 136, jt * 16, ks * 32, fr, fq), lfrag(Y, 136, it * 16, ks * 32, fr, fq), acc);
            const int i = it * 16 + fr, j0 = jt * 16 + 4 * fq;
            const float gci = SC[128 + i];
            if (which == 0) {
                const float fi = SC[192 + i] * SC[64 + i];
                f32x4 o;
#pragma unroll
                for (int r = 0; r < 4; ++r) { const int j = j0 + r; o[r] = (j < i) ? fi * SC[64 + j] * acc[r] * __expf(gci - SC[128 + j]) : 0.f; }
                *(LAS f32x4*)(LM + i * 68 + j0) = o;
            } else {
                const float fi = SC[i] * 0.08838834764831845f;
                float o[4];
#pragma unroll
                for (int r = 0; r < 4; ++r) { const int j = j0 + r; o[r] = (j <= i) ? fi * SC[64 + j] * acc[r] * __expf(gci - SC[128 + j]) : 0.f; }
                u32x2 w; w.x = pk2(o[0], o[1]); w.y = pk2(o[2], o[3]);
                *(u32x2*)(ATT + foff(i, j0, 2)) = w;
            }
        }
    }
    LBAR();
    if (wave == 0) {
        const int c = lane;
        int zero = 0; asm volatile("v_mov_b32 %0, 0" : "=v"(zero));
        const LAS float* LMv = LM + zero;
        const float b1 = SC[192 + c], b2 = b1 * SC[64 + c] * __expf(SC[128 + c]);
        unsigned t1a = (unsigned)(uintptr_t)(T1 + c), t2a = (unsigned)(uintptr_t)(T2 + c);
        asm volatile("" : "+v"(t1a), "+v"(t2a));
        LAS bf16_t* T1v = (LAS bf16_t*)(uintptr_t)t1a; LAS bf16_t* T2v = (LAS bf16_t*)(uintptr_t)t2a;
        float t[64];
#pragma unroll
        for (int i = 0; i < 64; ++i) {
            float ps[4] = {(i == c) ? 1.f : 0.f, 0.f, 0.f, 0.f};
#pragma unroll
            for (int j4 = 0; j4 < (i + 3) / 4; ++j4) {
                const f32x4 l = *(const LAS f32x4*)(LMv + i * 68 + 4 * j4);
#pragma unroll
                for (int e = 0; e < 4; ++e) if (4 * j4 + e < i) ps[e] -= l[e] * t[4 * j4 + e];
            }
            const float s = (ps[0] + ps[1]) + (ps[2] + ps[3]);
            t[i] = s;
            T1v[i * 72] = (bf16_t)f2bf(s * b1); T2v[i * 72] = (bf16_t)f2bf(s * b2);
            asm volatile("" ::: "memory");
        }
    } else {
        bf16_t* QGo = (bf16_t*)((unsigned char*)F.out + (size_t)idx * GP_BYTES) + GP_Q;
        bf16_t* KDo = (bf16_t*)((unsigned char*)F.out + (size_t)idx * GP_BYTES) + GP_K;
        const float gl = SC[128 + 63];
        for (int task = tid - 64; task < 2048; task += 448) {
            if (task < 1024) {
                const int c = task >> 4, d0 = (task & 15) * 8;
                const float f = SC[c] * 0.08838834764831845f * __expf(SC[128 + c]);
                const u32x4 w = *(const LAS u32x4*)(QN + c * 136 + d0);
                u32x2 o0, o1; o0.x = pk2(bflo(w.x) * f, bfhi(w.x) * f); o0.y = pk2(bflo(w.y) * f, bfhi(w.y) * f); o1.x = pk2(bflo(w.z) * f, bfhi(w.z) * f); o1.y = pk2(bflo(w.w) * f, bfhi(w.w) * f);
                *(u32x2*)(QGo + foff(c, d0, 4)) = o0; *(u32x2*)(QGo + foff(c, d0 + 4, 4)) = o1;
            } else {
                const int tk = task - 1024, d = tk >> 3, c0 = (tk & 7) * 8;
                const u32x4 w = *(const LAS u32x4*)(KT + d * 72 + c0);
                float f[8];
#pragma unroll
                for (int e = 0; e < 8; ++e) f[e] = SC[64 + c0 + e] * __expf(gl - SC[128 + c0 + e]);
                u32x2 o0, o1; o0.x = pk2(bflo(w.x) * f[0], bfhi(w.x) * f[1]); o0.y = pk2(bflo(w.y) * f[2], bfhi(w.y) * f[3]); o1.x = pk2(bflo(w.z) * f[4], bfhi(w.z) * f[5]); o1.y = pk2(bflo(w.w) * f[6], bfhi(w.w) * f[7]);
                *(u32x2*)(KDo + foff(d, c0, 2)) = o0; *(u32x2*)(KDo + foff(d, c0 + 4, 2)) = o1;
            }
        }
    }
    LBAR();
    {
        bf16_t* UTo = (bf16_t*)(F.ws + WS_UT) + (size_t)idx * 8192;
        bf16_t* WNo = (bf16_t*)((unsigned char*)F.out + (size_t)idx * GP_BYTES) + GP_W;
#pragma unroll 1
        for (int job = wave * 8; job < wave * 8 + 8; ++job) {
            f32x4 acc = {0.f, 0.f, 0.f, 0.f};
            if (job < 32) {
                const int it = job >> 3, dvt = job & 7;
#pragma unroll
                for (int ks = 0; ks < 2; ++ks) acc = mma16(lfrag(T1, 72, it * 16, ks * 32, fr, fq), lfrag(VT, 72, dvt * 16, ks * 32, fr, fq), acc);
                u32x2 w; w.x = pk2(acc[0], acc[1]); w.y = pk2(acc[2], acc[3]);
                *(u32x2*)(UTo + (dvt * 16 + fr) * 64 + it * 16 + 4 * fq) = w;
            } else {
                const int dkt = (job - 32) >> 2, it = (job - 32) & 3;
#pragma unroll
                for (int ks = 0; ks < 2; ++ks) acc = mma16(lfrag(KT, 72, dkt * 16, ks * 32, fr, fq), lfrag(T2, 72, it * 16, ks * 32, fr, fq), acc);
                u32x2 w; w.x = pk2(-acc[0], -acc[1]); w.y = pk2(-acc[2], -acc[3]);
                const int d0 = dkt * 16 + 4 * fq;
                *(u32x2*)(WNo + foff(it * 16 + fr, d0, 4)) = w;
            }
        }
    }
    LBAR();
}

__device__ __forceinline__ float ret_log2_gamma(int h) { return log2f(1.0f - exp2f(-5.0f - (float)h)); }
__device__ __forceinline__ void ret_kv_item(Frame& F, int idx2) {
    const int bh = idx2 >> 4, n = idx2 & 15, b = bh >> 2, h = bh & 3;
    const int tok0 = b * SEQ + n * 128;
    LAS bf16_t* KS = (LAS bf16_t*)(F.lds);
    LAS bf16_t* VN = (LAS bf16_t*)(F.lds + 34816);
    const int tid = F.tid, lane = F.lane, fr = lane & 15, fq = lane >> 4, wave = F.wave;
    const float l2g = ret_log2_gamma(h);
    const bf16_t* RQK = (const bf16_t*)(F.ws + WS_RQK); const bf16_t* RV = (const bf16_t*)(F.ws + WS_RV);
#pragma unroll
    for (int i = 0; i < 4; ++i) { const int p = tid + i * 512, c = p >> 4, d0 = (p & 15) * 8;
        const u32x4 w = *(const u32x4*)(RQK + (size_t)(tok0 + c) * 1024 + 512 + h * 128 + d0);
        const float f = exp2f(l2g * (float)(127 - c));
        u32x4 o; o.x = pk2(bflo(w.x) * f, bfhi(w.x) * f); o.y = pk2(bflo(w.y) * f, bfhi(w.y) * f); o.z = pk2(bflo(w.z) * f, bfhi(w.z) * f); o.w = pk2(bflo(w.w) * f, bfhi(w.w) * f);
        *(LAS u32x4*)(KS + c * 136 + d0) = o; }
#pragma unroll
    for (int i = 0; i < 8; ++i) { const int p = tid + i * 512, c = p >> 5, d0 = (p & 31) * 8;
        *(LAS u32x4*)(VN + c * 264 + d0) = *(const u32x4*)(RV + (size_t)(tok0 + c) * 1024 + h * 256 + d0); }
    LBAR();
    f32x4 acc[8][2];
#pragma unroll
    for (int a = 0; a < 8; ++a) { acc[a][0] = (f32x4){0.f, 0.f, 0.f, 0.f}; acc[a][1] = acc[a][0]; }
#pragma unroll
    for (int ks = 0; ks < 4; ++ks) {
        const bf16x8 y0 = tfrag(VN, 264, ks * 32, (2 * wave) * 16, lane), y1 = tfrag(VN, 264, ks * 32, (2 * wave + 1) * 16, lane);
#pragma unroll
        for (int dkt = 0; dkt < 8; ++dkt) { const bf16x8 x = tfrag(KS, 136, ks * 32, dkt * 16, lane); acc[dkt][0] = mma16(x, y0, acc[dkt][0]); acc[dkt][1] = mma16(x, y1, acc[dkt][1]); }
    }
    bf16_t* KVo = (bf16_t*)(F.ws + WS_KV) + (size_t)idx2 * 32768;
#pragma unroll
    for (int dkt = 0; dkt < 8; ++dkt)
#pragma unroll
        for (int q = 0; q < 2; ++q) { u32x2 w; w.x = pk2(acc[dkt][q][0], acc[dkt][q][1]); w.y = pk2(acc[dkt][q][2], acc[dkt][q][3]);
            *(u32x2*)(KVo + ((2 * wave + q) * 16 + fr) * 128 + dkt * 16 + 4 * fq) = w; }
    LBAR();
}

template <int MODE> __device__ __forceinline__ void gdn_scan_block(Frame& F, int cu) {
    const int bh = cu >> 1, b = bh >> 2, h = bh & 3;
    const int lane = F.lane, wave = F.wave, fr = lane & 15, fq = lane >> 4;
    const unsigned char* GPb = (const unsigned char*)F.out + (size_t)(bh * 32) * GP_BYTES;
    const unsigned char* UTb = (const unsigned char*)(F.ws + WS_UT) + (size_t)(bh * 32) * 16384 + (cu & 1) * 8192;
    constexpr int BUFB = 65536;
    int wpa[8], wpb[8]; int wsum = 0;
#pragma unroll
    for (int i = 0; i < 8; ++i) { wpa[i] = 0; wpb[i] = 0; }
#define SCAN_DMA(nn, lw) do { const unsigned char* _g = GPb + (size_t)(nn) * GP_BYTES; const unsigned char* _u = UTb + (size_t)(nn) * 16384; LAS unsigned char* _d = F.lds + ((nn) & 1) * BUFB; \
        _Pragma("unroll") for (int _i = 0; _i < 22; ++_i) { const int piece = (lw) + 3 * _i; if (piece < 64) { const unsigned char* src = piece < 56 ? _g + piece * 1024 : _u + (piece - 56) * 1024; \
            __builtin_amdgcn_global_load_lds((const unsigned*)(src + lane * 16), (LAS unsigned*)(_d + piece * 1024), 16, 0, 0); } } } while (0)
#define SCAN_WARM(wp, nn) do { const unsigned char* _g = GPb + (size_t)(nn) * GP_BYTES; const unsigned char* _u = UTb + (size_t)(nn) * 16384; \
        _Pragma("unroll") for (int _i = 0; _i < 7; ++_i) { wsum ^= wp[_i]; wp[_i] = *(const int*)(_g + (_i * 64 + lane) * 128); } wsum ^= wp[7]; wp[7] = *(const int*)(_u + lane * 128); } while (0)
    if (wave >= 4 && wave <= 6) { SCAN_DMA(0, wave - 4); asm volatile("s_waitcnt vmcnt(0)" ::: "memory"); }
    else if (wave == 7) { SCAN_WARM(wpa, 1); SCAN_WARM(wpb, 2); }
    float glall = 0.f;
    if (wave < 4 && lane < 32) glall = ((const float*)(F.ws + WS_GL))[bh * 32 + lane];
    LBAR();
    const int sl = (cu & 1) * 4 + (wave & 3);
    bf16_t* OG = (bf16_t*)(F.ws + WS_OGDN);
    f32x4 S[8];
#pragma unroll
    for (int d = 0; d < 8; ++d) S[d] = (f32x4){0.f, 0.f, 0.f, 0.f};
#pragma unroll 1
    for (int n = 0; n < 32; ++n) {
        if (wave >= 4 && wave <= 6) {
            if (MODE != 1 && n + 1 < 32) { SCAN_DMA(n + 1, wave - 4); asm volatile("s_waitcnt vmcnt(0)" ::: "memory"); }
        } else if (wave == 7) {
            if (n + 3 < 32) { if (n & 1) SCAN_WARM(wpb, n + 3); else SCAN_WARM(wpa, n + 3); }
        } else if (MODE != 2) {
            const LAS unsigned char* buf = F.lds + (n & 1) * BUFB;
            const LAS bf16x8* Bf = (const LAS bf16x8*)buf + lane;
            const float egl = __expf(rdlane(glall, n));
            f32x4 av[4], ao[4];
#pragma unroll
            for (int ct = 0; ct < 4; ++ct) {
                const u32x2 un = *(const LAS u32x2*)(buf + GP_BYTES + (((wave & 3) * 16 + fr) * 64 + ct * 16 + 4 * fq) * 2);
                av[ct] = (f32x4){bflo(un.x), bfhi(un.x), bflo(un.y), bfhi(un.y)}; ao[ct] = (f32x4){0.f, 0.f, 0.f, 0.f};
            }
#define LDG(dst, blk0) do { _Pragma("unroll") for (int _j = 0; _j < 8; ++_j) dst[_j] = Bf[((blk0) + _j) * 64]; } while (0)
#define SB() __builtin_amdgcn_sched_barrier(0)
            bf16x8 ga[8], gb[8];
            LDG(ga, 0); LDG(gb, 8); SB();
            bf16x8 Sf[4];
#pragma unroll
            for (int ks = 0; ks < 4; ++ks) Sf[ks] = pack_acc(S[2 * ks], S[2 * ks + 1]);
            SB();
#pragma unroll
            for (int j = 0; j < 8; ++j) av[j >> 2] = mma16(ga[j], Sf[j & 3], av[j >> 2]);
            SB(); LDG(ga, 16); SB();
#pragma unroll
            for (int j = 0; j < 8; ++j) av[2 + (j >> 2)] = mma16(gb[j], Sf[j & 3], av[2 + (j >> 2)]);
            SB(); LDG(gb, 24); SB();
#pragma unroll
            for (int j = 0; j < 8; ++j) ao[j >> 2] = mma16(ga[j], Sf[j & 3], ao[j >> 2]);
            SB(); LDG(ga, 48); SB();
#pragma unroll
            for (int j = 0; j < 8; ++j) ao[2 + (j >> 2)] = mma16(gb[j], Sf[j & 3], ao[2 + (j >> 2)]);
            SB(); LDG(gb, 32); SB();
            bf16x8 Vf[2];
            Vf[0] = pack_acc(av[0], av[1]); Vf[1] = pack_acc(av[2], av[3]);
#pragma unroll
            for (int dt = 0; dt < 8; ++dt) S[dt] = S[dt] * egl;
            SB();
#pragma unroll
            for (int j = 0; j < 8; ++j) ao[j >> 1] = mma16(ga[j], Vf[j & 1], ao[j >> 1]);
            SB(); LDG(ga, 40); SB();
#pragma unroll
            for (int j = 0; j < 8; ++j) S[j >> 1] = mma16(gb[j], Vf[j & 1], S[j >> 1]);
            SB();
#pragma unroll
            for (int j = 0; j < 8; ++j) S[4 + (j >> 1)] = mma16(ga[j], Vf[j & 1], S[4 + (j >> 1)]);
            SB();
#undef LDG
#undef SB
            const int tok0 = b * SEQ + n * 64;
#pragma unroll
            for (int ct = 0; ct < 4; ++ct)
#pragma unroll
                for (int r = 0; r < 4; ++r) {
                    const int c = ct * 16 + 4 * fq + r;
                    if (MODE != 3) OG[(size_t)(tok0 + c) * 512 + h * 128 + sl * 16 + fr] = (bf16_t)f2bf(ao[ct][r]);
                }
        }
        LBAR();
    }
#undef SCAN_DMA
#undef SCAN_WARM
#pragma unroll
    for (int i = 0; i < 8; ++i) wsum ^= wpa[i] ^ wpb[i];
    if (wsum == 0x5a17c0de) ((unsigned*)(F.ws + WS_CTL))[CW_TMO + 16] = 1u;
}

__device__ __forceinline__ void ret_prefix_task(Frame& F, int task) {
    const int bh = task >> 6, part = task & 63, h = bh & 3;
    const float cd = exp2f(ret_log2_gamma(h) * 128.0f);
    bf16_t* base = (bf16_t*)(F.ws + WS_KV) + (size_t)bh * 16 * 32768 + part * 512 + F.lane * 8;
    float st[8];
#pragma unroll
    for (int e = 0; e < 8; ++e) st[e] = 0.f;
#pragma unroll 4
    for (int n = 0; n < 16; ++n) {
        u32x4* p = (u32x4*)(base + (size_t)n * 32768);
        const u32x4 w = *p;
        u32x4 o; o.x = pk2(st[0], st[1]); o.y = pk2(st[2], st[3]); o.z = pk2(st[4], st[5]); o.w = pk2(st[6], st[7]);
        *p = o;
        st[0] = st[0] * cd + bflo(w.x); st[1] = st[1] * cd + bfhi(w.x); st[2] = st[2] * cd + bflo(w.y); st[3] = st[3] * cd + bfhi(w.y);
        st[4] = st[4] * cd + bflo(w.z); st[5] = st[5] * cd + bfhi(w.z); st[6] = st[6] * cd + bflo(w.w); st[7] = st[7] * cd + bfhi(w.w);
    }
}

__device__ __forceinline__ bf16x8 scale_frag(bf16x8 q, float f) {
    u32x4 w = __builtin_bit_cast(u32x4, q);
    w.x = pk2(bflo(w.x) * f, bfhi(w.x) * f); w.y = pk2(bflo(w.y) * f, bfhi(w.y) * f); w.z = pk2(bflo(w.z) * f, bfhi(w.z) * f); w.w = pk2(bflo(w.w) * f, bfhi(w.w) * f);
    return __builtin_bit_cast(bf16x8, w);
}
__device__ __forceinline__ void ret_out_item(Frame& F, int idx2) {
    const int bh = idx2 >> 4, n = idx2 & 15, b = bh >> 2, h = bh & 3;
    const int tok0 = b * SEQ + n * 128;
    LAS bf16_t* QN = (LAS bf16_t*)(F.lds);
    LAS bf16_t* SPn = (LAS bf16_t*)(F.lds + 34816);
    LAS bf16_t* KN = (LAS bf16_t*)(F.lds + 34816);
    LAS bf16_t* PM = (LAS bf16_t*)(F.lds + 69632);
    LAS bf16_t* VN = (LAS bf16_t*)(F.lds);
    LAS float*  NS = (LAS float*)(F.lds + 104448);
    const int tid = F.tid, lane = F.lane, fr = lane & 15, fq = lane >> 4, wave = F.wave;
    const float l2g = ret_log2_gamma(h);
    const bf16_t* RQK = (const bf16_t*)(F.ws + WS_RQK); const bf16_t* RV = (const bf16_t*)(F.ws + WS_RV);
    const bf16_t* SP = (const bf16_t*)(F.ws + WS_KV) + (size_t)idx2 * 32768;
#define SB() __builtin_amdgcn_sched_barrier(0)
    u32x4 kreg[4];
    {
        u32x4 qreg[4], sreg[8];
#pragma unroll
        for (int i = 0; i < 4; ++i) { const int p = tid + i * 512, c = p >> 4, d0 = (p & 15) * 8;
            qreg[i] = *(const u32x4*)(RQK + (size_t)(tok0 + c) * 1024 + h * 128 + d0); }
#pragma unroll
        for (int i = 0; i < 8; ++i) { const int p = tid + i * 512; sreg[i] = *(const u32x4*)(SP + p * 8); }
#pragma unroll
        for (int i = 0; i < 4; ++i) { const int p = tid + i * 512, c = p >> 4, d0 = (p & 15) * 8;
            kreg[i] = *(const u32x4*)(RQK + (size_t)(tok0 + c) * 1024 + 512 + h * 128 + d0); }
#pragma unroll
        for (int i = 0; i < 4; ++i) { const int p = tid + i * 512, c = p >> 4, d0 = (p & 15) * 8; *(LAS u32x4*)(QN + c * 136 + d0) = qreg[i]; }
#pragma unroll
        for (int i = 0; i < 8; ++i) { const int p = tid + i * 512, r = p >> 4, d0 = (p & 15) * 8; *(LAS u32x4*)(SPn + r * 136 + d0) = sreg[i]; }
    }
    LBAR();
    const int wi = wave >> 1, wd = wave & 1;
    f32x4 a1[8][2];
#pragma unroll
    for (int d = 0; d < 8; ++d) { a1[d][0] = (f32x4){0.f, 0.f, 0.f, 0.f}; a1[d][1] = a1[d][0]; }
    {
        const float qd0 = exp2f(l2g * (float)((2 * wi) * 16 + fr + 1)), qd1 = exp2f(l2g * (float)((2 * wi + 1) * 16 + fr + 1));
        bf16x8 xa[8], qa[2];
#define LD0(x, q, ks) do { _Pragma("unroll") for (int _d = 0; _d < 8; ++_d) x[_d] = lfrag(SPn, 136, (wd * 8 + _d) * 16, (ks) * 32, fr, fq); \
        q[0] = lfrag(QN, 136, (2 * wi) * 16, (ks) * 32, fr, fq); q[1] = lfrag(QN, 136, (2 * wi + 1) * 16, (ks) * 32, fr, fq); } while (0)
#define MM0(x, q) do { const bf16x8 _q0 = scale_frag(q[0], qd0), _q1 = scale_frag(q[1], qd1); _Pragma("unroll") for (int _d = 0; _d < 8; ++_d) { a1[_d][0] = mma16(x[_d], _q0, a1[_d][0]); a1[_d][1] = mma16(x[_d], _q1, a1[_d][1]); } } while (0)
        LD0(xa, qa, 0); SB(); MM0(xa, qa); SB(); LD0(xa, qa, 1); SB(); MM0(xa, qa); SB(); LD0(xa, qa, 2); SB(); MM0(xa, qa); SB(); LD0(xa, qa, 3); SB(); MM0(xa, qa); SB();
#undef LD0
#undef MM0
    }
    LBAR();
    u32x4 vreg[8];
#pragma unroll
    for (int i = 0; i < 8; ++i) { const int p = tid + i * 512, c = p >> 5, d0 = (p & 31) * 8; vreg[i] = *(const u32x4*)(RV + (size_t)(tok0 + c) * 1024 + h * 256 + d0); }
#pragma unroll
    for (int i = 0; i < 4; ++i) { const int p = tid + i * 512, c = p >> 4, d0 = (p & 15) * 8; *(LAS u32x4*)(KN + c * 136 + d0) = kreg[i]; }
    LBAR();
    {
        bf16x8 yq[4];
#pragma unroll
        for (int ks = 0; ks < 4; ++ks) yq[ks] = lfrag(QN, 136, wave * 16, ks * 32, fr, fq);
        const int i = wave * 16 + fr;
        bf16x8 ka[4], kb[4];
#define LD1(k, jt) do { _Pragma("unroll") for (int _s = 0; _s < 4; ++_s) k[_s] = lfrag(KN, 136, (jt) * 16, _s * 32, fr, fq); } while (0)
#define MM1(k, jt) do { f32x4 acc = {0.f, 0.f, 0.f, 0.f}; _Pragma("unroll") for (int _s = 0; _s < 4; ++_s) acc = mma16(k[_s], yq[_s], acc); \
        float o[4]; _Pragma("unroll") for (int r = 0; r < 4; ++r) { const int j = (jt) * 16 + 4 * fq + r; o[r] = (j <= i) ? acc[r] * exp2f(l2g * (float)(i - j)) : 0.f; } \
        u32x2 w; w.x = pk2(o[0], o[1]); w.y = pk2(o[2], o[3]); *(LAS u32x2*)(PM + i * 136 + (jt) * 16 + 4 * fq) = w; } while (0)
        LD1(ka, 0); SB();
#pragma unroll
        for (int jt = 0; jt < 8; jt += 2) { LD1(kb, jt + 1); SB(); MM1(ka, jt); SB(); if (jt + 2 < 8) { LD1(ka, jt + 2); } SB(); MM1(kb, jt + 1); SB(); }
#undef LD1
#undef MM1
    }
    LBAR();
#pragma unroll
    for (int i = 0; i < 8; ++i) { const int p = tid + i * 512, c = p >> 5, d0 = (p & 31) * 8; *(LAS u32x4*)(VN + c * 264 + d0) = vreg[i]; }
    LBAR();
    {
        bf16x8 xa[8], pa[2];
#define LD2(x, p, ks) do { _Pragma("unroll") for (int _d = 0; _d < 8; ++_d) x[_d] = tfrag(VN, 264, (ks) * 32, (wd * 8 + _d) * 16, lane); \
        p[0] = lfrag(PM, 136, (2 * wi) * 16, (ks) * 32, fr, fq); p[1] = lfrag(PM, 136, (2 * wi + 1) * 16, (ks) * 32, fr, fq); } while (0)
#define MM2(x, p) do { _Pragma("unroll") for (int _d = 0; _d < 8; ++_d) { a1[_d][0] = mma16(x[_d], p[0], a1[_d][0]); a1[_d][1] = mma16(x[_d], p[1], a1[_d][1]); } } while (0)
        LD2(xa, pa, 0); SB(); MM2(xa, pa); SB(); LD2(xa, pa, 1); SB(); MM2(xa, pa); SB(); LD2(xa, pa, 2); SB(); MM2(xa, pa); SB(); LD2(xa, pa, 3); SB(); MM2(xa, pa); SB();
#undef LD2
#undef MM2
    }
#undef SB
#pragma unroll
    for (int t = 0; t < 2; ++t) {
        const int i = (2 * wi + t) * 16 + fr;
        float s = 0.f;
#pragma unroll
        for (int d = 0; d < 8; ++d) { const f32x4 v = a1[d][t]; s += (v[0] * v[0] + v[1] * v[1]) + (v[2] * v[2] + v[3] * v[3]); }
        s += __shfl_xor(s, 16); s += __shfl_xor(s, 32);
        if (fq == 0) NS[i * 2 + wd] = s;
    }
    LBAR();
    const bf16_t* RG = (const bf16_t*)(F.ws + WS_RG);
    bf16_t* YB = (bf16_t*)(F.ws + WS_YB);
#pragma unroll
    for (int t = 0; t < 2; ++t) {
        const int i = (2 * wi + t) * 16 + fr;
        const float rstd = rsqrtf_((NS[i * 2] + NS[i * 2 + 1]) * (1.0f / 256.0f) + EPS);
        u32x2 g[8];
#pragma unroll
        for (int d = 0; d < 8; ++d) g[d] = *(const u32x2*)(RG + (size_t)(tok0 + i) * 1024 + h * 256 + (wd * 8 + d) * 16 + 4 * fq);
#pragma unroll
        for (int d = 0; d < 8; ++d) {
            const int dv = (wd * 8 + d) * 16 + 4 * fq;
            const f32x4 v = a1[d][t] * rstd;
            u32x2 w; w.x = pk2(v[0] * siluf_(bflo(g[d].x)), v[1] * siluf_(bfhi(g[d].x))); w.y = pk2(v[2] * siluf_(bflo(g[d].y)), v[3] * siluf_(bfhi(g[d].y)));
            *(u32x2*)(YB + (size_t)(tok0 + i) * 1024 + h * 256 + dv) = w;
        }
    }
    LBAR();
}

__device__ __forceinline__ void gdn_normgate_row(Frame& F, int m) {
    const int lane = F.lane;
    const u32x4 ow = *(const u32x4*)((const bf16_t*)(F.ws + WS_OGDN) + (size_t)m * 512 + lane * 8);
    const u32x4 z = *(const u32x4*)((const bf16_t*)(F.ws + WS_GZ) + (size_t)m * 512 + lane * 8);
    float o[8] = {bflo(ow.x), bfhi(ow.x), bflo(ow.y), bfhi(ow.y), bflo(ow.z), bfhi(ow.z), bflo(ow.w), bfhi(ow.w)};
    float ss = 0.f;
#pragma unroll
    for (int e = 0; e < 8; ++e) ss += o[e] * o[e];
    ss = row16_sum(ss);
    const float rstd = rsqrtf_(ss * (1.0f / 128.0f) + EPS);
    const float* nw = F.in[I_GNW] + (lane & 15) * 8;
    const f32x4 w0 = *(const f32x4*)nw, w1 = *(const f32x4*)(nw + 4);
    u32x4 y;
    y.x = pk2(o[0] * rstd * w0[0] * siluf_(bflo(z.x)), o[1] * rstd * w0[1] * siluf_(bfhi(z.x)));
    y.y = pk2(o[2] * rstd * w0[2] * siluf_(bflo(z.y)), o[3] * rstd * w0[3] * siluf_(bfhi(z.y)));
    y.z = pk2(o[4] * rstd * w1[0] * siluf_(bflo(z.z)), o[5] * rstd * w1[1] * siluf_(bfhi(z.z)));
    y.w = pk2(o[6] * rstd * w1[2] * siluf_(bflo(z.w)), o[7] * rstd * w1[3] * siluf_(bfhi(z.w)));
    *(u32x4*)((bf16_t*)(F.ws + WS_YA) + (size_t)m * 512 + lane * 8) = y;
}

struct EpiUp1 {
    static constexpr bool PERM = true;
    unsigned char* ws;
    __device__ __forceinline__ void operator()(const f32x4 (&acc)[2][2][4][2], const pg8::Unit& u, int wr, int wc, int fr, int fq) const {
        const int row0 = u.pm * 256 + wr * 64 + fr, col0 = u.pn * 256 + wc * 32 + 8 * fq;
        const bf16_t* MAB = (const bf16_t*)(ws + WS_MAB); float* TMP = (float*)(ws + WS_TMP);
#pragma unroll
        for (int ai = 0; ai < 2; ++ai)
#pragma unroll
            for (int m = 0; m < 4; ++m) { const int row = row0 + ai * 128 + m * 16;
#pragma unroll
                for (int bj = 0; bj < 2; ++bj) {
                    const int col = col0 + bj * 128;
                    const u32x4 g = *(const u32x4*)(MAB + (size_t)row * 2048 + col);
                    const f32x4 v0 = acc[ai][bj][m][0], v1 = acc[ai][bj][m][1];
                    f32x4 o0, o1;
                    o0[0] = v0[0] * sigmoidf_(bflo(g.x)); o0[1] = v0[1] * sigmoidf_(bfhi(g.x)); o0[2] = v0[2] * sigmoidf_(bflo(g.y)); o0[3] = v0[3] * sigmoidf_(bfhi(g.y));
                    o1[0] = v1[0] * sigmoidf_(bflo(g.z)); o1[1] = v1[1] * sigmoidf_(bfhi(g.z)); o1[2] = v1[2] * sigmoidf_(bflo(g.w)); o1[3] = v1[3] * sigmoidf_(bfhi(g.w));
                    float* p = TMP + (size_t)row * 1024 + col;
                    *(f32x4*)p = o0; *(f32x4*)(p + 4) = o1;
                } }
    }
};
struct EpiUp1R {
    static constexpr bool PERM = true;
    unsigned char* ws;
    __device__ __forceinline__ void operator()(f32x4 (&acc)[2][2][4][2], const pg8::Unit& u, int wr, int wc, int fr, int fq) const {
        const int row0 = u.pm * 256 + wr * 64 + fr, col0 = u.pn * 256 + wc * 32 + 8 * fq;
        const bf16_t* MAB = (const bf16_t*)(ws + WS_MAB);
#pragma unroll
        for (int ai = 0; ai < 2; ++ai)
#pragma unroll
            for (int m = 0; m < 4; ++m) { const int row = row0 + ai * 128 + m * 16;
#pragma unroll
                for (int bj = 0; bj < 2; ++bj) {
                    const int col = col0 + bj * 128;
                    const u32x4 ga = *(const u32x4*)(MAB + (size_t)row * 2048 + col), gb = *(const u32x4*)(MAB + (size_t)row * 2048 + 1024 + col);
                    const unsigned gaw[4] = {ga.x, ga.y, ga.z, ga.w}, gbw[4] = {gb.x, gb.y, gb.z, gb.w};
#pragma unroll
                    for (int q = 0; q < 4; ++q) {
                        const float a0 = bflo(gaw[q]), a1 = bfhi(gaw[q]), b0 = fmaxf(bflo(gbw[q]), -80.f), b1 = fmaxf(bfhi(gbw[q]), -80.f);
                        const float r0 = (1.0f + __builtin_amdgcn_exp2f(-1.4426950408889634f * b0)) * sigmoidf_(a0);
                        const float r1 = (1.0f + __builtin_amdgcn_exp2f(-1.4426950408889634f * b1)) * sigmoidf_(a1);
                        acc[ai][bj][m][q >> 1][(q & 1) * 2] *= r0; acc[ai][bj][m][q >> 1][(q & 1) * 2 + 1] *= r1;
                    }
                    asm volatile("" : "+v"(acc[ai][bj][m][0]), "+v"(acc[ai][bj][m][1]) :: "memory");
                } }
    }
};
struct EpiUp2R {
    static constexpr bool PERM = true;
    unsigned char* ws;
    __device__ __forceinline__ void operator()(const f32x4 (&acc)[2][2][4][2], const pg8::Unit& u, int wr, int wc, int fr, int fq) const {
        const int row0 = u.pm * 256 + wr * 64 + fr, col0 = u.pn * 256 + wc * 32 + 8 * fq;
        const bf16_t* MAB = (const bf16_t*)(ws + WS_MAB); bf16_t* MG = (bf16_t*)(ws + WS_MERGED);
#pragma unroll
        for (int ai = 0; ai < 2; ++ai)
#pragma unroll
            for (int m = 0; m < 4; ++m) { const int row = row0 + ai * 128 + m * 16;
#pragma unroll
                for (int bj = 0; bj < 2; ++bj) {
                    const int col = col0 + bj * 128;
                    const u32x4 g = *(const u32x4*)(MAB + (size_t)row * 2048 + 1024 + col);
                    const f32x4 v0 = acc[ai][bj][m][0], v1 = acc[ai][bj][m][1];
                    u32x4 w;
                    w.x = pk2(v0[0] * sigmoidf_(fmaxf(bflo(g.x), -80.f)), v0[1] * sigmoidf_(fmaxf(bfhi(g.x), -80.f)));
                    w.y = pk2(v0[2] * sigmoidf_(fmaxf(bflo(g.y), -80.f)), v0[3] * sigmoidf_(fmaxf(bfhi(g.y), -80.f)));
                    w.z = pk2(v1[0] * sigmoidf_(fmaxf(bflo(g.z), -80.f)), v1[1] * sigmoidf_(fmaxf(bfhi(g.z), -80.f)));
                    w.w = pk2(v1[2] * sigmoidf_(fmaxf(bflo(g.w), -80.f)), v1[3] * sigmoidf_(fmaxf(bfhi(g.w), -80.f)));
                    *(u32x4*)(MG + (size_t)row * 1024 + col) = w;
                } }
    }
};
struct EpiUp2 {
    static constexpr bool PERM = true;
    unsigned char* ws;
    __device__ __forceinline__ void operator()(const f32x4 (&acc)[2][2][4][2], const pg8::Unit& u, int wr, int wc, int fr, int fq) const {
        const int row0 = u.pm * 256 + wr * 64 + fr, col0 = u.pn * 256 + wc * 32 + 8 * fq;
        const bf16_t* MAB = (const bf16_t*)(ws + WS_MAB); const float* TMP = (const float*)(ws + WS_TMP); bf16_t* MG = (bf16_t*)(ws + WS_MERGED);
#pragma unroll
        for (int ai = 0; ai < 2; ++ai)
#pragma unroll
            for (int m = 0; m < 4; ++m) { const int row = row0 + ai * 128 + m * 16;
#pragma unroll
                for (int bj = 0; bj < 2; ++bj) {
                    const int col = col0 + bj * 128;
                    const u32x4 g = *(const u32x4*)(MAB + (size_t)row * 2048 + 1024 + col);
                    const float* p = TMP + (size_t)row * 1024 + col;
                    const f32x4 t0 = *(const f32x4*)p, t1 = *(const f32x4*)(p + 4);
                    const f32x4 v0 = acc[ai][bj][m][0], v1 = acc[ai][bj][m][1];
                    u32x4 w;
                    w.x = pk2(t0[0] + v0[0] * sigmoidf_(bflo(g.x)), t0[1] + v0[1] * sigmoidf_(bfhi(g.x)));
                    w.y = pk2(t0[2] + v0[2] * sigmoidf_(bflo(g.y)), t0[3] + v0[3] * sigmoidf_(bfhi(g.y)));
                    w.z = pk2(t1[0] + v1[0] * sigmoidf_(bflo(g.z)), t1[1] + v1[1] * sigmoidf_(bfhi(g.z)));
                    w.w = pk2(t1[2] + v1[2] * sigmoidf_(bflo(g.w)), t1[3] + v1[3] * sigmoidf_(bfhi(g.w)));
                    *(u32x4*)(MG + (size_t)row * 1024 + col) = w;
                } }
    }
};
struct EpiOut {
    static constexpr bool PERM = false;
    const float* x; float* h;
    __device__ __forceinline__ void operator()(const f32x4 (&acc)[2][2][4][2], const pg8::Unit& u, int wr, int wc, int fr, int fq) const {
        const int row0 = u.pm * 256 + wr * 64 + fr, col0 = u.pn * 256 + wc * 32 + 4 * fq;
#pragma unroll
        for (int ai = 0; ai < 2; ++ai)
#pragma unroll
            for (int m = 0; m < 4; ++m) { const size_t off = (size_t)(row0 + ai * 128 + m * 16) * 1024 + col0;
#pragma unroll
                for (int bj = 0; bj < 2; ++bj)
#pragma unroll
                    for (int n = 0; n < 2; ++n) *(f32x4*)(h + off + bj * 128 + n * 16) = *(const f32x4*)(x + off + bj * 128 + n * 16) + acc[ai][bj][m][n]; }
    }
};

__device__ __forceinline__ void p7_router(Frame& F, bool commit) {
    const int lane = F.lane, wave = F.wave, fr = lane & 15, fq = lane >> 4, p = wave >> 1, hk = wave & 1;
    const int gw = F.vcu * NWAVES + F.wave, NGW = F.G * NWAVES;
    LAS float* PL = (LAS float*)(F.lds);
    LAS float* SQ = (LAS float*)(F.lds + 25600);
    LAS float* RS = (LAS float*)(F.lds + 26112);
    const float* hb = (const float*)F.out; const float* wrt = (const float*)(F.ws + WS_WRT);
    LBAR();
    for (int it0 = 0; it0 < M / 16; it0 += F.G * 4) {
        const int t = it0 + F.vcu * 4 + p; const bool act = t < M / 16; const int tok0 = t * 16;
        if (act) {
            f32x4 acc[3];
#pragma unroll
            for (int ct = 0; ct < 3; ++ct) acc[ct] = (f32x4){0.f, 0.f, 0.f, 0.f};
            float ssq = 0.f;
            const float* hp = hb + (size_t)(tok0 + fr) * DM + hk * 512 + 4 * fq;
            const float* wp = wrt + (size_t)fr * DM + hk * 512 + 4 * fq;
#pragma unroll 4
            for (int g = 0; g < 32; ++g) {
                const f32x4 xv = *(const f32x4*)(hp + 16 * g);
                ssq += (xv.x * xv.x + xv.y * xv.y) + (xv.z * xv.z + xv.w * xv.w);
#pragma unroll
                for (int ct = 0; ct < 3; ++ct) {
                    const f32x4 wv = *(const f32x4*)(wp + ct * 16 * DM + 16 * g);
#pragma unroll
                    for (int e = 0; e < 4; ++e) acc[ct] = __builtin_amdgcn_mfma_f32_16x16x4f32(wv[e], xv[e], acc[ct], 0, 0, 0);
                }
            }
            ssq += __shfl_xor(ssq, 16); ssq += __shfl_xor(ssq, 32);
            LAS float* pl = PL + ((p * 2 + hk) * 16 + fr) * 49;
#pragma unroll
            for (int ct = 0; ct < 3; ++ct)
#pragma unroll
                for (int r = 0; r < 4; ++r) pl[ct * 16 + 4 * fq + r] = acc[ct][r];
            if (fq == 0) SQ[(p * 2 + hk) * 16 + fr] = ssq;
        }
        LBAR();
        if (act && hk == 0 && lane < 16) {
            const int m = tok0 + lane;
            const float rstd = rsqrtf_((SQ[(p * 2) * 16 + lane] + SQ[(p * 2 + 1) * 16 + lane]) * (1.f / DM) + EPS);
            RS[p * 16 + lane] = rstd;
            const LAS float* p0 = PL + ((p * 2) * 16 + lane) * 49; const LAS float* p1 = p0 + 16 * 49;
            float gl[4];
#pragma unroll
            for (int j = 0; j < 4; ++j) gl[j] = rstd * (p0[j] + p1[j]) + F.in[I_BGRP][j];
            int gi = 0; float gm = gl[0];
            if (gl[1] > gm) { gm = gl[1]; gi = 1; } if (gl[2] > gm) { gm = gl[2]; gi = 2; } if (gl[3] > gm) { gm = gl[3]; gi = 3; }
            const float gp = 1.0f / (__expf(gl[0] - gm) + __expf(gl[1] - gm) + __expf(gl[2] - gm) + __expf(gl[3] - gm));
            int i0 = 0, i1 = 0; float v0 = -3.0e38f, v1 = -3.0e38f;
#pragma unroll
            for (int i = 0; i < 8; ++i) {
                const float ev = rstd * (p0[4 + gi * 8 + i] + p1[4 + gi * 8 + i]) + F.in[I_BEXP][gi * 8 + i];
                if (ev > v0) { v1 = v0; i1 = i0; v0 = ev; i0 = i; } else if (ev > v1) { v1 = ev; i1 = i; }
            }
            const float w0 = gp / (1.0f + __expf(v1 - v0)), w1 = gp / (1.0f + __expf(v0 - v1));
            if (commit) {
                int* LTOK = (int*)(F.ws + WS_LTOK); int* LDST = (int*)(F.ws + WS_LDST); float* LW = (float*)(F.ws + WS_LW);
                unsigned* cnt = (unsigned*)(F.ws + WS_CTL) + CW_CNT;
                const int e0 = gi * 8 + i0, e1 = gi * 8 + i1;
                const unsigned q0 = __hip_atomic_fetch_add(cnt + e0, 1u, __ATOMIC_RELAXED, __HIP_MEMORY_SCOPE_AGENT);
                LTOK[e0 * 16384 + q0] = m; LDST[e0 * 16384 + q0] = 2 * m; LW[e0 * 16384 + q0] = w0;
                const unsigned q1 = __hip_atomic_fetch_add(cnt + e1, 1u, __ATOMIC_RELAXED, __HIP_MEMORY_SCOPE_AGENT);
                LTOK[e1 * 16384 + q1] = m; LDST[e1 * 16384 + q1] = 2 * m + 1; LW[e1 * 16384 + q1] = w1;
            }
        }
        LBAR();
        if (act) {
            const f32x4 wa = *(const f32x4*)(F.in[I_NFW] + hk * 512 + 8 * lane), wb = *(const f32x4*)(F.in[I_NFW] + hk * 512 + 8 * lane + 4);
#pragma unroll 4
            for (int j = 0; j < 16; ++j) {
                const float rstd = RS[p * 16 + j];
                const float* hp = hb + (size_t)(tok0 + j) * DM + hk * 512 + 8 * lane;
                const f32x4 a = *(const f32x4*)hp, c = *(const f32x4*)(hp + 4);
                u32x4 o; o.x = pk2(a.x * rstd * wa.x, a.y * rstd * wa.y); o.y = pk2(a.z * rstd * wa.z, a.w * rstd * wa.w);
                o.z = pk2(c.x * rstd * wb.x, c.y * rstd * wb.y); o.w = pk2(c.z * rstd * wb.z, c.w * rstd * wb.w);
                *(u32x4*)((bf16_t*)(F.ws + WS_XN) + (size_t)(tok0 + j) * DM + hk * 512 + 8 * lane) = o;
            }
        }
        LBAR();
    }
    LAS float* scr = (LAS float*)(F.lds + F.wave * 16384);
    constexpr int IG = 16 * 16, ID = 8 * 32, IPE = 2 * IG + ID;
    const float* wg = F.in[I_WGATE]; const float* wu = F.in[I_WUP]; const float* wdn = F.in[I_WDOWN]; unsigned char* ws = F.ws;
    auto dec = [=](int it) -> TrItem {
        const int e = it / IPE; int r = it % IPE; TrItem t;
        if (r < 2 * IG) { const int up = r >= IG; if (up) r -= IG; const int nb = r % 16, kb = r / 16, n0 = nb * 32;
            t.W = (up ? wu : wg) + (size_t)e * 1024 * 512; t.ldw = 512; t.col0 = n0; t.WT = (bf16_t*)(ws + WS_WGU) + (size_t)e * 1024 * 1024; t.K = 1024;
            t.row0 = (n0 >> 7) * 256 + (up ? 128 : 0) + (n0 & 127); t.k0 = kb * 64; return t; }
        r -= 2 * IG; const int nb = r % 32, kb = r / 32;
        t.W = wdn + (size_t)e * 512 * 1024; t.ldw = 1024; t.col0 = nb * 32; t.WT = (bf16_t*)(ws + WS_WD) + (size_t)e * 1024 * 512; t.K = 512; t.row0 = nb * 32; t.k0 = kb * 64; return t;
    };
    tr_run(dec, gw, NE * IPE, NGW, F.lane, scr);
}

constexpr int TOFF_OFF = MISC_OFF + 512;
struct MoeProb {
    const LAS int* toff; const unsigned* cnt; const int* ltok;
    const bf16_t* A; const bf16_t* Bt; int K; int G, c; int total;
    __device__ __forceinline__ bool next(int i, pg8::Unit& u) const {
        const int L = i * G + c; if (L >= total) return false;
        const int tile = L >> 2; int e = 0;
#pragma unroll 1
        for (int s = 16; s > 0; s >>= 1) if (toff[e + s] <= tile) e += s;
        u.e = e; u.pm = tile - toff[e]; u.pn = L & 3; u.base = tile * 256;
        const int c_e = (int)cnt[e]; const int rem = c_e - u.pm * 256; u.rows = rem < 256 ? rem : 256;
        return true;
    }
    __device__ __forceinline__ int a_row(const pg8::Unit& u, int r) const { return ltok[u.e * 16384 + u.pm * 256 + (r < u.rows ? r : 0)]; }
    __device__ __forceinline__ const char* a_ptr(const pg8::Unit& u) const { return (const char*)A; }
    __device__ __forceinline__ const char* a_ptr_rows(const pg8::Unit& u) const { return (const char*)A + (size_t)u.base * K * 2; }
    __device__ __forceinline__ const char* b_ptr(const pg8::Unit& u) const { return (const char*)Bt + ((size_t)u.e * 1024 + u.pn * 256) * K * 2; }
};
struct MoeProbD : MoeProb { __device__ __forceinline__ const char* a_ptr(const pg8::Unit& u) const { return a_ptr_rows(u); } };
struct EpiGU {
    static constexpr bool PERM = true;
    bf16_t* hid;
    __device__ __forceinline__ void operator()(const f32x4 (&acc)[2][2][4][2], const pg8::Unit& u, int wr, int wc, int fr, int fq) const {
        const int col0 = u.pn * 128 + wc * 32 + 8 * fq;
#pragma unroll
        for (int ai = 0; ai < 2; ++ai)
#pragma unroll
            for (int m = 0; m < 4; ++m) { const int r = ai * 128 + wr * 64 + m * 16 + fr;
                const f32x4 g0 = acc[ai][0][m][0], g1 = acc[ai][0][m][1], u0 = acc[ai][1][m][0], u1 = acc[ai][1][m][1];
                u32x4 w;
                w.x = pk2(siluf_(g0[0]) * u0[0], siluf_(g0[1]) * u0[1]); w.y = pk2(siluf_(g0[2]) * u0[2], siluf_(g0[3]) * u0[3]);
                w.z = pk2(siluf_(g1[0]) * u1[0], siluf_(g1[1]) * u1[1]); w.w = pk2(siluf_(g1[2]) * u1[2], siluf_(g1[3]) * u1[3]);
                *(u32x4*)(hid + (size_t)(u.base + r) * 512 + col0) = w; }
    }
};
struct EpiDown {
    static constexpr bool PERM = true;
    bf16_t* y2; const int* ldst; const float* lw;
    __device__ __forceinline__ void operator()(const f32x4 (&acc)[2][2][4][2], const pg8::Unit& u, int wr, int wc, int fr, int fq) const {
        const int col0 = u.pn * 256 + wc * 32 + 8 * fq;
#pragma unroll
        for (int ai = 0; ai < 2; ++ai)
#pragma unroll
            for (int m = 0; m < 4; ++m) { const int r = ai * 128 + wr * 64 + m * 16 + fr;
                if (r < u.rows) {
                    const int li = u.e * 16384 + u.pm * 256 + r; const int dst = ldst[li]; const float cw = lw[li];
#pragma unroll
                    for (int bj = 0; bj < 2; ++bj) { const f32x4 v0 = acc[ai][bj][m][0] * cw, v1 = acc[ai][bj][m][1] * cw;
                        u32x4 w; w.x = pk2(v0[0], v0[1]); w.y = pk2(v0[2], v0[3]); w.z = pk2(v1[0], v1[1]); w.w = pk2(v1[2], v1[3]);
                        *(u32x4*)(y2 + (size_t)dst * 1024 + col0 + bj * 128) = w; }
                } }
    }
};
__device__ __forceinline__ void moe_toff(Frame& F) {
    LAS int* toff = (LAS int*)(F.lds + TOFF_OFF);
    __syncthreads();
    if (F.tid == 0) { const unsigned* cnt = (const unsigned*)(F.ws + WS_CTL) + CW_CNT; int a = 0;
        for (int e = 0; e < NE; ++e) { toff[e] = a; a += ((int)cnt[e] + 255) >> 8; } toff[NE] = a; }
    __syncthreads();
}

__device__ __forceinline__ void final_row(Frame& F, int m, float* dstbase) {
    const int lane = F.lane;
    float* hr = F.out + (size_t)m * DM;
    const bf16_t* y0 = (const bf16_t*)(F.ws + WS_Y2) + (size_t)(2 * m) * DM; const bf16_t* y1 = y0 + DM;
    f32x4 v[4]; float s = 0.f;
#pragma unroll
    for (int j = 0; j < 4; ++j) {
        v[j] = *(const f32x4*)(hr + 4 * lane + 256 * j);
        const u32x2 a = *(const u32x2*)(y0 + 4 * lane + 256 * j), b = *(const u32x2*)(y1 + 4 * lane + 256 * j);
        v[j][0] += bflo(a.x) + bflo(b.x); v[j][1] += bfhi(a.x) + bfhi(b.x); v[j][2] += bflo(a.y) + bflo(b.y); v[j][3] += bfhi(a.y) + bfhi(b.y);
        s += (v[j].x * v[j].x + v[j].y * v[j].y) + (v[j].z * v[j].z + v[j].w * v[j].w);
    }
    const float rstd = 1.0f / sqrtf(wave_sum(s) * (1.f / DM) + EPS);
#pragma unroll
    for (int j = 0; j < 4; ++j) { const f32x4 w = *(const f32x4*)(F.in[I_NFINW] + 4 * lane + 256 * j); *(f32x4*)(dstbase + (size_t)m * DM + 4 * lane + 256 * j) = v[j] * rstd * w; }
}

__device__ __forceinline__ void ph1_body(Frame& F) {
    pg8::Dense P; P.init((const bf16_t*)(F.ws + WS_U), (const bf16_t*)(F.ws + WS_WINT), M, NP, DM, F.G, (int)blockIdx.x);
    EpiProj E{F.ws};
    pg8::gemm_phase<EpiProj, pg8::Dense, false, true, true>(F.lds, P, E);
}
__device__ __forceinline__ void ph5_body(Frame& F) {
    if (F.G * 1 >= (M / 256) * (DM / 256)) {
        f32x4 xacc[2][2][4][2];
        { pg8::Dense P; P.init((const bf16_t*)(F.ws + WS_YA), (const bf16_t*)(F.ws + WS_WUPA), M, DM, 512, F.G, (int)blockIdx.x);
          EpiUp1R E{F.ws}; pg8::gemm_phase<EpiUp1R, pg8::Dense, false, false, true, 1>(F.lds, P, E, xacc); }
        { pg8::Dense P; P.init((const bf16_t*)(F.ws + WS_YB), (const bf16_t*)(F.ws + WS_WUPR), M, DM, 1024, F.G, (int)blockIdx.x);
          EpiUp2R E{F.ws}; pg8::gemm_phase<EpiUp2R, pg8::Dense, false, false, true, 2>(F.lds, P, E, xacc); }
    } else {
        { pg8::Dense P; P.init((const bf16_t*)(F.ws + WS_YA), (const bf16_t*)(F.ws + WS_WUPA), M, DM, 512, F.G, (int)blockIdx.x);
          EpiUp1 E{F.ws}; pg8::gemm_phase<EpiUp1, pg8::Dense, false, false, true>(F.lds, P, E); }
        { pg8::Dense P; P.init((const bf16_t*)(F.ws + WS_YB), (const bf16_t*)(F.ws + WS_WUPR), M, DM, 1024, F.G, (int)blockIdx.x);
          EpiUp2 E{F.ws}; pg8::gemm_phase<EpiUp2, pg8::Dense, false, false, true>(F.lds, P, E); }
    }
}

struct Args { const float* in[19]; float* out; unsigned char* ws; int ph_lo, ph_hi; };
__global__ void __launch_bounds__(NTHR, 2) hgrh_fwd(Args args) {
    extern __shared__ __attribute__((aligned(16))) unsigned char lds_raw[];
    Frame F;
    F.lds = (LAS unsigned char*)lds_raw;
    F.MISC = (volatile LAS unsigned*)(F.lds + MISC_OFF);
    F.tid = threadIdx.x; F.lane = F.tid & 63; F.wave = __builtin_amdgcn_readfirstlane(F.tid >> 6);
    F.G = gridDim.x; { const int bx = blockIdx.x; F.vcu = (F.G % 8 == 0) ? (bx % 8) * (F.G / 8) + bx / 8 : bx; }
#pragma unroll
    for (int i = 0; i < 19; ++i) F.in[i] = args.in[i];
    F.out = args.out; F.ws = args.ws;
    F.ctl = (GAS unsigned*)(args.ws + WS_CTL);
    for (int u = F.tid; u < (LDS_BYTES - MISC_OFF) / 4; u += NTHR) ((LAS unsigned*)(F.lds + MISC_OFF))[u] = 0u;
    __syncthreads();
    const int lo = args.ph_lo, hi = args.ph_hi;
    XcdBarrier bar; bar.bar = (unsigned*)(args.ws + WS_CTL) + CW_BAR; bar.x = 0; bar.st = nullptr;
    if (hi - lo > 1) bar = xcd_barrier_post((unsigned*)(args.ws + WS_CTL) + CW_BAR, F.MISC + 8);
#ifndef PH_MASK
#define PH_MASK 0xFFFF
#endif
#define IN(k) (((PH_MASK >> (k)) & 1) && lo <= (k) && (k) < hi)
#define SEAM(k) do { if (IN(k) && IN((k) + 1)) { xcd_barrier(bar); if (REPS(13) == 2) xcd_barrier(bar); } } while (0)
    const int gw = F.vcu * NWAVES + F.wave, NGW = F.G * NWAVES;

    if (IN(0)) { for (int rep = 0; rep < REPS(0); ++rep) p0_prologue(F); }
    SEAM(0);
    if (IN(1)) {
        ph1_body(F);
        if (REPS(1) == 2) ph1_body(F);
    }
    SEAM(1);
    if (IN(2)) {
        for (int rep = 0; rep < REPS(2); ++rep) {
        for (int it = F.vcu; it < 1024; it += F.G) gdn_prep_item(F, it);
        for (int it = F.vcu; it < 512; it += F.G) ret_kv_item(F, it);
        }
        if (REPS(11) == 2) for (int it = F.vcu; it < 1024; it += F.G) gdn_prep_item(F, it);
        if (REPS(12) == 2) for (int it = F.vcu + 1024; it < 1024 + 512; it += F.G) ret_kv_item(F, it - 1024);
    }
    SEAM(2);
    if (IN(3)) {
        if (F.vcu < 64) {
#ifdef SCAN_PROBE
            gdn_scan_block<SCAN_PROBE>(F, F.vcu);
#endif
            for (int rep = 0; rep < REPS(3); ++rep) gdn_scan_block<0>(F, F.vcu); }
        else {
            const int NB = F.G - 64, ob = F.vcu - 64;
            for (int t = ob * NWAVES + F.wave; t < 2048; t += NB * NWAVES) ret_prefix_task(F, t);
            asm volatile("s_waitcnt vmcnt(0)" ::: "memory");
            __syncthreads();
            if (F.tid == 0) {
                unsigned* pc = (unsigned*)(F.ws + WS_CTL) + CW_PFX;
                __builtin_amdgcn_fence(__ATOMIC_RELEASE, "agent");
                asm volatile("s_waitcnt vmcnt(0)" ::: "memory");
                xb_add(pc, 1u);
                unsigned sp = 0;
                while (xb_ld(pc) < (unsigned)NB) { __builtin_amdgcn_s_sleep(2); if (++sp > (1u << 22)) break; }
                __builtin_amdgcn_fence(__ATOMIC_ACQUIRE, "agent");
                asm volatile("s_waitcnt vmcnt(0)" ::: "memory");
            }
            __syncthreads();
            for (int rep = 0; rep < REPS(4); ++rep)
            for (int it = ob; it < 512; it += NB) ret_out_item(F, it);
        }
    }
    SEAM(3);
    if (IN(4)) {
        for (int rep = 0; rep < REPS(14); ++rep)
        for (int m = gw; m < M; m += NGW) gdn_normgate_row(F, m);
    }
    SEAM(4);
    if (IN(5)) {
        ph5_body(F);
        if (REPS(5) == 2) ph5_body(F);
    }
    SEAM(5);
    if (IN(6)) {
        for (int rep = 0; rep < REPS(6); ++rep) {
        pg8::Dense P; P.init((const bf16_t*)(F.ws + WS_MERGED), (const bf16_t*)(F.ws + WS_WOUT), M, DM, DM, F.G, (int)blockIdx.x);
        EpiOut E{F.in[I_X], F.out}; pg8::gemm_phase<EpiOut, pg8::Dense, false, false, true>(F.lds, P, E);
        }
    }
    SEAM(6);
    if (IN(7)) { for (int rep = 0; rep < REPS(7); ++rep) { __syncthreads(); p7_router(F, rep == REPS(7) - 1); } }
    SEAM(7);
    if (IN(8)) {
        for (int rep = 0; rep < REPS(8); ++rep) {
        moe_toff(F);
        MoeProb P; P.toff = (const LAS int*)(F.lds + TOFF_OFF); P.cnt = (const unsigned*)(F.ws + WS_CTL) + CW_CNT; P.ltok = (const int*)(F.ws + WS_LTOK);
        P.A = (const bf16_t*)(F.ws + WS_XN); P.Bt = (const bf16_t*)(F.ws + WS_WGU); P.K = 1024; P.G = F.G; P.c = F.vcu; P.total = 4 * P.toff[NE];
        EpiGU E{(bf16_t*)(F.ws + WS_HID)};
        pg8::gemm_phase<EpiGU, MoeProb, true, true, true>(F.lds, P, E);
        }
    }
    SEAM(8);
    if (IN(9)) {
        for (int rep = 0; rep < REPS(9); ++rep) {
        moe_toff(F);
        MoeProbD P; P.toff = (const LAS int*)(F.lds + TOFF_OFF); P.cnt = (const unsigned*)(F.ws + WS_CTL) + CW_CNT; P.ltok = (const int*)(F.ws + WS_LTOK);
        P.A = (const bf16_t*)(F.ws + WS_HID); P.Bt = (const bf16_t*)(F.ws + WS_WD); P.K = 512; P.G = F.G; P.c = F.vcu; P.total = 4 * P.toff[NE];
        EpiDown E{(bf16_t*)(F.ws + WS_Y2), (const int*)(F.ws + WS_LDST), (const float*)(F.ws + WS_LW)};
        pg8::gemm_phase<EpiDown, MoeProbD, false, true, true>(F.lds, P, E);
        }
    }
    SEAM(9);
    if (IN(10)) { for (int rep = 0; rep < REPS(10); ++rep) { float* dst = (rep == REPS(10) - 1) ? F.out : (float*)(F.ws + WS_MAB); for (int m = gw; m < M; m += NGW) final_row(F, m, dst); } }
#undef IN
#undef SEAM
}

extern "C" void kernel_launch(void* const* d_in, const int* in_sizes, int n_in, void* d_out, int out_size, void* d_ws, size_t ws_size, hipStream_t stream) {
    static int grid = 0;
    if (grid == 0) {
        if (n_in != 19 || in_sizes[0] != M * DM || out_size != M * DM || ws_size < WS_END) {
            fprintf(stderr, "kernel_launch: unexpected problem (n_in %d, in0 %d, out %d, ws %zu < %zu); nothing launched\n", n_in, n_in > 0 ? in_sizes[0] : -1, out_size, ws_size, (size_t)WS_END); grid = -1; return; }
        int dev = 0, cus = 0;
        if (hipGetDevice(&dev) != hipSuccess || hipDeviceGetAttribute(&cus, hipDeviceAttributeMultiprocessorCount, dev) != hipSuccess) { grid = -1; return; }
        if (hipFuncSetAttribute((const void*)hgrh_fwd, hipFuncAttributeMaxDynamicSharedMemorySize, LDS_BYTES) != hipSuccess) { fprintf(stderr, "kernel_launch: hipFuncSetAttribute failed\n"); grid = -1; return; }
        int per_cu = 0;
        if (hipOccupancyMaxActiveBlocksPerMultiprocessor(&per_cu, (const void*)hgrh_fwd, NTHR, LDS_BYTES) != hipSuccess || per_cu < 1)
            fprintf(stderr, "kernel_launch: occupancy query reports %d workgroups per CU\n", per_cu);
        (void)hipGetLastError();
        grid = cus;
    }
    if (grid < 0) return;
    (void)hipMemsetAsync((char*)d_ws + WS_CTL, 0, CTL_ZERO_BYTES, stream);
    Args a{};
    for (int i = 0; i < 19; ++i) a.in[i] = (const float*)d_in[i];
    a.out = (float*)d_out; a.ws = (unsigned char*)d_ws;
#if MK_N_LAUNCHES == 1
    a.ph_lo = 0; a.ph_hi = NPH;
    hipLaunchKernelGGL(hgrh_fwd, dim3(grid), dim3(NTHR), LDS_BYTES, stream, a);
#else
    for (int p = 0; p < NPH; ++p) { a.ph_lo = p; a.ph_hi = p + 1; hipLaunchKernelGGL(hgrh_fwd, dim3(grid), dim3(NTHR), LDS_BYTES, stream, a); }
#endif
}
```

```cpp
#include <hip/hip_runtime.h>
#include <cstdio>
#include <cstdint>

#ifndef MK_N_LAUNCHES
#define MK_N_LAUNCHES 1
#endif

#ifndef REP_MASK
#define REP_MASK 0
#endif
#define REPS(k) (((REP_MASK >> (k)) & 1) ? 2 : 1)
#define LAS __attribute__((address_space(3)))
#define GAS __attribute__((address_space(1)))
typedef unsigned short bf16_t;
typedef short bf16x8 __attribute__((ext_vector_type(8)));
typedef short bf16x4 __attribute__((ext_vector_type(4)));
typedef float f32x4 __attribute__((ext_vector_type(4)));
typedef float f32x2 __attribute__((ext_vector_type(2)));
typedef unsigned u32x4 __attribute__((ext_vector_type(4)));
typedef unsigned u32x2 __attribute__((ext_vector_type(2)));

constexpr int BATCH = 8, SEQ = 2048, DM = 1024, M = BATCH * SEQ;
constexpr int D_IN = 7176, NP = 7168;
constexpr int NE = 32, DE = 512;
constexpr float EPS = 1e-6f;
constexpr int NWAVES = 8, NTHR = 512;
constexpr int NPH = 11;

constexpr size_t MiB = 1u << 20;
constexpr size_t WS_CTL = 0, CTL_ZERO_BYTES = 1 * MiB;
constexpr size_t WS_LTOK = 1 * MiB, WS_LDST = 3 * MiB, WS_LW = 5 * MiB;
constexpr size_t WS_ROPE = 7 * MiB;
constexpr size_t WS_G = 8 * MiB, WS_BETA = 8 * MiB + 256 * 1024;
constexpr size_t WS_WUPA = 9 * MiB, WS_WUPR = 10 * MiB, WS_WOUT = 12 * MiB;
constexpr size_t WS_WRT = 14 * MiB;
constexpr size_t WS_SSQ = 15 * MiB;
constexpr size_t WS_GQKV = 18 * MiB;
constexpr size_t WS_OGDN = 18 * MiB;
constexpr size_t WS_YB = 34 * MiB;
constexpr size_t WS_YA = 274 * MiB;
constexpr size_t WS_XN = 18 * MiB;
constexpr size_t WS_Y2 = 218 * MiB;
constexpr size_t WS_GZ = 66 * MiB;
constexpr size_t WS_RQK = 82 * MiB;
constexpr size_t WS_RV = 114 * MiB;
constexpr size_t WS_TMP = 82 * MiB;
constexpr size_t WS_WGU = 82 * MiB;
constexpr size_t WS_RG = 146 * MiB;
constexpr size_t WS_WD = 146 * MiB;
constexpr size_t WS_MAB = 178 * MiB;
constexpr size_t WS_HID = 178 * MiB;
constexpr size_t WS_U = 242 * MiB;
constexpr size_t WS_KV = 242 * MiB;
constexpr size_t WS_MERGED = 242 * MiB;
constexpr size_t WS_WINT = 274 * MiB;
constexpr size_t WS_UT = 274 * MiB;
constexpr size_t WS_END = 290 * MiB;
constexpr size_t GP_BYTES = 57344;
constexpr int GP_W = 0, GP_Q = 8192, GP_K = 16384, GP_A = 24576;
constexpr size_t DO_YA = 0, DO_YB = 16 * MiB;

constexpr int CW_TMO = 0;
constexpr int CW_CNT = 64;
constexpr int CW_PFX = 256;
constexpr int CW_BAR = 4096;

constexpr int RING_BYTES = 131072;
constexpr int MISC_OFF = RING_BYTES;
constexpr int LDS_BYTES = 147456;

#define LDS_WAIT() asm volatile("s_waitcnt lgkmcnt(0)" ::: "memory")
#define VM_WAIT() asm volatile("s_waitcnt vmcnt(0)" ::: "memory")
#define LBAR() do { asm volatile("s_waitcnt lgkmcnt(0)" ::: "memory"); __builtin_amdgcn_s_barrier(); asm volatile("" ::: "memory"); } while (0)
__device__ __forceinline__ unsigned f2bf(float f) { unsigned u = __builtin_bit_cast(unsigned, f); return (u + 0x7fffu + ((u >> 16) & 1u)) >> 16; }
typedef __bf16 bf16v2_t __attribute__((ext_vector_type(2)));
__device__ __forceinline__ unsigned pk2(float lo, float hi) { return __builtin_bit_cast(unsigned, __builtin_convertvector((f32x2){lo, hi}, bf16v2_t)); }
__device__ __forceinline__ float bf2f(unsigned short h) { return __builtin_bit_cast(float, (unsigned)h << 16); }
__device__ __forceinline__ float bflo(unsigned w) { return __builtin_bit_cast(float, w << 16); }
__device__ __forceinline__ float bfhi(unsigned w) { return __builtin_bit_cast(float, w & 0xffff0000u); }
template <int CTRL> __device__ __forceinline__ float dpp_f(float v) { return __builtin_bit_cast(float, __builtin_amdgcn_update_dpp(0, __builtin_bit_cast(int, v), CTRL, 0xf, 0xf, true)); }
__device__ __forceinline__ float row16_sum(float v) {
    v += dpp_f<0xB1>(v);
    v += dpp_f<0x4E>(v);
    v += dpp_f<0x141>(v);
    v += dpp_f<0x140>(v);
    return v;
}
__device__ __forceinline__ float rdlane(float v, int l) { return __builtin_bit_cast(float, __builtin_amdgcn_readlane(__builtin_bit_cast(int, v), l)); }
__device__ __forceinline__ float wave_sum(float v) {
    v = row16_sum(v);
    return (rdlane(v, 0) + rdlane(v, 16)) + (rdlane(v, 32) + rdlane(v, 48));
}
__device__ __forceinline__ float sigmoidf_(float x) { return __builtin_amdgcn_rcpf(1.0f + __builtin_amdgcn_exp2f(-1.4426950408889634f * x)); }
__device__ __forceinline__ float siluf_(float x) { return x * sigmoidf_(x); }
__device__ __forceinline__ float rsqrtf_(float x) { return __builtin_amdgcn_rsqf(x); }

#define XB_TMO      128
#define XB_XCNT(j)  (256  + 64 * (j))
#define XB_XSUB(j)  (1280 + 64 * (j))
#define XB_XGEN(j)  (2304 + 64 * (j))
#define XB_TOP      3328
#define XB_TOPGEN   3392
#define XCD_BAR_WORDS 3456
#define XB_SPIN_CAP (1u << 18)
__device__ __forceinline__ unsigned xb_ld(unsigned* p)              { return __hip_atomic_load(p, __ATOMIC_RELAXED, __HIP_MEMORY_SCOPE_AGENT); }
__device__ __forceinline__ unsigned xb_add(unsigned* p, unsigned v) { return __hip_atomic_fetch_add(p, v, __ATOMIC_RELAXED, __HIP_MEMORY_SCOPE_AGENT); }
__device__ __forceinline__ unsigned xb_xcc_id() { return (unsigned)__builtin_amdgcn_s_getreg((3 << 11) | 20) & 0xFu; }
#define XB_SPIN(cond, bar) do { unsigned _sp = 0; while (cond) { __builtin_amdgcn_s_sleep(1); \
    if ((++_sp & 255u) == 0u) { if (xb_ld(&(bar)[XB_TMO])) break; if (_sp > XB_SPIN_CAP) { atomicAdd(&(bar)[XB_TMO], 1u); break; } } } } while (0)
struct XcdBarrier { unsigned* bar; unsigned x; volatile LAS unsigned* st; };
__device__ __forceinline__ XcdBarrier xcd_barrier_post(unsigned* bar, volatile LAS unsigned* st) {
    XcdBarrier b; b.bar = bar; b.x = xb_xcc_id(); b.st = st;
    if (threadIdx.x == 0) (void)xb_add(&bar[XB_XCNT(b.x)], 1u);
    return b;
}
__device__ __forceinline__ void xcd_barrier_complete(unsigned* bar, unsigned x, unsigned& nloc, unsigned& nx) {
    const unsigned G = gridDim.x * gridDim.y * gridDim.z;
    unsigned sum, cnt, mine, sp = 0u;
    for (;;) {
        sum = 0u; cnt = 0u; mine = 0u;
#pragma unroll
        for (unsigned j = 0; j < 16; ++j) { const unsigned c = xb_ld(&bar[XB_XCNT(j)]); sum += c; cnt += (c > 0u) ? 1u : 0u; mine = (j == x) ? c : mine; }
        if (sum == G) break;
        __builtin_amdgcn_s_sleep(1);
        if ((++sp & 255u) == 0u) { if (xb_ld(&bar[XB_TMO])) break; if (sp > XB_SPIN_CAP) { atomicAdd(&bar[XB_TMO], 1u); break; } }
    }
    nloc = mine > 0u ? mine : 1u; nx = cnt > 0u ? cnt : 1u;
}
__device__ __forceinline__ void xcd_barrier(const XcdBarrier& b) {
    asm volatile("s_waitcnt vmcnt(0)" ::: "memory");
    __syncthreads();
    if (threadIdx.x == 0) {
        unsigned* bar = b.bar;
        __builtin_amdgcn_s_waitcnt(0);
        unsigned nloc = b.st[0], nx = b.st[1];
        if (nloc == 0u) { xcd_barrier_complete(bar, b.x, nloc, nx); b.st[0] = nloc; b.st[1] = nx; }
        const unsigned old = xb_add(&bar[XB_XSUB(b.x)], 1u);
        const unsigned gen = old / nloc;
        if (old + 1u == (gen + 1u) * nloc) {
            __builtin_amdgcn_fence(__ATOMIC_RELEASE, "agent");
            asm volatile("s_waitcnt vmcnt(0)" ::: "memory");
            const unsigned og = xb_add(&bar[XB_TOP], 1u);
            const unsigned tg = og / nx;
            if (og + 1u == (tg + 1u) * nx) xb_add(&bar[XB_TOPGEN], 1u);
            else XB_SPIN(xb_ld(&bar[XB_TOPGEN]) == tg, bar);
            __builtin_amdgcn_fence(__ATOMIC_ACQUIRE, "agent");
            xb_add(&bar[XB_XGEN(b.x)], 1u);
            asm volatile("s_waitcnt vmcnt(0)" ::: "memory");
        } else {
            XB_SPIN(xb_ld(&bar[XB_XGEN(b.x)]) == gen, bar);
            __builtin_amdgcn_fence(__ATOMIC_ACQUIRE, "agent");
            asm volatile("s_waitcnt vmcnt(0)" ::: "memory");
        }
    }
    __syncthreads();
}

namespace pg8 {
constexpr int BM = 256, BK = 64, HALF = 128, HTB = HALF * BK * 2, STAGE_BYTES = 8 * HTB, NXCD = 8, WGM = 8;
__host__ __device__ __forceinline__ int lds_byte(int r, int c) { const int st = (r >> 4) * 2 + (c >> 5), rr = r & 15, cc = c & 31, ob = rr * 64 + cc * 2; return st * 1024 + (ob ^ (((ob >> 9) & 1) << 5)); }
__host__ __device__ __forceinline__ void stage_rc(int b, int& R, int& C) { const int st = b / 1024, sb = b % 1024, swz = sb ^ (((sb >> 9) & 1) << 5); R = (st >> 1) * 16 + swz / 64; C = (st & 1) * 32 + (swz % 64) / 2; }
__host__ __device__ __forceinline__ int perm32(int rho) { const int n = rho >> 4, i = rho & 15; return 8 * (i >> 2) + 4 * n + (i & 3); }

struct Unit { int pm, pn, e, rows, base; };

__device__ __forceinline__ unsigned cvt_pk_bf16(float lo, float hi) { return pk2(lo, hi); }

struct Dense {
    const bf16_t* A; const bf16_t* Bt; int K; int nM, nN, nwg, G, c;
    __device__ void init(const bf16_t* A_, const bf16_t* Bt_, int M_, int N_, int K_, int G_, int c_) { A = A_; Bt = Bt_; K = K_; nM = M_ / BM; nN = N_ / BM; nwg = nM * nN; G = G_; c = c_; }
    __device__ __forceinline__ bool next(int i, Unit& u) const {
        const long L = (long)i * G + c; if (L >= nwg) return false;
        int wgid = (int)L; { const int q = nwg / NXCD, r = nwg % NXCD, xcd = wgid % NXCD, off = wgid / NXCD; wgid = (xcd < r ? xcd * (q + 1) : r * (q + 1) + (xcd - r) * q) + off; }
        const int nig = WGM * nN, gid = wgid / nig, fm = gid * WGM, gsz = (nM - fm) < WGM ? (nM - fm) : WGM;
        u.pm = fm + ((wgid % nig) % gsz); u.pn = (wgid % nig) / gsz; u.e = 0; u.rows = 256; u.base = 0; return true;
    }
    __device__ __forceinline__ const char* a_ptr(const Unit& u) const { return (const char*)A + (size_t)u.pm * (size_t)(2 * HALF) * K * 2; }
    __device__ __forceinline__ const char* b_ptr(const Unit& u) const { return (const char*)Bt + (size_t)u.pn * (size_t)(2 * HALF) * K * 2; }
    __device__ __forceinline__ void a_ready(const Unit&) const {}
    __device__ __forceinline__ void done(const Unit&) const {}
};

template <class Epi, class Prob, bool GATHER, bool ALIGN_EPI, bool SP2, int ACCMODE = 0>
__device__ __forceinline__ void gemm_phase(LAS unsigned char* lds, const Prob& S, const Epi& E, f32x4 (*xacc)[2][4][2] = nullptr) {
    const int tid = threadIdx.x, wid = __builtin_amdgcn_readfirstlane(tid >> 6), lane = tid & 63, wr = wid >> 2, wc = wid & 3, fr = lane & 15, fq = lane >> 4;
    const int K = S.K, nt = K / BK;
    unsigned voffB[2]; int RA[2], CA[2];
    unsigned cvo[2][2], nvo[2][2];
#pragma unroll
    for (int i = 0; i < 2; ++i) { int R, C; stage_rc(tid * 16 + i * 8192, R, C); const int Rb = Epi::PERM ? ((R & ~31) + perm32(R & 31)) : R;
        RA[i] = R; CA[i] = C; voffB[i] = (unsigned)(Rb * K + C) * 2u; }
    const size_t kstep = (size_t)(BK * 2);
    const size_t hstep = (size_t)HALF * K * 2;
    const unsigned ldsw = (unsigned)wid * 1024u;
    const int aoff = lds_byte(wr * 64 + fr, fq * 8), boff = lds_byte(wc * 32 + fr, fq * 8);
#define PG8_SA(b, h) (((b) * 2 + (h)) * HTB)
#define PG8_SB(b, h) ((4 + (b) * 2 + (h)) * HTB)
#define PG8_STAGE(bufoff, gbase, voff) do { _Pragma("unroll") for (int _i = 0; _i < 2; ++_i) \
        __builtin_amdgcn_global_load_lds((const unsigned*)((const char*)(gbase) + (voff)[_i]), (LAS unsigned*)(lds + (bufoff) + ldsw + _i * 8192), 16, 0, 0); } while (0)
#define PG8_LDA(dst, b, h) do { _Pragma("unroll") for (int m = 0; m < 4; ++m) _Pragma("unroll") for (int k = 0; k < 2; ++k) dst[m][k] = *(const LAS bf16x8*)(lds + PG8_SA(b, h) + aoff + m * 2048 + k * 1024); } while (0)
#define PG8_LDB(dst, b, h) do { _Pragma("unroll") for (int n = 0; n < 2; ++n) _Pragma("unroll") for (int k = 0; k < 2; ++k) dst[n][k] = *(const LAS bf16x8*)(lds + PG8_SB(b, h) + boff + n * 2048 + k * 1024); } while (0)
#define PG8_MMA(ai, bj, At, Bt) do { __builtin_amdgcn_s_setprio(1); _Pragma("unroll") for (int m = 0; m < 4; ++m) _Pragma("unroll") for (int n = 0; n < 2; ++n) _Pragma("unroll") for (int k = 0; k < 2; ++k) \
        acc[ai][bj][m][n] = __builtin_amdgcn_mfma_f32_16x16x32_bf16(Bt[n][k], At[m][k], acc[ai][bj][m][n], 0, 0, 0); __builtin_amdgcn_s_setprio(0); } while (0)
#define PG8_WAIT_V(n) asm volatile("s_waitcnt vmcnt(" #n ")" ::: "memory")
#define PG8_WAIT_L(n) asm volatile("s_waitcnt lgkmcnt(" #n ")" ::: "memory")
#define PG8_BAR __builtin_amdgcn_s_barrier()
#define PG8_SCHED __builtin_amdgcn_sched_barrier(0)
    Unit cur, nxt; int ui = 0;
    if (!S.next(0, cur)) return;
    f32x4 acc_local[2][2][4][2];
    f32x4 (&acc)[2][2][4][2] = (ACCMODE == 0) ? acc_local : *(f32x4 (*)[2][2][4][2])xacc;
    if constexpr (ACCMODE != 2) {
#pragma unroll
    for (int a = 0; a < 2; ++a)
#pragma unroll
        for (int b = 0; b < 2; ++b)
#pragma unroll
            for (int m = 0; m < 4; ++m)
#pragma unroll
                for (int n = 0; n < 2; ++n) acc[a][b][m][n] = (f32x4){0.f, 0.f, 0.f, 0.f};
    }
    bf16x8 At[4][2], B0[2][2], B1[2][2];
    S.a_ready(cur);
    const char* cA = S.a_ptr(cur); const char* cB = S.b_ptr(cur);
#pragma unroll
    for (int h = 0; h < 2; ++h)
#pragma unroll
        for (int i = 0; i < 2; ++i) {
            if constexpr (GATHER) cvo[h][i] = (unsigned)(((size_t)S.a_row(cur, h * HALF + RA[i]) * K + CA[i]) * 2u);
            else cvo[h][i] = (unsigned)((RA[i] * K + CA[i]) * 2u + h * hstep);
            nvo[h][i] = cvo[h][i];
        }
    if constexpr (SP2) {
        PG8_STAGE(PG8_SB(0, 0), cB, voffB); PG8_STAGE(PG8_SB(0, 1), cB + hstep, voffB); PG8_STAGE(PG8_SA(0, 0), cA, cvo[0]); PG8_STAGE(PG8_SA(0, 1), cA, cvo[1]);
        if (wr == 1) PG8_BAR;
        PG8_WAIT_V(2); PG8_BAR;
        PG8_STAGE(PG8_SB(1, 0), cB + kstep, voffB); PG8_STAGE(PG8_SA(1, 0), cA + kstep, cvo[0]); PG8_STAGE(PG8_SB(1, 1), cB + hstep + kstep, voffB);
        PG8_WAIT_V(6); PG8_BAR;
    } else {
        PG8_STAGE(PG8_SB(0, 0), cB, voffB); PG8_STAGE(PG8_SA(0, 0), cA, cvo[0]); PG8_STAGE(PG8_SB(0, 1), cB + hstep, voffB); PG8_STAGE(PG8_SA(0, 1), cA, cvo[1]);
        if (wr == 1) PG8_BAR;
        PG8_WAIT_V(4); PG8_BAR;
        PG8_STAGE(PG8_SB(1, 0), cB + kstep, voffB); PG8_STAGE(PG8_SA(1, 0), cA + kstep, cvo[0]); PG8_STAGE(PG8_SB(1, 1), cB + hstep + kstep, voffB);
        PG8_WAIT_V(6); PG8_BAR;
    }
    for (;;) {
        const bool has_next = (ACCMODE == 0) ? S.next(ui + 1, nxt) : false;
        const char* nA = has_next ? S.a_ptr(nxt) : cA; const char* nB = has_next ? S.b_ptr(nxt) : cB;
        if constexpr (GATHER) {
#pragma unroll
            for (int h = 0; h < 2; ++h)
#pragma unroll
                for (int i = 0; i < 2; ++i) nvo[h][i] = has_next ? (unsigned)(((size_t)S.a_row(nxt, h * HALF + RA[i]) * K + CA[i]) * 2u) : cvo[h][i];
        }
        for (int t = 0; t < nt; t += 2) {
            const bool last = (t == nt - 2);
            if (last && has_next) S.a_ready(nxt);
            const char* a1 = cA + (size_t)(t + 1) * kstep;
            const char* a2 = last ? nA : cA + (size_t)(t + 2) * kstep; const char* b2 = last ? nB : cB + (size_t)(t + 2) * kstep;
            const char* a3 = a2 + kstep; const char* b3 = b2 + kstep;
            unsigned v2[2][2];
#pragma unroll
            for (int h = 0; h < 2; ++h)
#pragma unroll
                for (int i = 0; i < 2; ++i) v2[h][i] = (GATHER && last) ? nvo[h][i] : cvo[h][i];
            if constexpr (SP2) {
            PG8_LDB(B0, 0, 0); PG8_LDB(B1, 0, 1); PG8_SCHED; PG8_LDA(At, 0, 0); PG8_STAGE(PG8_SA(1, 1), a1, cvo[1]);
            PG8_WAIT_V(8); PG8_WAIT_L(0); PG8_BAR; PG8_MMA(0, 0, At, B0); PG8_MMA(0, 1, At, B1); PG8_BAR; PG8_SCHED;
            PG8_LDA(At, 0, 1); PG8_STAGE(PG8_SB(0, 0), b2, voffB); PG8_STAGE(PG8_SB(0, 1), b2 + hstep, voffB); PG8_STAGE(PG8_SA(0, 0), a2, v2[0]);
            PG8_WAIT_V(8); PG8_WAIT_L(0); PG8_BAR; PG8_MMA(1, 0, At, B0); PG8_MMA(1, 1, At, B1); PG8_BAR; PG8_SCHED;
            PG8_LDB(B0, 1, 0); PG8_LDB(B1, 1, 1); PG8_SCHED; PG8_LDA(At, 1, 0); PG8_STAGE(PG8_SA(0, 1), a2, v2[1]);
            PG8_WAIT_V(8); PG8_WAIT_L(0); PG8_BAR; PG8_MMA(0, 0, At, B0); PG8_MMA(0, 1, At, B1); PG8_BAR; PG8_SCHED;
            PG8_LDA(At, 1, 1); PG8_STAGE(PG8_SB(1, 0), b3, voffB); PG8_STAGE(PG8_SB(1, 1), b3 + hstep, voffB); PG8_STAGE(PG8_SA(1, 0), a3, v2[0]);
            PG8_WAIT_V(8); PG8_WAIT_L(0); PG8_BAR; PG8_MMA(1, 0, At, B0); PG8_MMA(1, 1, At, B1); PG8_BAR; PG8_SCHED;
            } else {
            PG8_LDB(B0, 0, 0); PG8_SCHED; PG8_LDA(At, 0, 0); PG8_STAGE(PG8_SA(1, 1), a1, cvo[1]);
            PG8_WAIT_L(8); PG8_BAR; PG8_WAIT_L(0); PG8_MMA(0, 0, At, B0); PG8_BAR; PG8_SCHED;
            PG8_LDB(B1, 0, 1); PG8_STAGE(PG8_SB(0, 0), b2, voffB);
            PG8_BAR; PG8_WAIT_L(0); PG8_MMA(0, 1, At, B1); PG8_BAR;
            PG8_LDA(At, 0, 1); PG8_STAGE(PG8_SA(0, 0), a2, v2[0]);
            PG8_BAR; PG8_WAIT_L(0); PG8_MMA(1, 0, At, B0); PG8_BAR; PG8_SCHED;
            PG8_STAGE(PG8_SB(0, 1), b2 + hstep, voffB);
            PG8_WAIT_V(6); PG8_BAR; PG8_MMA(1, 1, At, B1); PG8_BAR;
            PG8_LDB(B0, 1, 0); PG8_SCHED; PG8_LDA(At, 1, 0); PG8_STAGE(PG8_SA(0, 1), a2, v2[1]);
            PG8_WAIT_L(8); PG8_BAR; PG8_WAIT_L(0); PG8_MMA(0, 0, At, B0); PG8_BAR; PG8_SCHED;
            PG8_LDB(B1, 1, 1); PG8_STAGE(PG8_SB(1, 0), b3, voffB);
            PG8_BAR; PG8_WAIT_L(0); PG8_MMA(0, 1, At, B1); PG8_BAR;
            PG8_LDA(At, 1, 1); PG8_STAGE(PG8_SA(1, 0), a3, v2[0]);
            PG8_BAR; PG8_WAIT_L(0); PG8_MMA(1, 0, At, B0); PG8_BAR; PG8_SCHED;
            PG8_STAGE(PG8_SB(1, 1), b3 + hstep, voffB);
            PG8_WAIT_V(6); PG8_BAR; PG8_MMA(1, 1, At, B1); PG8_BAR;
            }
        }
        if constexpr (ALIGN_EPI) { if (wr == 0) PG8_BAR; }
        E(acc, cur, wr, wc, fr, fq);
        S.done(cur);
        if (!has_next) break;
#pragma unroll
        for (int a = 0; a < 2; ++a)
#pragma unroll
            for (int b = 0; b < 2; ++b)
#pragma unroll
                for (int m = 0; m < 4; ++m)
#pragma unroll
                    for (int n = 0; n < 2; ++n) acc[a][b][m][n] = (f32x4){0.f, 0.f, 0.f, 0.f};
        cur = nxt; cA = nA; cB = nB; ++ui;
#pragma unroll
        for (int h = 0; h < 2; ++h)
#pragma unroll
            for (int i = 0; i < 2; ++i) cvo[h][i] = nvo[h][i];
        if constexpr (ALIGN_EPI) { if (wr == 1) PG8_BAR; }
    }
    PG8_WAIT_V(0);
    if constexpr (!ALIGN_EPI) { if (wr == 0) PG8_BAR; }
    PG8_BAR;
#undef PG8_SA
#undef PG8_SB
#undef PG8_STAGE
#undef PG8_LDA
#undef PG8_LDB
#undef PG8_MMA
#undef PG8_WAIT_V
#undef PG8_WAIT_L
#undef PG8_BAR
#undef PG8_SCHED
}
}

struct Frame {
    LAS unsigned char* lds;
    volatile LAS unsigned* MISC;
    GAS unsigned* ctl;
    int tid, lane, wave;
    int vcu, G;
    const float* in[19];
    float* out; unsigned char* ws;
};
enum { I_X = 0, I_NMW, I_WIN, I_CONVW, I_ALOG, I_DTB, I_GNW, I_WUPG, I_WUPR, I_WOUT, I_NFW, I_WGRP, I_BGRP, I_WEXP, I_BEXP, I_WGATE, I_WUP, I_WDOWN, I_NFINW };

struct TrItem { const float* W; bf16_t* WT; int ldw, col0, K, row0, k0; };
__device__ __forceinline__ void tr_load(const TrItem& t, int lane, f32x4 (&ld)[8]) {
#pragma unroll
    for (int i = 0; i < 8; ++i) ld[i] = *(const f32x4*)(t.W + (size_t)(t.k0 + i * 8 + (lane >> 3)) * t.ldw + t.col0 + (lane & 7) * 4);
}
__device__ __forceinline__ void tr_store(const TrItem& t, int lane, const f32x4 (&ld)[8], LAS float* scr) {
#pragma unroll
    for (int i = 0; i < 8; ++i) { LAS float* d = scr + (i * 8 + (lane >> 3)) * 33 + (lane & 7) * 4; d[0] = ld[i].x; d[1] = ld[i].y; d[2] = ld[i].z; d[3] = ld[i].w; }
    LDS_WAIT(); asm volatile("" ::: "memory");
    const int c = lane & 7;
#pragma unroll
    for (int j = 0; j < 4; ++j) { const int n = (lane >> 3) + 8 * j; const LAS float* sp = scr + (8 * c) * 33 + n;
        u32x4 o; o.x = pk2(sp[0 * 33], sp[1 * 33]); o.y = pk2(sp[2 * 33], sp[3 * 33]); o.z = pk2(sp[4 * 33], sp[5 * 33]); o.w = pk2(sp[6 * 33], sp[7 * 33]);
        *(GAS u32x4*)(t.WT + (size_t)(t.row0 + n) * t.K + t.k0 + 8 * c) = o; }
    LDS_WAIT(); asm volatile("" ::: "memory");
}
template <class Dec> __device__ __forceinline__ void tr_run(const Dec& dec, int first, int count, int stride, int lane, LAS float* scr) {
    if (first >= count) return;
    f32x4 la[8], lb[8];
    TrItem ta = dec(first), tb = ta;
    tr_load(ta, lane, la);
    for (int it = first; it < count; it += 2 * stride) {
        const bool hb = it + stride < count;
        if (hb) { tb = dec(it + stride); tr_load(tb, lane, lb); }
        tr_store(ta, lane, la, scr);
        const bool ha = it + 2 * stride < count;
        if (ha) { ta = dec(it + 2 * stride); tr_load(ta, lane, la); }
        if (hb) tr_store(tb, lane, lb, scr);
    }
}

__device__ __forceinline__ void p0_prologue(Frame& F) {
    LAS float* scr = (LAS float*)(F.lds + F.wave * 16384);
    const int gw = F.vcu * NWAVES + F.wave, NGW = F.G * NWAVES;
    unsigned char* ws = F.ws;
    {
        constexpr int I_IN = (DM / 64) * (NP / 32);
        constexpr int I_UA = (512 / 64) * (DM / 32);
        constexpr int I_UR = (1024 / 64) * (DM / 32);
        constexpr int I_WO = (1024 / 64) * (DM / 32);
        constexpr int NIT = I_IN + I_UA + I_UR + I_WO;
        const float* win = F.in[I_WIN]; const float* wua = F.in[I_WUPG]; const float* wur = F.in[I_WUPR]; const float* wo = F.in[I_WOUT];
        auto dec = [=](int it) -> TrItem {
            int r = it; TrItem t;
            if (r < I_IN) { const int nb = r % (NP / 32), kb = r / (NP / 32); const int n0 = nb * 32;
                t.W = win; t.ldw = D_IN; t.col0 = n0 + (n0 >= 1536 ? 8 : 0); t.WT = (bf16_t*)(ws + WS_WINT); t.K = DM; t.row0 = n0; t.k0 = kb * 64; return t; }
            r -= I_IN;
            if (r < I_UA) { const int nb = r % 32, kb = r / 32; t.W = wua; t.ldw = DM; t.col0 = nb * 32; t.WT = (bf16_t*)(ws + WS_WUPA); t.K = 512; t.row0 = nb * 32; t.k0 = kb * 64; return t; }
            r -= I_UA;
            if (r < I_UR) { const int nb = r % 32, kb = r / 32; t.W = wur; t.ldw = DM; t.col0 = nb * 32; t.WT = (bf16_t*)(ws + WS_WUPR); t.K = 1024; t.row0 = nb * 32; t.k0 = kb * 64; return t; }
            r -= I_UR;
            { const int nb = r % 32, kb = r / 32; t.W = wo; t.ldw = DM; t.col0 = nb * 32; t.WT = (bf16_t*)(ws + WS_WOUT); t.K = 1024; t.row0 = nb * 32; t.k0 = kb * 64; return t; }
        };
        tr_run(dec, gw, NIT, NGW, F.lane, scr);
    }
    {
        GAS f32x2* tab = (GAS f32x2*)(ws + WS_ROPE);
        const int gt = (F.vcu * NTHR + F.tid), NGT = F.G * NTHR;
        for (int i = gt; i < SEQ * 64; i += NGT) {
            const int t = i >> 6, p = i & 63;
            const float invf = 1.0f / powf(10000.0f, (float)p * (1.0f / 63.0f));
            const float ang = (float)t * invf;
            float s, c; sincosf(ang, &s, &c);
            tab[i] = (f32x2){c, s};
        }
    }
    {
        GAS float* wrt = (GAS float*)(ws + WS_WRT);
        const int gt = (F.vcu * NTHR + F.tid), NGT = F.G * NTHR;
        for (int i = gt; i < 48 * DM; i += NGT) {
            const int j = i / DM, k = i % DM;
            const float nf = F.in[I_NFW][k];
            wrt[i] = j < 4 ? F.in[I_WGRP][k * 4 + j] * nf : (j < 36 ? F.in[I_WEXP][k * 32 + (j - 4)] * nf : 0.f);
        }
    }
    {
        __syncthreads();
        LAS float* wab2 = (LAS float*)F.lds;
        for (int idx = F.tid; idx < 8192; idx += NTHR) { const int k = idx >> 3, q = idx & 7; const int j = k >> 8, l_ = (k & 255) >> 2, e = k & 3;
            wab2[((j * 4 + e) * 64 + l_) * 8 + q] = F.in[I_WIN][(size_t)k * D_IN + 1536 + q]; }
        __syncthreads();
        const float* nw = F.in[I_NMW];
        f32x4 wv[4];
#pragma unroll
        for (int j = 0; j < 4; ++j) wv[j] = *(const f32x4*)(nw + 4 * F.lane + 256 * j);
        float alog = 0.f, dtb = 0.f;
        if (F.lane < 4) { alog = F.in[I_ALOG][F.lane]; dtb = F.in[I_DTB][F.lane]; }
        for (int m = gw; m < M; m += NGW) {
            const GAS f32x4* xr = (const GAS f32x4*)(F.in[I_X] + (size_t)m * DM) + F.lane;
            f32x4 v[4]; float s = 0.f;
#pragma unroll
            for (int j = 0; j < 4; ++j) { v[j] = xr[64 * j]; s += (v[j].x * v[j].x + v[j].y * v[j].y) + (v[j].z * v[j].z + v[j].w * v[j].w); }
            const float rstd = 1.0f / sqrtf(wave_sum(s) * (1.f / DM) + EPS);
            float ab[8];
#pragma unroll
            for (int q = 0; q < 8; ++q) ab[q] = 0.f;
            GAS unsigned long long* o8 = (GAS unsigned long long*)((bf16_t*)(ws + WS_U) + (size_t)m * DM) + F.lane;
#pragma unroll
            for (int j = 0; j < 4; ++j) {
                v[j] = v[j] * rstd * wv[j];
                o8[64 * j] = (unsigned long long)pk2(v[j].x, v[j].y) | ((unsigned long long)pk2(v[j].z, v[j].w) << 32);
#pragma unroll
                for (int e = 0; e < 4; ++e) {
                    const LAS f32x4* wp = (const LAS f32x4*)(wab2 + ((j * 4 + e) * 64 + F.lane) * 8);
                    const f32x4 w0 = wp[0], w1 = wp[1];
                    const float xv = v[j][e];
                    ab[0] += xv * w0.x; ab[1] += xv * w0.y; ab[2] += xv * w0.z; ab[3] += xv * w0.w;
                    ab[4] += xv * w1.x; ab[5] += xv * w1.y; ab[6] += xv * w1.z; ab[7] += xv * w1.w;
                }
            }
#pragma unroll
            for (int q = 0; q < 8; ++q) ab[q] = wave_sum(ab[q]);
            if (F.lane < 4) {
                const float a = F.lane == 0 ? ab[0] : F.lane == 1 ? ab[1] : F.lane == 2 ? ab[2] : ab[3];
                const float b = F.lane == 0 ? ab[4] : F.lane == 1 ? ab[5] : F.lane == 2 ? ab[6] : ab[7];
                const float z = a + dtb;
                const float sp = z > 20.f ? z : log1pf(__expf(z));
                ((GAS float*)(ws + WS_G))[(size_t)m * 4 + F.lane] = -__expf(alog) * sp;
                ((GAS float*)(ws + WS_BETA))[(size_t)m * 4 + F.lane] = 1.0f / (1.0f + __expf(-b));
            }
        }
    }
}

struct EpiProj {
    static constexpr bool PERM = true;
    unsigned char* ws;
    __device__ __forceinline__ void operator()(const f32x4 (&acc)[2][2][4][2], const pg8::Unit& u, int wr, int wc, int fr, int fq) const {
        const int pn = u.pn; bf16_t* base; int ldc, colt, mode = 0;
        if (pn < 6) { base = (bf16_t*)(ws + WS_GQKV); ldc = 1536; colt = 256 * pn; }
        else if (pn < 8) { base = (bf16_t*)(ws + WS_GZ); ldc = 512; colt = 256 * (pn - 6); }
        else if (pn < 12) { base = (bf16_t*)(ws + WS_RQK); ldc = 1024; colt = 256 * (pn - 8); mode = pn < 10 ? 1 : 2; }
        else if (pn < 16) { base = (bf16_t*)(ws + WS_RV); ldc = 1024; colt = 256 * (pn - 12); }
        else if (pn < 20) { base = (bf16_t*)(ws + WS_RG); ldc = 1024; colt = 256 * (pn - 16); }
        else { base = (bf16_t*)(ws + WS_MAB); ldc = 2048; colt = 256 * (pn - 20); }
        const int row0 = u.pm * 256 + wr * 64 + fr, col0 = colt + wc * 32 + 8 * fq;
        const float sc = mode == 2 ? 0.08838834764831845f : 1.0f;
        const GAS f32x4* tab = (const GAS f32x4*)(ws + WS_ROPE);
#pragma unroll
        for (int ai = 0; ai < 2; ++ai)
#pragma unroll
            for (int m = 0; m < 4; ++m) {
                const int row = row0 + ai * 128 + m * 16;
                bf16_t* rowp = base + (size_t)row * ldc + col0;
                f32x4 cs0 = {1.f, 0.f, 1.f, 0.f}, cs1 = cs0;
                if (mode) { const GAS f32x4* tp = tab + ((size_t)(row & (SEQ - 1)) * 64 + wc * 16 + 4 * fq) / 2; cs0 = tp[0]; cs1 = tp[1]; }
#pragma unroll
                for (int bj = 0; bj < 2; ++bj) {
                    f32x4 v0 = acc[ai][bj][m][0], v1 = acc[ai][bj][m][1];
                    if (mode) {
                        f32x4 r0, r1;
                        r0[0] = v0[0] * cs0[0] - v0[1] * cs0[1]; r0[1] = v0[1] * cs0[0] + v0[0] * cs0[1];
                        r0[2] = v0[2] * cs0[2] - v0[3] * cs0[3]; r0[3] = v0[3] * cs0[2] + v0[2] * cs0[3];
                        r1[0] = v1[0] * cs1[0] - v1[1] * cs1[1]; r1[1] = v1[1] * cs1[0] + v1[0] * cs1[1];
                        r1[2] = v1[2] * cs1[2] - v1[3] * cs1[3]; r1[3] = v1[3] * cs1[2] + v1[2] * cs1[3];
                        v0 = r0 * sc; v1 = r1 * sc;
                    }
                    u32x4 w; w.x = pg8::cvt_pk_bf16(v0[0], v0[1]); w.y = pg8::cvt_pk_bf16(v0[2], v0[3]); w.z = pg8::cvt_pk_bf16(v1[0], v1[1]); w.w = pg8::cvt_pk_bf16(v1[2], v1[3]);
                    *(u32x4*)(rowp + bj * 128) = w;
                }
            }
    }
};

__device__ __forceinline__ f32x4 mma16(bf16x8 x, bf16x8 y, f32x4 c) { return __builtin_amdgcn_mfma_f32_16x16x32_bf16(x, y, c, 0, 0, 0); }
__device__ __forceinline__ bf16x8 lfrag(const LAS bf16_t* base, int ld, int row0, int k0, int fr, int fq) { return *(const LAS bf16x8*)(base + (row0 + fr) * ld + k0 + 8 * fq); }
__device__ __forceinline__ bf16x8 gfrag(const bf16_t* base, int ld, int row0, int k0, int fr, int fq) { return *(const bf16x8*)(base + (size_t)(row0 + fr) * ld + k0 + 8 * fq); }
__device__ __forceinline__ bf16x8 tfrag(const LAS bf16_t* base, int ld, int k0, int n0, int lane) {
    const int g = lane >> 4, q = (lane & 15) >> 2, p = lane & 3;
    const LAS bf16_t* a = base + (k0 + 8 * g + q) * ld + n0 + 4 * p;
    const bf16x4 v0 = __builtin_amdgcn_ds_read_tr16_b64_v4i16((LAS bf16x4*)a);
    const bf16x4 v1 = __builtin_amdgcn_ds_read_tr16_b64_v4i16((LAS bf16x4*)(a + 4 * ld));
    return (bf16x8){v0[0], v0[1], v0[2], v0[3], v1[0], v1[1], v1[2], v1[3]};
}
__device__ __forceinline__ bf16x8 pack_acc(f32x4 a, f32x4 b) {
    u32x4 w; w.x = pk2(a[0], a[1]); w.y = pk2(a[2], a[3]); w.z = pk2(b[0], b[1]); w.w = pk2(b[2], b[3]);
    return __builtin_bit_cast(bf16x8, w);
}
__device__ __forceinline__ int ppos(int kap) { return 8 * ((kap & 15) >> 2) + 4 * (kap >> 4) + (kap & 3); }
__device__ __forceinline__ int foff(int row, int col, int kc32) { const int p = ppos(col & 31); return ((row >> 4) * kc32 + (col >> 5)) * 512 + ((row & 15) + 16 * (p >> 3)) * 8 + (p & 7); }

constexpr size_t WS_GL = 8 * MiB + 512 * 1024;

__device__ __forceinline__ void gdn_prep_fetch(Frame& F, int idx, u32x4 (&xw)[2][7], float& gpre, float& bpre) {
    const int bh = idx >> 5, n = idx & 31, b = bh >> 2, h = bh & 3, tok0 = b * SEQ + n * 64, tid = F.tid;
    const bf16_t* GQKV = (const bf16_t*)(F.ws + WS_GQKV);
    if (F.wave == 0) { gpre = ((const float*)(F.ws + WS_G))[(size_t)(tok0 + F.lane) * 4 + h]; bpre = ((const float*)(F.ws + WS_BETA))[(size_t)(tok0 + F.lane) * 4 + h]; }
#pragma unroll
    for (int q = 0; q < 2; ++q) {
        const int task = tid + q * NTHR;
        const int cg = task % 48, tr = task / 48, part = cg >> 4, cl = (cg & 15) * 8, gcol = part * 512 + h * 128 + cl;
#pragma unroll
        for (int r = 0; r < 7; ++r) {
            const int tt = tr * 4 - 3 + r;
            xw[q][r] = (u32x4){0u, 0u, 0u, 0u};
            if (task < 768 && n * 64 + tt >= 0) xw[q][r] = *(const u32x4*)((const unsigned char*)GQKV + (unsigned)(((tok0 + tt) * 1536 + gcol) * 2));
        }
    }
}
template <int PM> __device__ __forceinline__ void gdn_prep_item(Frame& F, int idx, int idx_next, u32x4 (&xw)[2][7], float& gpre, float& bpre) {
    const int bh = idx >> 5, n = idx & 31, b = bh >> 2, h = bh & 3;
    const int tok0 = b * SEQ + n * 64;
    LAS bf16_t* QN = (LAS bf16_t*)(F.lds);
    LAS bf16_t* KN = (LAS bf16_t*)(F.lds + 17408);
    LAS bf16_t* KT = (LAS bf16_t*)(F.lds + 34816);
    LAS bf16_t* VT = (LAS bf16_t*)(F.lds + 53248);
    LAS float*  LM = (LAS float*)(F.lds + 71680);
    LAS bf16_t* T1 = (LAS bf16_t*)(F.lds + 89088);
    LAS bf16_t* T2 = (LAS bf16_t*)(F.lds + 98304);
    LAS float*  SC = (LAS float*)(F.lds + 107520);
    LAS float*  SSQ = (LAS float*)(F.lds + 108544);
    const int tid = F.tid, lane = F.lane, fr = lane & 15, fq = lane >> 4, wave = F.wave;
    const bf16_t* GQKV = (const bf16_t*)(F.ws + WS_GQKV);
    if (!(PM & 1)) {
#pragma unroll
        for (int q = 0; q < 2; ++q) {
            const int task = tid + q * NTHR;
            if (task < 768) {
                const int cg = task % 48, tr = task / 48, part = cg >> 4, cl = (cg & 15) * 8, gcol = part * 512 + h * 128 + cl;
                unsigned nat[4][4];
                float ssq[4];
#pragma unroll
                for (int t = 0; t < 4; ++t) ssq[t] = 0.f;
#pragma unroll
                for (int e2 = 0; e2 < 4; ++e2) {
                    float c0[4], c1[4];
#pragma unroll
                    for (int k = 0; k < 4; ++k) { const f32x2 cc = *(const f32x2*)(F.in[I_CONVW] + k * 1536 + gcol + 2 * e2); c0[k] = cc.x; c1[k] = cc.y; }
                    float xa[7], xb[7];
#pragma unroll
                    for (int r = 0; r < 7; ++r) { const unsigned w = xw[q][r][e2]; xa[r] = bflo(w); xb[r] = bfhi(w); }
                    float ya[4], yb[4];
#pragma unroll
                    for (int t = 0; t < 4; ++t) {
                        ya[t] = siluf_(c0[0] * xa[t] + c0[1] * xa[t + 1] + c0[2] * xa[t + 2] + c0[3] * xa[t + 3]);
                        yb[t] = siluf_(c1[0] * xb[t] + c1[1] * xb[t + 1] + c1[2] * xb[t + 2] + c1[3] * xb[t + 3]);
                        ssq[t] += ya[t] * ya[t] + yb[t] * yb[t];
                        nat[t][e2] = pk2(ya[t], yb[t]);
                    }
                    if (part >= 1) {
                        LAS bf16_t* Tt = part == 1 ? KT : VT;
                        u32x2 w; w.x = pk2(ya[0], ya[1]); w.y = pk2(ya[2], ya[3]);
                        *(LAS u32x2*)(Tt + (cl + 2 * e2) * 72 + tr * 4) = w;
                        w.x = pk2(yb[0], yb[1]); w.y = pk2(yb[2], yb[3]);
                        *(LAS u32x2*)(Tt + (cl + 2 * e2 + 1) * 72 + tr * 4) = w;
                    }
                }
                if (part < 2) {
                    LAS bf16_t* N = part == 0 ? QN : KN;
#pragma unroll
                    for (int t = 0; t < 4; ++t) {
                        SSQ[(part * 64 + tr * 4 + t) * 16 + (cg & 15)] = ssq[t];
                        *(LAS u32x4*)(N + (tr * 4 + t) * 136 + cl) = (u32x4){nat[t][0], nat[t][1], nat[t][2], nat[t][3]};
                    }
                }
            }
        }
    }
    LBAR();
    if (wave == 0) {
        const int c = lane;
        float sq = 0.f, sk = 0.f;
#pragma unroll
        for (int j = 0; j < 16; ++j) { sq += SSQ[c * 16 + j]; sk += SSQ[(64 + c) * 16 + j]; }
        const float rq = 1.0f / sqrtf(sq + EPS), rk = 1.0f / sqrtf(sk + EPS);
        const float g = gpre, be = bpre;
        float gc = g;
#pragma unroll
        for (int o = 1; o < 64; o <<= 1) { const float t = __shfl_up(gc, o); if (lane >= o) gc += t; }
        SC[c] = rq; SC[64 + c] = rk; SC[128 + c] = gc; SC[192 + c] = be;
        if (c == 63) ((float*)(F.ws + WS_GL))[idx] = gc;
    }
    LBAR();
    if (!(PM & 4)) {
        bf16_t* ATT = (bf16_t*)((unsigned char*)F.out + (size_t)idx * GP_BYTES) + GP_A;
#pragma unroll 1
        for (int job = wave * 4; job < wave * 4 + 4; ++job) {
            const int which = job >> 4, it = (job >> 2) & 3, jt = job & 3;
            f32x4 acc = {0.f, 0.f, 0.f, 0.f};
            const LAS bf16_t* Y = which ? QN : KN;
            bf16x8 fx[4], fy[4];
#pragma unroll
            for (int ks = 0; ks < 4; ++ks) { fx[ks] = lfrag(KN, 136, jt * 16, ks * 32, fr, fq); fy[ks] = lfrag(Y, 136, it * 16, ks * 32, fr, fq); }
            __builtin_amdgcn_sched_barrier(0);
#pragma unroll
            for (int ks = 0; ks < 4; ++ks) acc = mma16(fx[ks], fy[ks], acc);
            const int i = it * 16 + fr, j0 = jt * 16 + 4 * fq;
            const float gci = SC[128 + i];
            if (which == 0) {
                const float fi = SC[192 + i] * SC[64 + i];
                f32x4 o;
#pragma unroll
                for (int r = 0; r < 4; ++r) { const int j = j0 + r; o[r] = (j < i) ? fi * SC[64 + j] * acc[r] * __expf(gci - SC[128 + j]) : 0.f; }
                *(LAS f32x4*)(LM + i * 68 + j0) = o;
            } else {
                const float fi = SC[i] * 0.08838834764831845f;
                float o[4];
#pragma unroll
                for (int r = 0; r < 4; ++r) { const int j = j0 + r; o[r] = (j <= i) ? fi * SC[64 + j] * acc[r] * __expf(gci - SC[128 + j]) : 0.f; }
                u32x2 w; w.x = pk2(o[0], o[1]); w.y = pk2(o[2], o[3]);
                *(u32x2*)(ATT + foff(i, j0, 2)) = w;
            }
        }
    }
    LBAR();
    if (idx_next >= 0) gdn_prep_fetch(F, idx_next, xw, gpre, bpre);
    LAS float* TD = (LAS float*)(F.lds + 116736);
    LAS float* PS = (LAS float*)(F.lds + 124928);
    if (wave == 0) { if (!(PM & 2)) {
        const int blk = lane >> 5, c = lane & 31;
        const LAS float* Lb = LM + (blk * 32) * 68 + blk * 32;
        LAS float* Tw = TD + blk * 1024 + c;
        float t[32];
        f32x4 la[8], lb[8];
#define INV_LD(dst, i) do { _Pragma("unroll") for (int _j = 0; _j < ((i) + 3) / 4; ++_j) dst[_j] = *(const LAS f32x4*)(Lb + (i) * 68 + 4 * _j); } while (0)
#define INV_ROW(src, i) do { float ps[4] = {((i) == c) ? 1.f : 0.f, 0.f, 0.f, 0.f}; _Pragma("unroll") for (int _j = 0; _j < ((i) + 3) / 4; ++_j) { _Pragma("unroll") for (int _e = 0; _e < 4; ++_e) if (4 * _j + _e < (i)) ps[_e] -= src[_j][_e] * t[4 * _j + _e]; } \
        t[i] = (ps[0] + ps[1]) + (ps[2] + ps[3]); Tw[(i) * 32] = t[i]; } while (0)
        INV_LD(la, 1);
#pragma unroll
        for (int i = 0; i < 32; i += 2) {
            if (i + 1 < 32) { INV_LD(lb, i + 1); }
            __builtin_amdgcn_sched_barrier(0);
            INV_ROW(la, i);
            if (i + 2 < 32) { INV_LD(la, i + 2); }
            __builtin_amdgcn_sched_barrier(0);
            INV_ROW(lb, i + 1);
        }
#undef INV_LD
#undef INV_ROW
    } } else {
        bf16_t* QGo = (bf16_t*)((unsigned char*)F.out + (size_t)idx * GP_BYTES) + GP_Q;
        bf16_t* KDo = (bf16_t*)((unsigned char*)F.out + (size_t)idx * GP_BYTES) + GP_K;
        const float gl = SC[128 + 63];
        for (int task = tid - 64; task < 2048; task += 448) {
            if (task < 1024) {
                const int c = task >> 4, d0 = (task & 15) * 8;
                const float f = SC[c] * 0.08838834764831845f * __expf(SC[128 + c]);
                const u32x4 w = *(const LAS u32x4*)(QN + c * 136 + d0);
                u32x2 o0, o1; o0.x = pk2(bflo(w.x) * f, bfhi(w.x) * f); o0.y = pk2(bflo(w.y) * f, bfhi(w.y) * f); o1.x = pk2(bflo(w.z) * f, bfhi(w.z) * f); o1.y = pk2(bflo(w.w) * f, bfhi(w.w) * f);
                *(u32x2*)(QGo + foff(c, d0, 4)) = o0; *(u32x2*)(QGo + foff(c, d0 + 4, 4)) = o1;
            } else {
                const int tk = task - 1024, d = tk >> 3, c0 = (tk & 7) * 8;
                const u32x4 w = *(const LAS u32x4*)(KT + d * 72 + c0);
                float f[8];
#pragma unroll
                for (int e = 0; e < 8; ++e) f[e] = SC[64 + c0 + e] * __expf(gl - SC[128 + c0 + e]);
                u32x2 o0, o1; o0.x = pk2(bflo(w.x) * f[0], bfhi(w.x) * f[1]); o0.y = pk2(bflo(w.y) * f[2], bfhi(w.y) * f[3]); o1.x = pk2(bflo(w.z) * f[4], bfhi(w.z) * f[5]); o1.y = pk2(bflo(w.w) * f[6], bfhi(w.w) * f[7]);
                *(u32x2*)(KDo + foff(d, c0, 2)) = o0; *(u32x2*)(KDo + foff(d, c0 + 4, 2)) = o1;
            }
        }
    }
    LBAR();
    if (wave < 4 && !(PM & 2)) {
        const int ti = wave >> 1, tj = wave & 1;
        f32x4 acc = {0.f, 0.f, 0.f, 0.f};
#pragma unroll
        for (int ks = 0; ks < 8; ++ks) acc = __builtin_amdgcn_mfma_f32_16x16x4f32(LM[(32 + 16 * ti + fr) * 68 + 4 * ks + fq], TD[(4 * ks + fq) * 32 + 16 * tj + fr], acc, 0, 0, 0);
#pragma unroll
        for (int r = 0; r < 4; ++r) PS[(16 * ti + 4 * fq + r) * 33 + 16 * tj + fr] = acc[r];
    }
    LBAR();
    if (wave < 4 && !(PM & 2)) {
        const int ti = wave >> 1, tj = wave & 1;
        f32x4 acc = {0.f, 0.f, 0.f, 0.f};
#pragma unroll
        for (int ks = 0; ks < 8; ++ks) acc = __builtin_amdgcn_mfma_f32_16x16x4f32(TD[1024 + (16 * ti + fr) * 32 + 4 * ks + fq], PS[(4 * ks + fq) * 33 + 16 * tj + fr], acc, 0, 0, 0);
#pragma unroll
        for (int r = 0; r < 4; ++r) LM[(32 + 16 * ti + 4 * fq + r) * 68 + 16 * tj + fr] = -acc[r];
    }
    LBAR();
    if (!(PM & 2)) {
#pragma unroll
        for (int q = 0; q < 2; ++q) {
            const int task = tid + q * NTHR, i = task >> 4, j0 = (task & 15) * 4;
            f32x4 tv = {0.f, 0.f, 0.f, 0.f};
            if (i < 32) { if (j0 < 32) tv = *(const LAS f32x4*)(TD + i * 32 + j0); }
            else if (j0 < 32) { tv = *(const LAS f32x4*)(LM + i * 68 + j0); }
            else { tv = *(const LAS f32x4*)(TD + 1024 + (i - 32) * 32 + (j0 - 32)); }
            float b1[4], b2[4];
#pragma unroll
            for (int e = 0; e < 4; ++e) { b1[e] = SC[192 + j0 + e]; b2[e] = b1[e] * SC[64 + j0 + e] * __expf(SC[128 + j0 + e]); }
            u32x2 w1, w2; w1.x = pk2(tv[0] * b1[0], tv[1] * b1[1]); w1.y = pk2(tv[2] * b1[2], tv[3] * b1[3]); w2.x = pk2(tv[0] * b2[0], tv[1] * b2[1]); w2.y = pk2(tv[2] * b2[2], tv[3] * b2[3]);
            *(LAS u32x2*)(T1 + i * 72 + j0) = w1; *(LAS u32x2*)(T2 + i * 72 + j0) = w2;
        }
    }
    LBAR();
    if (!(PM & 4)) {
        bf16_t* UTo = (bf16_t*)(F.ws + WS_UT) + (size_t)idx * 8192;
        bf16_t* WNo = (bf16_t*)((unsigned char*)F.out + (size_t)idx * GP_BYTES) + GP_W;
#pragma unroll 1
        for (int job = wave * 8; job < wave * 8 + 8; ++job) {
            f32x4 acc = {0.f, 0.f, 0.f, 0.f};
            if (job < 32) {
                const int it = job >> 3, dvt = job & 7;
#pragma unroll
                for (int ks = 0; ks < 2; ++ks) acc = mma16(lfrag(T1, 72, it * 16, ks * 32, fr, fq), lfrag(VT, 72, dvt * 16, ks * 32, fr, fq), acc);
                u32x2 w; w.x = pk2(acc[0], acc[1]); w.y = pk2(acc[2], acc[3]);
                *(u32x2*)(UTo + (dvt * 16 + fr) * 64 + it * 16 + 4 * fq) = w;
            } else {
                const int dkt = (job - 32) >> 2, it = (job - 32) & 3;
#pragma unroll
                for (int ks = 0; ks < 2; ++ks) acc = mma16(lfrag(KT, 72, dkt * 16, ks * 32, fr, fq), lfrag(T2, 72, it * 16, ks * 32, fr, fq), acc);
                u32x2 w; w.x = pk2(-acc[0], -acc[1]); w.y = pk2(-acc[2], -acc[3]);
                const int d0 = dkt * 16 + 4 * fq;
                *(u32x2*)(WNo + foff(it * 16 + fr, d0, 4)) = w;
            }
        }
    }
    LBAR();
}

__device__ __forceinline__ float ret_log2_gamma(int h) { return log2f(1.0f - exp2f(-5.0f - (float)h)); }
__device__ __forceinline__ void ret_kv_item(Frame& F, int idx2) {
    const int bh = idx2 >> 4, n = idx2 & 15, b = bh >> 2, h = bh & 3;
    const int tok0 = b * SEQ + n * 128;
    LAS bf16_t* KS = (LAS bf16_t*)(F.lds);
    LAS bf16_t* VN = (LAS bf16_t*)(F.lds + 34816);
    const int tid = F.tid, lane = F.lane, fr = lane & 15, fq = lane >> 4, wave = F.wave;
    const float l2g = ret_log2_gamma(h);
    const bf16_t* RQK = (const bf16_t*)(F.ws + WS_RQK); const bf16_t* RV = (const bf16_t*)(F.ws + WS_RV);
#pragma unroll
    for (int i = 0; i < 4; ++i) { const int p = tid + i * 512, c = p >> 4, d0 = (p & 15) * 8;
        const u32x4 w = *(const u32x4*)(RQK + (size_t)(tok0 + c) * 1024 + 512 + h * 128 + d0);
        const float f = exp2f(l2g * (float)(127 - c));
        u32x4 o; o.x = pk2(bflo(w.x) * f, bfhi(w.x) * f); o.y = pk2(bflo(w.y) * f, bfhi(w.y) * f); o.z = pk2(bflo(w.z) * f, bfhi(w.z) * f); o.w = pk2(bflo(w.w) * f, bfhi(w.w) * f);
        *(LAS u32x4*)(KS + c * 136 + d0) = o; }
#pragma unroll
    for (int i = 0; i < 8; ++i) { const int p = tid + i * 512, c = p >> 5, d0 = (p & 31) * 8;
        *(LAS u32x4*)(VN + c * 264 + d0) = *(const u32x4*)(RV + (size_t)(tok0 + c) * 1024 + h * 256 + d0); }
    LBAR();
    f32x4 acc[8][2];
#pragma unroll
    for (int a = 0; a < 8; ++a) { acc[a][0] = (f32x4){0.f, 0.f, 0.f, 0.f}; acc[a][1] = acc[a][0]; }
#pragma unroll
    for (int ks = 0; ks < 4; ++ks) {
        const bf16x8 y0 = tfrag(VN, 264, ks * 32, (2 * wave) * 16, lane), y1 = tfrag(VN, 264, ks * 32, (2 * wave + 1) * 16, lane);
#pragma unroll
        for (int dkt = 0; dkt < 8; ++dkt) { const bf16x8 x = tfrag(KS, 136, ks * 32, dkt * 16, lane); acc[dkt][0] = mma16(x, y0, acc[dkt][0]); acc[dkt][1] = mma16(x, y1, acc[dkt][1]); }
    }
    bf16_t* KVo = (bf16_t*)(F.ws + WS_KV) + (size_t)idx2 * 32768;
#pragma unroll
    for (int dkt = 0; dkt < 8; ++dkt)
#pragma unroll
        for (int q = 0; q < 2; ++q) { u32x2 w; w.x = pk2(acc[dkt][q][0], acc[dkt][q][1]); w.y = pk2(acc[dkt][q][2], acc[dkt][q][3]);
            *(u32x2*)(KVo + ((2 * wave + q) * 16 + fr) * 128 + dkt * 16 + 4 * fq) = w; }
    LBAR();
}

template <int MODE> __device__ __forceinline__ void gdn_scan_block(Frame& F, int cu) {
    const int bh = cu >> 1, b = bh >> 2, h = bh & 3;
    const int lane = F.lane, wave = F.wave, fr = lane & 15, fq = lane >> 4;
    const unsigned char* GPb = (const unsigned char*)F.out + (size_t)(bh * 32) * GP_BYTES;
    const unsigned char* UTb = (const unsigned char*)(F.ws + WS_UT) + (size_t)(bh * 32) * 16384 + (cu & 1) * 8192;
    constexpr int BUFB = 65536;
    int wpa[8], wpb[8]; int wsum = 0;
#pragma unroll
    for (int i = 0; i < 8; ++i) { wpa[i] = 0; wpb[i] = 0; }
#define SCAN_DMA(nn, lw) do { const unsigned char* _g = GPb + (size_t)(nn) * GP_BYTES; const unsigned char* _u = UTb + (size_t)(nn) * 16384; LAS unsigned char* _d = F.lds + ((nn) & 1) * BUFB; \
        _Pragma("unroll") for (int _i = 0; _i < 22; ++_i) { const int piece = (lw) + 3 * _i; if (piece < 64) { const unsigned char* src = piece < 56 ? _g + piece * 1024 : _u + (piece - 56) * 1024; \
            __builtin_amdgcn_global_load_lds((const unsigned*)(src + lane * 16), (LAS unsigned*)(_d + piece * 1024), 16, 0, 0); } } } while (0)
#define SCAN_WARM(wp, nn) do { const unsigned char* _g = GPb + (size_t)(nn) * GP_BYTES; const unsigned char* _u = UTb + (size_t)(nn) * 16384; \
        _Pragma("unroll") for (int _i = 0; _i < 7; ++_i) { wsum ^= wp[_i]; wp[_i] = *(const int*)(_g + (_i * 64 + lane) * 128); } wsum ^= wp[7]; wp[7] = *(const int*)(_u + lane * 128); } while (0)
    if (wave >= 4 && wave <= 6) { SCAN_DMA(0, wave - 4); asm volatile("s_waitcnt vmcnt(0)" ::: "memory"); }
    else if (wave == 7) { SCAN_WARM(wpa, 1); SCAN_WARM(wpb, 2); }
    float glall = 0.f;
    if (wave < 4 && lane < 32) glall = ((const float*)(F.ws + WS_GL))[bh * 32 + lane];
    LBAR();
    const int sl = (cu & 1) * 4 + (wave & 3);
    bf16_t* OG = (bf16_t*)(F.ws + WS_OGDN);
    f32x4 S[8];
#pragma unroll
    for (int d = 0; d < 8; ++d) S[d] = (f32x4){0.f, 0.f, 0.f, 0.f};
#pragma unroll 1
    for (int n = 0; n < 32; ++n) {
        if (wave >= 4 && wave <= 6) {
            if (MODE != 1 && n + 1 < 32) { SCAN_DMA(n + 1, wave - 4); asm volatile("s_waitcnt vmcnt(0)" ::: "memory"); }
        } else if (wave == 7) {
            if (n + 3 < 32) { if (n & 1) SCAN_WARM(wpb, n + 3); else SCAN_WARM(wpa, n + 3); }
        } else if (MODE != 2) {
            const LAS unsigned char* buf = F.lds + (n & 1) * BUFB;
            const LAS bf16x8* Bf = (const LAS bf16x8*)buf + lane;
            const float egl = __expf(rdlane(glall, n));
            f32x4 av[4], ao[4];
#pragma unroll
            for (int ct = 0; ct < 4; ++ct) {
                const u32x2 un = *(const LAS u32x2*)(buf + GP_BYTES + (((wave & 3) * 16 + fr) * 64 + ct * 16 + 4 * fq) * 2);
                av[ct] = (f32x4){bflo(un.x), bfhi(un.x), bflo(un.y), bfhi(un.y)}; ao[ct] = (f32x4){0.f, 0.f, 0.f, 0.f};
            }
#define LDG(dst, blk0) do { _Pragma("unroll") for (int _j = 0; _j < 8; ++_j) dst[_j] = Bf[((blk0) + _j) * 64]; } while (0)
#define SB() __builtin_amdgcn_sched_barrier(0)
            bf16x8 ga[8], gb[8];
            LDG(ga, 0); LDG(gb, 8); SB();
            bf16x8 Sf[4];
#pragma unroll
            for (int ks = 0; ks < 4; ++ks) Sf[ks] = pack_acc(S[2 * ks], S[2 * ks + 1]);
            SB();
#pragma unroll
            for (int jj = 0; jj < 8; ++jj) { const int j = (jj >> 1) + 4 * (jj & 1); av[j >> 2] = mma16(ga[j], Sf[j & 3], av[j >> 2]); }
            SB(); LDG(ga, 16); SB();
#pragma unroll
            for (int jj = 0; jj < 8; ++jj) { const int j = (jj >> 1) + 4 * (jj & 1); av[2 + (j >> 2)] = mma16(gb[j], Sf[j & 3], av[2 + (j >> 2)]); }
            SB(); LDG(gb, 24); SB();
#pragma unroll
            for (int jj = 0; jj < 8; ++jj) { const int j = (jj >> 1) + 4 * (jj & 1); ao[j >> 2] = mma16(ga[j], Sf[j & 3], ao[j >> 2]); }
            SB(); LDG(ga, 48); SB();
#pragma unroll
            for (int jj = 0; jj < 8; ++jj) { const int j = (jj >> 1) + 4 * (jj & 1); ao[2 + (j >> 2)] = mma16(gb[j], Sf[j & 3], ao[2 + (j >> 2)]); }
            SB(); LDG(gb, 32); SB();
            bf16x8 Vf[2];
            Vf[0] = pack_acc(av[0], av[1]); Vf[1] = pack_acc(av[2], av[3]);
#pragma unroll
            for (int dt = 0; dt < 8; ++dt) S[dt] = S[dt] * egl;
            SB();
#pragma unroll
            for (int jj = 0; jj < 8; ++jj) { const int j = 2 * (jj & 3) + (jj >> 2); ao[j >> 1] = mma16(ga[j], Vf[j & 1], ao[j >> 1]); }
            SB(); LDG(ga, 40); SB();
#pragma unroll
            for (int jj = 0; jj < 8; ++jj) { const int j = 2 * (jj & 3) + (jj >> 2); S[j >> 1] = mma16(gb[j], Vf[j & 1], S[j >> 1]); }
            SB();
#pragma unroll
            for (int jj = 0; jj < 8; ++jj) { const int j = 2 * (jj & 3) + (jj >> 2); S[4 + (j >> 1)] = mma16(ga[j], Vf[j & 1], S[4 + (j >> 1)]); }
            SB();
#undef LDG
#undef SB
            const int tok0 = b * SEQ + n * 64;
#pragma unroll
            for (int ct = 0; ct < 4; ++ct)
#pragma unroll
                for (int r = 0; r < 4; ++r) {
                    const int c = ct * 16 + 4 * fq + r;
                    if (MODE != 3) OG[(size_t)(tok0 + c) * 512 + h * 128 + sl * 16 + fr] = (bf16_t)f2bf(ao[ct][r]);
                }
        }
        LBAR();
    }
#undef SCAN_DMA
#undef SCAN_WARM
#pragma unroll
    for (int i = 0; i < 8; ++i) wsum ^= wpa[i] ^ wpb[i];
    if (wsum == 0x5a17c0de) ((unsigned*)(F.ws + WS_CTL))[CW_TMO + 16] = 1u;
}

__device__ __forceinline__ void ret_prefix_task(Frame& F, int task) {
    const int bh = task >> 6, part = task & 63, h = bh & 3;
    const float cd = exp2f(ret_log2_gamma(h) * 128.0f);
    bf16_t* base = (bf16_t*)(F.ws + WS_KV) + (size_t)bh * 16 * 32768 + part * 512 + F.lane * 8;
    float st[8];
#pragma unroll
    for (int e = 0; e < 8; ++e) st[e] = 0.f;
#pragma unroll 4
    for (int n = 0; n < 16; ++n) {
        u32x4* p = (u32x4*)(base + (size_t)n * 32768);
        const u32x4 w = *p;
        u32x4 o; o.x = pk2(st[0], st[1]); o.y = pk2(st[2], st[3]); o.z = pk2(st[4], st[5]); o.w = pk2(st[6], st[7]);
        *p = o;
        st[0] = st[0] * cd + bflo(w.x); st[1] = st[1] * cd + bfhi(w.x); st[2] = st[2] * cd + bflo(w.y); st[3] = st[3] * cd + bfhi(w.y);
        st[4] = st[4] * cd + bflo(w.z); st[5] = st[5] * cd + bfhi(w.z); st[6] = st[6] * cd + bflo(w.w); st[7] = st[7] * cd + bfhi(w.w);
    }
}

__device__ __forceinline__ bf16x8 scale_frag(bf16x8 q, float f) {
    u32x4 w = __builtin_bit_cast(u32x4, q);
    w.x = pk2(bflo(w.x) * f, bfhi(w.x) * f); w.y = pk2(bflo(w.y) * f, bfhi(w.y) * f); w.z = pk2(bflo(w.z) * f, bfhi(w.z) * f); w.w = pk2(bflo(w.w) * f, bfhi(w.w) * f);
    return __builtin_bit_cast(bf16x8, w);
}
struct RetPre { u32x4 q[4], k[4]; };
__device__ __forceinline__ void ret_out_fetch(Frame& F, int idx2, RetPre& P) {
    const int bh = idx2 >> 4, n = idx2 & 15, b = bh >> 2, h = bh & 3, tok0 = b * SEQ + n * 128, tid = F.tid;
    const bf16_t* RQK = (const bf16_t*)(F.ws + WS_RQK);
#pragma unroll
    for (int i = 0; i < 4; ++i) { const int p = tid + i * 512, c = p >> 4, d0 = (p & 15) * 8; P.q[i] = *(const u32x4*)((const unsigned char*)RQK + (unsigned)(((tok0 + c) * 1024 + h * 128 + d0) * 2)); }
#pragma unroll
    for (int i = 0; i < 4; ++i) { const int p = tid + i * 512, c = p >> 4, d0 = (p & 15) * 8; P.k[i] = *(const u32x4*)((const unsigned char*)RQK + (unsigned)(((tok0 + c) * 1024 + 512 + h * 128 + d0) * 2)); }
}
__device__ __forceinline__ void ret_out_item(Frame& F, int idx2, int idx_next, RetPre& P) {
    const int bh = idx2 >> 4, n = idx2 & 15, b = bh >> 2, h = bh & 3;
    const int tok0 = b * SEQ + n * 128;
    LAS bf16_t* QN = (LAS bf16_t*)(F.lds);
    LAS bf16_t* SPn = (LAS bf16_t*)(F.lds + 34816);
    LAS bf16_t* KN = (LAS bf16_t*)(F.lds + 34816);
    LAS bf16_t* PM = (LAS bf16_t*)(F.lds + 69632);
    LAS bf16_t* VN = (LAS bf16_t*)(F.lds);
    LAS float*  NS = (LAS float*)(F.lds + 104448);
    const int tid = F.tid, lane = F.lane, fr = lane & 15, fq = lane >> 4, wave = F.wave;
    const float l2g = ret_log2_gamma(h);
    const bf16_t* RQK = (const bf16_t*)(F.ws + WS_RQK); const bf16_t* RV = (const bf16_t*)(F.ws + WS_RV);
    const bf16_t* SP = (const bf16_t*)(F.ws + WS_KV) + (size_t)idx2 * 32768;
#define SB() __builtin_amdgcn_sched_barrier(0)
    u32x4 kreg[4];
    {
        u32x4 sreg[8];
#pragma unroll
        for (int i = 0; i < 8; ++i) { const int p = tid + i * 512; sreg[i] = *(const u32x4*)((const unsigned char*)SP + (unsigned)(p * 16)); }
#pragma unroll
        for (int i = 0; i < 4; ++i) { const int p = tid + i * 512, c = p >> 4, d0 = (p & 15) * 8; *(LAS u32x4*)(QN + c * 136 + d0) = P.q[i]; kreg[i] = P.k[i]; }
#pragma unroll
        for (int i = 0; i < 8; ++i) { const int p = tid + i * 512, r = p >> 4, d0 = (p & 15) * 8; *(LAS u32x4*)(SPn + r * 136 + d0) = sreg[i]; }
    }
    LBAR();
    const int wi = wave >> 1, wd = wave & 1;
    f32x4 a1[8][2];
#pragma unroll
    for (int d = 0; d < 8; ++d) { a1[d][0] = (f32x4){0.f, 0.f, 0.f, 0.f}; a1[d][1] = a1[d][0]; }
    {
        const float qd0 = exp2f(l2g * (float)((2 * wi) * 16 + fr + 1)), qd1 = exp2f(l2g * (float)((2 * wi + 1) * 16 + fr + 1));
        bf16x8 xa[8], qa[2];
#define LD0(x, q, ks) do { _Pragma("unroll") for (int _d = 0; _d < 8; ++_d) x[_d] = lfrag(SPn, 136, (wd * 8 + _d) * 16, (ks) * 32, fr, fq); \
        q[0] = lfrag(QN, 136, (2 * wi) * 16, (ks) * 32, fr, fq); q[1] = lfrag(QN, 136, (2 * wi + 1) * 16, (ks) * 32, fr, fq); } while (0)
#define MM0(x, q) do { const bf16x8 _q0 = scale_frag(q[0], qd0), _q1 = scale_frag(q[1], qd1); _Pragma("unroll") for (int _d = 0; _d < 8; ++_d) { a1[_d][0] = mma16(x[_d], _q0, a1[_d][0]); a1[_d][1] = mma16(x[_d], _q1, a1[_d][1]); } } while (0)
        LD0(xa, qa, 0); SB(); MM0(xa, qa); SB(); LD0(xa, qa, 1); SB(); MM0(xa, qa); SB(); LD0(xa, qa, 2); SB(); MM0(xa, qa); SB(); LD0(xa, qa, 3); SB(); MM0(xa, qa); SB();
#undef LD0
#undef MM0
    }
    LBAR();
    u32x4 vreg[8];
#pragma unroll
    for (int i = 0; i < 8; ++i) { const int p = tid + i * 512, c = p >> 5, d0 = (p & 31) * 8; vreg[i] = *(const u32x4*)((const unsigned char*)RV + (unsigned)(((tok0 + c) * 1024 + h * 256 + d0) * 2)); }
#pragma unroll
    for (int i = 0; i < 4; ++i) { const int p = tid + i * 512, c = p >> 4, d0 = (p & 15) * 8; *(LAS u32x4*)(KN + c * 136 + d0) = kreg[i]; }
    LBAR();
    {
        bf16x8 yq[4];
#pragma unroll
        for (int ks = 0; ks < 4; ++ks) yq[ks] = lfrag(QN, 136, wave * 16, ks * 32, fr, fq);
        const int i = wave * 16 + fr;
        bf16x8 ka[4], kb[4];
#define LD1(k, jt) do { _Pragma("unroll") for (int _s = 0; _s < 4; ++_s) k[_s] = lfrag(KN, 136, (jt) * 16, _s * 32, fr, fq); } while (0)
#define MM1(k, jt) do { f32x4 acc = {0.f, 0.f, 0.f, 0.f}; _Pragma("unroll") for (int _s = 0; _s < 4; ++_s) acc = mma16(k[_s], yq[_s], acc); \
        float o[4]; _Pragma("unroll") for (int r = 0; r < 4; ++r) { const int j = (jt) * 16 + 4 * fq + r; o[r] = (j <= i) ? acc[r] * exp2f(l2g * (float)(i - j)) : 0.f; } \
        u32x2 w; w.x = pk2(o[0], o[1]); w.y = pk2(o[2], o[3]); *(LAS u32x2*)(PM + i * 136 + (jt) * 16 + 4 * fq) = w; } while (0)
        LD1(ka, 0); SB();
#pragma unroll
        for (int jt = 0; jt < 8; jt += 2) { LD1(kb, jt + 1); SB(); MM1(ka, jt); SB(); if (jt + 2 < 8) { LD1(ka, jt + 2); } SB(); MM1(kb, jt + 1); SB(); }
#undef LD1
#undef MM1
    }
    LBAR();
#pragma unroll
    for (int i = 0; i < 8; ++i) { const int p = tid + i * 512, c = p >> 5, d0 = (p & 31) * 8; *(LAS u32x4*)(VN + c * 264 + d0) = vreg[i]; }
    LBAR();
    const bf16_t* RG = (const bf16_t*)(F.ws + WS_RG);
    u32x2 gt[2][8];
    {
        bf16x8 xa[8], pa[2];
#define LD2(x, p, ks) do { _Pragma("unroll") for (int _d = 0; _d < 8; ++_d) x[_d] = tfrag(VN, 264, (ks) * 32, (wd * 8 + _d) * 16, lane); \
        p[0] = lfrag(PM, 136, (2 * wi) * 16, (ks) * 32, fr, fq); p[1] = lfrag(PM, 136, (2 * wi + 1) * 16, (ks) * 32, fr, fq); } while (0)
#define MM2(x, p) do { _Pragma("unroll") for (int _d = 0; _d < 8; ++_d) { a1[_d][0] = mma16(x[_d], p[0], a1[_d][0]); a1[_d][1] = mma16(x[_d], p[1], a1[_d][1]); } } while (0)
        LD2(xa, pa, 0); SB(); MM2(xa, pa); SB(); LD2(xa, pa, 1); SB(); MM2(xa, pa); SB(); LD2(xa, pa, 2); SB(); MM2(xa, pa); SB(); LD2(xa, pa, 3); SB(); MM2(xa, pa); SB();
#undef LD2
#undef MM2
    }
#undef SB
#define LDGATE(t) do { _Pragma("unroll") for (int d = 0; d < 8; ++d) gt[t][d] = *(const u32x2*)((const unsigned char*)RG + (unsigned)(((tok0 + (2 * wi + (t)) * 16 + fr) * 1024 + h * 256 + (wd * 8 + d) * 16 + 4 * fq) * 2)); } while (0)
    LDGATE(0);
    ret_out_fetch(F, idx_next >= 0 ? idx_next : idx2, P);
#pragma unroll
    for (int t = 0; t < 2; ++t) {
        const int i = (2 * wi + t) * 16 + fr;
        float s = 0.f;
#pragma unroll
        for (int d = 0; d < 8; ++d) { const f32x4 v = a1[d][t]; s += (v[0] * v[0] + v[1] * v[1]) + (v[2] * v[2] + v[3] * v[3]); }
        s += __shfl_xor(s, 16); s += __shfl_xor(s, 32);
        if (fq == 0) NS[i * 2 + wd] = s;
    }
    LBAR();
    bf16_t* YB = (bf16_t*)(F.ws + WS_YB);
#pragma unroll
    for (int t = 0; t < 2; ++t) {
        const int i = (2 * wi + t) * 16 + fr;
        const float rstd = rsqrtf_((NS[i * 2] + NS[i * 2 + 1]) * (1.0f / 256.0f) + EPS);
        if (t == 0) { LDGATE(1); }
#pragma unroll
        for (int d = 0; d < 8; ++d) {
            const int dv = (wd * 8 + d) * 16 + 4 * fq;
            const f32x4 v = a1[d][t] * rstd;
            u32x2 w; w.x = pk2(v[0] * siluf_(bflo(gt[t][d].x)), v[1] * siluf_(bfhi(gt[t][d].x))); w.y = pk2(v[2] * siluf_(bflo(gt[t][d].y)), v[3] * siluf_(bfhi(gt[t][d].y)));
            *(u32x2*)(YB + (size_t)(tok0 + i) * 1024 + h * 256 + dv) = w;
        }
    }
#undef LDGATE
    LBAR();
}

__device__ __forceinline__ void gdn_normgate_row(Frame& F, int m) {
    const int lane = F.lane;
    const u32x4 ow = *(const u32x4*)((const bf16_t*)(F.ws + WS_OGDN) + (size_t)m * 512 + lane * 8);
    const u32x4 z = *(const u32x4*)((const bf16_t*)(F.ws + WS_GZ) + (size_t)m * 512 + lane * 8);
    float o[8] = {bflo(ow.x), bfhi(ow.x), bflo(ow.y), bfhi(ow.y), bflo(ow.z), bfhi(ow.z), bflo(ow.w), bfhi(ow.w)};
    float ss = 0.f;
#pragma unroll
    for (int e = 0; e < 8; ++e) ss += o[e] * o[e];
    ss = row16_sum(ss);
    const float rstd = rsqrtf_(ss * (1.0f / 128.0f) + EPS);
    const float* nw = F.in[I_GNW] + (lane & 15) * 8;
    const f32x4 w0 = *(const f32x4*)nw, w1 = *(const f32x4*)(nw + 4);
    u32x4 y;
    y.x = pk2(o[0] * rstd * w0[0] * siluf_(bflo(z.x)), o[1] * rstd * w0[1] * siluf_(bfhi(z.x)));
    y.y = pk2(o[2] * rstd * w0[2] * siluf_(bflo(z.y)), o[3] * rstd * w0[3] * siluf_(bfhi(z.y)));
    y.z = pk2(o[4] * rstd * w1[0] * siluf_(bflo(z.z)), o[5] * rstd * w1[1] * siluf_(bfhi(z.z)));
    y.w = pk2(o[6] * rstd * w1[2] * siluf_(bflo(z.w)), o[7] * rstd * w1[3] * siluf_(bfhi(z.w)));
    *(u32x4*)((bf16_t*)(F.ws + WS_YA) + (size_t)m * 512 + lane * 8) = y;
}

struct EpiUp1 {
    static constexpr bool PERM = true;
    unsigned char* ws;
    __device__ __forceinline__ void operator()(const f32x4 (&acc)[2][2][4][2], const pg8::Unit& u, int wr, int wc, int fr, int fq) const {
        const int row0 = u.pm * 256 + wr * 64 + fr, col0 = u.pn * 256 + wc * 32 + 8 * fq;
        const bf16_t* MAB = (const bf16_t*)(ws + WS_MAB); float* TMP = (float*)(ws + WS_TMP);
#pragma unroll
        for (int ai = 0; ai < 2; ++ai)
#pragma unroll
            for (int m = 0; m < 4; ++m) { const int row = row0 + ai * 128 + m * 16;
#pragma unroll
                for (int bj = 0; bj < 2; ++bj) {
                    const int col = col0 + bj * 128;
                    const u32x4 g = *(const u32x4*)(MAB + (size_t)row * 2048 + col);
                    const f32x4 v0 = acc[ai][bj][m][0], v1 = acc[ai][bj][m][1];
                    f32x4 o0, o1;
                    o0[0] = v0[0] * sigmoidf_(bflo(g.x)); o0[1] = v0[1] * sigmoidf_(bfhi(g.x)); o0[2] = v0[2] * sigmoidf_(bflo(g.y)); o0[3] = v0[3] * sigmoidf_(bfhi(g.y));
                    o1[0] = v1[0] * sigmoidf_(bflo(g.z)); o1[1] = v1[1] * sigmoidf_(bfhi(g.z)); o1[2] = v1[2] * sigmoidf_(bflo(g.w)); o1[3] = v1[3] * sigmoidf_(bfhi(g.w));
                    float* p = TMP + (size_t)row * 1024 + col;
                    *(f32x4*)p = o0; *(f32x4*)(p + 4) = o1;
                } }
    }
};
struct EpiUp1R {
    static constexpr bool PERM = true;
    unsigned char* ws;
    __device__ __forceinline__ void operator()(f32x4 (&acc)[2][2][4][2], const pg8::Unit& u, int wr, int wc, int fr, int fq) const {
        const int row0 = u.pm * 256 + wr * 64 + fr, col0 = u.pn * 256 + wc * 32 + 8 * fq;
        const bf16_t* MAB = (const bf16_t*)(ws + WS_MAB);
#pragma unroll
        for (int ai = 0; ai < 2; ++ai)
#pragma unroll
            for (int m = 0; m < 4; ++m) { const int row = row0 + ai * 128 + m * 16;
#pragma unroll
                for (int bj = 0; bj < 2; ++bj) {
                    const int col = col0 + bj * 128;
                    const u32x4 ga = *(const u32x4*)(MAB + (size_t)row * 2048 + col), gb = *(const u32x4*)(MAB + (size_t)row * 2048 + 1024 + col);
                    const unsigned gaw[4] = {ga.x, ga.y, ga.z, ga.w}, gbw[4] = {gb.x, gb.y, gb.z, gb.w};
#pragma unroll
                    for (int q = 0; q < 4; ++q) {
                        const float a0 = bflo(gaw[q]), a1 = bfhi(gaw[q]), b0 = fmaxf(bflo(gbw[q]), -80.f), b1 = fmaxf(bfhi(gbw[q]), -80.f);
                        const float r0 = (1.0f + __builtin_amdgcn_exp2f(-1.4426950408889634f * b0)) * sigmoidf_(a0);
                        const float r1 = (1.0f + __builtin_amdgcn_exp2f(-1.4426950408889634f * b1)) * sigmoidf_(a1);
                        acc[ai][bj][m][q >> 1][(q & 1) * 2] *= r0; acc[ai][bj][m][q >> 1][(q & 1) * 2 + 1] *= r1;
                    }
                    asm volatile("" : "+v"(acc[ai][bj][m][0]), "+v"(acc[ai][bj][m][1]) :: "memory");
                } }
    }
};
struct EpiUp2R {
    static constexpr bool PERM = true;
    unsigned char* ws;
    __device__ __forceinline__ void operator()(const f32x4 (&acc)[2][2][4][2], const pg8::Unit& u, int wr, int wc, int fr, int fq) const {
        const int row0 = u.pm * 256 + wr * 64 + fr, col0 = u.pn * 256 + wc * 32 + 8 * fq;
        const bf16_t* MAB = (const bf16_t*)(ws + WS_MAB); bf16_t* MG = (bf16_t*)(ws + WS_MERGED);
#pragma unroll
        for (int ai = 0; ai < 2; ++ai)
#pragma unroll
            for (int m = 0; m < 4; ++m) { const int row = row0 + ai * 128 + m * 16;
#pragma unroll
                for (int bj = 0; bj < 2; ++bj) {
                    const int col = col0 + bj * 128;
                    const u32x4 g = *(const u32x4*)(MAB + (size_t)row * 2048 + 1024 + col);
                    const f32x4 v0 = acc[ai][bj][m][0], v1 = acc[ai][bj][m][1];
                    u32x4 w;
                    w.x = pk2(v0[0] * sigmoidf_(fmaxf(bflo(g.x), -80.f)), v0[1] * sigmoidf_(fmaxf(bfhi(g.x), -80.f)));
                    w.y = pk2(v0[2] * sigmoidf_(fmaxf(bflo(g.y), -80.f)), v0[3] * sigmoidf_(fmaxf(bfhi(g.y), -80.f)));
                    w.z = pk2(v1[0] * sigmoidf_(fmaxf(bflo(g.z), -80.f)), v1[1] * sigmoidf_(fmaxf(bfhi(g.z), -80.f)));
                    w.w = pk2(v1[2] * sigmoidf_(fmaxf(bflo(g.w), -80.f)), v1[3] * sigmoidf_(fmaxf(bfhi(g.w), -80.f)));
                    *(u32x4*)(MG + (size_t)row * 1024 + col) = w;
                } }
    }
};
struct EpiUp2 {
    static constexpr bool PERM = true;
    unsigned char* ws;
    __device__ __forceinline__ void operator()(const f32x4 (&acc)[2][2][4][2], const pg8::Unit& u, int wr, int wc, int fr, int fq) const {
        const int row0 = u.pm * 256 + wr * 64 + fr, col0 = u.pn * 256 + wc * 32 + 8 * fq;
        const bf16_t* MAB = (const bf16_t*)(ws + WS_MAB); const float* TMP = (const float*)(ws + WS_TMP); bf16_t* MG = (bf16_t*)(ws + WS_MERGED);
#pragma unroll
        for (int ai = 0; ai < 2; ++ai)
#pragma unroll
            for (int m = 0; m < 4; ++m) { const int row = row0 + ai * 128 + m * 16;
#pragma unroll
                for (int bj = 0; bj < 2; ++bj) {
                    const int col = col0 + bj * 128;
                    const u32x4 g = *(const u32x4*)(MAB + (size_t)row * 2048 + 1024 + col);
                    const float* p = TMP + (size_t)row * 1024 + col;
                    const f32x4 t0 = *(const f32x4*)p, t1 = *(const f32x4*)(p + 4);
                    const f32x4 v0 = acc[ai][bj][m][0], v1 = acc[ai][bj][m][1];
                    u32x4 w;
                    w.x = pk2(t0[0] + v0[0] * sigmoidf_(bflo(g.x)), t0[1] + v0[1] * sigmoidf_(bfhi(g.x)));
                    w.y = pk2(t0[2] + v0[2] * sigmoidf_(bflo(g.y)), t0[3] + v0[3] * sigmoidf_(bfhi(g.y)));
                    w.z = pk2(t1[0] + v1[0] * sigmoidf_(bflo(g.z)), t1[1] + v1[1] * sigmoidf_(bfhi(g.z)));
                    w.w = pk2(t1[2] + v1[2] * sigmoidf_(bflo(g.w)), t1[3] + v1[3] * sigmoidf_(bfhi(g.w)));
                    *(u32x4*)(MG + (size_t)row * 1024 + col) = w;
                } }
    }
};
struct EpiOut {
    static constexpr bool PERM = false;
    const float* x; float* h;
    __device__ __forceinline__ void operator()(const f32x4 (&acc)[2][2][4][2], const pg8::Unit& u, int wr, int wc, int fr, int fq) const {
        const int row0 = u.pm * 256 + wr * 64 + fr, col0 = u.pn * 256 + wc * 32 + 4 * fq;
#pragma unroll
        for (int ai = 0; ai < 2; ++ai)
#pragma unroll
            for (int m = 0; m < 4; ++m) { const size_t off = (size_t)(row0 + ai * 128 + m * 16) * 1024 + col0;
#pragma unroll
                for (int bj = 0; bj < 2; ++bj)
#pragma unroll
                    for (int n = 0; n < 2; ++n) *(f32x4*)(h + off + bj * 128 + n * 16) = *(const f32x4*)(x + off + bj * 128 + n * 16) + acc[ai][bj][m][n]; }
    }
};

__device__ __forceinline__ void p7_router(Frame& F, bool commit) {
    const int lane = F.lane, wave = F.wave, fr = lane & 15, fq = lane >> 4, p = wave >> 1, hk = wave & 1;
    const int gw = F.vcu * NWAVES + F.wave, NGW = F.G * NWAVES;
    LAS float* PL = (LAS float*)(F.lds);
    LAS float* SQ = (LAS float*)(F.lds + 25600);
    LAS float* RS = (LAS float*)(F.lds + 26112);
    const float* hb = (const float*)F.out; const float* wrt = (const float*)(F.ws + WS_WRT);
    LBAR();
    for (int it0 = 0; it0 < M / 16; it0 += F.G * 4) {
        const int t = it0 + F.vcu * 4 + p; const bool act = t < M / 16; const int tok0 = t * 16;
        if (act) {
            f32x4 acc[3];
#pragma unroll
            for (int ct = 0; ct < 3; ++ct) acc[ct] = (f32x4){0.f, 0.f, 0.f, 0.f};
            float ssq = 0.f;
            const float* hp = hb + (size_t)(tok0 + fr) * DM + hk * 512 + 4 * fq;
            const float* wp = wrt + (size_t)fr * DM + hk * 512 + 4 * fq;
#pragma unroll 4
            for (int g = 0; g < 32; ++g) {
                const f32x4 xv = *(const f32x4*)(hp + 16 * g);
                ssq += (xv.x * xv.x + xv.y * xv.y) + (xv.z * xv.z + xv.w * xv.w);
#pragma unroll
                for (int ct = 0; ct < 3; ++ct) {
                    const f32x4 wv = *(const f32x4*)(wp + ct * 16 * DM + 16 * g);
#pragma unroll
                    for (int e = 0; e < 4; ++e) acc[ct] = __builtin_amdgcn_mfma_f32_16x16x4f32(wv[e], xv[e], acc[ct], 0, 0, 0);
                }
            }
            ssq += __shfl_xor(ssq, 16); ssq += __shfl_xor(ssq, 32);
            LAS float* pl = PL + ((p * 2 + hk) * 16 + fr) * 49;
#pragma unroll
            for (int ct = 0; ct < 3; ++ct)
#pragma unroll
                for (int r = 0; r < 4; ++r) pl[ct * 16 + 4 * fq + r] = acc[ct][r];
            if (fq == 0) SQ[(p * 2 + hk) * 16 + fr] = ssq;
        }
        LBAR();
        if (act && hk == 0 && lane < 16) {
            const int m = tok0 + lane;
            const float rstd = rsqrtf_((SQ[(p * 2) * 16 + lane] + SQ[(p * 2 + 1) * 16 + lane]) * (1.f / DM) + EPS);
            RS[p * 16 + lane] = rstd;
            const LAS float* p0 = PL + ((p * 2) * 16 + lane) * 49; const LAS float* p1 = p0 + 16 * 49;
            float gl[4];
#pragma unroll
            for (int j = 0; j < 4; ++j) gl[j] = rstd * (p0[j] + p1[j]) + F.in[I_BGRP][j];
            int gi = 0; float gm = gl[0];
            if (gl[1] > gm) { gm = gl[1]; gi = 1; } if (gl[2] > gm) { gm = gl[2]; gi = 2; } if (gl[3] > gm) { gm = gl[3]; gi = 3; }
            const float gp = 1.0f / (__expf(gl[0] - gm) + __expf(gl[1] - gm) + __expf(gl[2] - gm) + __expf(gl[3] - gm));
            int i0 = 0, i1 = 0; float v0 = -3.0e38f, v1 = -3.0e38f;
#pragma unroll
            for (int i = 0; i < 8; ++i) {
                const float ev = rstd * (p0[4 + gi * 8 + i] + p1[4 + gi * 8 + i]) + F.in[I_BEXP][gi * 8 + i];
                if (ev > v0) { v1 = v0; i1 = i0; v0 = ev; i0 = i; } else if (ev > v1) { v1 = ev; i1 = i; }
            }
            const float w0 = gp / (1.0f + __expf(v1 - v0)), w1 = gp / (1.0f + __expf(v0 - v1));
            if (commit) {
                int* LTOK = (int*)(F.ws + WS_LTOK); int* LDST = (int*)(F.ws + WS_LDST); float* LW = (float*)(F.ws + WS_LW);
                unsigned* cnt = (unsigned*)(F.ws + WS_CTL) + CW_CNT;
                const int e0 = gi * 8 + i0, e1 = gi * 8 + i1;
                const unsigned q0 = __hip_atomic_fetch_add(cnt + e0, 1u, __ATOMIC_RELAXED, __HIP_MEMORY_SCOPE_AGENT);
                LTOK[e0 * 16384 + q0] = m; LDST[e0 * 16384 + q0] = 2 * m; LW[e0 * 16384 + q0] = w0;
                const unsigned q1 = __hip_atomic_fetch_add(cnt + e1, 1u, __ATOMIC_RELAXED, __HIP_MEMORY_SCOPE_AGENT);
                LTOK[e1 * 16384 + q1] = m; LDST[e1 * 16384 + q1] = 2 * m + 1; LW[e1 * 16384 + q1] = w1;
            }
        }
        LBAR();
        if (act) {
            const f32x4 wa = *(const f32x4*)(F.in[I_NFW] + hk * 512 + 8 * lane), wb = *(const f32x4*)(F.in[I_NFW] + hk * 512 + 8 * lane + 4);
#pragma unroll 4
            for (int j = 0; j < 16; ++j) {
                const float rstd = RS[p * 16 + j];
                const float* hp = hb + (size_t)(tok0 + j) * DM + hk * 512 + 8 * lane;
                const f32x4 a = *(const f32x4*)hp, c = *(const f32x4*)(hp + 4);
                u32x4 o; o.x = pk2(a.x * rstd * wa.x, a.y * rstd * wa.y); o.y = pk2(a.z * rstd * wa.z, a.w * rstd * wa.w);
                o.z = pk2(c.x * rstd * wb.x, c.y * rstd * wb.y); o.w = pk2(c.z * rstd * wb.z, c.w * rstd * wb.w);
                *(u32x4*)((bf16_t*)(F.ws + WS_XN) + (size_t)(tok0 + j) * DM + hk * 512 + 8 * lane) = o;
            }
        }
        LBAR();
    }
    LAS float* scr = (LAS float*)(F.lds + F.wave * 16384);
    constexpr int IG = 16 * 16, ID = 8 * 32, IPE = 2 * IG + ID;
    const float* wg = F.in[I_WGATE]; const float* wu = F.in[I_WUP]; const float* wdn = F.in[I_WDOWN]; unsigned char* ws = F.ws;
    auto dec = [=](int it) -> TrItem {
        const int e = it / IPE; int r = it % IPE; TrItem t;
        if (r < 2 * IG) { const int up = r >= IG; if (up) r -= IG; const int nb = r % 16, kb = r / 16, n0 = nb * 32;
            t.W = (up ? wu : wg) + (size_t)e * 1024 * 512; t.ldw = 512; t.col0 = n0; t.WT = (bf16_t*)(ws + WS_WGU) + (size_t)e * 1024 * 1024; t.K = 1024;
            t.row0 = (n0 >> 7) * 256 + (up ? 128 : 0) + (n0 & 127); t.k0 = kb * 64; return t; }
        r -= 2 * IG; const int nb = r % 32, kb = r / 32;
        t.W = wdn + (size_t)e * 512 * 1024; t.ldw = 1024; t.col0 = nb * 32; t.WT = (bf16_t*)(ws + WS_WD) + (size_t)e * 1024 * 512; t.K = 512; t.row0 = nb * 32; t.k0 = kb * 64; return t;
    };
    tr_run(dec, gw, NE * IPE, NGW, F.lane, scr);
}

constexpr int TOFF_OFF = MISC_OFF + 512;
constexpr int MYU_OFF = MISC_OFF + 768;
constexpr int CW_TILE = 8192;
struct MoeProb {
    const LAS int* toff; const unsigned* cnt; const int* ltok; unsigned* tilecnt;
    const bf16_t* A; const bf16_t* Bt; int K; int G, c; int total;
    __device__ __forceinline__ void unit_of(int L, pg8::Unit& u) const {
        const int tile = L >> 2; int e = 0;
#pragma unroll 1
        for (int s = 16; s > 0; s >>= 1) if (toff[e + s] <= tile) e += s;
        u.e = e; u.pm = tile - toff[e]; u.pn = L & 3; u.base = tile * 256;
        const int c_e = (int)cnt[e]; const int rem = c_e - u.pm * 256; u.rows = rem < 256 ? rem : 256;
    }
    __device__ __forceinline__ bool next(int i, pg8::Unit& u) const { const int L = i * G + c; if (L >= total) return false; unit_of(L, u); return true; }
    __device__ __forceinline__ int a_row(const pg8::Unit& u, int r) const { return ltok[u.e * 16384 + u.pm * 256 + (r < u.rows ? r : 0)]; }
    __device__ __forceinline__ const char* a_ptr(const pg8::Unit& u) const { return (const char*)A; }
    __device__ __forceinline__ const char* a_ptr_rows(const pg8::Unit& u) const { return (const char*)A + (size_t)u.base * K * 2; }
    __device__ __forceinline__ const char* b_ptr(const pg8::Unit& u) const { return (const char*)Bt + ((size_t)u.e * 1024 + u.pn * 256) * K * 2; }
    __device__ __forceinline__ void a_ready(const pg8::Unit&) const {}
    __device__ __forceinline__ void done(const pg8::Unit& u) const {
        asm volatile("s_waitcnt vmcnt(0)" ::: "memory");
        if ((threadIdx.x & 63) == 0) __hip_atomic_fetch_add(tilecnt + 64 * (u.base >> 8), 1u, __ATOMIC_RELAXED, __HIP_MEMORY_SCOPE_AGENT);
    }
};
struct MoeProbD : MoeProb {
    const LAS int* myu;
    __device__ __forceinline__ const char* a_ptr(const pg8::Unit& u) const { return a_ptr_rows(u); }
    __device__ __forceinline__ bool next(int i, pg8::Unit& u) const { if (i >= myu[0]) return false; unit_of(myu[1 + i], u); return true; }
    __device__ __forceinline__ void done(const pg8::Unit&) const {}
    __device__ __forceinline__ void a_ready(const pg8::Unit& u) const {
        if (threadIdx.x < 64) {
            const unsigned* w = tilecnt + 64 * (u.base >> 8); unsigned polls = 0;
            while ((unsigned)__builtin_amdgcn_readfirstlane(__hip_atomic_load(w, __ATOMIC_RELAXED, __HIP_MEMORY_SCOPE_AGENT)) < 32u) {
                __builtin_amdgcn_s_sleep(2);
                if (++polls > (1u << 20)) break;
            }
            __builtin_amdgcn_fence(__ATOMIC_ACQUIRE, "agent");
            asm volatile("s_waitcnt vmcnt(0)" ::: "memory");
        }
        asm volatile("" ::: "memory"); __builtin_amdgcn_s_barrier(); asm volatile("" ::: "memory");
    }
};
struct EpiGU {
    static constexpr bool PERM = true;
    bf16_t* hid;
    __device__ __forceinline__ void operator()(const f32x4 (&acc)[2][2][4][2], const pg8::Unit& u, int wr, int wc, int fr, int fq) const {
        const int col0 = u.pn * 128 + wc * 32 + 8 * fq;
#pragma unroll
        for (int ai = 0; ai < 2; ++ai)
#pragma unroll
            for (int m = 0; m < 4; ++m) { const int r = ai * 128 + wr * 64 + m * 16 + fr;
                const f32x4 g0 = acc[ai][0][m][0], g1 = acc[ai][0][m][1], u0 = acc[ai][1][m][0], u1 = acc[ai][1][m][1];
                u32x4 w;
                w.x = pk2(siluf_(g0[0]) * u0[0], siluf_(g0[1]) * u0[1]); w.y = pk2(siluf_(g0[2]) * u0[2], siluf_(g0[3]) * u0[3]);
                w.z = pk2(siluf_(g1[0]) * u1[0], siluf_(g1[1]) * u1[1]); w.w = pk2(siluf_(g1[2]) * u1[2], siluf_(g1[3]) * u1[3]);
                { bf16_t* p = hid + (size_t)(u.base + r) * 512 + col0; asm volatile("global_store_dwordx4 %0, %1, off sc1\n\ts_nop 1" :: "v"(p), "v"(w) : "memory"); } }
    }
};
struct EpiDown {
    static constexpr bool PERM = true;
    bf16_t* y2; const int* ldst; const float* lw;
    __device__ __forceinline__ void operator()(const f32x4 (&acc)[2][2][4][2], const pg8::Unit& u, int wr, int wc, int fr, int fq) const {
        const int col0 = u.pn * 256 + wc * 32 + 8 * fq;
#pragma unroll
        for (int ai = 0; ai < 2; ++ai)
#pragma unroll
            for (int m = 0; m < 4; ++m) { const int r = ai * 128 + wr * 64 + m * 16 + fr;
                if (r < u.rows) {
                    const int li = u.e * 16384 + u.pm * 256 + r; const int dst = ldst[li]; const float cw = lw[li];
#pragma unroll
                    for (int bj = 0; bj < 2; ++bj) { const f32x4 v0 = acc[ai][bj][m][0] * cw, v1 = acc[ai][bj][m][1] * cw;
                        u32x4 w; w.x = pk2(v0[0], v0[1]); w.y = pk2(v0[2], v0[3]); w.z = pk2(v1[0], v1[1]); w.w = pk2(v1[2], v1[3]);
                        *(u32x4*)(y2 + (size_t)dst * 1024 + col0 + bj * 128) = w; }
                } }
    }
};
__device__ __forceinline__ void moe_toff(Frame& F) {
    LAS int* toff = (LAS int*)(F.lds + TOFF_OFF);
    __syncthreads();
    if (F.tid == 0) { const unsigned* cnt = (const unsigned*)(F.ws + WS_CTL) + CW_CNT; int a = 0;
        for (int e = 0; e < NE; ++e) { toff[e] = a; a += ((int)cnt[e] + 255) >> 8; } toff[NE] = a; }
    __syncthreads();
}

__device__ __forceinline__ void moe_down_list(Frame& F, int U, int c) {
    LAS int* myu = (LAS int*)(F.lds + MYU_OFF);
    if (F.tid == 0) {
        const int G = F.G, A = U % G, k = U / G;
        int tH = 5 * (k + 1), tL = 5 * k, rem = U, j0 = 0, n = 0;
        while (rem > 0 && n < 30) {
            const bool heavy = (A > 0) && (tH < tL);
            const int gsz = heavy ? A : (G - A), rank = heavy ? c : (c - A);
            const int cntr = rem < gsz ? rem : gsz;
            if ((heavy ? (c < A) : (c >= A)) && rank < cntr) { myu[1 + n] = j0 + rank; ++n; }
            if (heavy) tH += 3; else tL += 3;
            j0 += cntr; rem -= cntr;
        }
        myu[0] = n;
    }
    __syncthreads();
}

__device__ __forceinline__ void final_row(Frame& F, int m, float* dstbase) {
    const int lane = F.lane;
    float* hr = F.out + (size_t)m * DM;
    const bf16_t* y0 = (const bf16_t*)(F.ws + WS_Y2) + (size_t)(2 * m) * DM; const bf16_t* y1 = y0 + DM;
    f32x4 v[4]; float s = 0.f;
#pragma unroll
    for (int j = 0; j < 4; ++j) {
        v[j] = *(const f32x4*)(hr + 4 * lane + 256 * j);
        const u32x2 a = *(const u32x2*)(y0 + 4 * lane + 256 * j), b = *(const u32x2*)(y1 + 4 * lane + 256 * j);
        v[j][0] += bflo(a.x) + bflo(b.x); v[j][1] += bfhi(a.x) + bfhi(b.x); v[j][2] += bflo(a.y) + bflo(b.y); v[j][3] += bfhi(a.y) + bfhi(b.y);
        s += (v[j].x * v[j].x + v[j].y * v[j].y) + (v[j].z * v[j].z + v[j].w * v[j].w);
    }
    const float rstd = 1.0f / sqrtf(wave_sum(s) * (1.f / DM) + EPS);
#pragma unroll
    for (int j = 0; j < 4; ++j) { const f32x4 w = *(const f32x4*)(F.in[I_NFINW] + 4 * lane + 256 * j); *(f32x4*)(dstbase + (size_t)m * DM + 4 * lane + 256 * j) = v[j] * rstd * w; }
}

__device__ __forceinline__ void ph1_body(Frame& F) {
    pg8::Dense P; P.init((const bf16_t*)(F.ws + WS_U), (const bf16_t*)(F.ws + WS_WINT), M, NP, DM, F.G, (int)blockIdx.x);
    EpiProj E{F.ws};
    pg8::gemm_phase<EpiProj, pg8::Dense, false, true, true>(F.lds, P, E);
}
__device__ __forceinline__ void ph5_body(Frame& F) {
    if (F.G * 1 >= (M / 256) * (DM / 256)) {
        f32x4 xacc[2][2][4][2];
        { pg8::Dense P; P.init((const bf16_t*)(F.ws + WS_YA), (const bf16_t*)(F.ws + WS_WUPA), M, DM, 512, F.G, (int)blockIdx.x);
          EpiUp1R E{F.ws}; pg8::gemm_phase<EpiUp1R, pg8::Dense, false, false, true, 1>(F.lds, P, E, xacc); }
        { pg8::Dense P; P.init((const bf16_t*)(F.ws + WS_YB), (const bf16_t*)(F.ws + WS_WUPR), M, DM, 1024, F.G, (int)blockIdx.x);
          EpiUp2R E{F.ws}; pg8::gemm_phase<EpiUp2R, pg8::Dense, false, false, true, 2>(F.lds, P, E, xacc); }
    } else {
        { pg8::Dense P; P.init((const bf16_t*)(F.ws + WS_YA), (const bf16_t*)(F.ws + WS_WUPA), M, DM, 512, F.G, (int)blockIdx.x);
          EpiUp1 E{F.ws}; pg8::gemm_phase<EpiUp1, pg8::Dense, false, false, true>(F.lds, P, E); }
        { pg8::Dense P; P.init((const bf16_t*)(F.ws + WS_YB), (const bf16_t*)(F.ws + WS_WUPR), M, DM, 1024, F.G, (int)blockIdx.x);
          EpiUp2 E{F.ws}; pg8::gemm_phase<EpiUp2, pg8::Dense, false, false, true>(F.lds, P, E); }
    }
}

struct Args { const float* in[19]; float* out; unsigned char* ws; int ph_lo, ph_hi; };
__global__ void __launch_bounds__(NTHR, 2) hgrh_fwd(Args args) {
    extern __shared__ __attribute__((aligned(16))) unsigned char lds_raw[];
    Frame F;
    F.lds = (LAS unsigned char*)lds_raw;
    F.MISC = (volatile LAS unsigned*)(F.lds + MISC_OFF);
    F.tid = threadIdx.x; F.lane = F.tid & 63; F.wave = __builtin_amdgcn_readfirstlane(F.tid >> 6);
    F.G = gridDim.x; { const int bx = blockIdx.x; F.vcu = (F.G % 8 == 0) ? (bx % 8) * (F.G / 8) + bx / 8 : bx; }
#pragma unroll
    for (int i = 0; i < 19; ++i) F.in[i] = args.in[i];
    F.out = args.out; F.ws = args.ws;
    F.ctl = (GAS unsigned*)(args.ws + WS_CTL);
    for (int u = F.tid; u < (LDS_BYTES - MISC_OFF) / 4; u += NTHR) ((LAS unsigned*)(F.lds + MISC_OFF))[u] = 0u;
    __syncthreads();
    const int lo = args.ph_lo, hi = args.ph_hi;
    XcdBarrier bar; bar.bar = (unsigned*)(args.ws + WS_CTL) + CW_BAR; bar.x = 0; bar.st = nullptr;
    if (hi - lo > 1) bar = xcd_barrier_post((unsigned*)(args.ws + WS_CTL) + CW_BAR, F.MISC + 8);
#ifndef PH_MASK
#define PH_MASK 0xFFFF
#endif
#define IN(k) (((PH_MASK >> (k)) & 1) && lo <= (k) && (k) < hi)
#define SEAM(k) do { if (IN(k) && IN((k) + 1)) { xcd_barrier(bar); if (REPS(13) == 2) xcd_barrier(bar); } } while (0)
    const int gw = F.vcu * NWAVES + F.wave, NGW = F.G * NWAVES;

    if (IN(0)) { for (int rep = 0; rep < REPS(0); ++rep) p0_prologue(F); }
    SEAM(0);
    if (IN(1)) {
        ph1_body(F);
        if (REPS(1) == 2) ph1_body(F);
    }
    SEAM(1);
    if (IN(2)) {
        u32x4 pxw[2][7]; float pg = 0.f, pb = 0.f;
        for (int rep = 0; rep < REPS(2); ++rep) {
#ifdef PREP_PROBE
        if (F.vcu < 1024) gdn_prep_fetch(F, F.vcu, pxw, pg, pb);
        for (int it = F.vcu; it < 1024; it += F.G) gdn_prep_item<PREP_PROBE>(F, it, it + F.G < 1024 ? it + F.G : -1, pxw, pg, pb);
#endif
        if (F.vcu < 1024) gdn_prep_fetch(F, F.vcu, pxw, pg, pb);
        for (int it = F.vcu; it < 1024; it += F.G) gdn_prep_item<0>(F, it, it + F.G < 1024 ? it + F.G : -1, pxw, pg, pb);
        for (int it = F.vcu; it < 512; it += F.G) ret_kv_item(F, it);
        }
        if (REPS(11) == 2) { if (F.vcu < 1024) gdn_prep_fetch(F, F.vcu, pxw, pg, pb); for (int it = F.vcu; it < 1024; it += F.G) gdn_prep_item<0>(F, it, it + F.G < 1024 ? it + F.G : -1, pxw, pg, pb); }
        if (REPS(12) == 2) for (int it = F.vcu + 1024; it < 1024 + 512; it += F.G) ret_kv_item(F, it - 1024);
    }
    SEAM(2);
    if (IN(3)) {
        if (F.vcu < 64) {
#ifdef SCAN_PROBE
            gdn_scan_block<SCAN_PROBE>(F, F.vcu);
#endif
            for (int rep = 0; rep < REPS(3); ++rep) gdn_scan_block<0>(F, F.vcu); }
        else {
            const int NB = F.G - 64, ob = F.vcu - 64;
            for (int t = ob * NWAVES + F.wave; t < 2048; t += NB * NWAVES) ret_prefix_task(F, t);
            asm volatile("s_waitcnt vmcnt(0)" ::: "memory");
            __syncthreads();
            if (F.tid == 0) {
                unsigned* pc = (unsigned*)(F.ws + WS_CTL) + CW_PFX;
                __builtin_amdgcn_fence(__ATOMIC_RELEASE, "agent");
                asm volatile("s_waitcnt vmcnt(0)" ::: "memory");
                xb_add(pc, 1u);
                unsigned sp = 0;
                while (xb_ld(pc) < (unsigned)NB) { __builtin_amdgcn_s_sleep(2); if (++sp > (1u << 22)) break; }
                __builtin_amdgcn_fence(__ATOMIC_ACQUIRE, "agent");
                asm volatile("s_waitcnt vmcnt(0)" ::: "memory");
            }
            __syncthreads();
            for (int rep = 0; rep < REPS(4); ++rep) {
                RetPre RP;
                ret_out_fetch(F, ob < 512 ? ob : 0, RP);
                for (int it = ob; it < 512; it += NB) ret_out_item(F, it, it + NB < 512 ? it + NB : -1, RP);
            }
        }
    }
    SEAM(3);
    if (IN(4)) {
        for (int rep = 0; rep < REPS(14); ++rep)
        for (int m = gw; m < M; m += NGW) gdn_normgate_row(F, m);
    }
    SEAM(4);
    if (IN(5)) {
        ph5_body(F);
        if (REPS(5) == 2) ph5_body(F);
    }
    SEAM(5);
    if (IN(6)) {
        for (int rep = 0; rep < REPS(6); ++rep) {
        pg8::Dense P; P.init((const bf16_t*)(F.ws + WS_MERGED), (const bf16_t*)(F.ws + WS_WOUT), M, DM, DM, F.G, (int)blockIdx.x);
        EpiOut E{F.in[I_X], F.out}; pg8::gemm_phase<EpiOut, pg8::Dense, false, false, true>(F.lds, P, E);
        }
    }
    SEAM(6);
    if (IN(7)) { for (int rep = 0; rep < REPS(7); ++rep) { __syncthreads(); p7_router(F, rep == REPS(7) - 1); } }
    SEAM(7);
    if (IN(8)) {
        moe_toff(F);
        MoeProb P; P.toff = (const LAS int*)(F.lds + TOFF_OFF); P.cnt = (const unsigned*)(F.ws + WS_CTL) + CW_CNT; P.ltok = (const int*)(F.ws + WS_LTOK); P.tilecnt = (unsigned*)(F.ws + WS_CTL) + CW_TILE;
        P.A = (const bf16_t*)(F.ws + WS_XN); P.Bt = (const bf16_t*)(F.ws + WS_WGU); P.K = 1024; P.G = F.G; P.c = F.vcu; P.total = 4 * P.toff[NE];
        moe_down_list(F, P.total, F.vcu);
        EpiGU E{(bf16_t*)(F.ws + WS_HID)};
        pg8::gemm_phase<EpiGU, MoeProb, true, true, true>(F.lds, P, E);
        MoeProbD Q; Q.toff = P.toff; Q.cnt = P.cnt; Q.ltok = P.ltok; Q.tilecnt = P.tilecnt; Q.myu = (const LAS int*)(F.lds + MYU_OFF);
        Q.A = (const bf16_t*)(F.ws + WS_HID); Q.Bt = (const bf16_t*)(F.ws + WS_WD); Q.K = 512; Q.G = F.G; Q.c = F.vcu; Q.total = P.total;
        EpiDown E2{(bf16_t*)(F.ws + WS_Y2), (const int*)(F.ws + WS_LDST), (const float*)(F.ws + WS_LW)};
        pg8::gemm_phase<EpiDown, MoeProbD, false, true, true>(F.lds, Q, E2);
    }
    SEAM(8);
    if (IN(10)) { for (int rep = 0; rep < REPS(10); ++rep) { float* dst = (rep == REPS(10) - 1) ? F.out : (float*)(F.ws + WS_MAB); for (int m = gw; m < M; m += NGW) final_row(F, m, dst); } }
#undef IN
#undef SEAM
}

extern "C" void kernel_launch(void* const* d_in, const int* in_sizes, int n_in, void* d_out, int out_size, void* d_ws, size_t ws_size, hipStream_t stream) {
    static int grid = 0;
    if (grid == 0) {
        if (n_in != 19 || in_sizes[0] != M * DM || out_size != M * DM || ws_size < WS_END) {
            fprintf(stderr, "kernel_launch: unexpected problem (n_in %d, in0 %d, out %d, ws %zu < %zu); nothing launched\n", n_in, n_in > 0 ? in_sizes[0] : -1, out_size, ws_size, (size_t)WS_END); grid = -1; return; }
        int dev = 0, cus = 0;
        if (hipGetDevice(&dev) != hipSuccess || hipDeviceGetAttribute(&cus, hipDeviceAttributeMultiprocessorCount, dev) != hipSuccess) { grid = -1; return; }
        if (hipFuncSetAttribute((const void*)hgrh_fwd, hipFuncAttributeMaxDynamicSharedMemorySize, LDS_BYTES) != hipSuccess) { fprintf(stderr, "kernel_launch: hipFuncSetAttribute failed\n"); grid = -1; return; }
        int per_cu = 0;
        if (hipOccupancyMaxActiveBlocksPerMultiprocessor(&per_cu, (const void*)hgrh_fwd, NTHR, LDS_BYTES) != hipSuccess || per_cu < 1)
            fprintf(stderr, "kernel_launch: occupancy query reports %d workgroups per CU\n", per_cu);
        (void)hipGetLastError();
        grid = cus;
    }
    if (grid < 0) return;
    (void)hipMemsetAsync((char*)d_ws + WS_CTL, 0, CTL_ZERO_BYTES, stream);
    Args a{};
    for (int i = 0; i < 19; ++i) a.in[i] = (const float*)d_in[i];
    a.out = (float*)d_out; a.ws = (unsigned char*)d_ws;
#if MK_N_LAUNCHES == 1
    a.ph_lo = 0; a.ph_hi = NPH;
    hipLaunchKernelGGL(hgrh_fwd, dim3(grid), dim3(NTHR), LDS_BYTES, stream, a);
#else
    for (int p = 0; p < NPH; ++p) { a.ph_lo = p; a.ph_hi = p + 1; hipLaunchKernelGGL(hgrh_fwd, dim3(grid), dim3(NTHR), LDS_BYTES, stream, a); }
#endif
}
```

```cpp
#include <hip/hip_runtime.h>
#include <cstdio>
#include <cstdint>

#ifndef MK_N_LAUNCHES
#define MK_N_LAUNCHES 1
#endif

#ifndef REP_MASK
#define REP_MASK 0
#endif
#define REPS(k) (((REP_MASK >> (k)) & 1) ? 2 : 1)
#define LAS __attribute__((address_space(3)))
#define GAS __attribute__((address_space(1)))
typedef unsigned short bf16_t;
typedef short bf16x8 __attribute__((ext_vector_type(8)));
typedef short bf16x4 __attribute__((ext_vector_type(4)));
typedef float f32x4 __attribute__((ext_vector_type(4)));
typedef float f32x2 __attribute__((ext_vector_type(2)));
typedef unsigned u32x4 __attribute__((ext_vector_type(4)));
typedef unsigned u32x2 __attribute__((ext_vector_type(2)));

constexpr int BATCH = 8, SEQ = 2048, DM = 1024, M = BATCH * SEQ;
constexpr int D_IN = 7176, NP = 7168;
constexpr int NE = 32, DE = 512;
constexpr float EPS = 1e-6f;
constexpr int NWAVES = 8, NTHR = 512;
constexpr int NPH = 11;

constexpr size_t MiB = 1u << 20;
constexpr size_t WS_CTL = 0, CTL_ZERO_BYTES = 128 * 1024;
constexpr size_t WS_LTOK = 1 * MiB, WS_LDST = 3 * MiB, WS_LW = 5 * MiB;
constexpr size_t WS_ROPE = 7 * MiB;
constexpr size_t WS_G = 8 * MiB, WS_BETA = 8 * MiB + 256 * 1024;
constexpr size_t WS_WUPA = 9 * MiB, WS_WUPR = 10 * MiB, WS_WOUT = 12 * MiB;
constexpr size_t WS_WRT = 14 * MiB;
constexpr size_t WS_SSQ = 15 * MiB;
constexpr size_t WS_GQKV = 18 * MiB;
constexpr size_t WS_OGDN = 18 * MiB;
constexpr size_t WS_YB = 34 * MiB;
constexpr size_t WS_YA = 274 * MiB;
constexpr size_t WS_XN = 18 * MiB;
constexpr size_t WS_Y2 = 218 * MiB;
constexpr size_t WS_GZ = 66 * MiB;
constexpr size_t WS_RQK = 82 * MiB;
constexpr size_t WS_RV = 114 * MiB;
constexpr size_t WS_TMP = 82 * MiB;
constexpr size_t WS_WGU = 82 * MiB;
constexpr size_t WS_RG = 146 * MiB;
constexpr size_t WS_WD = 146 * MiB;
constexpr size_t WS_MAB = 178 * MiB;
constexpr size_t WS_HID = 178 * MiB;
constexpr size_t WS_U = 242 * MiB;
constexpr size_t WS_KV = 242 * MiB;
constexpr size_t WS_MERGED = 242 * MiB;
constexpr size_t WS_WINT = 274 * MiB;
constexpr size_t WS_UT = 274 * MiB;
constexpr size_t WS_END = 290 * MiB;
constexpr size_t GP_BYTES = 57344;
constexpr int GP_W = 0, GP_Q = 8192, GP_K = 16384, GP_A = 24576;
constexpr size_t DO_YA = 0, DO_YB = 16 * MiB;

constexpr int CW_TMO = 0;
constexpr int CW_CNT = 64;
constexpr int CW_PFX = 256;
constexpr int CW_BAR = 4096;

constexpr int RING_BYTES = 131072;
constexpr int MISC_OFF = RING_BYTES;
constexpr int LDS_BYTES = 147456;

#define LDS_WAIT() asm volatile("s_waitcnt lgkmcnt(0)" ::: "memory")
#define VM_WAIT() asm volatile("s_waitcnt vmcnt(0)" ::: "memory")
#define LBAR() do { asm volatile("s_waitcnt lgkmcnt(0)" ::: "memory"); __builtin_amdgcn_s_barrier(); asm volatile("" ::: "memory"); } while (0)
__device__ __forceinline__ unsigned f2bf(float f) { unsigned u = __builtin_bit_cast(unsigned, f); return (u + 0x7fffu + ((u >> 16) & 1u)) >> 16; }
typedef __bf16 bf16v2_t __attribute__((ext_vector_type(2)));
__device__ __forceinline__ unsigned pk2(float lo, float hi) { return __builtin_bit_cast(unsigned, __builtin_convertvector((f32x2){lo, hi}, bf16v2_t)); }
__device__ __forceinline__ float bf2f(unsigned short h) { return __builtin_bit_cast(float, (unsigned)h << 16); }
__device__ __forceinline__ float bflo(unsigned w) { return __builtin_bit_cast(float, w << 16); }
__device__ __forceinline__ float bfhi(unsigned w) { return __builtin_bit_cast(float, w & 0xffff0000u); }
template <int CTRL> __device__ __forceinline__ float dpp_f(float v) { return __builtin_bit_cast(float, __builtin_amdgcn_update_dpp(0, __builtin_bit_cast(int, v), CTRL, 0xf, 0xf, true)); }
__device__ __forceinline__ float row16_sum(float v) {
    v += dpp_f<0xB1>(v);
    v += dpp_f<0x4E>(v);
    v += dpp_f<0x141>(v);
    v += dpp_f<0x140>(v);
    return v;
}
__device__ __forceinline__ float rdlane(float v, int l) { return __builtin_bit_cast(float, __builtin_amdgcn_readlane(__builtin_bit_cast(int, v), l)); }
__device__ __forceinline__ float wave_sum(float v) {
    v = row16_sum(v);
    return (rdlane(v, 0) + rdlane(v, 16)) + (rdlane(v, 32) + rdlane(v, 48));
}
__device__ __forceinline__ float sigmoidf_(float x) { return __builtin_amdgcn_rcpf(1.0f + __builtin_amdgcn_exp2f(-1.4426950408889634f * x)); }
__device__ __forceinline__ float siluf_(float x) { return x * sigmoidf_(x); }
__device__ __forceinline__ float rsqrtf_(float x) { return __builtin_amdgcn_rsqf(x); }

#define XB_TMO      128
#define XB_XCNT(j)  (256  + 64 * (j))
#define XB_XSUB(j)  (1280 + 64 * (j))
#define XB_XGEN(j)  (2304 + 64 * (j))
#define XB_TOP      3328
#define XB_TOPGEN   3392
#define XCD_BAR_WORDS 3456
#define XB_SPIN_CAP (1u << 18)
__device__ __forceinline__ unsigned xb_ld(unsigned* p)              { return __hip_atomic_load(p, __ATOMIC_RELAXED, __HIP_MEMORY_SCOPE_AGENT); }
__device__ __forceinline__ unsigned xb_add(unsigned* p, unsigned v) { return __hip_atomic_fetch_add(p, v, __ATOMIC_RELAXED, __HIP_MEMORY_SCOPE_AGENT); }
__device__ __forceinline__ unsigned xb_xcc_id() { return (unsigned)__builtin_amdgcn_s_getreg((3 << 11) | 20) & 0xFu; }
#define XB_SPIN(cond, bar) do { unsigned _sp = 0; while (cond) { __builtin_amdgcn_s_sleep(1); \
    if ((++_sp & 255u) == 0u) { if (xb_ld(&(bar)[XB_TMO])) break; if (_sp > XB_SPIN_CAP) { atomicAdd(&(bar)[XB_TMO], 1u); break; } } } } while (0)
struct XcdBarrier { unsigned* bar; unsigned x; volatile LAS unsigned* st; };
__device__ __forceinline__ XcdBarrier xcd_barrier_post(unsigned* bar, volatile LAS unsigned* st) {
    XcdBarrier b; b.bar = bar; b.x = xb_xcc_id(); b.st = st;
    if (threadIdx.x == 0) (void)xb_add(&bar[XB_XCNT(b.x)], 1u);
    return b;
}
__device__ __forceinline__ void xcd_barrier_complete(unsigned* bar, unsigned x, unsigned& nloc, unsigned& nx) {
    const unsigned G = gridDim.x * gridDim.y * gridDim.z;
    unsigned sum, cnt, mine, sp = 0u;
    for (;;) {
        sum = 0u; cnt = 0u; mine = 0u;
#pragma unroll
        for (unsigned j = 0; j < 16; ++j) { const unsigned c = xb_ld(&bar[XB_XCNT(j)]); sum += c; cnt += (c > 0u) ? 1u : 0u; mine = (j == x) ? c : mine; }
        if (sum == G) break;
        __builtin_amdgcn_s_sleep(1);
        if ((++sp & 255u) == 0u) { if (xb_ld(&bar[XB_TMO])) break; if (sp > XB_SPIN_CAP) { atomicAdd(&bar[XB_TMO], 1u); break; } }
    }
    nloc = mine > 0u ? mine : 1u; nx = cnt > 0u ? cnt : 1u;
}
__device__ __forceinline__ void xcd_barrier(const XcdBarrier& b) {
    asm volatile("s_waitcnt vmcnt(0)" ::: "memory");
    __syncthreads();
    if (threadIdx.x == 0) {
        unsigned* bar = b.bar;
        __builtin_amdgcn_s_waitcnt(0);
        unsigned nloc = b.st[0], nx = b.st[1];
        if (nloc == 0u) { xcd_barrier_complete(bar, b.x, nloc, nx); b.st[0] = nloc; b.st[1] = nx; }
        const unsigned old = xb_add(&bar[XB_XSUB(b.x)], 1u);
        const unsigned gen = old / nloc;
        if (old + 1u == (gen + 1u) * nloc) {
            __builtin_amdgcn_fence(__ATOMIC_RELEASE, "agent");
            asm volatile("s_waitcnt vmcnt(0)" ::: "memory");
            const unsigned og = xb_add(&bar[XB_TOP], 1u);
            const unsigned tg = og / nx;
            if (og + 1u == (tg + 1u) * nx) xb_add(&bar[XB_TOPGEN], 1u);
            else XB_SPIN(xb_ld(&bar[XB_TOPGEN]) == tg, bar);
            __builtin_amdgcn_fence(__ATOMIC_ACQUIRE, "agent");
            xb_add(&bar[XB_XGEN(b.x)], 1u);
            asm volatile("s_waitcnt vmcnt(0)" ::: "memory");
        } else {
            XB_SPIN(xb_ld(&bar[XB_XGEN(b.x)]) == gen, bar);
            __builtin_amdgcn_fence(__ATOMIC_ACQUIRE, "agent");
            asm volatile("s_waitcnt vmcnt(0)" ::: "memory");
        }
    }
    __syncthreads();
}

namespace pg8 {
constexpr int BM = 256, BK = 64, HALF = 128, HTB = HALF * BK * 2, STAGE_BYTES = 8 * HTB, NXCD = 8, WGM = 8;
__host__ __device__ __forceinline__ int lds_byte(int r, int c) { const int st = (r >> 4) * 2 + (c >> 5), rr = r & 15, cc = c & 31, ob = rr * 64 + cc * 2; return st * 1024 + (ob ^ (((ob >> 9) & 1) << 5)); }
__host__ __device__ __forceinline__ void stage_rc(int b, int& R, int& C) { const int st = b / 1024, sb = b % 1024, swz = sb ^ (((sb >> 9) & 1) << 5); R = (st >> 1) * 16 + swz / 64; C = (st & 1) * 32 + (swz % 64) / 2; }
__host__ __device__ __forceinline__ int perm32(int rho) { const int n = rho >> 4, i = rho & 15; return 8 * (i >> 2) + 4 * n + (i & 3); }

struct Unit { int pm, pn, e, rows, base; };

__device__ __forceinline__ unsigned cvt_pk_bf16(float lo, float hi) { return pk2(lo, hi); }

struct Dense {
    const bf16_t* A; const bf16_t* Bt; int K; int nM, nN, nwg, G, c;
    __device__ void init(const bf16_t* A_, const bf16_t* Bt_, int M_, int N_, int K_, int G_, int c_) { A = A_; Bt = Bt_; K = K_; nM = M_ / BM; nN = N_ / BM; nwg = nM * nN; G = G_; c = c_; }
    __device__ __forceinline__ bool next(int i, Unit& u) const {
        const long L = (long)i * G + c; if (L >= nwg) return false;
        int wgid = (int)L; { const int q = nwg / NXCD, r = nwg % NXCD, xcd = wgid % NXCD, off = wgid / NXCD; wgid = (xcd < r ? xcd * (q + 1) : r * (q + 1) + (xcd - r) * q) + off; }
        const int nig = WGM * nN, gid = wgid / nig, fm = gid * WGM, gsz = (nM - fm) < WGM ? (nM - fm) : WGM;
        u.pm = fm + ((wgid % nig) % gsz); u.pn = (wgid % nig) / gsz; u.e = 0; u.rows = 256; u.base = 0; return true;
    }
    __device__ __forceinline__ const char* a_ptr(const Unit& u) const { return (const char*)A + (size_t)u.pm * (size_t)(2 * HALF) * K * 2; }
    __device__ __forceinline__ const char* b_ptr(const Unit& u) const { return (const char*)Bt + (size_t)u.pn * (size_t)(2 * HALF) * K * 2; }
    __device__ __forceinline__ void a_ready(const Unit&) const {}
    __device__ __forceinline__ void done(const Unit&) const {}
};

template <class Epi, class Prob, bool GATHER, bool ALIGN_EPI, bool SP2, int ACCMODE = 0>
__device__ __forceinline__ void gemm_phase(LAS unsigned char* lds, const Prob& S, const Epi& E, f32x4 (*xacc)[2][4][2] = nullptr) {
    const int tid = threadIdx.x, wid = __builtin_amdgcn_readfirstlane(tid >> 6), lane = tid & 63, wr = wid >> 2, wc = wid & 3, fr = lane & 15, fq = lane >> 4;
    const int K = S.K, nt = K / BK;
    unsigned voffB[2]; int RA[2], CA[2];
    unsigned cvo[2][2], nvo[2][2];
#pragma unroll
    for (int i = 0; i < 2; ++i) { int R, C; stage_rc(tid * 16 + i * 8192, R, C); const int Rb = Epi::PERM ? ((R & ~31) + perm32(R & 31)) : R;
        RA[i] = R; CA[i] = C; voffB[i] = (unsigned)(Rb * K + C) * 2u; }
    const size_t kstep = (size_t)(BK * 2);
    const size_t hstep = (size_t)HALF * K * 2;
    const unsigned ldsw = (unsigned)wid * 1024u;
    const int aoff = lds_byte(wr * 64 + fr, fq * 8), boff = lds_byte(wc * 32 + fr, fq * 8);
#define PG8_SA(b, h) (((b) * 2 + (h)) * HTB)
#define PG8_SB(b, h) ((4 + (b) * 2 + (h)) * HTB)
#define PG8_STAGE(bufoff, gbase, voff) do { _Pragma("unroll") for (int _i = 0; _i < 2; ++_i) \
        __builtin_amdgcn_global_load_lds((const unsigned*)((const char*)(gbase) + (voff)[_i]), (LAS unsigned*)(lds + (bufoff) + ldsw + _i * 8192), 16, 0, 0); } while (0)
#define PG8_LDA(dst, b, h) do { _Pragma("unroll") for (int m = 0; m < 4; ++m) _Pragma("unroll") for (int k = 0; k < 2; ++k) dst[m][k] = *(const LAS bf16x8*)(lds + PG8_SA(b, h) + aoff + m * 2048 + k * 1024); } while (0)
#define PG8_LDB(dst, b, h) do { _Pragma("unroll") for (int n = 0; n < 2; ++n) _Pragma("unroll") for (int k = 0; k < 2; ++k) dst[n][k] = *(const LAS bf16x8*)(lds + PG8_SB(b, h) + boff + n * 2048 + k * 1024); } while (0)
#define PG8_MMA(ai, bj, At, Bt) do { __builtin_amdgcn_s_setprio(1); _Pragma("unroll") for (int m = 0; m < 4; ++m) _Pragma("unroll") for (int n = 0; n < 2; ++n) _Pragma("unroll") for (int k = 0; k < 2; ++k) \
        acc[ai][bj][m][n] = __builtin_amdgcn_mfma_f32_16x16x32_bf16(Bt[n][k], At[m][k], acc[ai][bj][m][n], 0, 0, 0); __builtin_amdgcn_s_setprio(0); } while (0)
#define PG8_WAIT_V(n) asm volatile("s_waitcnt vmcnt(" #n ")" ::: "memory")
#define PG8_WAIT_L(n) asm volatile("s_waitcnt lgkmcnt(" #n ")" ::: "memory")
#define PG8_BAR __builtin_amdgcn_s_barrier()
#define PG8_SCHED __builtin_amdgcn_sched_barrier(0)
    Unit cur, nxt; int ui = 0;
    if (!S.next(0, cur)) return;
    f32x4 acc_local[2][2][4][2];
    f32x4 (&acc)[2][2][4][2] = (ACCMODE == 0) ? acc_local : *(f32x4 (*)[2][2][4][2])xacc;
    if constexpr (ACCMODE != 2) {
#pragma unroll
    for (int a = 0; a < 2; ++a)
#pragma unroll
        for (int b = 0; b < 2; ++b)
#pragma unroll
            for (int m = 0; m < 4; ++m)
#pragma unroll
                for (int n = 0; n < 2; ++n) acc[a][b][m][n] = (f32x4){0.f, 0.f, 0.f, 0.f};
    }
    bf16x8 At[4][2], B0[2][2], B1[2][2];
    S.a_ready(cur);
    const char* cA = S.a_ptr(cur); const char* cB = S.b_ptr(cur);
#pragma unroll
    for (int h = 0; h < 2; ++h)
#pragma unroll
        for (int i = 0; i < 2; ++i) {
            if constexpr (GATHER) cvo[h][i] = (unsigned)(((size_t)S.a_row(cur, h * HALF + RA[i]) * K + CA[i]) * 2u);
            else cvo[h][i] = (unsigned)((RA[i] * K + CA[i]) * 2u + h * hstep);
            nvo[h][i] = cvo[h][i];
        }
    if constexpr (SP2) {
        PG8_STAGE(PG8_SB(0, 0), cB, voffB); PG8_STAGE(PG8_SB(0, 1), cB + hstep, voffB); PG8_STAGE(PG8_SA(0, 0), cA, cvo[0]); PG8_STAGE(PG8_SA(0, 1), cA, cvo[1]);
        if (wr == 1) PG8_BAR;
        PG8_WAIT_V(2); PG8_BAR;
        PG8_STAGE(PG8_SB(1, 0), cB + kstep, voffB); PG8_STAGE(PG8_SA(1, 0), cA + kstep, cvo[0]); PG8_STAGE(PG8_SB(1, 1), cB + hstep + kstep, voffB);
        PG8_WAIT_V(6); PG8_BAR;
    } else {
        PG8_STAGE(PG8_SB(0, 0), cB, voffB); PG8_STAGE(PG8_SA(0, 0), cA, cvo[0]); PG8_STAGE(PG8_SB(0, 1), cB + hstep, voffB); PG8_STAGE(PG8_SA(0, 1), cA, cvo[1]);
        if (wr == 1) PG8_BAR;
        PG8_WAIT_V(4); PG8_BAR;
        PG8_STAGE(PG8_SB(1, 0), cB + kstep, voffB); PG8_STAGE(PG8_SA(1, 0), cA + kstep, cvo[0]); PG8_STAGE(PG8_SB(1, 1), cB + hstep + kstep, voffB);
        PG8_WAIT_V(6); PG8_BAR;
    }
    for (;;) {
        const bool has_next = (ACCMODE == 0) ? S.next(ui + 1, nxt) : false;
        const char* nA = has_next ? S.a_ptr(nxt) : cA; const char* nB = has_next ? S.b_ptr(nxt) : cB;
        if constexpr (GATHER) {
#pragma unroll
            for (int h = 0; h < 2; ++h)
#pragma unroll
                for (int i = 0; i < 2; ++i) nvo[h][i] = has_next ? (unsigned)(((size_t)S.a_row(nxt, h * HALF + RA[i]) * K + CA[i]) * 2u) : cvo[h][i];
        }
        for (int t = 0; t < nt; t += 2) {
            const bool last = (t == nt - 2);
            if (last && has_next) S.a_ready(nxt);
            const char* a1 = cA + (size_t)(t + 1) * kstep;
            const char* a2 = last ? nA : cA + (size_t)(t + 2) * kstep; const char* b2 = last ? nB : cB + (size_t)(t + 2) * kstep;
            const char* a3 = a2 + kstep; const char* b3 = b2 + kstep;
            unsigned v2[2][2];
#pragma unroll
            for (int h = 0; h < 2; ++h)
#pragma unroll
                for (int i = 0; i < 2; ++i) v2[h][i] = (GATHER && last) ? nvo[h][i] : cvo[h][i];
            if constexpr (SP2) {
            PG8_LDB(B0, 0, 0); PG8_LDB(B1, 0, 1); PG8_SCHED; PG8_LDA(At, 0, 0); PG8_STAGE(PG8_SA(1, 1), a1, cvo[1]);
            PG8_WAIT_V(8); PG8_WAIT_L(0); PG8_BAR; PG8_MMA(0, 0, At, B0); PG8_MMA(0, 1, At, B1); PG8_BAR; PG8_SCHED;
            PG8_LDA(At, 0, 1); PG8_STAGE(PG8_SB(0, 0), b2, voffB); PG8_STAGE(PG8_SB(0, 1), b2 + hstep, voffB); PG8_STAGE(PG8_SA(0, 0), a2, v2[0]);
            PG8_WAIT_V(8); PG8_WAIT_L(0); PG8_BAR; PG8_MMA(1, 0, At, B0); PG8_MMA(1, 1, At, B1); PG8_BAR; PG8_SCHED;
            PG8_LDB(B0, 1, 0); PG8_LDB(B1, 1, 1); PG8_SCHED; PG8_LDA(At, 1, 0); PG8_STAGE(PG8_SA(0, 1), a2, v2[1]);
            PG8_WAIT_V(8); PG8_WAIT_L(0); PG8_BAR; PG8_MMA(0, 0, At, B0); PG8_MMA(0, 1, At, B1); PG8_BAR; PG8_SCHED;
            PG8_LDA(At, 1, 1); PG8_STAGE(PG8_SB(1, 0), b3, voffB); PG8_STAGE(PG8_SB(1, 1), b3 + hstep, voffB); PG8_STAGE(PG8_SA(1, 0), a3, v2[0]);
            PG8_WAIT_V(8); PG8_WAIT_L(0); PG8_BAR; PG8_MMA(1, 0, At, B0); PG8_MMA(1, 1, At, B1); PG8_BAR; PG8_SCHED;
            } else {
            PG8_LDB(B0, 0, 0); PG8_SCHED; PG8_LDA(At, 0, 0); PG8_STAGE(PG8_SA(1, 1), a1, cvo[1]);
            PG8_WAIT_L(8); PG8_BAR; PG8_WAIT_L(0); PG8_MMA(0, 0, At, B0); PG8_BAR; PG8_SCHED;
            PG8_LDB(B1, 0, 1); PG8_STAGE(PG8_SB(0, 0), b2, voffB);
            PG8_BAR; PG8_WAIT_L(0); PG8_MMA(0, 1, At, B1); PG8_BAR;
            PG8_LDA(At, 0, 1); PG8_STAGE(PG8_SA(0, 0), a2, v2[0]);
            PG8_BAR; PG8_WAIT_L(0); PG8_MMA(1, 0, At, B0); PG8_BAR; PG8_SCHED;
            PG8_STAGE(PG8_SB(0, 1), b2 + hstep, voffB);
            PG8_WAIT_V(6); PG8_BAR; PG8_MMA(1, 1, At, B1); PG8_BAR;
            PG8_LDB(B0, 1, 0); PG8_SCHED; PG8_LDA(At, 1, 0); PG8_STAGE(PG8_SA(0, 1), a2, v2[1]);
            PG8_WAIT_L(8); PG8_BAR; PG8_WAIT_L(0); PG8_MMA(0, 0, At, B0); PG8_BAR; PG8_SCHED;
            PG8_LDB(B1, 1, 1); PG8_STAGE(PG8_SB(1, 0), b3, voffB);
            PG8_BAR; PG8_WAIT_L(0); PG8_MMA(0, 1, At, B1); PG8_BAR;
            PG8_LDA(At, 1, 1); PG8_STAGE(PG8_SA(1, 0), a3, v2[0]);
            PG8_BAR; PG8_WAIT_L(0); PG8_MMA(1, 0, At, B0); PG8_BAR; PG8_SCHED;
            PG8_STAGE(PG8_SB(1, 1), b3 + hstep, voffB);
            PG8_WAIT_V(6); PG8_BAR; PG8_MMA(1, 1, At, B1); PG8_BAR;
            }
        }
        if constexpr (ALIGN_EPI) { if (wr == 0) PG8_BAR; }
        E(acc, cur, wr, wc, fr, fq);
        S.done(cur);
        if (!has_next) break;
#pragma unroll
        for (int a = 0; a < 2; ++a)
#pragma unroll
            for (int b = 0; b < 2; ++b)
#pragma unroll
                for (int m = 0; m < 4; ++m)
#pragma unroll
                    for (int n = 0; n < 2; ++n) acc[a][b][m][n] = (f32x4){0.f, 0.f, 0.f, 0.f};
        cur = nxt; cA = nA; cB = nB; ++ui;
#pragma unroll
        for (int h = 0; h < 2; ++h)
#pragma unroll
            for (int i = 0; i < 2; ++i) cvo[h][i] = nvo[h][i];
        if constexpr (ALIGN_EPI) { if (wr == 1) PG8_BAR; }
    }
    PG8_WAIT_V(0);
    if constexpr (!ALIGN_EPI) { if (wr == 0) PG8_BAR; }
    PG8_BAR;
#undef PG8_SA
#undef PG8_SB
#undef PG8_STAGE
#undef PG8_LDA
#undef PG8_LDB
#undef PG8_MMA
#undef PG8_WAIT_V
#undef PG8_WAIT_L
#undef PG8_BAR
#undef PG8_SCHED
}
}

struct Frame {
    LAS unsigned char* lds;
    volatile LAS unsigned* MISC;
    GAS unsigned* ctl;
    int tid, lane, wave;
    int vcu, G;
    const float* in[19];
    float* out; unsigned char* ws;
};
enum { I_X = 0, I_NMW, I_WIN, I_CONVW, I_ALOG, I_DTB, I_GNW, I_WUPG, I_WUPR, I_WOUT, I_NFW, I_WGRP, I_BGRP, I_WEXP, I_BEXP, I_WGATE, I_WUP, I_WDOWN, I_NFINW };

struct TrItem { const float* W; bf16_t* WT; int ldw, col0, K, row0, k0; };
__device__ __forceinline__ void tr_load(const TrItem& t, int lane, f32x4 (&ld)[8]) {
#pragma unroll
    for (int i = 0; i < 8; ++i) ld[i] = __builtin_nontemporal_load((const f32x4*)(t.W + (size_t)(t.k0 + i * 8 + (lane >> 3)) * t.ldw + t.col0 + (lane & 7) * 4));
}
__device__ __forceinline__ void tr_store(const TrItem& t, int lane, const f32x4 (&ld)[8], LAS float* scr) {
#pragma unroll
    for (int i = 0; i < 8; ++i) { LAS float* d = scr + (i * 8 + (lane >> 3)) * 33 + (lane & 7) * 4; d[0] = ld[i].x; d[1] = ld[i].y; d[2] = ld[i].z; d[3] = ld[i].w; }
    LDS_WAIT(); asm volatile("" ::: "memory");
    const int c = lane & 7;
#pragma unroll
    for (int j = 0; j < 4; ++j) { const int n = (lane >> 3) + 8 * j; const LAS float* sp = scr + (8 * c) * 33 + n;
        u32x4 o; o.x = pk2(sp[0 * 33], sp[1 * 33]); o.y = pk2(sp[2 * 33], sp[3 * 33]); o.z = pk2(sp[4 * 33], sp[5 * 33]); o.w = pk2(sp[6 * 33], sp[7 * 33]);
        *(GAS u32x4*)(t.WT + (size_t)(t.row0 + n) * t.K + t.k0 + 8 * c) = o; }
    LDS_WAIT(); asm volatile("" ::: "memory");
}
template <class Dec> __device__ __forceinline__ void tr_run(const Dec& dec, int first, int count, int stride, int lane, LAS float* scr) {
    if (first >= count) return;
    f32x4 la[8], lb[8];
    TrItem ta = dec(first), tb = ta;
    tr_load(ta, lane, la);
    for (int it = first; it < count; it += 2 * stride) {
        const bool hb = it + stride < count;
        if (hb) { tb = dec(it + stride); tr_load(tb, lane, lb); }
        tr_store(ta, lane, la, scr);
        const bool ha = it + 2 * stride < count;
        if (ha) { ta = dec(it + 2 * stride); tr_load(ta, lane, la); }
        if (hb) tr_store(tb, lane, lb, scr);
    }
}

__device__ __forceinline__ void p0_prologue(Frame& F) {
    LAS float* scr = (LAS float*)(F.lds + F.wave * 16384);
    const int gw = F.vcu * NWAVES + F.wave, NGW = F.G * NWAVES;
    unsigned char* ws = F.ws;
    {
        constexpr int I_IN = (DM / 64) * (NP / 32);
        constexpr int I_UA = (512 / 64) * (DM / 32);
        constexpr int I_UR = (1024 / 64) * (DM / 32);
        constexpr int I_WO = (1024 / 64) * (DM / 32);
        constexpr int NIT = I_IN + I_UA + I_UR + I_WO;
        const float* win = F.in[I_WIN]; const float* wua = F.in[I_WUPG]; const float* wur = F.in[I_WUPR]; const float* wo = F.in[I_WOUT];
        auto dec = [=](int it) -> TrItem {
            int r = it; TrItem t;
            if (r < I_IN) { const int nb = r % (NP / 32), kb = r / (NP / 32); const int n0 = nb * 32;
                t.W = win; t.ldw = D_IN; t.col0 = n0 + (n0 >= 1536 ? 8 : 0); t.WT = (bf16_t*)(ws + WS_WINT); t.K = DM; t.row0 = n0; t.k0 = kb * 64; return t; }
            r -= I_IN;
            if (r < I_UA) { const int nb = r % 32, kb = r / 32; t.W = wua; t.ldw = DM; t.col0 = nb * 32; t.WT = (bf16_t*)(ws + WS_WUPA); t.K = 512; t.row0 = nb * 32; t.k0 = kb * 64; return t; }
            r -= I_UA;
            if (r < I_UR) { const int nb = r % 32, kb = r / 32; t.W = wur; t.ldw = DM; t.col0 = nb * 32; t.WT = (bf16_t*)(ws + WS_WUPR); t.K = 1024; t.row0 = nb * 32; t.k0 = kb * 64; return t; }
            r -= I_UR;
            { const int nb = r % 32, kb = r / 32; t.W = wo; t.ldw = DM; t.col0 = nb * 32; t.WT = (bf16_t*)(ws + WS_WOUT); t.K = 1024; t.row0 = nb * 32; t.k0 = kb * 64; return t; }
        };
        tr_run(dec, gw, NIT, NGW, F.lane, scr);
    }
    {
        GAS f32x2* tab = (GAS f32x2*)(ws + WS_ROPE);
        const int gt = (F.vcu * NTHR + F.tid), NGT = F.G * NTHR;
        for (int i = gt; i < SEQ * 64; i += NGT) {
            const int t = i >> 6, p = i & 63;
            const float invf = 1.0f / powf(10000.0f, (float)p * (1.0f / 63.0f));
            const float ang = (float)t * invf;
            float s, c; sincosf(ang, &s, &c);
            tab[i] = (f32x2){c, s};
        }
    }
    {
        GAS float* wrt = (GAS float*)(ws + WS_WRT);
        const int gt = (F.vcu * NTHR + F.tid), NGT = F.G * NTHR;
        for (int i = gt; i < 48 * DM; i += NGT) {
            const int j = i / DM, k = i % DM;
            const float nf = F.in[I_NFW][k];
            wrt[i] = j < 4 ? F.in[I_WGRP][k * 4 + j] * nf : (j < 36 ? F.in[I_WEXP][k * 32 + (j - 4)] * nf : 0.f);
        }
    }
    {
        __syncthreads();
        LAS float* wab2 = (LAS float*)F.lds;
        for (int idx = F.tid; idx < 8192; idx += NTHR) { const int k = idx >> 3, q = idx & 7; const int j = k >> 8, l_ = (k & 255) >> 2, e = k & 3;
            wab2[((j * 4 + e) * 64 + l_) * 8 + q] = F.in[I_WIN][(size_t)k * D_IN + 1536 + q]; }
        __syncthreads();
        const float* nw = F.in[I_NMW];
        f32x4 wv[4];
#pragma unroll
        for (int j = 0; j < 4; ++j) wv[j] = *(const f32x4*)(nw + 4 * F.lane + 256 * j);
        float alog = 0.f, dtb = 0.f;
        if (F.lane < 4) { alog = F.in[I_ALOG][F.lane]; dtb = F.in[I_DTB][F.lane]; }
        f32x4 vn[4];
#pragma unroll
        for (int j = 0; j < 4; ++j) vn[j] = __builtin_nontemporal_load((const f32x4*)(F.in[I_X] + (size_t)(gw < M ? gw : 0) * DM) + F.lane + 64 * j);
        for (int m = gw; m < M; m += NGW) {
            f32x4 v[4]; float s = 0.f;
#pragma unroll
            for (int j = 0; j < 4; ++j) { v[j] = vn[j]; s += (v[j].x * v[j].x + v[j].y * v[j].y) + (v[j].z * v[j].z + v[j].w * v[j].w); }
            { const int mn = (m + NGW < M) ? m + NGW : m;
#pragma unroll
              for (int j = 0; j < 4; ++j) vn[j] = __builtin_nontemporal_load((const f32x4*)(F.in[I_X] + (size_t)mn * DM) + F.lane + 64 * j); }
            const float rstd = 1.0f / sqrtf(wave_sum(s) * (1.f / DM) + EPS);
            float ab[8];
#pragma unroll
            for (int q = 0; q < 8; ++q) ab[q] = 0.f;
            GAS unsigned long long* o8 = (GAS unsigned long long*)((bf16_t*)(ws + WS_U) + (size_t)m * DM) + F.lane;
#pragma unroll
            for (int j = 0; j < 4; ++j) {
                v[j] = v[j] * rstd * wv[j];
                o8[64 * j] = (unsigned long long)pk2(v[j].x, v[j].y) | ((unsigned long long)pk2(v[j].z, v[j].w) << 32);
#pragma unroll
                for (int e = 0; e < 4; ++e) {
                    const LAS f32x4* wp = (const LAS f32x4*)(wab2 + ((j * 4 + e) * 64 + F.lane) * 8);
                    const f32x4 w0 = wp[0], w1 = wp[1];
                    const float xv = v[j][e];
                    ab[0] += xv * w0.x; ab[1] += xv * w0.y; ab[2] += xv * w0.z; ab[3] += xv * w0.w;
                    ab[4] += xv * w1.x; ab[5] += xv * w1.y; ab[6] += xv * w1.z; ab[7] += xv * w1.w;
                }
            }
#pragma unroll
            for (int q = 0; q < 8; ++q) ab[q] = wave_sum(ab[q]);
            if (F.lane < 4) {
                const float a = F.lane == 0 ? ab[0] : F.lane == 1 ? ab[1] : F.lane == 2 ? ab[2] : ab[3];
                const float b = F.lane == 0 ? ab[4] : F.lane == 1 ? ab[5] : F.lane == 2 ? ab[6] : ab[7];
                const float z = a + dtb;
                const float sp = z > 20.f ? z : log1pf(__expf(z));
                ((GAS float*)(ws + WS_G))[(size_t)m * 4 + F.lane] = -__expf(alog) * sp;
                ((GAS float*)(ws + WS_BETA))[(size_t)m * 4 + F.lane] = 1.0f / (1.0f + __expf(-b));
            }
        }
    }
}

struct EpiProj {
    static constexpr bool PERM = true;
    unsigned char* ws;
    __device__ __forceinline__ void operator()(const f32x4 (&acc)[2][2][4][2], const pg8::Unit& u, int wr, int wc, int fr, int fq) const {
        const int pn = u.pn; bf16_t* base; int ldc, colt, mode = 0;
        if (pn < 6) { base = (bf16_t*)(ws + WS_GQKV); ldc = 1536; colt = 256 * pn; }
        else if (pn < 8) { base = (bf16_t*)(ws + WS_GZ); ldc = 512; colt = 256 * (pn - 6); }
        else if (pn < 12) { base = (bf16_t*)(ws + WS_RQK); ldc = 1024; colt = 256 * (pn - 8); mode = pn < 10 ? 1 : 2; }
        else if (pn < 16) { base = (bf16_t*)(ws + WS_RV); ldc = 1024; colt = 256 * (pn - 12); }
        else if (pn < 20) { base = (bf16_t*)(ws + WS_RG); ldc = 1024; colt = 256 * (pn - 16); }
        else { base = (bf16_t*)(ws + WS_MAB); ldc = 2048; colt = 256 * (pn - 20); }
        const int row0 = u.pm * 256 + wr * 64 + fr, col0 = colt + wc * 32 + 8 * fq;
        const float sc = mode == 2 ? 0.08838834764831845f : 1.0f;
        const GAS f32x4* tab = (const GAS f32x4*)(ws + WS_ROPE);
#pragma unroll
        for (int ai = 0; ai < 2; ++ai)
#pragma unroll
            for (int m = 0; m < 4; ++m) {
                const int row = row0 + ai * 128 + m * 16;
                bf16_t* rowp = base + (size_t)row * ldc + col0;
                f32x4 cs0 = {1.f, 0.f, 1.f, 0.f}, cs1 = cs0;
                if (mode) { const GAS f32x4* tp = tab + ((size_t)(row & (SEQ - 1)) * 64 + wc * 16 + 4 * fq) / 2; cs0 = tp[0]; cs1 = tp[1]; }
#pragma unroll
                for (int bj = 0; bj < 2; ++bj) {
                    f32x4 v0 = acc[ai][bj][m][0], v1 = acc[ai][bj][m][1];
                    if (mode) {
                        f32x4 r0, r1;
                        r0[0] = v0[0] * cs0[0] - v0[1] * cs0[1]; r0[1] = v0[1] * cs0[0] + v0[0] * cs0[1];
                        r0[2] = v0[2] * cs0[2] - v0[3] * cs0[3]; r0[3] = v0[3] * cs0[2] + v0[2] * cs0[3];
                        r1[0] = v1[0] * cs1[0] - v1[1] * cs1[1]; r1[1] = v1[1] * cs1[0] + v1[0] * cs1[1];
                        r1[2] = v1[2] * cs1[2] - v1[3] * cs1[3]; r1[3] = v1[3] * cs1[2] + v1[2] * cs1[3];
                        v0 = r0 * sc; v1 = r1 * sc;
                    }
                    u32x4 w; w.x = pg8::cvt_pk_bf16(v0[0], v0[1]); w.y = pg8::cvt_pk_bf16(v0[2], v0[3]); w.z = pg8::cvt_pk_bf16(v1[0], v1[1]); w.w = pg8::cvt_pk_bf16(v1[2], v1[3]);
                    *(u32x4*)(rowp + bj * 128) = w;
                }
            }
    }
};

__device__ __forceinline__ f32x4 mma16(bf16x8 x, bf16x8 y, f32x4 c) { return __builtin_amdgcn_mfma_f32_16x16x32_bf16(x, y, c, 0, 0, 0); }
__device__ __forceinline__ bf16x8 lfrag(const LAS bf16_t* base, int ld, int row0, int k0, int fr, int fq) { return *(const LAS bf16x8*)(base + (row0 + fr) * ld + k0 + 8 * fq); }
__device__ __forceinline__ bf16x8 gfrag(const bf16_t* base, int ld, int row0, int k0, int fr, int fq) { return *(const bf16x8*)(base + (size_t)(row0 + fr) * ld + k0 + 8 * fq); }
__device__ __forceinline__ bf16x8 tfrag(const LAS bf16_t* base, int ld, int k0, int n0, int lane) {
    const int g = lane >> 4, q = (lane & 15) >> 2, p = lane & 3;
    const LAS bf16_t* a = base + (k0 + 8 * g + q) * ld + n0 + 4 * p;
    const bf16x4 v0 = __builtin_amdgcn_ds_read_tr16_b64_v4i16((LAS bf16x4*)a);
    const bf16x4 v1 = __builtin_amdgcn_ds_read_tr16_b64_v4i16((LAS bf16x4*)(a + 4 * ld));
    return (bf16x8){v0[0], v0[1], v0[2], v0[3], v1[0], v1[1], v1[2], v1[3]};
}
__device__ __forceinline__ bf16x8 pack_acc(f32x4 a, f32x4 b) {
    u32x4 w; w.x = pk2(a[0], a[1]); w.y = pk2(a[2], a[3]); w.z = pk2(b[0], b[1]); w.w = pk2(b[2], b[3]);
    return __builtin_bit_cast(bf16x8, w);
}
__device__ __forceinline__ int ppos(int kap) { return 8 * ((kap & 15) >> 2) + 4 * (kap >> 4) + (kap & 3); }
__device__ __forceinline__ int foff(int row, int col, int kc32) { const int p = ppos(col & 31); return ((row >> 4) * kc32 + (col >> 5)) * 512 + ((row & 15) + 16 * (p >> 3)) * 8 + (p & 7); }

constexpr size_t WS_GL = 8 * MiB + 512 * 1024;

__device__ __forceinline__ void gdn_prep_fetch(Frame& F, int idx, u32x4 (&xw)[2][7], float& gpre, float& bpre) {
    const int bh = idx >> 5, n = idx & 31, b = bh >> 2, h = bh & 3, tok0 = b * SEQ + n * 64, tid = F.tid;
    const bf16_t* GQKV = (const bf16_t*)(F.ws + WS_GQKV);
    if (F.wave == 0) { gpre = ((const float*)(F.ws + WS_G))[(size_t)(tok0 + F.lane) * 4 + h]; bpre = ((const float*)(F.ws + WS_BETA))[(size_t)(tok0 + F.lane) * 4 + h]; }
#pragma unroll
    for (int q = 0; q < 2; ++q) {
        const int task = tid + q * NTHR;
        const int cg = task % 48, tr = task / 48, part = cg >> 4, cl = (cg & 15) * 8, gcol = part * 512 + h * 128 + cl;
#pragma unroll
        for (int r = 0; r < 7; ++r) {
            const int tt = tr * 4 - 3 + r;
            xw[q][r] = (u32x4){0u, 0u, 0u, 0u};
            if (task < 768 && n * 64 + tt >= 0) xw[q][r] = *(const u32x4*)((const unsigned char*)GQKV + (unsigned)(((tok0 + tt) * 1536 + gcol) * 2));
        }
    }
}
template <int PM> __device__ __forceinline__ void gdn_prep_item(Frame& F, int idx, int idx_next, u32x4 (&xw)[2][7], float& gpre, float& bpre) {
    const int bh = idx >> 5, n = idx & 31, b = bh >> 2, h = bh & 3;
    const int tok0 = b * SEQ + n * 64;
    LAS bf16_t* QN = (LAS bf16_t*)(F.lds);
    LAS bf16_t* KN = (LAS bf16_t*)(F.lds + 17408);
    LAS bf16_t* KT = (LAS bf16_t*)(F.lds + 34816);
    LAS bf16_t* VT = (LAS bf16_t*)(F.lds + 53248);
    LAS float*  LM = (LAS float*)(F.lds + 71680);
    LAS bf16_t* T1 = (LAS bf16_t*)(F.lds + 89088);
    LAS bf16_t* T2 = (LAS bf16_t*)(F.lds + 98304);
    LAS float*  SC = (LAS float*)(F.lds + 107520);
    LAS float*  SSQ = (LAS float*)(F.lds + 108544);
    const int tid = F.tid, lane = F.lane, fr = lane & 15, fq = lane >> 4, wave = F.wave;
    const bf16_t* GQKV = (const bf16_t*)(F.ws + WS_GQKV);
    if (!(PM & 1)) {
#pragma unroll
        for (int q = 0; q < 2; ++q) {
            const int task = tid + q * NTHR;
            if (task < 768) {
                const int cg = task % 48, tr = task / 48, part = cg >> 4, cl = (cg & 15) * 8, gcol = part * 512 + h * 128 + cl;
                unsigned nat[4][4];
                float ssq[4];
#pragma unroll
                for (int t = 0; t < 4; ++t) ssq[t] = 0.f;
#pragma unroll
                for (int e2 = 0; e2 < 4; ++e2) {
                    float c0[4], c1[4];
#pragma unroll
                    for (int k = 0; k < 4; ++k) { const f32x2 cc = *(const f32x2*)(F.in[I_CONVW] + k * 1536 + gcol + 2 * e2); c0[k] = cc.x; c1[k] = cc.y; }
                    float xa[7], xb[7];
#pragma unroll
                    for (int r = 0; r < 7; ++r) { const unsigned w = xw[q][r][e2]; xa[r] = bflo(w); xb[r] = bfhi(w); }
                    float ya[4], yb[4];
#pragma unroll
                    for (int t = 0; t < 4; ++t) {
                        ya[t] = siluf_(c0[0] * xa[t] + c0[1] * xa[t + 1] + c0[2] * xa[t + 2] + c0[3] * xa[t + 3]);
                        yb[t] = siluf_(c1[0] * xb[t] + c1[1] * xb[t + 1] + c1[2] * xb[t + 2] + c1[3] * xb[t + 3]);
                        ssq[t] += ya[t] * ya[t] + yb[t] * yb[t];
                        nat[t][e2] = pk2(ya[t], yb[t]);
                    }
                    if (part >= 1) {
                        LAS bf16_t* Tt = part == 1 ? KT : VT;
                        u32x2 w; w.x = pk2(ya[0], ya[1]); w.y = pk2(ya[2], ya[3]);
                        *(LAS u32x2*)(Tt + (cl + 2 * e2) * 72 + tr * 4) = w;
                        w.x = pk2(yb[0], yb[1]); w.y = pk2(yb[2], yb[3]);
                        *(LAS u32x2*)(Tt + (cl + 2 * e2 + 1) * 72 + tr * 4) = w;
                    }
                }
                if (part < 2) {
                    LAS bf16_t* N = part == 0 ? QN : KN;
#pragma unroll
                    for (int t = 0; t < 4; ++t) {
                        SSQ[(part * 64 + tr * 4 + t) * 16 + (cg & 15)] = ssq[t];
                        *(LAS u32x4*)(N + (tr * 4 + t) * 136 + cl) = (u32x4){nat[t][0], nat[t][1], nat[t][2], nat[t][3]};
                    }
                }
            }
        }
    }
    LBAR();
    if (wave == 0) {
        const int c = lane;
        float sq = 0.f, sk = 0.f;
#pragma unroll
        for (int j = 0; j < 16; ++j) { sq += SSQ[c * 16 + j]; sk += SSQ[(64 + c) * 16 + j]; }
        const float rq = 1.0f / sqrtf(sq + EPS), rk = 1.0f / sqrtf(sk + EPS);
        const float g = gpre, be = bpre;
        float gc = g;
#pragma unroll
        for (int o = 1; o < 64; o <<= 1) { const float t = __shfl_up(gc, o); if (lane >= o) gc += t; }
        SC[c] = rq; SC[64 + c] = rk; SC[128 + c] = gc; SC[192 + c] = be;
        if (c == 63) ((float*)(F.ws + WS_GL))[idx] = gc;
    }
    LBAR();
    if (!(PM & 4)) {
        bf16_t* ATT = (bf16_t*)((unsigned char*)F.out + (size_t)idx * GP_BYTES) + GP_A;
#pragma unroll 1
        for (int job = wave * 4; job < wave * 4 + 4; ++job) {
            const int which = job >> 4, it = (job >> 2) & 3, jt = job & 3;
            f32x4 acc = {0.f, 0.f, 0.f, 0.f};
            const LAS bf16_t* Y = which ? QN : KN;
            bf16x8 fx[4], fy[4];
#pragma unroll
            for (int ks = 0; ks < 4; ++ks) { fx[ks] = lfrag(KN, 136, jt * 16, ks * 32, fr, fq); fy[ks] = lfrag(Y, 136, it * 16, ks * 32, fr, fq); }
            __builtin_amdgcn_sched_barrier(0);
#pragma unroll
            for (int ks = 0; ks < 4; ++ks) acc = mma16(fx[ks], fy[ks], acc);
            const int i = it * 16 + fr, j0 = jt * 16 + 4 * fq;
            const float gci = SC[128 + i];
            if (which == 0) {
                const float fi = SC[192 + i] * SC[64 + i];
                f32x4 o;
#pragma unroll
                for (int r = 0; r < 4; ++r) { const int j = j0 + r; o[r] = (j < i) ? fi * SC[64 + j] * acc[r] * __expf(gci - SC[128 + j]) : 0.f; }
                *(LAS f32x4*)(LM + i * 68 + j0) = o;
            } else {
                const float fi = SC[i] * 0.08838834764831845f;
                float o[4];
#pragma unroll
                for (int r = 0; r < 4; ++r) { const int j = j0 + r; o[r] = (j <= i) ? fi * SC[64 + j] * acc[r] * __expf(gci - SC[128 + j]) : 0.f; }
                u32x2 w; w.x = pk2(o[0], o[1]); w.y = pk2(o[2], o[3]);
                *(u32x2*)(ATT + foff(i, j0, 2)) = w;
            }
        }
    }
    LBAR();
    if (idx_next >= 0) gdn_prep_fetch(F, idx_next, xw, gpre, bpre);
    LAS float* TD = (LAS float*)(F.lds + 116736);
    LAS float* PS = (LAS float*)(F.lds + 124928);
    if (wave == 0) { if (!(PM & 2)) {
        const int blk = lane >> 5, c = lane & 31;
        const LAS float* Lb = LM + (blk * 32) * 68 + blk * 32;
        LAS float* Tw = TD + blk * 1024 + c;
        float t[32];
        f32x4 la[8], lb[8];
#define INV_LD(dst, i) do { _Pragma("unroll") for (int _j = 0; _j < ((i) + 3) / 4; ++_j) dst[_j] = *(const LAS f32x4*)(Lb + (i) * 68 + 4 * _j); } while (0)
#define INV_ROW(src, i) do { float ps[4] = {((i) == c) ? 1.f : 0.f, 0.f, 0.f, 0.f}; _Pragma("unroll") for (int _j = 0; _j < ((i) + 3) / 4; ++_j) { _Pragma("unroll") for (int _e = 0; _e < 4; ++_e) if (4 * _j + _e < (i)) ps[_e] -= src[_j][_e] * t[4 * _j + _e]; } \
        t[i] = (ps[0] + ps[1]) + (ps[2] + ps[3]); Tw[(i) * 32] = t[i]; } while (0)
        INV_LD(la, 1);
#pragma unroll
        for (int i = 0; i < 32; i += 2) {
            if (i + 1 < 32) { INV_LD(lb, i + 1); }
            __builtin_amdgcn_sched_barrier(0);
            INV_ROW(la, i);
            if (i + 2 < 32) { INV_LD(la, i + 2); }
            __builtin_amdgcn_sched_barrier(0);
            INV_ROW(lb, i + 1);
        }
#undef INV_LD
#undef INV_ROW
    } } else {
        bf16_t* QGo = (bf16_t*)((unsigned char*)F.out + (size_t)idx * GP_BYTES) + GP_Q;
        bf16_t* KDo = (bf16_t*)((unsigned char*)F.out + (size_t)idx * GP_BYTES) + GP_K;
        const float gl = SC[128 + 63];
        for (int task = tid - 64; task < 2048; task += 448) {
            if (task < 1024) {
                const int c = task >> 4, d0 = (task & 15) * 8;
                const float f = SC[c] * 0.08838834764831845f * __expf(SC[128 + c]);
                const u32x4 w = *(const LAS u32x4*)(QN + c * 136 + d0);
                u32x2 o0, o1; o0.x = pk2(bflo(w.x) * f, bfhi(w.x) * f); o0.y = pk2(bflo(w.y) * f, bfhi(w.y) * f); o1.x = pk2(bflo(w.z) * f, bfhi(w.z) * f); o1.y = pk2(bflo(w.w) * f, bfhi(w.w) * f);
                *(u32x2*)(QGo + foff(c, d0, 4)) = o0; *(u32x2*)(QGo + foff(c, d0 + 4, 4)) = o1;
            } else {
                const int tk = task - 1024, d = tk >> 3, c0 = (tk & 7) * 8;
                const u32x4 w = *(const LAS u32x4*)(KT + d * 72 + c0);
                float f[8];
#pragma unroll
                for (int e = 0; e < 8; ++e) f[e] = SC[64 + c0 + e] * __expf(gl - SC[128 + c0 + e]);
                u32x2 o0, o1; o0.x = pk2(bflo(w.x) * f[0], bfhi(w.x) * f[1]); o0.y = pk2(bflo(w.y) * f[2], bfhi(w.y) * f[3]); o1.x = pk2(bflo(w.z) * f[4], bfhi(w.z) * f[5]); o1.y = pk2(bflo(w.w) * f[6], bfhi(w.w) * f[7]);
                *(u32x2*)(KDo + foff(d, c0, 2)) = o0; *(u32x2*)(KDo + foff(d, c0 + 4, 2)) = o1;
            }
        }
    }
    LBAR();
    if (wave < 4 && !(PM & 2)) {
        const int ti = wave >> 1, tj = wave & 1;
        f32x4 acc = {0.f, 0.f, 0.f, 0.f};
#pragma unroll
        for (int ks = 0; ks < 8; ++ks) acc = __builtin_amdgcn_mfma_f32_16x16x4f32(LM[(32 + 16 * ti + fr) * 68 + 4 * ks + fq], TD[(4 * ks + fq) * 32 + 16 * tj + fr], acc, 0, 0, 0);
#pragma unroll
        for (int r = 0; r < 4; ++r) PS[(16 * ti + 4 * fq + r) * 33 + 16 * tj + fr] = acc[r];
    }
    LBAR();
    if (wave < 4 && !(PM & 2)) {
        const int ti = wave >> 1, tj = wave & 1;
        f32x4 acc = {0.f, 0.f, 0.f, 0.f};
#pragma unroll
        for (int ks = 0; ks < 8; ++ks) acc = __builtin_amdgcn_mfma_f32_16x16x4f32(TD[1024 + (16 * ti + fr) * 32 + 4 * ks + fq], PS[(4 * ks + fq) * 33 + 16 * tj + fr], acc, 0, 0, 0);
#pragma unroll
        for (int r = 0; r < 4; ++r) LM[(32 + 16 * ti + 4 * fq + r) * 68 + 16 * tj + fr] = -acc[r];
    }
    LBAR();
    if (!(PM & 2)) {
#pragma unroll
        for (int q = 0; q < 2; ++q) {
            const int task = tid + q * NTHR, i = task >> 4, j0 = (task & 15) * 4;
            f32x4 tv = {0.f, 0.f, 0.f, 0.f};
            if (i < 32) { if (j0 < 32) tv = *(const LAS f32x4*)(TD + i * 32 + j0); }
            else if (j0 < 32) { tv = *(const LAS f32x4*)(LM + i * 68 + j0); }
            else { tv = *(const LAS f32x4*)(TD + 1024 + (i - 32) * 32 + (j0 - 32)); }
            float b1[4], b2[4];
#pragma unroll
            for (int e = 0; e < 4; ++e) { b1[e] = SC[192 + j0 + e]; b2[e] = b1[e] * SC[64 + j0 + e] * __expf(SC[128 + j0 + e]); }
            u32x2 w1, w2; w1.x = pk2(tv[0] * b1[0], tv[1] * b1[1]); w1.y = pk2(tv[2] * b1[2], tv[3] * b1[3]); w2.x = pk2(tv[0] * b2[0], tv[1] * b2[1]); w2.y = pk2(tv[2] * b2[2], tv[3] * b2[3]);
            *(LAS u32x2*)(T1 + i * 72 + j0) = w1; *(LAS u32x2*)(T2 + i * 72 + j0) = w2;
        }
    }
    LBAR();
    if (!(PM & 4)) {
        bf16_t* UTo = (bf16_t*)(F.ws + WS_UT) + (size_t)idx * 8192;
        bf16_t* WNo = (bf16_t*)((unsigned char*)F.out + (size_t)idx * GP_BYTES) + GP_W;
#pragma unroll 1
        for (int job = wave * 8; job < wave * 8 + 8; ++job) {
            f32x4 acc = {0.f, 0.f, 0.f, 0.f};
            if (job < 32) {
                const int it = job >> 3, dvt = job & 7;
#pragma unroll
                for (int ks = 0; ks < 2; ++ks) acc = mma16(lfrag(T1, 72, it * 16, ks * 32, fr, fq), lfrag(VT, 72, dvt * 16, ks * 32, fr, fq), acc);
                u32x2 w; w.x = pk2(acc[0], acc[1]); w.y = pk2(acc[2], acc[3]);
                *(u32x2*)(UTo + (dvt * 16 + fr) * 64 + it * 16 + 4 * fq) = w;
            } else {
                const int dkt = (job - 32) >> 2, it = (job - 32) & 3;
#pragma unroll
                for (int ks = 0; ks < 2; ++ks) acc = mma16(lfrag(KT, 72, dkt * 16, ks * 32, fr, fq), lfrag(T2, 72, it * 16, ks * 32, fr, fq), acc);
                u32x2 w; w.x = pk2(-acc[0], -acc[1]); w.y = pk2(-acc[2], -acc[3]);
                const int d0 = dkt * 16 + 4 * fq;
                *(u32x2*)(WNo + foff(it * 16 + fr, d0, 4)) = w;
            }
        }
    }
    LBAR();
}

__device__ __forceinline__ float ret_log2_gamma(int h) { return log2f(1.0f - exp2f(-5.0f - (float)h)); }
__device__ __forceinline__ void ret_kv_item(Frame& F, int idx2) {
    const int bh = idx2 >> 4, n = idx2 & 15, b = bh >> 2, h = bh & 3;
    const int tok0 = b * SEQ + n * 128;
    LAS bf16_t* KS = (LAS bf16_t*)(F.lds);
    LAS bf16_t* VN = (LAS bf16_t*)(F.lds + 34816);
    const int tid = F.tid, lane = F.lane, fr = lane & 15, fq = lane >> 4, wave = F.wave;
    const float l2g = ret_log2_gamma(h);
    const bf16_t* RQK = (const bf16_t*)(F.ws + WS_RQK); const bf16_t* RV = (const bf16_t*)(F.ws + WS_RV);
#pragma unroll
    for (int i = 0; i < 4; ++i) { const int p = tid + i * 512, c = p >> 4, d0 = (p & 15) * 8;
        const u32x4 w = *(const u32x4*)(RQK + (size_t)(tok0 + c) * 1024 + 512 + h * 128 + d0);
        const float f = exp2f(l2g * (float)(127 - c));
        u32x4 o; o.x = pk2(bflo(w.x) * f, bfhi(w.x) * f); o.y = pk2(bflo(w.y) * f, bfhi(w.y) * f); o.z = pk2(bflo(w.z) * f, bfhi(w.z) * f); o.w = pk2(bflo(w.w) * f, bfhi(w.w) * f);
        *(LAS u32x4*)(KS + c * 136 + d0) = o; }
#pragma unroll
    for (int i = 0; i < 8; ++i) { const int p = tid + i * 512, c = p >> 5, d0 = (p & 31) * 8;
        *(LAS u32x4*)(VN + c * 264 + d0) = *(const u32x4*)(RV + (size_t)(tok0 + c) * 1024 + h * 256 + d0); }
    LBAR();
    f32x4 acc[8][2];
#pragma unroll
    for (int a = 0; a < 8; ++a) { acc[a][0] = (f32x4){0.f, 0.f, 0.f, 0.f}; acc[a][1] = acc[a][0]; }
#pragma unroll
    for (int ks = 0; ks < 4; ++ks) {
        const bf16x8 y0 = tfrag(VN, 264, ks * 32, (2 * wave) * 16, lane), y1 = tfrag(VN, 264, ks * 32, (2 * wave + 1) * 16, lane);
#pragma unroll
        for (int dkt = 0; dkt < 8; ++dkt) { const bf16x8 x = tfrag(KS, 136, ks * 32, dkt * 16, lane); acc[dkt][0] = mma16(x, y0, acc[dkt][0]); acc[dkt][1] = mma16(x, y1, acc[dkt][1]); }
    }
    bf16_t* KVo = (bf16_t*)(F.ws + WS_KV) + (size_t)idx2 * 32768;
#pragma unroll
    for (int dkt = 0; dkt < 8; ++dkt)
#pragma unroll
        for (int q = 0; q < 2; ++q) { u32x2 w; w.x = pk2(acc[dkt][q][0], acc[dkt][q][1]); w.y = pk2(acc[dkt][q][2], acc[dkt][q][3]);
            *(u32x2*)(KVo + ((2 * wave + q) * 16 + fr) * 128 + dkt * 16 + 4 * fq) = w; }
    LBAR();
}

template <int MODE> __device__ __forceinline__ void gdn_scan_block(Frame& F, int cu) {
    const int bh = cu >> 1, b = bh >> 2, h = bh & 3;
    const int lane = F.lane, wave = F.wave, fr = lane & 15, fq = lane >> 4;
    const unsigned char* GPb = (const unsigned char*)F.out + (size_t)(bh * 32) * GP_BYTES;
    const unsigned char* UTb = (const unsigned char*)(F.ws + WS_UT) + (size_t)(bh * 32) * 16384 + (cu & 1) * 8192;
    constexpr int BUFB = 65536;
    int wpa[8], wpb[8]; int wsum = 0;
#pragma unroll
    for (int i = 0; i < 8; ++i) { wpa[i] = 0; wpb[i] = 0; }
#define SCAN_DMA(nn, lw) do { const unsigned char* _g = GPb + (size_t)(nn) * GP_BYTES; const unsigned char* _u = UTb + (size_t)(nn) * 16384; LAS unsigned char* _d = F.lds + ((nn) & 1) * BUFB; \
        _Pragma("unroll") for (int _i = 0; _i < 16; ++_i) { const int piece = (lw) + 4 * _i; const unsigned char* src = piece < 56 ? _g + piece * 1024 : _u + (piece - 56) * 1024; \
            __builtin_amdgcn_global_load_lds((const unsigned*)(src + lane * 16), (LAS unsigned*)(_d + piece * 1024), 16, 0, 0); } } while (0)
#define SCAN_WARM(wp, nn) do { const unsigned char* _g = GPb + (size_t)(nn) * GP_BYTES; const unsigned char* _u = UTb + (size_t)(nn) * 16384; \
        _Pragma("unroll") for (int _k = 0; _k < 2; ++_k) { const int _L = (2 * wave + _k) * 64 + lane; wsum ^= wp[_k]; wp[_k] = *(const int*)(_L < 448 ? _g + _L * 128 : _u + (_L - 448) * 128); } } while (0)
    if (wave >= 4) { SCAN_DMA(0, wave - 4); asm volatile("s_waitcnt vmcnt(0)" ::: "memory"); }
    else { SCAN_WARM(wpa, 1); SCAN_WARM(wpb, 2); }
    float glall = 0.f;
    if (wave < 4 && lane < 32) glall = ((const float*)(F.ws + WS_GL))[bh * 32 + lane];
    LBAR();
    const int sl = (cu & 1) * 4 + (wave & 3);
    bf16_t* OG = (bf16_t*)(F.ws + WS_OGDN);
    f32x4 S[8];
#pragma unroll
    for (int d = 0; d < 8; ++d) S[d] = (f32x4){0.f, 0.f, 0.f, 0.f};
#pragma unroll 1
    for (int n = 0; n < 32; ++n) {
        if (wave >= 4) {
            if (MODE != 1 && n + 1 < 32) { SCAN_DMA(n + 1, wave - 4); asm volatile("s_waitcnt vmcnt(0)" ::: "memory"); }
        } else if (MODE != 2) {
            if (n + 3 < 32) { if (n & 1) SCAN_WARM(wpb, n + 3); else SCAN_WARM(wpa, n + 3); }
            const LAS unsigned char* buf = F.lds + (n & 1) * BUFB;
            const LAS bf16x8* Bf = (const LAS bf16x8*)buf + lane;
            const float egl = __expf(rdlane(glall, n));
            f32x4 av[4], ao[4];
#pragma unroll
            for (int ct = 0; ct < 4; ++ct) {
                const u32x2 un = *(const LAS u32x2*)(buf + GP_BYTES + (((wave & 3) * 16 + fr) * 64 + ct * 16 + 4 * fq) * 2);
                av[ct] = (f32x4){bflo(un.x), bfhi(un.x), bflo(un.y), bfhi(un.y)}; ao[ct] = (f32x4){0.f, 0.f, 0.f, 0.f};
            }
#define LDG(dst, blk0) do { _Pragma("unroll") for (int _j = 0; _j < 8; ++_j) dst[_j] = Bf[((blk0) + _j) * 64]; } while (0)
#define SB() __builtin_amdgcn_sched_barrier(0)
            bf16x8 ga[8], gb[8];
            LDG(ga, 0); LDG(gb, 8); SB();
            bf16x8 Sf[4];
#pragma unroll
            for (int ks = 0; ks < 4; ++ks) Sf[ks] = pack_acc(S[2 * ks], S[2 * ks + 1]);
            SB();
#pragma unroll
            for (int jj = 0; jj < 8; ++jj) { const int j = (jj >> 1) + 4 * (jj & 1); av[j >> 2] = mma16(ga[j], Sf[j & 3], av[j >> 2]); }
            SB(); LDG(ga, 16); SB();
#pragma unroll
            for (int jj = 0; jj < 8; ++jj) { const int j = (jj >> 1) + 4 * (jj & 1); av[2 + (j >> 2)] = mma16(gb[j], Sf[j & 3], av[2 + (j >> 2)]); }
            SB(); LDG(gb, 24); SB();
#pragma unroll
            for (int jj = 0; jj < 8; ++jj) { const int j = (jj >> 1) + 4 * (jj & 1); ao[j >> 2] = mma16(ga[j], Sf[j & 3], ao[j >> 2]); }
            SB(); LDG(ga, 48); SB();
#pragma unroll
            for (int jj = 0; jj < 8; ++jj) { const int j = (jj >> 1) + 4 * (jj & 1); ao[2 + (j >> 2)] = mma16(gb[j], Sf[j & 3], ao[2 + (j >> 2)]); }
            SB(); LDG(gb, 32); SB();
            bf16x8 Vf[2];
            Vf[0] = pack_acc(av[0], av[1]); Vf[1] = pack_acc(av[2], av[3]);
#pragma unroll
            for (int dt = 0; dt < 8; ++dt) S[dt] = S[dt] * egl;
            SB();
#pragma unroll
            for (int jj = 0; jj < 8; ++jj) { const int j = 2 * (jj & 3) + (jj >> 2); ao[j >> 1] = mma16(ga[j], Vf[j & 1], ao[j >> 1]); }
            SB(); LDG(ga, 40); SB();
#pragma unroll
            for (int jj = 0; jj < 8; ++jj) { const int j = 2 * (jj & 3) + (jj >> 2); S[j >> 1] = mma16(gb[j], Vf[j & 1], S[j >> 1]); }
            SB();
#pragma unroll
            for (int jj = 0; jj < 8; ++jj) { const int j = 2 * (jj & 3) + (jj >> 2); S[4 + (j >> 1)] = mma16(ga[j], Vf[j & 1], S[4 + (j >> 1)]); }
            SB();
#undef LDG
#undef SB
            const int tok0 = b * SEQ + n * 64;
#pragma unroll
            for (int ct = 0; ct < 4; ++ct)
#pragma unroll
                for (int r = 0; r < 4; ++r) {
                    const int c = ct * 16 + 4 * fq + r;
                    if (MODE != 3) OG[(size_t)(tok0 + c) * 512 + h * 128 + sl * 16 + fr] = (bf16_t)f2bf(ao[ct][r]);
                }
        }
        LBAR();
    }
#undef SCAN_DMA
#undef SCAN_WARM
#pragma unroll
    for (int i = 0; i < 8; ++i) wsum ^= wpa[i] ^ wpb[i];
    if (wsum == 0x5a17c0de) ((unsigned*)(F.ws + WS_CTL))[CW_TMO + 16] = 1u;
}

__device__ __forceinline__ void ret_prefix_task(Frame& F, int task) {
    const int bh = task >> 6, part = task & 63, h = bh & 3;
    const float cd = exp2f(ret_log2_gamma(h) * 128.0f);
    bf16_t* base = (bf16_t*)(F.ws + WS_KV) + (size_t)bh * 16 * 32768 + part * 512 + F.lane * 8;
    float st[8];
#pragma unroll
    for (int e = 0; e < 8; ++e) st[e] = 0.f;
#pragma unroll 4
    for (int n = 0; n < 16; ++n) {
        u32x4* p = (u32x4*)(base + (size_t)n * 32768);
        const u32x4 w = *p;
        u32x4 o; o.x = pk2(st[0], st[1]); o.y = pk2(st[2], st[3]); o.z = pk2(st[4], st[5]); o.w = pk2(st[6], st[7]);
        *p = o;
        st[0] = st[0] * cd + bflo(w.x); st[1] = st[1] * cd + bfhi(w.x); st[2] = st[2] * cd + bflo(w.y); st[3] = st[3] * cd + bfhi(w.y);
        st[4] = st[4] * cd + bflo(w.z); st[5] = st[5] * cd + bfhi(w.z); st[6] = st[6] * cd + bflo(w.w); st[7] = st[7] * cd + bfhi(w.w);
    }
}

__device__ __forceinline__ bf16x8 scale_frag(bf16x8 q, float f) {
    u32x4 w = __builtin_bit_cast(u32x4, q);
    w.x = pk2(bflo(w.x) * f, bfhi(w.x) * f); w.y = pk2(bflo(w.y) * f, bfhi(w.y) * f); w.z = pk2(bflo(w.z) * f, bfhi(w.z) * f); w.w = pk2(bflo(w.w) * f, bfhi(w.w) * f);
    return __builtin_bit_cast(bf16x8, w);
}
struct RetPre { u32x4 q[4], k[4]; };
__device__ __forceinline__ void ret_out_fetch(Frame& F, int idx2, RetPre& P) {
    const int bh = idx2 >> 4, n = idx2 & 15, b = bh >> 2, h = bh & 3, tok0 = b * SEQ + n * 128, tid = F.tid;
    const bf16_t* RQK = (const bf16_t*)(F.ws + WS_RQK);
#pragma unroll
    for (int i = 0; i < 4; ++i) { const int p = tid + i * 512, c = p >> 4, d0 = (p & 15) * 8; P.q[i] = *(const u32x4*)((const unsigned char*)RQK + (unsigned)(((tok0 + c) * 1024 + h * 128 + d0) * 2)); }
#pragma unroll
    for (int i = 0; i < 4; ++i) { const int p = tid + i * 512, c = p >> 4, d0 = (p & 15) * 8; P.k[i] = *(const u32x4*)((const unsigned char*)RQK + (unsigned)(((tok0 + c) * 1024 + 512 + h * 128 + d0) * 2)); }
}
__device__ __forceinline__ void ret_out_item(Frame& F, int idx2, int idx_next, RetPre& P) {
    const int bh = idx2 >> 4, n = idx2 & 15, b = bh >> 2, h = bh & 3;
    const int tok0 = b * SEQ + n * 128;
    LAS bf16_t* QN = (LAS bf16_t*)(F.lds);
    LAS bf16_t* SPn = (LAS bf16_t*)(F.lds + 34816);
    LAS bf16_t* KN = (LAS bf16_t*)(F.lds + 34816);
    LAS bf16_t* PM = (LAS bf16_t*)(F.lds + 69632);
    LAS bf16_t* VN = (LAS bf16_t*)(F.lds);
    LAS float*  NS = (LAS float*)(F.lds + 104448);
    const int tid = F.tid, lane = F.lane, fr = lane & 15, fq = lane >> 4, wave = F.wave;
    const float l2g = ret_log2_gamma(h);
    const bf16_t* RQK = (const bf16_t*)(F.ws + WS_RQK); const bf16_t* RV = (const bf16_t*)(F.ws + WS_RV);
    const bf16_t* SP = (const bf16_t*)(F.ws + WS_KV) + (size_t)idx2 * 32768;
#define SB() __builtin_amdgcn_sched_barrier(0)
    u32x4 kreg[4];
    {
        u32x4 sreg[8];
#pragma unroll
        for (int i = 0; i < 8; ++i) { const int p = tid + i * 512; sreg[i] = *(const u32x4*)((const unsigned char*)SP + (unsigned)(p * 16)); }
#pragma unroll
        for (int i = 0; i < 4; ++i) { const int p = tid + i * 512, c = p >> 4, d0 = (p & 15) * 8; *(LAS u32x4*)(QN + c * 136 + d0) = P.q[i]; kreg[i] = P.k[i]; }
#pragma unroll
        for (int i = 0; i < 8; ++i) { const int p = tid + i * 512, r = p >> 4, d0 = (p & 15) * 8; *(LAS u32x4*)(SPn + r * 136 + d0) = sreg[i]; }
    }
    LBAR();
    const int wi = wave >> 1, wd = wave & 1;
    f32x4 a1[8][2];
#pragma unroll
    for (int d = 0; d < 8; ++d) { a1[d][0] = (f32x4){0.f, 0.f, 0.f, 0.f}; a1[d][1] = a1[d][0]; }
    {
        const float qd0 = exp2f(l2g * (float)((2 * wi) * 16 + fr + 1)), qd1 = exp2f(l2g * (float)((2 * wi + 1) * 16 + fr + 1));
        bf16x8 xa[8], qa[2];
#define LD0(x, q, ks) do { _Pragma("unroll") for (int _d = 0; _d < 8; ++_d) x[_d] = lfrag(SPn, 136, (wd * 8 + _d) * 16, (ks) * 32, fr, fq); \
        q[0] = lfrag(QN, 136, (2 * wi) * 16, (ks) * 32, fr, fq); q[1] = lfrag(QN, 136, (2 * wi + 1) * 16, (ks) * 32, fr, fq); } while (0)
#define MM0(x, q) do { const bf16x8 _q0 = scale_frag(q[0], qd0), _q1 = scale_frag(q[1], qd1); _Pragma("unroll") for (int _d = 0; _d < 8; ++_d) { a1[_d][0] = mma16(x[_d], _q0, a1[_d][0]); a1[_d][1] = mma16(x[_d], _q1, a1[_d][1]); } } while (0)
        LD0(xa, qa, 0); SB(); MM0(xa, qa); SB(); LD0(xa, qa, 1); SB(); MM0(xa, qa); SB(); LD0(xa, qa, 2); SB(); MM0(xa, qa); SB(); LD0(xa, qa, 3); SB(); MM0(xa, qa); SB();
#undef LD0
#undef MM0
    }
    LBAR();
    u32x4 vreg[8];
#pragma unroll
    for (int i = 0; i < 8; ++i) { const int p = tid + i * 512, c = p >> 5, d0 = (p & 31) * 8; vreg[i] = *(const u32x4*)((const unsigned char*)RV + (unsigned)(((tok0 + c) * 1024 + h * 256 + d0) * 2)); }
#pragma unroll
    for (int i = 0; i < 4; ++i) { const int p = tid + i * 512, c = p >> 4, d0 = (p & 15) * 8; *(LAS u32x4*)(KN + c * 136 + d0) = kreg[i]; }
    LBAR();
    {
        bf16x8 yq[4];
#pragma unroll
        for (int ks = 0; ks < 4; ++ks) yq[ks] = lfrag(QN, 136, wave * 16, ks * 32, fr, fq);
        const int i = wave * 16 + fr;
        bf16x8 ka[4], kb[4];
#define LD1(k, jt) do { _Pragma("unroll") for (int _s = 0; _s < 4; ++_s) k[_s] = lfrag(KN, 136, (jt) * 16, _s * 32, fr, fq); } while (0)
#define MM1(k, jt) do { f32x4 acc = {0.f, 0.f, 0.f, 0.f}; _Pragma("unroll") for (int _s = 0; _s < 4; ++_s) acc = mma16(k[_s], yq[_s], acc); \
        float o[4]; _Pragma("unroll") for (int r = 0; r < 4; ++r) { const int j = (jt) * 16 + 4 * fq + r; o[r] = (j <= i) ? acc[r] * exp2f(l2g * (float)(i - j)) : 0.f; } \
        u32x2 w; w.x = pk2(o[0], o[1]); w.y = pk2(o[2], o[3]); *(LAS u32x2*)(PM + i * 136 + (jt) * 16 + 4 * fq) = w; } while (0)
        LD1(ka, 0); SB();
#pragma unroll
        for (int jt = 0; jt < 8; jt += 2) { LD1(kb, jt + 1); SB(); MM1(ka, jt); SB(); if (jt + 2 < 8) { LD1(ka, jt + 2); } SB(); MM1(kb, jt + 1); SB(); }
#undef LD1
#undef MM1
    }
    LBAR();
#pragma unroll
    for (int i = 0; i < 8; ++i) { const int p = tid + i * 512, c = p >> 5, d0 = (p & 31) * 8; *(LAS u32x4*)(VN + c * 264 + d0) = vreg[i]; }
    LBAR();
    const bf16_t* RG = (const bf16_t*)(F.ws + WS_RG);
    u32x2 gt[2][8];
    {
        bf16x8 xa[8], pa[2];
#define LD2(x, p, ks) do { _Pragma("unroll") for (int _d = 0; _d < 8; ++_d) x[_d] = tfrag(VN, 264, (ks) * 32, (wd * 8 + _d) * 16, lane); \
        p[0] = lfrag(PM, 136, (2 * wi) * 16, (ks) * 32, fr, fq); p[1] = lfrag(PM, 136, (2 * wi + 1) * 16, (ks) * 32, fr, fq); } while (0)
#define MM2(x, p) do { _Pragma("unroll") for (int _d = 0; _d < 8; ++_d) { a1[_d][0] = mma16(x[_d], p[0], a1[_d][0]); a1[_d][1] = mma16(x[_d], p[1], a1[_d][1]); } } while (0)
        LD2(xa, pa, 0); SB(); MM2(xa, pa); SB(); LD2(xa, pa, 1); SB(); MM2(xa, pa); SB(); LD2(xa, pa, 2); SB(); MM2(xa, pa); SB(); LD2(xa, pa, 3); SB(); MM2(xa, pa); SB();
#undef LD2
#undef MM2
    }
#undef SB
#define LDGATE(t) do { _Pragma("unroll") for (int d = 0; d < 8; ++d) gt[t][d] = *(const u32x2*)((const unsigned char*)RG + (unsigned)(((tok0 + (2 * wi + (t)) * 16 + fr) * 1024 + h * 256 + (wd * 8 + d) * 16 + 4 * fq) * 2)); } while (0)
    LDGATE(0);
    ret_out_fetch(F, idx_next >= 0 ? idx_next : idx2, P);
#pragma unroll
    for (int t = 0; t < 2; ++t) {
        const int i = (2 * wi + t) * 16 + fr;
        float s = 0.f;
#pragma unroll
        for (int d = 0; d < 8; ++d) { const f32x4 v = a1[d][t]; s += (v[0] * v[0] + v[1] * v[1]) + (v[2] * v[2] + v[3] * v[3]); }
        s += __shfl_xor(s, 16); s += __shfl_xor(s, 32);
        if (fq == 0) NS[i * 2 + wd] = s;
    }
    LBAR();
    bf16_t* YB = (bf16_t*)(F.ws + WS_YB);
#pragma unroll
    for (int t = 0; t < 2; ++t) {
        const int i = (2 * wi + t) * 16 + fr;
        const float rstd = rsqrtf_((NS[i * 2] + NS[i * 2 + 1]) * (1.0f / 256.0f) + EPS);
        if (t == 0) { LDGATE(1); }
#pragma unroll
        for (int d = 0; d < 8; ++d) {
            const int dv = (wd * 8 + d) * 16 + 4 * fq;
            const f32x4 v = a1[d][t] * rstd;
            u32x2 w; w.x = pk2(v[0] * siluf_(bflo(gt[t][d].x)), v[1] * siluf_(bfhi(gt[t][d].x))); w.y = pk2(v[2] * siluf_(bflo(gt[t][d].y)), v[3] * siluf_(bfhi(gt[t][d].y)));
            *(u32x2*)(YB + (size_t)(tok0 + i) * 1024 + h * 256 + dv) = w;
        }
    }
#undef LDGATE
    LBAR();
}

__device__ __forceinline__ void gdn_normgate_row(Frame& F, int m) {
    const int lane = F.lane;
    const u32x4 ow = *(const u32x4*)((const bf16_t*)(F.ws + WS_OGDN) + (size_t)m * 512 + lane * 8);
    const u32x4 z = *(const u32x4*)((const bf16_t*)(F.ws + WS_GZ) + (size_t)m * 512 + lane * 8);
    float o[8] = {bflo(ow.x), bfhi(ow.x), bflo(ow.y), bfhi(ow.y), bflo(ow.z), bfhi(ow.z), bflo(ow.w), bfhi(ow.w)};
    float ss = 0.f;
#pragma unroll
    for (int e = 0; e < 8; ++e) ss += o[e] * o[e];
    ss = row16_sum(ss);
    const float rstd = rsqrtf_(ss * (1.0f / 128.0f) + EPS);
    const float* nw = F.in[I_GNW] + (lane & 15) * 8;
    const f32x4 w0 = *(const f32x4*)nw, w1 = *(const f32x4*)(nw + 4);
    u32x4 y;
    y.x = pk2(o[0] * rstd * w0[0] * siluf_(bflo(z.x)), o[1] * rstd * w0[1] * siluf_(bfhi(z.x)));
    y.y = pk2(o[2] * rstd * w0[2] * siluf_(bflo(z.y)), o[3] * rstd * w0[3] * siluf_(bfhi(z.y)));
    y.z = pk2(o[4] * rstd * w1[0] * siluf_(bflo(z.z)), o[5] * rstd * w1[1] * siluf_(bfhi(z.z)));
    y.w = pk2(o[6] * rstd * w1[2] * siluf_(bflo(z.w)), o[7] * rstd * w1[3] * siluf_(bfhi(z.w)));
    *(u32x4*)((bf16_t*)(F.ws + WS_YA) + (size_t)m * 512 + lane * 8) = y;
}

struct EpiUp1 {
    static constexpr bool PERM = true;
    unsigned char* ws;
    __device__ __forceinline__ void operator()(const f32x4 (&acc)[2][2][4][2], const pg8::Unit& u, int wr, int wc, int fr, int fq) const {
        const int row0 = u.pm * 256 + wr * 64 + fr, col0 = u.pn * 256 + wc * 32 + 8 * fq;
        const bf16_t* MAB = (const bf16_t*)(ws + WS_MAB); float* TMP = (float*)(ws + WS_TMP);
#pragma unroll
        for (int ai = 0; ai < 2; ++ai)
#pragma unroll
            for (int m = 0; m < 4; ++m) { const int row = row0 + ai * 128 + m * 16;
#pragma unroll
                for (int bj = 0; bj < 2; ++bj) {
                    const int col = col0 + bj * 128;
                    const u32x4 g = *(const u32x4*)(MAB + (size_t)row * 2048 + col);
                    const f32x4 v0 = acc[ai][bj][m][0], v1 = acc[ai][bj][m][1];
                    f32x4 o0, o1;
                    o0[0] = v0[0] * sigmoidf_(bflo(g.x)); o0[1] = v0[1] * sigmoidf_(bfhi(g.x)); o0[2] = v0[2] * sigmoidf_(bflo(g.y)); o0[3] = v0[3] * sigmoidf_(bfhi(g.y));
                    o1[0] = v1[0] * sigmoidf_(bflo(g.z)); o1[1] = v1[1] * sigmoidf_(bfhi(g.z)); o1[2] = v1[2] * sigmoidf_(bflo(g.w)); o1[3] = v1[3] * sigmoidf_(bfhi(g.w));
                    float* p = TMP + (size_t)row * 1024 + col;
                    *(f32x4*)p = o0; *(f32x4*)(p + 4) = o1;
                } }
    }
};
struct EpiUp1R {
    static constexpr bool PERM = true;
    unsigned char* ws;
    __device__ __forceinline__ void operator()(f32x4 (&acc)[2][2][4][2], const pg8::Unit& u, int wr, int wc, int fr, int fq) const {
        const int row0 = u.pm * 256 + wr * 64 + fr, col0 = u.pn * 256 + wc * 32 + 8 * fq;
        const bf16_t* MAB = (const bf16_t*)(ws + WS_MAB);
#pragma unroll
        for (int ai = 0; ai < 2; ++ai)
#pragma unroll
            for (int m = 0; m < 4; ++m) { const int row = row0 + ai * 128 + m * 16;
#pragma unroll
                for (int bj = 0; bj < 2; ++bj) {
                    const int col = col0 + bj * 128;
                    const u32x4 ga = *(const u32x4*)(MAB + (size_t)row * 2048 + col), gb = *(const u32x4*)(MAB + (size_t)row * 2048 + 1024 + col);
                    const unsigned gaw[4] = {ga.x, ga.y, ga.z, ga.w}, gbw[4] = {gb.x, gb.y, gb.z, gb.w};
#pragma unroll
                    for (int q = 0; q < 4; ++q) {
                        const float a0 = bflo(gaw[q]), a1 = bfhi(gaw[q]), b0 = fmaxf(bflo(gbw[q]), -80.f), b1 = fmaxf(bfhi(gbw[q]), -80.f);
                        const float r0 = (1.0f + __builtin_amdgcn_exp2f(-1.4426950408889634f * b0)) * sigmoidf_(a0);
                        const float r1 = (1.0f + __builtin_amdgcn_exp2f(-1.4426950408889634f * b1)) * sigmoidf_(a1);
                        acc[ai][bj][m][q >> 1][(q & 1) * 2] *= r0; acc[ai][bj][m][q >> 1][(q & 1) * 2 + 1] *= r1;
                    }
                    asm volatile("" : "+v"(acc[ai][bj][m][0]), "+v"(acc[ai][bj][m][1]) :: "memory");
                } }
    }
};
struct EpiUp2R {
    static constexpr bool PERM = true;
    unsigned char* ws;
    __device__ __forceinline__ void operator()(const f32x4 (&acc)[2][2][4][2], const pg8::Unit& u, int wr, int wc, int fr, int fq) const {
        const int row0 = u.pm * 256 + wr * 64 + fr, col0 = u.pn * 256 + wc * 32 + 8 * fq;
        const bf16_t* MAB = (const bf16_t*)(ws + WS_MAB); bf16_t* MG = (bf16_t*)(ws + WS_MERGED);
#pragma unroll
        for (int ai = 0; ai < 2; ++ai)
#pragma unroll
            for (int m = 0; m < 4; ++m) { const int row = row0 + ai * 128 + m * 16;
#pragma unroll
                for (int bj = 0; bj < 2; ++bj) {
                    const int col = col0 + bj * 128;
                    const u32x4 g = *(const u32x4*)(MAB + (size_t)row * 2048 + 1024 + col);
                    const f32x4 v0 = acc[ai][bj][m][0], v1 = acc[ai][bj][m][1];
                    u32x4 w;
                    w.x = pk2(v0[0] * sigmoidf_(fmaxf(bflo(g.x), -80.f)), v0[1] * sigmoidf_(fmaxf(bfhi(g.x), -80.f)));
                    w.y = pk2(v0[2] * sigmoidf_(fmaxf(bflo(g.y), -80.f)), v0[3] * sigmoidf_(fmaxf(bfhi(g.y), -80.f)));
                    w.z = pk2(v1[0] * sigmoidf_(fmaxf(bflo(g.z), -80.f)), v1[1] * sigmoidf_(fmaxf(bfhi(g.z), -80.f)));
                    w.w = pk2(v1[2] * sigmoidf_(fmaxf(bflo(g.w), -80.f)), v1[3] * sigmoidf_(fmaxf(bfhi(g.w), -80.f)));
                    *(u32x4*)(MG + (size_t)row * 1024 + col) = w;
                } }
    }
};
struct EpiUp2 {
    static constexpr bool PERM = true;
    unsigned char* ws;
    __device__ __forceinline__ void operator()(const f32x4 (&acc)[2][2][4][2], const pg8::Unit& u, int wr, int wc, int fr, int fq) const {
        const int row0 = u.pm * 256 + wr * 64 + fr, col0 = u.pn * 256 + wc * 32 + 8 * fq;
        const bf16_t* MAB = (const bf16_t*)(ws + WS_MAB); const float* TMP = (const float*)(ws + WS_TMP); bf16_t* MG = (bf16_t*)(ws + WS_MERGED);
#pragma unroll
        for (int ai = 0; ai < 2; ++ai)
#pragma unroll
            for (int m = 0; m < 4; ++m) { const int row = row0 + ai * 128 + m * 16;
#pragma unroll
                for (int bj = 0; bj < 2; ++bj) {
                    const int col = col0 + bj * 128;
                    const u32x4 g = *(const u32x4*)(MAB + (size_t)row * 2048 + 1024 + col);
                    const float* p = TMP + (size_t)row * 1024 + col;
                    const f32x4 t0 = *(const f32x4*)p, t1 = *(const f32x4*)(p + 4);
                    const f32x4 v0 = acc[ai][bj][m][0], v1 = acc[ai][bj][m][1];
                    u32x4 w;
                    w.x = pk2(t0[0] + v0[0] * sigmoidf_(bflo(g.x)), t0[1] + v0[1] * sigmoidf_(bfhi(g.x)));
                    w.y = pk2(t0[2] + v0[2] * sigmoidf_(bflo(g.y)), t0[3] + v0[3] * sigmoidf_(bfhi(g.y)));
                    w.z = pk2(t1[0] + v1[0] * sigmoidf_(bflo(g.z)), t1[1] + v1[1] * sigmoidf_(bfhi(g.z)));
                    w.w = pk2(t1[2] + v1[2] * sigmoidf_(bflo(g.w)), t1[3] + v1[3] * sigmoidf_(bfhi(g.w)));
                    *(u32x4*)(MG + (size_t)row * 1024 + col) = w;
                } }
    }
};
struct EpiOut {
    static constexpr bool PERM = false;
    const float* x; float* h;
    __device__ __forceinline__ void operator()(const f32x4 (&acc)[2][2][4][2], const pg8::Unit& u, int wr, int wc, int fr, int fq) const {
        const int row0 = u.pm * 256 + wr * 64 + fr, col0 = u.pn * 256 + wc * 32 + 4 * fq;
#pragma unroll
        for (int ai = 0; ai < 2; ++ai)
#pragma unroll
            for (int m = 0; m < 4; ++m) { const size_t off = (size_t)(row0 + ai * 128 + m * 16) * 1024 + col0;
#pragma unroll
                for (int bj = 0; bj < 2; ++bj)
#pragma unroll
                    for (int n = 0; n < 2; ++n) *(f32x4*)(h + off + bj * 128 + n * 16) = __builtin_nontemporal_load((const f32x4*)(x + off + bj * 128 + n * 16)) + acc[ai][bj][m][n]; }
    }
};

__device__ __forceinline__ void router_wave16(Frame& F, int t, bool commit) {
    const int lane = F.lane, fr = lane & 15, fq = lane >> 4, tok0 = t * 16;
    LAS float* PLw = (LAS float*)(F.lds + F.wave * 16384);
    LAS float* RSw = PLw + 16 * 49;
    const float* hb = (const float*)F.out; const float* wrt = (const float*)(F.ws + WS_WRT);
    f32x4 acc[3];
#pragma unroll
    for (int ct = 0; ct < 3; ++ct) acc[ct] = (f32x4){0.f, 0.f, 0.f, 0.f};
    float ssq = 0.f;
    const float* hp = hb + (size_t)(tok0 + fr) * DM + 4 * fq;
    const float* wp = wrt + (size_t)fr * DM + 4 * fq;
#pragma unroll 4
    for (int g = 0; g < 64; ++g) {
        const f32x4 xv = *(const f32x4*)(hp + 16 * g);
        ssq += (xv.x * xv.x + xv.y * xv.y) + (xv.z * xv.z + xv.w * xv.w);
#pragma unroll
        for (int ct = 0; ct < 3; ++ct) {
            const f32x4 wv = *(const f32x4*)(wp + ct * 16 * DM + 16 * g);
#pragma unroll
            for (int e = 0; e < 4; ++e) acc[ct] = __builtin_amdgcn_mfma_f32_16x16x4f32(wv[e], xv[e], acc[ct], 0, 0, 0);
        }
    }
    ssq += __shfl_xor(ssq, 16); ssq += __shfl_xor(ssq, 32);
    const float rstd = rsqrtf_(ssq * (1.f / DM) + EPS);
#pragma unroll
    for (int ct = 0; ct < 3; ++ct)
#pragma unroll
        for (int r = 0; r < 4; ++r) PLw[fr * 49 + ct * 16 + 4 * fq + r] = acc[ct][r] * rstd;
    if (fq == 0) RSw[fr] = rstd;
    asm volatile("s_waitcnt lgkmcnt(0)" ::: "memory");
    if (lane < 16) {
        const int m = tok0 + lane;
        const LAS float* p0 = PLw + lane * 49;
        float gl[4];
#pragma unroll
        for (int j = 0; j < 4; ++j) gl[j] = p0[j] + F.in[I_BGRP][j];
        int gi = 0; float gm = gl[0];
        if (gl[1] > gm) { gm = gl[1]; gi = 1; } if (gl[2] > gm) { gm = gl[2]; gi = 2; } if (gl[3] > gm) { gm = gl[3]; gi = 3; }
        const float gp = 1.0f / (__expf(gl[0] - gm) + __expf(gl[1] - gm) + __expf(gl[2] - gm) + __expf(gl[3] - gm));
        int i0 = 0, i1 = 0; float v0 = -3.0e38f, v1 = -3.0e38f;
#pragma unroll
        for (int i = 0; i < 8; ++i) {
            const float ev = p0[4 + gi * 8 + i] + F.in[I_BEXP][gi * 8 + i];
            if (ev > v0) { v1 = v0; i1 = i0; v0 = ev; i0 = i; } else if (ev > v1) { v1 = ev; i1 = i; }
        }
        const float w0 = gp / (1.0f + __expf(v1 - v0)), w1 = gp / (1.0f + __expf(v0 - v1));
        if (commit) {
            int* LTOK = (int*)(F.ws + WS_LTOK); int* LDST = (int*)(F.ws + WS_LDST); float* LW = (float*)(F.ws + WS_LW);
            unsigned* cnt = (unsigned*)(F.ws + WS_CTL) + CW_CNT;
            const int e0 = gi * 8 + i0, e1 = gi * 8 + i1;
            const unsigned q0 = __hip_atomic_fetch_add(cnt + e0, 1u, __ATOMIC_RELAXED, __HIP_MEMORY_SCOPE_AGENT);
            LTOK[e0 * 16384 + q0] = m; LDST[e0 * 16384 + q0] = 2 * m; LW[e0 * 16384 + q0] = w0;
            const unsigned q1 = __hip_atomic_fetch_add(cnt + e1, 1u, __ATOMIC_RELAXED, __HIP_MEMORY_SCOPE_AGENT);
            LTOK[e1 * 16384 + q1] = m; LDST[e1 * 16384 + q1] = 2 * m + 1; LW[e1 * 16384 + q1] = w1;
        }
    }
    f32x4 wn[4];
#pragma unroll
    for (int q = 0; q < 4; ++q) wn[q] = *(const f32x4*)(F.in[I_NFW] + 16 * lane + 4 * q);
#pragma unroll 2
    for (int j = 0; j < 16; ++j) {
        const float rs = RSw[j];
        const float* hr = hb + (size_t)(tok0 + j) * DM + 16 * lane;
        f32x4 a[4];
#pragma unroll
        for (int q = 0; q < 4; ++q) a[q] = *(const f32x4*)(hr + 4 * q);
        u32x4 o0, o1;
        o0.x = pk2(a[0].x * rs * wn[0].x, a[0].y * rs * wn[0].y); o0.y = pk2(a[0].z * rs * wn[0].z, a[0].w * rs * wn[0].w);
        o0.z = pk2(a[1].x * rs * wn[1].x, a[1].y * rs * wn[1].y); o0.w = pk2(a[1].z * rs * wn[1].z, a[1].w * rs * wn[1].w);
        o1.x = pk2(a[2].x * rs * wn[2].x, a[2].y * rs * wn[2].y); o1.y = pk2(a[2].z * rs * wn[2].z, a[2].w * rs * wn[2].w);
        o1.z = pk2(a[3].x * rs * wn[3].x, a[3].y * rs * wn[3].y); o1.w = pk2(a[3].z * rs * wn[3].z, a[3].w * rs * wn[3].w);
        bf16_t* xo = (bf16_t*)(F.ws + WS_XN) + (size_t)(tok0 + j) * DM + 16 * lane;
        *(u32x4*)xo = o0; *(u32x4*)(xo + 8) = o1;
    }
    asm volatile("s_waitcnt lgkmcnt(0)" ::: "memory");
}
constexpr int CW_CONV = 320;
__device__ __forceinline__ void p7_router(Frame& F, bool commit) {
    const int gw = F.vcu * NWAVES + F.wave, NGW = F.G * NWAVES;
    for (int t = F.vcu + F.G * F.wave; t < M / 16; t += F.G * NWAVES) router_wave16(F, t, commit);
    (void)gw; (void)NGW;
    LAS float* scr = (LAS float*)(F.lds + F.wave * 16384);
    constexpr int IG = 16 * 16, ID = 8 * 32, IPE = 2 * IG + ID;
    const float* wg = F.in[I_WGATE]; const float* wu = F.in[I_WUP]; const float* wdn = F.in[I_WDOWN]; unsigned char* ws = F.ws;
    auto dec = [=](int it) -> TrItem {
        const int e = it / IPE; int r = it % IPE; TrItem t;
        if (r < 2 * IG) { const int up = r >= IG; if (up) r -= IG; const int nb = r % 16, kb = r / 16, n0 = nb * 32;
            t.W = (up ? wu : wg) + (size_t)e * 1024 * 512; t.ldw = 512; t.col0 = n0; t.WT = (bf16_t*)(ws + WS_WGU) + (size_t)e * 1024 * 1024; t.K = 1024;
            t.row0 = (n0 >> 7) * 256 + (up ? 128 : 0) + (n0 & 127); t.k0 = kb * 64; return t; }
        r -= 2 * IG; const int nb = r % 32, kb = r / 32;
        t.W = wdn + (size_t)e * 512 * 1024; t.ldw = 1024; t.col0 = nb * 32; t.WT = (bf16_t*)(ws + WS_WD) + (size_t)e * 1024 * 512; t.K = 512; t.row0 = nb * 32; t.k0 = kb * 64; return t;
    };
    {
        const int NIT = NE * IPE, per = (NIT + F.G - 1) / F.G, base = F.vcu * per, lim = (base + per < NIT) ? base + per : NIT; const int lane = F.lane;
        volatile LAS unsigned* qc = F.MISC + 16;
        auto grab = [&]() -> int { unsigned v = 0; if (lane == 0) v = __hip_atomic_fetch_add((LAS unsigned*)qc, 1u, __ATOMIC_RELAXED, __HIP_MEMORY_SCOPE_WORKGROUP); return base + __builtin_amdgcn_readfirstlane((int)v); };
        f32x4 la[8], lb[8];
        int ia = grab(), ib;
        TrItem ta, tb;
        if (ia < lim) { ta = dec(ia); tr_load(ta, lane, la); }
        while (ia < lim) {
            ib = grab();
            if (ib < lim) { tb = dec(ib); tr_load(tb, lane, lb); }
            tr_store(ta, lane, la, scr);
            if (ib >= lim) break;
            ia = grab();
            if (ia < lim) { ta = dec(ia); tr_load(ta, lane, la); }
            tr_store(tb, lane, lb, scr);
        }
    }
}

constexpr int TOFF_OFF = MISC_OFF + 512;
constexpr int MYU_OFF = MISC_OFF + 768;
constexpr int CW_TILE = 8192;
struct MoeProb {
    const LAS int* toff; const unsigned* cnt; const int* ltok; unsigned* tilecnt;
    const bf16_t* A; const bf16_t* Bt; int K; int G, c; int total;
    __device__ __forceinline__ void unit_of(int L, pg8::Unit& u) const {
        const int tile = L >> 2; int e = 0;
#pragma unroll 1
        for (int s = 16; s > 0; s >>= 1) if (toff[e + s] <= tile) e += s;
        u.e = e; u.pm = tile - toff[e]; u.pn = L & 3; u.base = tile * 256;
        const int c_e = (int)cnt[e]; const int rem = c_e - u.pm * 256; u.rows = rem < 256 ? rem : 256;
    }
    __device__ __forceinline__ bool next(int i, pg8::Unit& u) const { const int L = i * G + c; if (L >= total) return false; unit_of(L, u); return true; }
    __device__ __forceinline__ int a_row(const pg8::Unit& u, int r) const { return ltok[u.e * 16384 + u.pm * 256 + (r < u.rows ? r : 0)]; }
    __device__ __forceinline__ const char* a_ptr(const pg8::Unit& u) const { return (const char*)A; }
    __device__ __forceinline__ const char* a_ptr_rows(const pg8::Unit& u) const { return (const char*)A + (size_t)u.base * K * 2; }
    __device__ __forceinline__ const char* b_ptr(const pg8::Unit& u) const { return (const char*)Bt + ((size_t)u.e * 1024 + u.pn * 256) * K * 2; }
    __device__ __forceinline__ void a_ready(const pg8::Unit&) const {}
    __device__ __forceinline__ void done(const pg8::Unit& u) const {
        asm volatile("s_waitcnt vmcnt(0)" ::: "memory");
        if ((threadIdx.x & 63) == 0) __hip_atomic_fetch_add(tilecnt + 64 * (u.base >> 8), 1u, __ATOMIC_RELAXED, __HIP_MEMORY_SCOPE_AGENT);
    }
};
struct MoeProbD : MoeProb {
    const LAS int* myu;
    __device__ __forceinline__ const char* a_ptr(const pg8::Unit& u) const { return a_ptr_rows(u); }
    __device__ __forceinline__ bool next(int i, pg8::Unit& u) const { if (i >= myu[0]) return false; unit_of(myu[1 + i], u); return true; }
    __device__ __forceinline__ void done(const pg8::Unit&) const {}
    __device__ __forceinline__ void a_ready(const pg8::Unit& u) const {
        if (threadIdx.x < 64) {
            const unsigned* w = tilecnt + 64 * (u.base >> 8); unsigned polls = 0;
            while ((unsigned)__builtin_amdgcn_readfirstlane(__hip_atomic_load(w, __ATOMIC_RELAXED, __HIP_MEMORY_SCOPE_AGENT)) < 32u) {
                __builtin_amdgcn_s_sleep(2);
                if (++polls > (1u << 20)) break;
            }
            __builtin_amdgcn_fence(__ATOMIC_ACQUIRE, "agent");
            asm volatile("s_waitcnt vmcnt(0)" ::: "memory");
        }
        asm volatile("" ::: "memory"); __builtin_amdgcn_s_barrier(); asm volatile("" ::: "memory");
    }
};
struct EpiGU {
    static constexpr bool PERM = true;
    bf16_t* hid;
    __device__ __forceinline__ void operator()(const f32x4 (&acc)[2][2][4][2], const pg8::Unit& u, int wr, int wc, int fr, int fq) const {
        const int col0 = u.pn * 128 + wc * 32 + 8 * fq;
#pragma unroll
        for (int ai = 0; ai < 2; ++ai)
#pragma unroll
            for (int m = 0; m < 4; ++m) { const int r = ai * 128 + wr * 64 + m * 16 + fr;
                const f32x4 g0 = acc[ai][0][m][0], g1 = acc[ai][0][m][1], u0 = acc[ai][1][m][0], u1 = acc[ai][1][m][1];
                u32x4 w;
                w.x = pk2(siluf_(g0[0]) * u0[0], siluf_(g0[1]) * u0[1]); w.y = pk2(siluf_(g0[2]) * u0[2], siluf_(g0[3]) * u0[3]);
                w.z = pk2(siluf_(g1[0]) * u1[0], siluf_(g1[1]) * u1[1]); w.w = pk2(siluf_(g1[2]) * u1[2], siluf_(g1[3]) * u1[3]);
                { bf16_t* p = hid + (size_t)(u.base + r) * 512 + col0; asm volatile("global_store_dwordx4 %0, %1, off sc1\n\ts_nop 1" :: "v"(p), "v"(w) : "memory"); } }
    }
};
struct EpiDown {
    static constexpr bool PERM = true;
    bf16_t* y2; const int* ldst; const float* lw;
    __device__ __forceinline__ void operator()(const f32x4 (&acc)[2][2][4][2], const pg8::Unit& u, int wr, int wc, int fr, int fq) const {
        const int col0 = u.pn * 256 + wc * 32 + 8 * fq;
#pragma unroll
        for (int ai = 0; ai < 2; ++ai)
#pragma unroll
            for (int m = 0; m < 4; ++m) { const int r = ai * 128 + wr * 64 + m * 16 + fr;
                if (r < u.rows) {
                    const int li = u.e * 16384 + u.pm * 256 + r; const int dst = ldst[li]; const float cw = lw[li];
#pragma unroll
                    for (int bj = 0; bj < 2; ++bj) { const f32x4 v0 = acc[ai][bj][m][0] * cw, v1 = acc[ai][bj][m][1] * cw;
                        u32x4 w; w.x = pk2(v0[0], v0[1]); w.y = pk2(v0[2], v0[3]); w.z = pk2(v1[0], v1[1]); w.w = pk2(v1[2], v1[3]);
                        *(u32x4*)(y2 + (size_t)dst * 1024 + col0 + bj * 128) = w; }
                } }
    }
};
__device__ __forceinline__ void moe_toff(Frame& F) {
    LAS int* toff = (LAS int*)(F.lds + TOFF_OFF);
    __syncthreads();
    if (F.tid == 0) { const unsigned* cnt = (const unsigned*)(F.ws + WS_CTL) + CW_CNT; int a = 0;
        for (int e = 0; e < NE; ++e) { toff[e] = a; a += ((int)cnt[e] + 255) >> 8; } toff[NE] = a; }
    __syncthreads();
}

__device__ __forceinline__ void moe_down_list(Frame& F, int U, int c) {
    LAS int* myu = (LAS int*)(F.lds + MYU_OFF);
    if (F.tid == 0) {
        const int G = F.G, A = U % G, k = U / G;
        int tH = 5 * (k + 1), tL = 5 * k, rem = U, j0 = 0, n = 0;
        while (rem > 0 && n < 30) {
            const bool heavy = (A > 0) && (tH < tL);
            const int gsz = heavy ? A : (G - A), rank = heavy ? c : (c - A);
            const int cntr = rem < gsz ? rem : gsz;
            if ((heavy ? (c < A) : (c >= A)) && rank < cntr) { myu[1 + n] = j0 + rank; ++n; }
            if (heavy) tH += 3; else tL += 3;
            j0 += cntr; rem -= cntr;
        }
        myu[0] = n;
    }
    __syncthreads();
}

struct FinPre { f32x4 h[4]; u32x2 a[4], b[4]; };
__device__ __forceinline__ void final_fetch(Frame& F, int m, FinPre& P) {
    const int lane = F.lane;
    const float* hr = F.out + (size_t)m * DM;
    const bf16_t* y0 = (const bf16_t*)(F.ws + WS_Y2) + (size_t)(2 * m) * DM; const bf16_t* y1 = y0 + DM;
#pragma unroll
    for (int j = 0; j < 4; ++j) {
        P.h[j] = __builtin_nontemporal_load((const f32x4*)(hr + 4 * lane + 256 * j));
        P.a[j] = __builtin_nontemporal_load((const u32x2*)(y0 + 4 * lane + 256 * j)); P.b[j] = __builtin_nontemporal_load((const u32x2*)(y1 + 4 * lane + 256 * j));
    }
}
__device__ __forceinline__ void final_row(Frame& F, int m, float* dstbase, const FinPre& P) {
    const int lane = F.lane;
    f32x4 v[4]; float s = 0.f;
#pragma unroll
    for (int j = 0; j < 4; ++j) {
        v[j] = P.h[j];
        const u32x2 a = P.a[j], b = P.b[j];
        v[j][0] += bflo(a.x) + bflo(b.x); v[j][1] += bfhi(a.x) + bfhi(b.x); v[j][2] += bflo(a.y) + bflo(b.y); v[j][3] += bfhi(a.y) + bfhi(b.y);
        s += (v[j].x * v[j].x + v[j].y * v[j].y) + (v[j].z * v[j].z + v[j].w * v[j].w);
    }
    const float rstd = 1.0f / sqrtf(wave_sum(s) * (1.f / DM) + EPS);
#pragma unroll
    for (int j = 0; j < 4; ++j) { const f32x4 w = *(const f32x4*)(F.in[I_NFINW] + 4 * lane + 256 * j); __builtin_nontemporal_store(v[j] * rstd * w, (f32x4*)(dstbase + (size_t)m * DM + 4 * lane + 256 * j)); }
}

__device__ __forceinline__ void ph1_body(Frame& F) {
    pg8::Dense P; P.init((const bf16_t*)(F.ws + WS_U), (const bf16_t*)(F.ws + WS_WINT), M, NP, DM, F.G, (int)blockIdx.x);
    EpiProj E{F.ws};
    pg8::gemm_phase<EpiProj, pg8::Dense, false, true, true>(F.lds, P, E);
}
__device__ __forceinline__ void ph5_body(Frame& F) {
    if (F.G * 1 >= (M / 256) * (DM / 256)) {
        f32x4 xacc[2][2][4][2];
        { pg8::Dense P; P.init((const bf16_t*)(F.ws + WS_YA), (const bf16_t*)(F.ws + WS_WUPA), M, DM, 512, F.G, (int)blockIdx.x);
          EpiUp1R E{F.ws}; pg8::gemm_phase<EpiUp1R, pg8::Dense, false, false, true, 1>(F.lds, P, E, xacc); }
        { pg8::Dense P; P.init((const bf16_t*)(F.ws + WS_YB), (const bf16_t*)(F.ws + WS_WUPR), M, DM, 1024, F.G, (int)blockIdx.x);
          EpiUp2R E{F.ws}; pg8::gemm_phase<EpiUp2R, pg8::Dense, false, false, true, 2>(F.lds, P, E, xacc); }
    } else {
        { pg8::Dense P; P.init((const bf16_t*)(F.ws + WS_YA), (const bf16_t*)(F.ws + WS_WUPA), M, DM, 512, F.G, (int)blockIdx.x);
          EpiUp1 E{F.ws}; pg8::gemm_phase<EpiUp1, pg8::Dense, false, false, true>(F.lds, P, E); }
        { pg8::Dense P; P.init((const bf16_t*)(F.ws + WS_YB), (const bf16_t*)(F.ws + WS_WUPR), M, DM, 1024, F.G, (int)blockIdx.x);
          EpiUp2 E{F.ws}; pg8::gemm_phase<EpiUp2, pg8::Dense, false, false, true>(F.lds, P, E); }
    }
}

struct Args { const float* in[19]; float* out; unsigned char* ws; int ph_lo, ph_hi; };
__global__ void __launch_bounds__(NTHR, 2) hgrh_fwd(Args args) {
    extern __shared__ __attribute__((aligned(16))) unsigned char lds_raw[];
    Frame F;
    F.lds = (LAS unsigned char*)lds_raw;
    F.MISC = (volatile LAS unsigned*)(F.lds + MISC_OFF);
    F.tid = threadIdx.x; F.lane = F.tid & 63; F.wave = __builtin_amdgcn_readfirstlane(F.tid >> 6);
    F.G = gridDim.x; { const int bx = blockIdx.x; F.vcu = (F.G % 8 == 0) ? (bx % 8) * (F.G / 8) + bx / 8 : bx; }
#pragma unroll
    for (int i = 0; i < 19; ++i) F.in[i] = args.in[i];
    F.out = args.out; F.ws = args.ws;
    F.ctl = (GAS unsigned*)(args.ws + WS_CTL);
    for (int u = F.tid; u < (LDS_BYTES - MISC_OFF) / 4; u += NTHR) ((LAS unsigned*)(F.lds + MISC_OFF))[u] = 0u;
    __syncthreads();
    const int lo = args.ph_lo, hi = args.ph_hi;
    XcdBarrier bar; bar.bar = (unsigned*)(args.ws + WS_CTL) + CW_BAR; bar.x = 0; bar.st = nullptr;
    if (hi - lo > 1) bar = xcd_barrier_post((unsigned*)(args.ws + WS_CTL) + CW_BAR, F.MISC + 8);
#ifndef PH_MASK
#define PH_MASK 0xFFFF
#endif
#define IN(k) (((PH_MASK >> (k)) & 1) && lo <= (k) && (k) < hi)
#define SEAM(k) do { if (IN(k) && IN((k) + 1)) { xcd_barrier(bar); if (REPS(13) == 2) xcd_barrier(bar); } } while (0)
    const int gw = F.vcu * NWAVES + F.wave, NGW = F.G * NWAVES;

    if (IN(0)) { for (int rep = 0; rep < REPS(0); ++rep) p0_prologue(F); }
    SEAM(0);
    if (IN(1)) {
        ph1_body(F);
        if (REPS(1) == 2) ph1_body(F);
    }
    SEAM(1);
    if (IN(2)) {
        u32x4 pxw[2][7]; float pg = 0.f, pb = 0.f;
        for (int rep = 0; rep < REPS(2); ++rep) {
#ifdef PREP_PROBE
        if (F.vcu < 1024) gdn_prep_fetch(F, F.vcu, pxw, pg, pb);
        for (int it = F.vcu; it < 1024; it += F.G) gdn_prep_item<PREP_PROBE>(F, it, it + F.G < 1024 ? it + F.G : -1, pxw, pg, pb);
#endif
        if (F.vcu < 1024) gdn_prep_fetch(F, F.vcu, pxw, pg, pb);
        for (int it = F.vcu; it < 1024; it += F.G) gdn_prep_item<0>(F, it, it + F.G < 1024 ? it + F.G : -1, pxw, pg, pb);
        for (int it = F.vcu; it < 512; it += F.G) ret_kv_item(F, it);
        }
        if (REPS(11) == 2) { if (F.vcu < 1024) gdn_prep_fetch(F, F.vcu, pxw, pg, pb); for (int it = F.vcu; it < 1024; it += F.G) gdn_prep_item<0>(F, it, it + F.G < 1024 ? it + F.G : -1, pxw, pg, pb); }
        if (REPS(12) == 2) for (int it = F.vcu + 1024; it < 1024 + 512; it += F.G) ret_kv_item(F, it - 1024);
    }
    SEAM(2);
    if (IN(3)) {
        if (F.vcu < 64) {
#ifdef SCAN_PROBE
            gdn_scan_block<SCAN_PROBE>(F, F.vcu);
#endif
            for (int rep = 0; rep < REPS(3); ++rep) gdn_scan_block<0>(F, F.vcu); }
        else {
            const int NB = F.G - 64, ob = F.vcu - 64;
            for (int t = ob * NWAVES + F.wave; t < 2048; t += NB * NWAVES) ret_prefix_task(F, t);
            asm volatile("s_waitcnt vmcnt(0)" ::: "memory");
            __syncthreads();
            if (F.tid == 0) {
                unsigned* pc = (unsigned*)(F.ws + WS_CTL) + CW_PFX;
                __builtin_amdgcn_fence(__ATOMIC_RELEASE, "agent");
                asm volatile("s_waitcnt vmcnt(0)" ::: "memory");
                xb_add(pc, 1u);
                unsigned sp = 0;
                while (xb_ld(pc) < (unsigned)NB) { __builtin_amdgcn_s_sleep(2); if (++sp > (1u << 22)) break; }
                __builtin_amdgcn_fence(__ATOMIC_ACQUIRE, "agent");
                asm volatile("s_waitcnt vmcnt(0)" ::: "memory");
            }
            __syncthreads();
            for (int rep = 0; rep < REPS(4); ++rep) {
                RetPre RP;
                ret_out_fetch(F, ob < 512 ? ob : 0, RP);
                for (int it = ob; it < 512; it += NB) ret_out_item(F, it, it + NB < 512 ? it + NB : -1, RP);
            }
        }
    }
    SEAM(3);
    if (IN(4)) {
        for (int rep = 0; rep < REPS(14); ++rep)
        for (int m = gw; m < M; m += NGW) gdn_normgate_row(F, m);
    }
    SEAM(4);
    if (IN(5)) {
        ph5_body(F);
        if (REPS(5) == 2) ph5_body(F);
    }
    SEAM(5);
    if (IN(6)) {
        for (int rep = 0; rep < REPS(6); ++rep) {
        pg8::Dense P; P.init((const bf16_t*)(F.ws + WS_MERGED), (const bf16_t*)(F.ws + WS_WOUT), M, DM, DM, F.G, (int)blockIdx.x);
        EpiOut E{F.in[I_X], F.out}; pg8::gemm_phase<EpiOut, pg8::Dense, false, false, true>(F.lds, P, E);
        }
    }
    SEAM(6);
    if (IN(7)) { for (int rep = 0; rep < REPS(7); ++rep) { __syncthreads(); if (F.tid == 0) F.MISC[16] = 0u; __syncthreads(); p7_router(F, rep == REPS(7) - 1); } }
    SEAM(7);
    if (IN(8)) {
        moe_toff(F);
        MoeProb P; P.toff = (const LAS int*)(F.lds + TOFF_OFF); P.cnt = (const unsigned*)(F.ws + WS_CTL) + CW_CNT; P.ltok = (const int*)(F.ws + WS_LTOK); P.tilecnt = (unsigned*)(F.ws + WS_CTL) + CW_TILE;
        P.A = (const bf16_t*)(F.ws + WS_XN); P.Bt = (const bf16_t*)(F.ws + WS_WGU); P.K = 1024; P.G = F.G; P.c = F.vcu; P.total = 4 * P.toff[NE];
        moe_down_list(F, P.total, F.vcu);
        EpiGU E{(bf16_t*)(F.ws + WS_HID)};
        pg8::gemm_phase<EpiGU, MoeProb, true, true, true>(F.lds, P, E);
        MoeProbD Q; Q.toff = P.toff; Q.cnt = P.cnt; Q.ltok = P.ltok; Q.tilecnt = P.tilecnt; Q.myu = (const LAS int*)(F.lds + MYU_OFF);
        Q.A = (const bf16_t*)(F.ws + WS_HID); Q.Bt = (const bf16_t*)(F.ws + WS_WD); Q.K = 512; Q.G = F.G; Q.c = F.vcu; Q.total = P.total;
        EpiDown E2{(bf16_t*)(F.ws + WS_Y2), (const int*)(F.ws + WS_LDST), (const float*)(F.ws + WS_LW)};
        pg8::gemm_phase<EpiDown, MoeProbD, false, true, true>(F.lds, Q, E2);
    }
    SEAM(8);
    if (IN(10)) { for (int rep = 0; rep < REPS(10); ++rep) { float* dst = (rep == REPS(10) - 1) ? F.out : (float*)(F.ws + WS_MAB); FinPre fa, fb; final_fetch(F, gw < M ? gw : 0, fa); for (int m = gw; m < M; m += 2 * NGW) { const int m1 = m + NGW, m2 = m + 2 * NGW; if (m1 < M) final_fetch(F, m1, fb); final_row(F, m, dst, fa); if (m2 < M) final_fetch(F, m2, fa); if (m1 < M) final_row(F, m1, dst, fb); } } }
#undef IN
#undef SEAM
}

extern "C" void kernel_launch(void* const* d_in, const int* in_sizes, int n_in, void* d_out, int out_size, void* d_ws, size_t ws_size, hipStream_t stream) {
    static int grid = 0;
    if (grid == 0) {
        if (n_in != 19 || in_sizes[0] != M * DM || out_size != M * DM || ws_size < WS_END) {
            fprintf(stderr, "kernel_launch: unexpected problem (n_in %d, in0 %d, out %d, ws %zu < %zu); nothing launched\n", n_in, n_in > 0 ? in_sizes[0] : -1, out_size, ws_size, (size_t)WS_END); grid = -1; return; }
        int dev = 0, cus = 0;
        if (hipGetDevice(&dev) != hipSuccess || hipDeviceGetAttribute(&cus, hipDeviceAttributeMultiprocessorCount, dev) != hipSuccess) { grid = -1; return; }
        if (hipFuncSetAttribute((const void*)hgrh_fwd, hipFuncAttributeMaxDynamicSharedMemorySize, LDS_BYTES) != hipSuccess) { fprintf(stderr, "kernel_launch: hipFuncSetAttribute failed\n"); grid = -1; return; }
        int per_cu = 0;
        if (hipOccupancyMaxActiveBlocksPerMultiprocessor(&per_cu, (const void*)hgrh_fwd, NTHR, LDS_BYTES) != hipSuccess || per_cu < 1)
            fprintf(stderr, "kernel_launch: occupancy query reports %d workgroups per CU\n", per_cu);
        (void)hipGetLastError();
        grid = cus;
    }
    if (grid < 0) return;
    (void)hipMemsetAsync((char*)d_ws + WS_CTL, 0, CTL_ZERO_BYTES, stream);
    Args a{};
    for (int i = 0; i < 19; ++i) a.in[i] = (const float*)d_in[i];
    a.out = (float*)d_out; a.ws = (unsigned char*)d_ws;
#if MK_N_LAUNCHES == 1
    a.ph_lo = 0; a.ph_hi = NPH;
    hipLaunchKernelGGL(hgrh_fwd, dim3(grid), dim3(NTHR), LDS_BYTES, stream, a);
#else
    for (int p = 0; p < NPH; ++p) { a.ph_lo = p; a.ph_hi = p + 1; hipLaunchKernelGGL(hgrh_fwd, dim3(grid), dim3(NTHR), LDS_BYTES, stream, a); }
#endif
}
```

```cpp
#include <hip/hip_runtime.h>
#include <cstdio>
#include <cstdint>

#ifndef MK_N_LAUNCHES
#define MK_N_LAUNCHES 1
#endif

#ifndef REP_MASK
#define REP_MASK 0
#endif
#define REPS(k) (((REP_MASK >> (k)) & 1) ? 2 : 1)
#define LAS __attribute__((address_space(3)))
#define GAS __attribute__((address_space(1)))
typedef unsigned short bf16_t;
typedef short bf16x8 __attribute__((ext_vector_type(8)));
typedef short bf16x4 __attribute__((ext_vector_type(4)));
typedef float f32x4 __attribute__((ext_vector_type(4)));
typedef float f32x2 __attribute__((ext_vector_type(2)));
typedef unsigned u32x4 __attribute__((ext_vector_type(4)));
typedef unsigned u32x2 __attribute__((ext_vector_type(2)));

constexpr int BATCH = 8, SEQ = 2048, DM = 1024, M = BATCH * SEQ;
constexpr int D_IN = 7176, NP = 7168;
constexpr int NE = 32, DE = 512;
constexpr float EPS = 1e-6f;
constexpr int NWAVES = 8, NTHR = 512;
constexpr int NPH = 11;

constexpr size_t MiB = 1u << 20;
constexpr size_t WS_CTL = 0, CTL_ZERO_BYTES = 128 * 1024;
constexpr size_t WS_LTOK = 1 * MiB, WS_LDST = 3 * MiB, WS_LW = 5 * MiB;
constexpr size_t WS_ROPE = 7 * MiB;
constexpr size_t WS_G = 8 * MiB, WS_BETA = 8 * MiB + 256 * 1024;
constexpr size_t WS_WUPA = 9 * MiB, WS_WUPR = 10 * MiB, WS_WOUT = 12 * MiB;
constexpr size_t WS_WRT = 14 * MiB;
constexpr size_t WS_SSQ = 15 * MiB;
constexpr size_t WS_GQKV = 18 * MiB;
constexpr size_t WS_OGDN = 18 * MiB;
constexpr size_t WS_YB = 34 * MiB;
constexpr size_t WS_YA = 274 * MiB;
constexpr size_t WS_XN = 18 * MiB;
constexpr size_t WS_Y2 = 218 * MiB;
constexpr size_t WS_GZ = 66 * MiB;
constexpr size_t WS_RQK = 82 * MiB;
constexpr size_t WS_RV = 114 * MiB;
constexpr size_t WS_TMP = 82 * MiB;
constexpr size_t WS_WGU = 82 * MiB;
constexpr size_t WS_RG = 146 * MiB;
constexpr size_t WS_WD = 146 * MiB;
constexpr size_t WS_MAB = 178 * MiB;
constexpr size_t WS_HID = 178 * MiB;
constexpr size_t WS_U = 242 * MiB;
constexpr size_t WS_KV = 242 * MiB;
constexpr size_t WS_MERGED = 242 * MiB;
constexpr size_t WS_WINT = 274 * MiB;
constexpr size_t WS_UT = 274 * MiB;
constexpr size_t WS_END = 290 * MiB;
constexpr size_t GP_BYTES = 57344;
constexpr int GP_W = 0, GP_Q = 8192, GP_K = 16384, GP_A = 24576;
constexpr size_t DO_YA = 0, DO_YB = 16 * MiB;

constexpr int CW_TMO = 0;
constexpr int CW_CNT = 64;
constexpr int CW_PFX = 256;
constexpr int CW_BAR = 4096;

constexpr int RING_BYTES = 131072;
constexpr int MISC_OFF = RING_BYTES;
constexpr int LDS_BYTES = 147456;

#define LDS_WAIT() asm volatile("s_waitcnt lgkmcnt(0)" ::: "memory")
#define VM_WAIT() asm volatile("s_waitcnt vmcnt(0)" ::: "memory")
#define LBAR() do { asm volatile("s_waitcnt lgkmcnt(0)" ::: "memory"); __builtin_amdgcn_s_barrier(); asm volatile("" ::: "memory"); } while (0)
__device__ __forceinline__ unsigned f2bf(float f) { unsigned u = __builtin_bit_cast(unsigned, f); return (u + 0x7fffu + ((u >> 16) & 1u)) >> 16; }
typedef __bf16 bf16v2_t __attribute__((ext_vector_type(2)));
__device__ __forceinline__ unsigned pk2(float lo, float hi) { return __builtin_bit_cast(unsigned, __builtin_convertvector((f32x2){lo, hi}, bf16v2_t)); }
__device__ __forceinline__ float bf2f(unsigned short h) { return __builtin_bit_cast(float, (unsigned)h << 16); }
__device__ __forceinline__ float bflo(unsigned w) { return __builtin_bit_cast(float, w << 16); }
__device__ __forceinline__ float bfhi(unsigned w) { return __builtin_bit_cast(float, w & 0xffff0000u); }
template <int CTRL> __device__ __forceinline__ float dpp_f(float v) { return __builtin_bit_cast(float, __builtin_amdgcn_update_dpp(0, __builtin_bit_cast(int, v), CTRL, 0xf, 0xf, true)); }
__device__ __forceinline__ float row16_sum(float v) {
    v += dpp_f<0xB1>(v);
    v += dpp_f<0x4E>(v);
    v += dpp_f<0x141>(v);
    v += dpp_f<0x140>(v);
    return v;
}
__device__ __forceinline__ float rdlane(float v, int l) { return __builtin_bit_cast(float, __builtin_amdgcn_readlane(__builtin_bit_cast(int, v), l)); }
__device__ __forceinline__ float wave_sum(float v) {
    v = row16_sum(v);
    return (rdlane(v, 0) + rdlane(v, 16)) + (rdlane(v, 32) + rdlane(v, 48));
}
__device__ __forceinline__ float sigmoidf_(float x) { return __builtin_amdgcn_rcpf(1.0f + __builtin_amdgcn_exp2f(-1.4426950408889634f * x)); }
__device__ __forceinline__ float siluf_(float x) { return x * sigmoidf_(x); }
__device__ __forceinline__ float rsqrtf_(float x) { return __builtin_amdgcn_rsqf(x); }

#define XB_TMO      128
#define XB_XCNT(j)  (256  + 64 * (j))
#define XB_XSUB(j)  (1280 + 64 * (j))
#define XB_XGEN(j)  (2304 + 64 * (j))
#define XB_TOP      3328
#define XB_TOPGEN   3392
#define XCD_BAR_WORDS 3456
#define XB_SPIN_CAP (1u << 18)
__device__ __forceinline__ unsigned xb_ld(unsigned* p)              { return __hip_atomic_load(p, __ATOMIC_RELAXED, __HIP_MEMORY_SCOPE_AGENT); }
__device__ __forceinline__ unsigned xb_add(unsigned* p, unsigned v) { return __hip_atomic_fetch_add(p, v, __ATOMIC_RELAXED, __HIP_MEMORY_SCOPE_AGENT); }
__device__ __forceinline__ unsigned xb_xcc_id() { return (unsigned)__builtin_amdgcn_s_getreg((3 << 11) | 20) & 0xFu; }
#define XB_SPIN(cond, bar) do { unsigned _sp = 0; while (cond) { __builtin_amdgcn_s_sleep(1); \
    if ((++_sp & 255u) == 0u) { if (xb_ld(&(bar)[XB_TMO])) break; if (_sp > XB_SPIN_CAP) { atomicAdd(&(bar)[XB_TMO], 1u); break; } } } } while (0)
struct XcdBarrier { unsigned* bar; unsigned x; volatile LAS unsigned* st; };
__device__ __forceinline__ XcdBarrier xcd_barrier_post(unsigned* bar, volatile LAS unsigned* st) {
    XcdBarrier b; b.bar = bar; b.x = xb_xcc_id(); b.st = st;
    if (threadIdx.x == 0) (void)xb_add(&bar[XB_XCNT(b.x)], 1u);
    return b;
}
__device__ __forceinline__ void xcd_barrier_complete(unsigned* bar, unsigned x, unsigned& nloc, unsigned& nx) {
    const unsigned G = gridDim.x * gridDim.y * gridDim.z;
    unsigned sum, cnt, mine, sp = 0u;
    for (;;) {
        sum = 0u; cnt = 0u; mine = 0u;
#pragma unroll
        for (unsigned j = 0; j < 16; ++j) { const unsigned c = xb_ld(&bar[XB_XCNT(j)]); sum += c; cnt += (c > 0u) ? 1u : 0u; mine = (j == x) ? c : mine; }
        if (sum == G) break;
        __builtin_amdgcn_s_sleep(1);
        if ((++sp & 255u) == 0u) { if (xb_ld(&bar[XB_TMO])) break; if (sp > XB_SPIN_CAP) { atomicAdd(&bar[XB_TMO], 1u); break; } }
    }
    nloc = mine > 0u ? mine : 1u; nx = cnt > 0u ? cnt : 1u;
}
__device__ __forceinline__ void xcd_barrier(const XcdBarrier& b) {
    asm volatile("s_waitcnt vmcnt(0)" ::: "memory");
    __syncthreads();
    if (threadIdx.x == 0) {
        unsigned* bar = b.bar;
        __builtin_amdgcn_s_waitcnt(0);
        unsigned nloc = b.st[0], nx = b.st[1];
        if (nloc == 0u) { xcd_barrier_complete(bar, b.x, nloc, nx); b.st[0] = nloc; b.st[1] = nx; }
        const unsigned old = xb_add(&bar[XB_XSUB(b.x)], 1u);
        const unsigned gen = old / nloc;
        if (old + 1u == (gen + 1u) * nloc) {
            __builtin_amdgcn_fence(__ATOMIC_RELEASE, "agent");
            asm volatile("s_waitcnt vmcnt(0)" ::: "memory");
            const unsigned og = xb_add(&bar[XB_TOP], 1u);
            const unsigned tg = og / nx;
            if (og + 1u == (tg + 1u) * nx) xb_add(&bar[XB_TOPGEN], 1u);
            else XB_SPIN(xb_ld(&bar[XB_TOPGEN]) == tg, bar);
            __builtin_amdgcn_fence(__ATOMIC_ACQUIRE, "agent");
            xb_add(&bar[XB_XGEN(b.x)], 1u);
            asm volatile("s_waitcnt vmcnt(0)" ::: "memory");
        } else {
            XB_SPIN(xb_ld(&bar[XB_XGEN(b.x)]) == gen, bar);
            __builtin_amdgcn_fence(__ATOMIC_ACQUIRE, "agent");
            asm volatile("s_waitcnt vmcnt(0)" ::: "memory");
        }
    }
    __syncthreads();
}

namespace pg8 {
constexpr int BM = 256, BK = 64, HALF = 128, HTB = HALF * BK * 2, STAGE_BYTES = 8 * HTB, NXCD = 8, WGM = 8;
__host__ __device__ __forceinline__ int lds_byte(int r, int c) { const int st = (r >> 4) * 2 + (c >> 5), rr = r & 15, cc = c & 31, ob = rr * 64 + cc * 2; return st * 1024 + (ob ^ (((ob >> 9) & 1) << 5)); }
__host__ __device__ __forceinline__ void stage_rc(int b, int& R, int& C) { const int st = b / 1024, sb = b % 1024, swz = sb ^ (((sb >> 9) & 1) << 5); R = (st >> 1) * 16 + swz / 64; C = (st & 1) * 32 + (swz % 64) / 2; }
__host__ __device__ __forceinline__ int perm32(int rho) { const int n = rho >> 4, i = rho & 15; return 8 * (i >> 2) + 4 * n + (i & 3); }

struct Unit { int pm, pn, e, rows, base; };

__device__ __forceinline__ unsigned cvt_pk_bf16(float lo, float hi) { return pk2(lo, hi); }

struct Dense {
    const bf16_t* A; const bf16_t* Bt; int K; int nM, nN, nwg, G, c;
    __device__ void init(const bf16_t* A_, const bf16_t* Bt_, int M_, int N_, int K_, int G_, int c_) { A = A_; Bt = Bt_; K = K_; nM = M_ / BM; nN = N_ / BM; nwg = nM * nN; G = G_; c = c_; }
    __device__ __forceinline__ bool next(int i, Unit& u) const {
        const long L = (long)i * G + c; if (L >= nwg) return false;
        int wgid = (int)L; { const int q = nwg / NXCD, r = nwg % NXCD, xcd = wgid % NXCD, off = wgid / NXCD; wgid = (xcd < r ? xcd * (q + 1) : r * (q + 1) + (xcd - r) * q) + off; }
        const int nig = WGM * nN, gid = wgid / nig, fm = gid * WGM, gsz = (nM - fm) < WGM ? (nM - fm) : WGM;
        u.pm = fm + ((wgid % nig) % gsz); u.pn = (wgid % nig) / gsz; u.e = 0; u.rows = 256; u.base = 0; return true;
    }
    __device__ __forceinline__ const char* a_ptr(const Unit& u) const { return (const char*)A + (size_t)u.pm * (size_t)(2 * HALF) * K * 2; }
    __device__ __forceinline__ const char* b_ptr(const Unit& u) const { return (const char*)Bt + (size_t)u.pn * (size_t)(2 * HALF) * K * 2; }
    __device__ __forceinline__ void a_ready(const Unit&) const {}
    __device__ __forceinline__ void done(const Unit&) const {}
};

template <class Epi, class Prob, bool GATHER, bool ALIGN_EPI, bool SP2, int ACCMODE = 0>
__device__ __forceinline__ void gemm_phase(LAS unsigned char* lds, const Prob& S, const Epi& E, f32x4 (*xacc)[2][4][2] = nullptr) {
    const int tid = threadIdx.x, wid = __builtin_amdgcn_readfirstlane(tid >> 6), lane = tid & 63, wr = wid >> 2, wc = wid & 3, fr = lane & 15, fq = lane >> 4;
    const int K = S.K, nt = K / BK;
    unsigned voffB[2]; int RA[2], CA[2];
    unsigned cvo[2][2], nvo[2][2];
#pragma unroll
    for (int i = 0; i < 2; ++i) { int R, C; stage_rc(tid * 16 + i * 8192, R, C); const int Rb = Epi::PERM ? ((R & ~31) + perm32(R & 31)) : R;
        RA[i] = R; CA[i] = C; voffB[i] = (unsigned)(Rb * K + C) * 2u; }
    const size_t kstep = (size_t)(BK * 2);
    const size_t hstep = (size_t)HALF * K * 2;
    const unsigned ldsw = (unsigned)wid * 1024u;
    const int aoff = lds_byte(wr * 64 + fr, fq * 8), boff = lds_byte(wc * 32 + fr, fq * 8);
#define PG8_SA(b, h) (((b) * 2 + (h)) * HTB)
#define PG8_SB(b, h) ((4 + (b) * 2 + (h)) * HTB)
#define PG8_STAGE(bufoff, gbase, voff) do { _Pragma("unroll") for (int _i = 0; _i < 2; ++_i) \
        __builtin_amdgcn_global_load_lds((const unsigned*)((const char*)(gbase) + (voff)[_i]), (LAS unsigned*)(lds + (bufoff) + ldsw + _i * 8192), 16, 0, 0); } while (0)
#define PG8_LDA(dst, b, h) do { _Pragma("unroll") for (int m = 0; m < 4; ++m) _Pragma("unroll") for (int k = 0; k < 2; ++k) dst[m][k] = *(const LAS bf16x8*)(lds + PG8_SA(b, h) + aoff + m * 2048 + k * 1024); } while (0)
#define PG8_LDB(dst, b, h) do { _Pragma("unroll") for (int n = 0; n < 2; ++n) _Pragma("unroll") for (int k = 0; k < 2; ++k) dst[n][k] = *(const LAS bf16x8*)(lds + PG8_SB(b, h) + boff + n * 2048 + k * 1024); } while (0)
#define PG8_MMA(ai, bj, At, Bt) do { __builtin_amdgcn_s_setprio(1); _Pragma("unroll") for (int m = 0; m < 4; ++m) _Pragma("unroll") for (int n = 0; n < 2; ++n) _Pragma("unroll") for (int k = 0; k < 2; ++k) \
        acc[ai][bj][m][n] = __builtin_amdgcn_mfma_f32_16x16x32_bf16(Bt[n][k], At[m][k], acc[ai][bj][m][n], 0, 0, 0); __builtin_amdgcn_s_setprio(0); } while (0)
#define PG8_WAIT_V(n) asm volatile("s_waitcnt vmcnt(" #n ")" ::: "memory")
#define PG8_WAIT_L(n) asm volatile("s_waitcnt lgkmcnt(" #n ")" ::: "memory")
#define PG8_BAR __builtin_amdgcn_s_barrier()
#define PG8_SCHED __builtin_amdgcn_sched_barrier(0)
    Unit cur, nxt; int ui = 0;
    if (!S.next(0, cur)) return;
    f32x4 acc_local[2][2][4][2];
    f32x4 (&acc)[2][2][4][2] = (ACCMODE == 0) ? acc_local : *(f32x4 (*)[2][2][4][2])xacc;
    if constexpr (ACCMODE != 2) {
#pragma unroll
    for (int a = 0; a < 2; ++a)
#pragma unroll
        for (int b = 0; b < 2; ++b)
#pragma unroll
            for (int m = 0; m < 4; ++m)
#pragma unroll
                for (int n = 0; n < 2; ++n) acc[a][b][m][n] = (f32x4){0.f, 0.f, 0.f, 0.f};
    }
    bf16x8 At[4][2], B0[2][2], B1[2][2];
    S.a_ready(cur);
    const char* cA = S.a_ptr(cur); const char* cB = S.b_ptr(cur);
#pragma unroll
    for (int h = 0; h < 2; ++h)
#pragma unroll
        for (int i = 0; i < 2; ++i) {
            if constexpr (GATHER) cvo[h][i] = (unsigned)(((size_t)S.a_row(cur, h * HALF + RA[i]) * K + CA[i]) * 2u);
            else cvo[h][i] = (unsigned)((RA[i] * K + CA[i]) * 2u + h * hstep);
            nvo[h][i] = cvo[h][i];
        }
    if constexpr (SP2) {
        PG8_STAGE(PG8_SB(0, 0), cB, voffB); PG8_STAGE(PG8_SB(0, 1), cB + hstep, voffB); PG8_STAGE(PG8_SA(0, 0), cA, cvo[0]); PG8_STAGE(PG8_SA(0, 1), cA, cvo[1]);
        if (wr == 1) PG8_BAR;
        PG8_WAIT_V(2); PG8_BAR;
        PG8_STAGE(PG8_SB(1, 0), cB + kstep, voffB); PG8_STAGE(PG8_SA(1, 0), cA + kstep, cvo[0]); PG8_STAGE(PG8_SB(1, 1), cB + hstep + kstep, voffB);
        PG8_WAIT_V(6); PG8_BAR;
    } else {
        PG8_STAGE(PG8_SB(0, 0), cB, voffB); PG8_STAGE(PG8_SA(0, 0), cA, cvo[0]); PG8_STAGE(PG8_SB(0, 1), cB + hstep, voffB); PG8_STAGE(PG8_SA(0, 1), cA, cvo[1]);
        if (wr == 1) PG8_BAR;
        PG8_WAIT_V(4); PG8_BAR;
        PG8_STAGE(PG8_SB(1, 0), cB + kstep, voffB); PG8_STAGE(PG8_SA(1, 0), cA + kstep, cvo[0]); PG8_STAGE(PG8_SB(1, 1), cB + hstep + kstep, voffB);
        PG8_WAIT_V(6); PG8_BAR;
    }
    for (;;) {
        const bool has_next = (ACCMODE == 0) ? S.next(ui + 1, nxt) : false;
        const char* nA = has_next ? S.a_ptr(nxt) : cA; const char* nB = has_next ? S.b_ptr(nxt) : cB;
        if constexpr (GATHER) {
#pragma unroll
            for (int h = 0; h < 2; ++h)
#pragma unroll
                for (int i = 0; i < 2; ++i) nvo[h][i] = has_next ? (unsigned)(((size_t)S.a_row(nxt, h * HALF + RA[i]) * K + CA[i]) * 2u) : cvo[h][i];
        }
        for (int t = 0; t < nt; t += 2) {
            const bool last = (t == nt - 2);
            if (last && has_next) S.a_ready(nxt);
            const char* a1 = cA + (size_t)(t + 1) * kstep;
            const char* a2 = last ? nA : cA + (size_t)(t + 2) * kstep; const char* b2 = last ? nB : cB + (size_t)(t + 2) * kstep;
            const char* a3 = a2 + kstep; const char* b3 = b2 + kstep;
            unsigned v2[2][2];
#pragma unroll
            for (int h = 0; h < 2; ++h)
#pragma unroll
                for (int i = 0; i < 2; ++i) v2[h][i] = (GATHER && last) ? nvo[h][i] : cvo[h][i];
            if constexpr (SP2) {
            PG8_LDB(B0, 0, 0); PG8_LDB(B1, 0, 1); PG8_SCHED; PG8_LDA(At, 0, 0); PG8_STAGE(PG8_SA(1, 1), a1, cvo[1]);
            PG8_WAIT_V(8); PG8_WAIT_L(0); PG8_BAR; PG8_MMA(0, 0, At, B0); PG8_MMA(0, 1, At, B1); PG8_BAR; PG8_SCHED;
            PG8_LDA(At, 0, 1); PG8_STAGE(PG8_SB(0, 0), b2, voffB); PG8_STAGE(PG8_SB(0, 1), b2 + hstep, voffB); PG8_STAGE(PG8_SA(0, 0), a2, v2[0]);
            PG8_WAIT_V(8); PG8_WAIT_L(0); PG8_BAR; PG8_MMA(1, 0, At, B0); PG8_MMA(1, 1, At, B1); PG8_BAR; PG8_SCHED;
            PG8_LDB(B0, 1, 0); PG8_LDB(B1, 1, 1); PG8_SCHED; PG8_LDA(At, 1, 0); PG8_STAGE(PG8_SA(0, 1), a2, v2[1]);
            PG8_WAIT_V(8); PG8_WAIT_L(0); PG8_BAR; PG8_MMA(0, 0, At, B0); PG8_MMA(0, 1, At, B1); PG8_BAR; PG8_SCHED;
            PG8_LDA(At, 1, 1); PG8_STAGE(PG8_SB(1, 0), b3, voffB); PG8_STAGE(PG8_SB(1, 1), b3 + hstep, voffB); PG8_STAGE(PG8_SA(1, 0), a3, v2[0]);
            PG8_WAIT_V(8); PG8_WAIT_L(0); PG8_BAR; PG8_MMA(1, 0, At, B0); PG8_MMA(1, 1, At, B1); PG8_BAR; PG8_SCHED;
            } else {
            PG8_LDB(B0, 0, 0); PG8_SCHED; PG8_LDA(At, 0, 0); PG8_STAGE(PG8_SA(1, 1), a1, cvo[1]);
            PG8_WAIT_L(8); PG8_BAR; PG8_WAIT_L(0); PG8_MMA(0, 0, At, B0); PG8_BAR; PG8_SCHED;
            PG8_LDB(B1, 0, 1); PG8_STAGE(PG8_SB(0, 0), b2, voffB);
            PG8_BAR; PG8_WAIT_L(0); PG8_MMA(0, 1, At, B1); PG8_BAR;
            PG8_LDA(At, 0, 1); PG8_STAGE(PG8_SA(0, 0), a2, v2[0]);
            PG8_BAR; PG8_WAIT_L(0); PG8_MMA(1, 0, At, B0); PG8_BAR; PG8_SCHED;
            PG8_STAGE(PG8_SB(0, 1), b2 + hstep, voffB);
            PG8_WAIT_V(6); PG8_BAR; PG8_MMA(1, 1, At, B1); PG8_BAR;
            PG8_LDB(B0, 1, 0); PG8_SCHED; PG8_LDA(At, 1, 0); PG8_STAGE(PG8_SA(0, 1), a2, v2[1]);
            PG8_WAIT_L(8); PG8_BAR; PG8_WAIT_L(0); PG8_MMA(0, 0, At, B0); PG8_BAR; PG8_SCHED;
            PG8_LDB(B1, 1, 1); PG8_STAGE(PG8_SB(1, 0), b3, voffB);
            PG8_BAR; PG8_WAIT_L(0); PG8_MMA(0, 1, At, B1); PG8_BAR;
            PG8_LDA(At, 1, 1); PG8_STAGE(PG8_SA(1, 0), a3, v2[0]);
            PG8_BAR; PG8_WAIT_L(0); PG8_MMA(1, 0, At, B0); PG8_BAR; PG8_SCHED;
            PG8_STAGE(PG8_SB(1, 1), b3 + hstep, voffB);
            PG8_WAIT_V(6); PG8_BAR; PG8_MMA(1, 1, At, B1); PG8_BAR;
            }
        }
        if constexpr (ALIGN_EPI) { if (wr == 0) PG8_BAR; }
        E(acc, cur, wr, wc, fr, fq);
        S.done(cur);
        if (!has_next) break;
#pragma unroll
        for (int a = 0; a < 2; ++a)
#pragma unroll
            for (int b = 0; b < 2; ++b)
#pragma unroll
                for (int m = 0; m < 4; ++m)
#pragma unroll
                    for (int n = 0; n < 2; ++n) acc[a][b][m][n] = (f32x4){0.f, 0.f, 0.f, 0.f};
        cur = nxt; cA = nA; cB = nB; ++ui;
#pragma unroll
        for (int h = 0; h < 2; ++h)
#pragma unroll
            for (int i = 0; i < 2; ++i) cvo[h][i] = nvo[h][i];
        if constexpr (ALIGN_EPI) { if (wr == 1) PG8_BAR; }
    }
    PG8_WAIT_V(0);
    if constexpr (!ALIGN_EPI) { if (wr == 0) PG8_BAR; }
    PG8_BAR;
#undef PG8_SA
#undef PG8_SB
#undef PG8_STAGE
#undef PG8_LDA
#undef PG8_LDB
#undef PG8_MMA
#undef PG8_WAIT_V
#undef PG8_WAIT_L
#undef PG8_BAR
#undef PG8_SCHED
}
}

struct Frame {
    LAS unsigned char* lds;
    volatile LAS unsigned* MISC;
    GAS unsigned* ctl;
    int tid, lane, wave;
    int vcu, G;
    const float* in[19];
    float* out; unsigned char* ws;
};
enum { I_X = 0, I_NMW, I_WIN, I_CONVW, I_ALOG, I_DTB, I_GNW, I_WUPG, I_WUPR, I_WOUT, I_NFW, I_WGRP, I_BGRP, I_WEXP, I_BEXP, I_WGATE, I_WUP, I_WDOWN, I_NFINW };

struct TrItem { const float* W; bf16_t* WT; int ldw, col0, K, row0, k0; };
__device__ __forceinline__ void tr_load(const TrItem& t, int lane, f32x4 (&ld)[8]) {
#pragma unroll
    for (int i = 0; i < 8; ++i) ld[i] = __builtin_nontemporal_load((const f32x4*)(t.W + (size_t)(t.k0 + i * 8 + (lane >> 3)) * t.ldw + t.col0 + (lane & 7) * 4));
}
__device__ __forceinline__ void tr_store(const TrItem& t, int lane, const f32x4 (&ld)[8], LAS float* scr) {
#pragma unroll
    for (int i = 0; i < 8; ++i) { LAS float* d = scr + (i * 8 + (lane >> 3)) * 33 + (lane & 7) * 4; d[0] = ld[i].x; d[1] = ld[i].y; d[2] = ld[i].z; d[3] = ld[i].w; }
    LDS_WAIT(); asm volatile("" ::: "memory");
    const int c = lane & 7;
#pragma unroll
    for (int j = 0; j < 4; ++j) { const int n = (lane >> 3) + 8 * j; const LAS float* sp = scr + (8 * c) * 33 + n;
        u32x4 o; o.x = pk2(sp[0 * 33], sp[1 * 33]); o.y = pk2(sp[2 * 33], sp[3 * 33]); o.z = pk2(sp[4 * 33], sp[5 * 33]); o.w = pk2(sp[6 * 33], sp[7 * 33]);
        *(GAS u32x4*)(t.WT + (size_t)(t.row0 + n) * t.K + t.k0 + 8 * c) = o; }
    LDS_WAIT(); asm volatile("" ::: "memory");
}
template <class Dec> __device__ __forceinline__ void tr_run(const Dec& dec, int first, int count, int stride, int lane, LAS float* scr) {
    if (first >= count) return;
    f32x4 la[8], lb[8];
    TrItem ta = dec(first), tb = ta;
    tr_load(ta, lane, la);
    for (int it = first; it < count; it += 2 * stride) {
        const bool hb = it + stride < count;
        if (hb) { tb = dec(it + stride); tr_load(tb, lane, lb); }
        tr_store(ta, lane, la, scr);
        const bool ha = it + 2 * stride < count;
        if (ha) { ta = dec(it + 2 * stride); tr_load(ta, lane, la); }
        if (hb) tr_store(tb, lane, lb, scr);
    }
}

__device__ __forceinline__ void p0_prologue(Frame& F) {
    LAS float* scr = (LAS float*)(F.lds + F.wave * 16384);
    const int gw = F.vcu * NWAVES + F.wave, NGW = F.G * NWAVES;
    unsigned char* ws = F.ws;
    {
        constexpr int I_IN = (DM / 64) * (NP / 32);
        constexpr int I_UA = (512 / 64) * (DM / 32);
        constexpr int I_UR = (1024 / 64) * (DM / 32);
        constexpr int I_WO = (1024 / 64) * (DM / 32);
        constexpr int NIT = I_IN + I_UA + I_UR + I_WO;
        const float* win = F.in[I_WIN]; const float* wua = F.in[I_WUPG]; const float* wur = F.in[I_WUPR]; const float* wo = F.in[I_WOUT];
        auto dec = [=](int it) -> TrItem {
            int r = it; TrItem t;
            if (r < I_IN) { const int nb = r % (NP / 32), kb = r / (NP / 32); const int n0 = nb * 32;
                t.W = win; t.ldw = D_IN; t.col0 = n0 + (n0 >= 1536 ? 8 : 0); t.WT = (bf16_t*)(ws + WS_WINT); t.K = DM; t.row0 = n0; t.k0 = kb * 64; return t; }
            r -= I_IN;
            if (r < I_UA) { const int nb = r % 32, kb = r / 32; t.W = wua; t.ldw = DM; t.col0 = nb * 32; t.WT = (bf16_t*)(ws + WS_WUPA); t.K = 512; t.row0 = nb * 32; t.k0 = kb * 64; return t; }
            r -= I_UA;
            if (r < I_UR) { const int nb = r % 32, kb = r / 32; t.W = wur; t.ldw = DM; t.col0 = nb * 32; t.WT = (bf16_t*)(ws + WS_WUPR); t.K = 1024; t.row0 = nb * 32; t.k0 = kb * 64; return t; }
            r -= I_UR;
            { const int nb = r % 32, kb = r / 32; t.W = wo; t.ldw = DM; t.col0 = nb * 32; t.WT = (bf16_t*)(ws + WS_WOUT); t.K = 1024; t.row0 = nb * 32; t.k0 = kb * 64; return t; }
        };
        tr_run(dec, gw, NIT, NGW, F.lane, scr);
    }
    {
        GAS f32x2* tab = (GAS f32x2*)(ws + WS_ROPE);
        const int gt = (F.vcu * NTHR + F.tid), NGT = F.G * NTHR;
        for (int i = gt; i < SEQ * 64; i += NGT) {
            const int t = i >> 6, p = i & 63;
            const float invf = 1.0f / powf(10000.0f, (float)p * (1.0f / 63.0f));
            const float ang = (float)t * invf;
            float s, c; sincosf(ang, &s, &c);
            tab[i] = (f32x2){c, s};
        }
    }
    {
        GAS float* wrt = (GAS float*)(ws + WS_WRT);
        const int gt = (F.vcu * NTHR + F.tid), NGT = F.G * NTHR;
        for (int i = gt; i < 48 * DM; i += NGT) {
            const int j = i / DM, k = i % DM;
            const float nf = F.in[I_NFW][k];
            wrt[i] = j < 4 ? F.in[I_WGRP][k * 4 + j] * nf : (j < 36 ? F.in[I_WEXP][k * 32 + (j - 4)] * nf : 0.f);
        }
    }
    {
        __syncthreads();
        LAS float* wab2 = (LAS float*)F.lds;
        for (int idx = F.tid; idx < 8192; idx += NTHR) { const int k = idx >> 3, q = idx & 7; const int j = k >> 8, l_ = (k & 255) >> 2, e = k & 3;
            wab2[((j * 4 + e) * 64 + l_) * 8 + q] = F.in[I_WIN][(size_t)k * D_IN + 1536 + q]; }
        __syncthreads();
        const float* nw = F.in[I_NMW];
        f32x4 wv[4];
#pragma unroll
        for (int j = 0; j < 4; ++j) wv[j] = *(const f32x4*)(nw + 4 * F.lane + 256 * j);
        float alog = 0.f, dtb = 0.f;
        if (F.lane < 4) { alog = F.in[I_ALOG][F.lane]; dtb = F.in[I_DTB][F.lane]; }
        f32x4 vn[4];
#pragma unroll
        for (int j = 0; j < 4; ++j) vn[j] = __builtin_nontemporal_load((const f32x4*)(F.in[I_X] + (size_t)(gw < M ? gw : 0) * DM) + F.lane + 64 * j);
        for (int m = gw; m < M; m += NGW) {
            f32x4 v[4]; float s = 0.f;
#pragma unroll
            for (int j = 0; j < 4; ++j) { v[j] = vn[j]; s += (v[j].x * v[j].x + v[j].y * v[j].y) + (v[j].z * v[j].z + v[j].w * v[j].w); }
            { const int mn = (m + NGW < M) ? m + NGW : m;
#pragma unroll
              for (int j = 0; j < 4; ++j) vn[j] = __builtin_nontemporal_load((const f32x4*)(F.in[I_X] + (size_t)mn * DM) + F.lane + 64 * j); }
            const float rstd = 1.0f / sqrtf(wave_sum(s) * (1.f / DM) + EPS);
            float ab[8];
#pragma unroll
            for (int q = 0; q < 8; ++q) ab[q] = 0.f;
            GAS unsigned long long* o8 = (GAS unsigned long long*)((bf16_t*)(ws + WS_U) + (size_t)m * DM) + F.lane;
#pragma unroll
            for (int j = 0; j < 4; ++j) {
                v[j] = v[j] * rstd * wv[j];
                o8[64 * j] = (unsigned long long)pk2(v[j].x, v[j].y) | ((unsigned long long)pk2(v[j].z, v[j].w) << 32);
#pragma unroll
                for (int e = 0; e < 4; ++e) {
                    const LAS f32x4* wp = (const LAS f32x4*)(wab2 + ((j * 4 + e) * 64 + F.lane) * 8);
                    const f32x4 w0 = wp[0], w1 = wp[1];
                    const float xv = v[j][e];
                    ab[0] += xv * w0.x; ab[1] += xv * w0.y; ab[2] += xv * w0.z; ab[3] += xv * w0.w;
                    ab[4] += xv * w1.x; ab[5] += xv * w1.y; ab[6] += xv * w1.z; ab[7] += xv * w1.w;
                }
            }
#pragma unroll
            for (int q = 0; q < 8; ++q) ab[q] = wave_sum(ab[q]);
            if (F.lane < 4) {
                const float a = F.lane == 0 ? ab[0] : F.lane == 1 ? ab[1] : F.lane == 2 ? ab[2] : ab[3];
                const float b = F.lane == 0 ? ab[4] : F.lane == 1 ? ab[5] : F.lane == 2 ? ab[6] : ab[7];
                const float z = a + dtb;
                const float sp = z > 20.f ? z : log1pf(__expf(z));
                ((GAS float*)(ws + WS_G))[(size_t)m * 4 + F.lane] = -__expf(alog) * sp;
                ((GAS float*)(ws + WS_BETA))[(size_t)m * 4 + F.lane] = 1.0f / (1.0f + __expf(-b));
            }
        }
    }
}

struct EpiProj {
    static constexpr bool PERM = true;
    unsigned char* ws;
    __device__ __forceinline__ void operator()(const f32x4 (&acc)[2][2][4][2], const pg8::Unit& u, int wr, int wc, int fr, int fq) const {
        const int pn = u.pn; bf16_t* base; int ldc, colt, mode = 0;
        if (pn < 6) { base = (bf16_t*)(ws + WS_GQKV); ldc = 1536; colt = 256 * pn; }
        else if (pn < 8) { base = (bf16_t*)(ws + WS_GZ); ldc = 512; colt = 256 * (pn - 6); }
        else if (pn < 12) { base = (bf16_t*)(ws + WS_RQK); ldc = 1024; colt = 256 * (pn - 8); mode = pn < 10 ? 1 : 2; }
        else if (pn < 16) { base = (bf16_t*)(ws + WS_RV); ldc = 1024; colt = 256 * (pn - 12); }
        else if (pn < 20) { base = (bf16_t*)(ws + WS_RG); ldc = 1024; colt = 256 * (pn - 16); }
        else { base = (bf16_t*)(ws + WS_MAB); ldc = 2048; colt = 256 * (pn - 20); }
        const int row0 = u.pm * 256 + wr * 64 + fr, col0 = colt + wc * 32 + 8 * fq;
        const float sc = mode == 2 ? 0.08838834764831845f : 1.0f;
        const GAS f32x4* tab = (const GAS f32x4*)(ws + WS_ROPE);
#pragma unroll
        for (int ai = 0; ai < 2; ++ai)
#pragma unroll
            for (int m = 0; m < 4; ++m) {
                const int row = row0 + ai * 128 + m * 16;
                bf16_t* rowp = base + (size_t)row * ldc + col0;
                f32x4 cs0 = {1.f, 0.f, 1.f, 0.f}, cs1 = cs0;
                if (mode) { const GAS f32x4* tp = tab + ((size_t)(row & (SEQ - 1)) * 64 + wc * 16 + 4 * fq) / 2; cs0 = tp[0]; cs1 = tp[1]; }
#pragma unroll
                for (int bj = 0; bj < 2; ++bj) {
                    f32x4 v0 = acc[ai][bj][m][0], v1 = acc[ai][bj][m][1];
                    if (mode) {
                        f32x4 r0, r1;
                        r0[0] = v0[0] * cs0[0] - v0[1] * cs0[1]; r0[1] = v0[1] * cs0[0] + v0[0] * cs0[1];
                        r0[2] = v0[2] * cs0[2] - v0[3] * cs0[3]; r0[3] = v0[3] * cs0[2] + v0[2] * cs0[3];
                        r1[0] = v1[0] * cs1[0] - v1[1] * cs1[1]; r1[1] = v1[1] * cs1[0] + v1[0] * cs1[1];
                        r1[2] = v1[2] * cs1[2] - v1[3] * cs1[3]; r1[3] = v1[3] * cs1[2] + v1[2] * cs1[3];
                        v0 = r0 * sc; v1 = r1 * sc;
                    }
                    u32x4 w; w.x = pg8::cvt_pk_bf16(v0[0], v0[1]); w.y = pg8::cvt_pk_bf16(v0[2], v0[3]); w.z = pg8::cvt_pk_bf16(v1[0], v1[1]); w.w = pg8::cvt_pk_bf16(v1[2], v1[3]);
                    __builtin_nontemporal_store(w, (u32x4*)(rowp + bj * 128));
                }
            }
    }
};

__device__ __forceinline__ f32x4 mma16(bf16x8 x, bf16x8 y, f32x4 c) { return __builtin_amdgcn_mfma_f32_16x16x32_bf16(x, y, c, 0, 0, 0); }
__device__ __forceinline__ bf16x8 lfrag(const LAS bf16_t* base, int ld, int row0, int k0, int fr, int fq) { return *(const LAS bf16x8*)(base + (row0 + fr) * ld + k0 + 8 * fq); }
__device__ __forceinline__ bf16x8 gfrag(const bf16_t* base, int ld, int row0, int k0, int fr, int fq) { return *(const bf16x8*)(base + (size_t)(row0 + fr) * ld + k0 + 8 * fq); }
__device__ __forceinline__ bf16x8 tfrag(const LAS bf16_t* base, int ld, int k0, int n0, int lane) {
    const int g = lane >> 4, q = (lane & 15) >> 2, p = lane & 3;
    const LAS bf16_t* a = base + (k0 + 8 * g + q) * ld + n0 + 4 * p;
    const bf16x4 v0 = __builtin_amdgcn_ds_read_tr16_b64_v4i16((LAS bf16x4*)a);
    const bf16x4 v1 = __builtin_amdgcn_ds_read_tr16_b64_v4i16((LAS bf16x4*)(a + 4 * ld));
    return (bf16x8){v0[0], v0[1], v0[2], v0[3], v1[0], v1[1], v1[2], v1[3]};
}
__device__ __forceinline__ bf16x8 pack_acc(f32x4 a, f32x4 b) {
    u32x4 w; w.x = pk2(a[0], a[1]); w.y = pk2(a[2], a[3]); w.z = pk2(b[0], b[1]); w.w = pk2(b[2], b[3]);
    return __builtin_bit_cast(bf16x8, w);
}
__device__ __forceinline__ int ppos(int kap) { return 8 * ((kap & 15) >> 2) + 4 * (kap >> 4) + (kap & 3); }
__device__ __forceinline__ int foff(int row, int col, int kc32) { const int p = ppos(col & 31); return ((row >> 4) * kc32 + (col >> 5)) * 512 + ((row & 15) + 16 * (p >> 3)) * 8 + (p & 7); }

constexpr size_t WS_GL = 8 * MiB + 512 * 1024;

__device__ __forceinline__ void gdn_prep_fetch(Frame& F, int idx, u32x4 (&xw)[2][7], float& gpre, float& bpre) {
    const int bh = idx >> 5, n = idx & 31, b = bh >> 2, h = bh & 3, tok0 = b * SEQ + n * 64, tid = F.tid;
    const bf16_t* GQKV = (const bf16_t*)(F.ws + WS_GQKV);
    if (F.wave == 0) { gpre = ((const float*)(F.ws + WS_G))[(size_t)(tok0 + F.lane) * 4 + h]; bpre = ((const float*)(F.ws + WS_BETA))[(size_t)(tok0 + F.lane) * 4 + h]; }
#pragma unroll
    for (int q = 0; q < 2; ++q) {
        const int task = tid + q * NTHR;
        const int cg = task % 48, tr = task / 48, part = cg >> 4, cl = (cg & 15) * 8, gcol = part * 512 + h * 128 + cl;
#pragma unroll
        for (int r = 0; r < 7; ++r) {
            const int tt = tr * 4 - 3 + r;
            xw[q][r] = (u32x4){0u, 0u, 0u, 0u};
            if (task < 768 && n * 64 + tt >= 0) xw[q][r] = *(const u32x4*)((const unsigned char*)GQKV + (unsigned)(((tok0 + tt) * 1536 + gcol) * 2));
        }
    }
}
template <int PM> __device__ __forceinline__ void gdn_prep_item(Frame& F, int idx, int idx_next, u32x4 (&xw)[2][7], float& gpre, float& bpre) {
    const int bh = idx >> 5, n = idx & 31, b = bh >> 2, h = bh & 3;
    const int tok0 = b * SEQ + n * 64;
    LAS bf16_t* QN = (LAS bf16_t*)(F.lds);
    LAS bf16_t* KN = (LAS bf16_t*)(F.lds + 17408);
    LAS bf16_t* KT = (LAS bf16_t*)(F.lds + 34816);
    LAS bf16_t* VT = (LAS bf16_t*)(F.lds + 53248);
    LAS float*  LM = (LAS float*)(F.lds + 71680);
    LAS bf16_t* T1 = (LAS bf16_t*)(F.lds + 89088);
    LAS bf16_t* T2 = (LAS bf16_t*)(F.lds + 98304);
    LAS float*  SC = (LAS float*)(F.lds + 107520);
    LAS float*  SSQ = (LAS float*)(F.lds + 108544);
    const int tid = F.tid, lane = F.lane, fr = lane & 15, fq = lane >> 4, wave = F.wave;
    const bf16_t* GQKV = (const bf16_t*)(F.ws + WS_GQKV);
    if (!(PM & 1)) {
#pragma unroll
        for (int q = 0; q < 2; ++q) {
            const int task = tid + q * NTHR;
            if (task < 768) {
                const int cg = task % 48, tr = task / 48, part = cg >> 4, cl = (cg & 15) * 8, gcol = part * 512 + h * 128 + cl;
                unsigned nat[4][4];
                float ssq[4];
#pragma unroll
                for (int t = 0; t < 4; ++t) ssq[t] = 0.f;
#pragma unroll
                for (int e2 = 0; e2 < 4; ++e2) {
                    float c0[4], c1[4];
#pragma unroll
                    for (int k = 0; k < 4; ++k) { const f32x2 cc = *(const f32x2*)(F.in[I_CONVW] + k * 1536 + gcol + 2 * e2); c0[k] = cc.x; c1[k] = cc.y; }
                    float xa[7], xb[7];
#pragma unroll
                    for (int r = 0; r < 7; ++r) { const unsigned w = xw[q][r][e2]; xa[r] = bflo(w); xb[r] = bfhi(w); }
                    float ya[4], yb[4];
#pragma unroll
                    for (int t = 0; t < 4; ++t) {
                        ya[t] = siluf_(c0[0] * xa[t] + c0[1] * xa[t + 1] + c0[2] * xa[t + 2] + c0[3] * xa[t + 3]);
                        yb[t] = siluf_(c1[0] * xb[t] + c1[1] * xb[t + 1] + c1[2] * xb[t + 2] + c1[3] * xb[t + 3]);
                        ssq[t] += ya[t] * ya[t] + yb[t] * yb[t];
                        nat[t][e2] = pk2(ya[t], yb[t]);
                    }
                    if (part >= 1) {
                        LAS bf16_t* Tt = part == 1 ? KT : VT;
                        u32x2 w; w.x = pk2(ya[0], ya[1]); w.y = pk2(ya[2], ya[3]);
                        *(LAS u32x2*)(Tt + (cl + 2 * e2) * 72 + tr * 4) = w;
                        w.x = pk2(yb[0], yb[1]); w.y = pk2(yb[2], yb[3]);
                        *(LAS u32x2*)(Tt + (cl + 2 * e2 + 1) * 72 + tr * 4) = w;
                    }
                }
                if (part < 2) {
                    LAS bf16_t* N = part == 0 ? QN : KN;
#pragma unroll
                    for (int t = 0; t < 4; ++t) {
                        SSQ[(part * 64 + tr * 4 + t) * 16 + (cg & 15)] = ssq[t];
                        *(LAS u32x4*)(N + (tr * 4 + t) * 136 + cl) = (u32x4){nat[t][0], nat[t][1], nat[t][2], nat[t][3]};
                    }
                }
            }
        }
    }
    LBAR();
    if (wave == 0) {
        const int c = lane;
        float sq = 0.f, sk = 0.f;
#pragma unroll
        for (int j = 0; j < 16; ++j) { sq += SSQ[c * 16 + j]; sk += SSQ[(64 + c) * 16 + j]; }
        const float rq = 1.0f / sqrtf(sq + EPS), rk = 1.0f / sqrtf(sk + EPS);
        const float g = gpre, be = bpre;
        float gc = g;
#pragma unroll
        for (int o = 1; o < 64; o <<= 1) { const float t = __shfl_up(gc, o); if (lane >= o) gc += t; }
        SC[c] = rq; SC[64 + c] = rk; SC[128 + c] = gc; SC[192 + c] = be;
        if (c == 63) ((float*)(F.ws + WS_GL))[idx] = gc;
    }
    LBAR();
    if (!(PM & 4)) {
        bf16_t* ATT = (bf16_t*)((unsigned char*)F.out + (size_t)idx * GP_BYTES) + GP_A;
#pragma unroll 1
        for (int job = wave * 4; job < wave * 4 + 4; ++job) {
            const int which = job >> 4, it = (job >> 2) & 3, jt = job & 3;
            f32x4 acc = {0.f, 0.f, 0.f, 0.f};
            const LAS bf16_t* Y = which ? QN : KN;
            bf16x8 fx[4], fy[4];
#pragma unroll
            for (int ks = 0; ks < 4; ++ks) { fx[ks] = lfrag(KN, 136, jt * 16, ks * 32, fr, fq); fy[ks] = lfrag(Y, 136, it * 16, ks * 32, fr, fq); }
            __builtin_amdgcn_sched_barrier(0);
#pragma unroll
            for (int ks = 0; ks < 4; ++ks) acc = mma16(fx[ks], fy[ks], acc);
            const int i = it * 16 + fr, j0 = jt * 16 + 4 * fq;
            const float gci = SC[128 + i];
            if (which == 0) {
                const float fi = SC[192 + i] * SC[64 + i];
                f32x4 o;
#pragma unroll
                for (int r = 0; r < 4; ++r) { const int j = j0 + r; o[r] = (j < i) ? fi * SC[64 + j] * acc[r] * __expf(gci - SC[128 + j]) : 0.f; }
                *(LAS f32x4*)(LM + i * 68 + j0) = o;
            } else {
                const float fi = SC[i] * 0.08838834764831845f;
                float o[4];
#pragma unroll
                for (int r = 0; r < 4; ++r) { const int j = j0 + r; o[r] = (j <= i) ? fi * SC[64 + j] * acc[r] * __expf(gci - SC[128 + j]) : 0.f; }
                u32x2 w; w.x = pk2(o[0], o[1]); w.y = pk2(o[2], o[3]);
                *(u32x2*)(ATT + foff(i, j0, 2)) = w;
            }
        }
    }
    LBAR();
    if (idx_next >= 0) gdn_prep_fetch(F, idx_next, xw, gpre, bpre);
    LAS float* TD = (LAS float*)(F.lds + 116736);
    LAS float* PS = (LAS float*)(F.lds + 124928);
    if (wave == 0) { if (!(PM & 2)) {
        const int blk = lane >> 5, c = lane & 31;
        const LAS float* Lb = LM + (blk * 32) * 68 + blk * 32;
        LAS float* Tw = TD + blk * 1024 + c;
        float t[32];
        f32x4 la[8], lb[8];
#define INV_LD(dst, i) do { _Pragma("unroll") for (int _j = 0; _j < ((i) + 3) / 4; ++_j) dst[_j] = *(const LAS f32x4*)(Lb + (i) * 68 + 4 * _j); } while (0)
#define INV_ROW(src, i) do { float ps[4] = {((i) == c) ? 1.f : 0.f, 0.f, 0.f, 0.f}; _Pragma("unroll") for (int _j = 0; _j < ((i) + 3) / 4; ++_j) { _Pragma("unroll") for (int _e = 0; _e < 4; ++_e) if (4 * _j + _e < (i)) ps[_e] -= src[_j][_e] * t[4 * _j + _e]; } \
        t[i] = (ps[0] + ps[1]) + (ps[2] + ps[3]); Tw[(i) * 32] = t[i]; } while (0)
        INV_LD(la, 1);
#pragma unroll
        for (int i = 0; i < 32; i += 2) {
            if (i + 1 < 32) { INV_LD(lb, i + 1); }
            __builtin_amdgcn_sched_barrier(0);
            INV_ROW(la, i);
            if (i + 2 < 32) { INV_LD(la, i + 2); }
            __builtin_amdgcn_sched_barrier(0);
            INV_ROW(lb, i + 1);
        }
#undef INV_LD
#undef INV_ROW
    } } else {
        bf16_t* QGo = (bf16_t*)((unsigned char*)F.out + (size_t)idx * GP_BYTES) + GP_Q;
        bf16_t* KDo = (bf16_t*)((unsigned char*)F.out + (size_t)idx * GP_BYTES) + GP_K;
        const float gl = SC[128 + 63];
        for (int task = tid - 64; task < 2048; task += 448) {
            if (task < 1024) {
                const int c = task >> 4, d0 = (task & 15) * 8;
                const float f = SC[c] * 0.08838834764831845f * __expf(SC[128 + c]);
                const u32x4 w = *(const LAS u32x4*)(QN + c * 136 + d0);
                u32x2 o0, o1; o0.x = pk2(bflo(w.x) * f, bfhi(w.x) * f); o0.y = pk2(bflo(w.y) * f, bfhi(w.y) * f); o1.x = pk2(bflo(w.z) * f, bfhi(w.z) * f); o1.y = pk2(bflo(w.w) * f, bfhi(w.w) * f);
                *(u32x2*)(QGo + foff(c, d0, 4)) = o0; *(u32x2*)(QGo + foff(c, d0 + 4, 4)) = o1;
            } else {
                const int tk = task - 1024, d = tk >> 3, c0 = (tk & 7) * 8;
                const u32x4 w = *(const LAS u32x4*)(KT + d * 72 + c0);
                float f[8];
#pragma unroll
                for (int e = 0; e < 8; ++e) f[e] = SC[64 + c0 + e] * __expf(gl - SC[128 + c0 + e]);
                u32x2 o0, o1; o0.x = pk2(bflo(w.x) * f[0], bfhi(w.x) * f[1]); o0.y = pk2(bflo(w.y) * f[2], bfhi(w.y) * f[3]); o1.x = pk2(bflo(w.z) * f[4], bfhi(w.z) * f[5]); o1.y = pk2(bflo(w.w) * f[6], bfhi(w.w) * f[7]);
                *(u32x2*)(KDo + foff(d, c0, 2)) = o0; *(u32x2*)(KDo + foff(d, c0 + 4, 2)) = o1;
            }
        }
    }
    LBAR();
    if (wave < 4 && !(PM & 2)) {
        const int ti = wave >> 1, tj = wave & 1;
        f32x4 acc = {0.f, 0.f, 0.f, 0.f};
#pragma unroll
        for (int ks = 0; ks < 8; ++ks) acc = __builtin_amdgcn_mfma_f32_16x16x4f32(LM[(32 + 16 * ti + fr) * 68 + 4 * ks + fq], TD[(4 * ks + fq) * 32 + 16 * tj + fr], acc, 0, 0, 0);
#pragma unroll
        for (int r = 0; r < 4; ++r) PS[(16 * ti + 4 * fq + r) * 33 + 16 * tj + fr] = acc[r];
    }
    LBAR();
    if (wave < 4 && !(PM & 2)) {
        const int ti = wave >> 1, tj = wave & 1;
        f32x4 acc = {0.f, 0.f, 0.f, 0.f};
#pragma unroll
        for (int ks = 0; ks < 8; ++ks) acc = __builtin_amdgcn_mfma_f32_16x16x4f32(TD[1024 + (16 * ti + fr) * 32 + 4 * ks + fq], PS[(4 * ks + fq) * 33 + 16 * tj + fr], acc, 0, 0, 0);
#pragma unroll
        for (int r = 0; r < 4; ++r) LM[(32 + 16 * ti + 4 * fq + r) * 68 + 16 * tj + fr] = -acc[r];
    }
    LBAR();
    if (!(PM & 2)) {
#pragma unroll
        for (int q = 0; q < 2; ++q) {
            const int task = tid + q * NTHR, i = task >> 4, j0 = (task & 15) * 4;
            f32x4 tv = {0.f, 0.f, 0.f, 0.f};
            if (i < 32) { if (j0 < 32) tv = *(const LAS f32x4*)(TD + i * 32 + j0); }
            else if (j0 < 32) { tv = *(const LAS f32x4*)(LM + i * 68 + j0); }
            else { tv = *(const LAS f32x4*)(TD + 1024 + (i - 32) * 32 + (j0 - 32)); }
            float b1[4], b2[4];
#pragma unroll
            for (int e = 0; e < 4; ++e) { b1[e] = SC[192 + j0 + e]; b2[e] = b1[e] * SC[64 + j0 + e] * __expf(SC[128 + j0 + e]); }
            u32x2 w1, w2; w1.x = pk2(tv[0] * b1[0], tv[1] * b1[1]); w1.y = pk2(tv[2] * b1[2], tv[3] * b1[3]); w2.x = pk2(tv[0] * b2[0], tv[1] * b2[1]); w2.y = pk2(tv[2] * b2[2], tv[3] * b2[3]);
            *(LAS u32x2*)(T1 + i * 72 + j0) = w1; *(LAS u32x2*)(T2 + i * 72 + j0) = w2;
        }
    }
    LBAR();
    if (!(PM & 4)) {
        bf16_t* UTo = (bf16_t*)(F.ws + WS_UT) + (size_t)idx * 8192;
        bf16_t* WNo = (bf16_t*)((unsigned char*)F.out + (size_t)idx * GP_BYTES) + GP_W;
#pragma unroll 1
        for (int job = wave * 8; job < wave * 8 + 8; ++job) {
            f32x4 acc = {0.f, 0.f, 0.f, 0.f};
            if (job < 32) {
                const int it = job >> 3, dvt = job & 7;
#pragma unroll
                for (int ks = 0; ks < 2; ++ks) acc = mma16(lfrag(T1, 72, it * 16, ks * 32, fr, fq), lfrag(VT, 72, dvt * 16, ks * 32, fr, fq), acc);
                u32x2 w; w.x = pk2(acc[0], acc[1]); w.y = pk2(acc[2], acc[3]);
                *(u32x2*)(UTo + (dvt * 16 + fr) * 64 + it * 16 + 4 * fq) = w;
            } else {
                const int dkt = (job - 32) >> 2, it = (job - 32) & 3;
#pragma unroll
                for (int ks = 0; ks < 2; ++ks) acc = mma16(lfrag(KT, 72, dkt * 16, ks * 32, fr, fq), lfrag(T2, 72, it * 16, ks * 32, fr, fq), acc);
                u32x2 w; w.x = pk2(-acc[0], -acc[1]); w.y = pk2(-acc[2], -acc[3]);
                const int d0 = dkt * 16 + 4 * fq;
                *(u32x2*)(WNo + foff(it * 16 + fr, d0, 4)) = w;
            }
        }
    }
    LBAR();
}

__device__ __forceinline__ float ret_log2_gamma(int h) { return log2f(1.0f - exp2f(-5.0f - (float)h)); }
__device__ __forceinline__ void ret_kv_item(Frame& F, int idx2) {
    const int bh = idx2 >> 4, n = idx2 & 15, b = bh >> 2, h = bh & 3;
    const int tok0 = b * SEQ + n * 128;
    LAS bf16_t* KS = (LAS bf16_t*)(F.lds);
    LAS bf16_t* VN = (LAS bf16_t*)(F.lds + 34816);
    const int tid = F.tid, lane = F.lane, fr = lane & 15, fq = lane >> 4, wave = F.wave;
    const float l2g = ret_log2_gamma(h);
    const bf16_t* RQK = (const bf16_t*)(F.ws + WS_RQK); const bf16_t* RV = (const bf16_t*)(F.ws + WS_RV);
#pragma unroll
    for (int i = 0; i < 4; ++i) { const int p = tid + i * 512, c = p >> 4, d0 = (p & 15) * 8;
        const u32x4 w = *(const u32x4*)(RQK + (size_t)(tok0 + c) * 1024 + 512 + h * 128 + d0);
        const float f = exp2f(l2g * (float)(127 - c));
        u32x4 o; o.x = pk2(bflo(w.x) * f, bfhi(w.x) * f); o.y = pk2(bflo(w.y) * f, bfhi(w.y) * f); o.z = pk2(bflo(w.z) * f, bfhi(w.z) * f); o.w = pk2(bflo(w.w) * f, bfhi(w.w) * f);
        *(LAS u32x4*)(KS + c * 136 + d0) = o; }
#pragma unroll
    for (int i = 0; i < 8; ++i) { const int p = tid + i * 512, c = p >> 5, d0 = (p & 31) * 8;
        *(LAS u32x4*)(VN + c * 264 + d0) = *(const u32x4*)(RV + (size_t)(tok0 + c) * 1024 + h * 256 + d0); }
    LBAR();
    f32x4 acc[8][2];
#pragma unroll
    for (int a = 0; a < 8; ++a) { acc[a][0] = (f32x4){0.f, 0.f, 0.f, 0.f}; acc[a][1] = acc[a][0]; }
#pragma unroll
    for (int ks = 0; ks < 4; ++ks) {
        const bf16x8 y0 = tfrag(VN, 264, ks * 32, (2 * wave) * 16, lane), y1 = tfrag(VN, 264, ks * 32, (2 * wave + 1) * 16, lane);
#pragma unroll
        for (int dkt = 0; dkt < 8; ++dkt) { const bf16x8 x = tfrag(KS, 136, ks * 32, dkt * 16, lane); acc[dkt][0] = mma16(x, y0, acc[dkt][0]); acc[dkt][1] = mma16(x, y1, acc[dkt][1]); }
    }
    bf16_t* KVo = (bf16_t*)(F.ws + WS_KV) + (size_t)idx2 * 32768;
#pragma unroll
    for (int dkt = 0; dkt < 8; ++dkt)
#pragma unroll
        for (int q = 0; q < 2; ++q) { u32x2 w; w.x = pk2(acc[dkt][q][0], acc[dkt][q][1]); w.y = pk2(acc[dkt][q][2], acc[dkt][q][3]);
            *(u32x2*)(KVo + ((2 * wave + q) * 16 + fr) * 128 + dkt * 16 + 4 * fq) = w; }
    LBAR();
}

template <int MODE> __device__ __forceinline__ void gdn_scan_block(Frame& F, int cu) {
    const int bh = cu >> 1, b = bh >> 2, h = bh & 3;
    const int lane = F.lane, wave = F.wave, fr = lane & 15, fq = lane >> 4;
    const unsigned char* GPb = (const unsigned char*)F.out + (size_t)(bh * 32) * GP_BYTES;
    const unsigned char* UTb = (const unsigned char*)(F.ws + WS_UT) + (size_t)(bh * 32) * 16384 + (cu & 1) * 8192;
    constexpr int BUFB = 65536;
    int wpa[8], wpb[8]; int wsum = 0;
#pragma unroll
    for (int i = 0; i < 8; ++i) { wpa[i] = 0; wpb[i] = 0; }
#define SCAN_DMA(nn, lw) do { const unsigned char* _g = GPb + (size_t)(nn) * GP_BYTES; const unsigned char* _u = UTb + (size_t)(nn) * 16384; LAS unsigned char* _d = F.lds + ((nn) & 1) * BUFB; \
        _Pragma("unroll") for (int _i = 0; _i < 16; ++_i) { const int piece = (lw) + 4 * _i; const unsigned char* src = piece < 56 ? _g + piece * 1024 : _u + (piece - 56) * 1024; \
            __builtin_amdgcn_global_load_lds((const unsigned*)(src + lane * 16), (LAS unsigned*)(_d + piece * 1024), 16, 0, 0); } } while (0)
#define SCAN_WARM(wp, nn) do { const unsigned char* _g = GPb + (size_t)(nn) * GP_BYTES; const unsigned char* _u = UTb + (size_t)(nn) * 16384; \
        _Pragma("unroll") for (int _k = 0; _k < 2; ++_k) { const int _L = (2 * wave + _k) * 64 + lane; wsum ^= wp[_k]; wp[_k] = *(const int*)(_L < 448 ? _g + _L * 128 : _u + (_L - 448) * 128); } } while (0)
    if (wave >= 4) { SCAN_DMA(0, wave - 4); asm volatile("s_waitcnt vmcnt(0)" ::: "memory"); }
    else { SCAN_WARM(wpa, 1); SCAN_WARM(wpb, 2); }
    float glall = 0.f;
    if (wave < 4 && lane < 32) glall = ((const float*)(F.ws + WS_GL))[bh * 32 + lane];
    LBAR();
    const int sl = (cu & 1) * 4 + (wave & 3);
    bf16_t* OG = (bf16_t*)(F.ws + WS_OGDN);
    f32x4 S[8];
#pragma unroll
    for (int d = 0; d < 8; ++d) S[d] = (f32x4){0.f, 0.f, 0.f, 0.f};
#pragma unroll 1
    for (int n = 0; n < 32; ++n) {
        if (wave >= 4) {
            if (MODE != 1 && n + 1 < 32) { SCAN_DMA(n + 1, wave - 4); asm volatile("s_waitcnt vmcnt(0)" ::: "memory"); }
        } else if (MODE != 2) {
            if (n + 3 < 32) { if (n & 1) SCAN_WARM(wpb, n + 3); else SCAN_WARM(wpa, n + 3); }
            const LAS unsigned char* buf = F.lds + (n & 1) * BUFB;
            const LAS bf16x8* Bf = (const LAS bf16x8*)buf + lane;
            const float egl = __expf(rdlane(glall, n));
            f32x4 av[4], ao[4];
#pragma unroll
            for (int ct = 0; ct < 4; ++ct) {
                const u32x2 un = *(const LAS u32x2*)(buf + GP_BYTES + (((wave & 3) * 16 + fr) * 64 + ct * 16 + 4 * fq) * 2);
                av[ct] = (f32x4){bflo(un.x), bfhi(un.x), bflo(un.y), bfhi(un.y)}; ao[ct] = (f32x4){0.f, 0.f, 0.f, 0.f};
            }
#define LDG(dst, blk0) do { _Pragma("unroll") for (int _j = 0; _j < 8; ++_j) dst[_j] = Bf[((blk0) + _j) * 64]; } while (0)
#define SB() __builtin_amdgcn_sched_barrier(0)
            bf16x8 ga[8], gb[8];
            LDG(ga, 0); LDG(gb, 8); SB();
            bf16x8 Sf[4];
#pragma unroll
            for (int ks = 0; ks < 4; ++ks) Sf[ks] = pack_acc(S[2 * ks], S[2 * ks + 1]);
            SB();
#pragma unroll
            for (int jj = 0; jj < 8; ++jj) { const int j = (jj >> 1) + 4 * (jj & 1); av[j >> 2] = mma16(ga[j], Sf[j & 3], av[j >> 2]); }
            SB(); LDG(ga, 16); SB();
#pragma unroll
            for (int jj = 0; jj < 8; ++jj) { const int j = (jj >> 1) + 4 * (jj & 1); av[2 + (j >> 2)] = mma16(gb[j], Sf[j & 3], av[2 + (j >> 2)]); }
            SB(); LDG(gb, 24); SB();
#pragma unroll
            for (int jj = 0; jj < 8; ++jj) { const int j = (jj >> 1) + 4 * (jj & 1); ao[j >> 2] = mma16(ga[j], Sf[j & 3], ao[j >> 2]); }
            SB(); LDG(ga, 48); SB();
#pragma unroll
            for (int jj = 0; jj < 8; ++jj) { const int j = (jj >> 1) + 4 * (jj & 1); ao[2 + (j >> 2)] = mma16(gb[j], Sf[j & 3], ao[2 + (j >> 2)]); }
            SB(); LDG(gb, 32); SB();
            bf16x8 Vf[2];
            Vf[0] = pack_acc(av[0], av[1]); Vf[1] = pack_acc(av[2], av[3]);
#pragma unroll
            for (int dt = 0; dt < 8; ++dt) S[dt] = S[dt] * egl;
            SB();
#pragma unroll
            for (int jj = 0; jj < 8; ++jj) { const int j = 2 * (jj & 3) + (jj >> 2); ao[j >> 1] = mma16(ga[j], Vf[j & 1], ao[j >> 1]); }
            SB(); LDG(ga, 40); SB();
#pragma unroll
            for (int jj = 0; jj < 8; ++jj) { const int j = 2 * (jj & 3) + (jj >> 2); S[j >> 1] = mma16(gb[j], Vf[j & 1], S[j >> 1]); }
            SB();
#pragma unroll
            for (int jj = 0; jj < 8; ++jj) { const int j = 2 * (jj & 3) + (jj >> 2); S[4 + (j >> 1)] = mma16(ga[j], Vf[j & 1], S[4 + (j >> 1)]); }
            SB();
#undef LDG
#undef SB
            const int tok0 = b * SEQ + n * 64;
#pragma unroll
            for (int ct = 0; ct < 4; ++ct)
#pragma unroll
                for (int r = 0; r < 4; ++r) {
                    const int c = ct * 16 + 4 * fq + r;
                    if (MODE != 3) OG[(size_t)(tok0 + c) * 512 + h * 128 + sl * 16 + fr] = (bf16_t)pk2(ao[ct][r], 0.f);
                }
        }
        LBAR();
    }
#undef SCAN_DMA
#undef SCAN_WARM
#pragma unroll
    for (int i = 0; i < 8; ++i) wsum ^= wpa[i] ^ wpb[i];
    if (wsum == 0x5a17c0de) ((unsigned*)(F.ws + WS_CTL))[CW_TMO + 16] = 1u;
}

__device__ __forceinline__ void ret_prefix_task(Frame& F, int task) {
    const int bh = task >> 6, part = task & 63, h = bh & 3;
    const float cd = exp2f(ret_log2_gamma(h) * 128.0f);
    bf16_t* base = (bf16_t*)(F.ws + WS_KV) + (size_t)bh * 16 * 32768 + part * 512 + F.lane * 8;
    float st[8];
#pragma unroll
    for (int e = 0; e < 8; ++e) st[e] = 0.f;
#pragma unroll 4
    for (int n = 0; n < 16; ++n) {
        u32x4* p = (u32x4*)(base + (size_t)n * 32768);
        const u32x4 w = *p;
        u32x4 o; o.x = pk2(st[0], st[1]); o.y = pk2(st[2], st[3]); o.z = pk2(st[4], st[5]); o.w = pk2(st[6], st[7]);
        *p = o;
        st[0] = st[0] * cd + bflo(w.x); st[1] = st[1] * cd + bfhi(w.x); st[2] = st[2] * cd + bflo(w.y); st[3] = st[3] * cd + bfhi(w.y);
        st[4] = st[4] * cd + bflo(w.z); st[5] = st[5] * cd + bfhi(w.z); st[6] = st[6] * cd + bflo(w.w); st[7] = st[7] * cd + bfhi(w.w);
    }
}

__device__ __forceinline__ bf16x8 scale_frag(bf16x8 q, float f) {
    u32x4 w = __builtin_bit_cast(u32x4, q);
    w.x = pk2(bflo(w.x) * f, bfhi(w.x) * f); w.y = pk2(bflo(w.y) * f, bfhi(w.y) * f); w.z = pk2(bflo(w.z) * f, bfhi(w.z) * f); w.w = pk2(bflo(w.w) * f, bfhi(w.w) * f);
    return __builtin_bit_cast(bf16x8, w);
}
struct RetPre { u32x4 q[4], k[4]; };
__device__ __forceinline__ void ret_out_fetch(Frame& F, int idx2, RetPre& P) {
    const int bh = idx2 >> 4, n = idx2 & 15, b = bh >> 2, h = bh & 3, tok0 = b * SEQ + n * 128, tid = F.tid;
    const bf16_t* RQK = (const bf16_t*)(F.ws + WS_RQK);
#pragma unroll
    for (int i = 0; i < 4; ++i) { const int p = tid + i * 512, c = p >> 4, d0 = (p & 15) * 8; P.q[i] = *(const u32x4*)((const unsigned char*)RQK + (unsigned)(((tok0 + c) * 1024 + h * 128 + d0) * 2)); }
#pragma unroll
    for (int i = 0; i < 4; ++i) { const int p = tid + i * 512, c = p >> 4, d0 = (p & 15) * 8; P.k[i] = *(const u32x4*)((const unsigned char*)RQK + (unsigned)(((tok0 + c) * 1024 + 512 + h * 128 + d0) * 2)); }
}
__device__ __forceinline__ void ret_out_item(Frame& F, int idx2, int idx_next, RetPre& P) {
    const int bh = idx2 >> 4, n = idx2 & 15, b = bh >> 2, h = bh & 3;
    const int tok0 = b * SEQ + n * 128;
    LAS bf16_t* QN = (LAS bf16_t*)(F.lds);
    LAS bf16_t* SPn = (LAS bf16_t*)(F.lds + 34816);
    LAS bf16_t* KN = (LAS bf16_t*)(F.lds + 34816);
    LAS bf16_t* PM = (LAS bf16_t*)(F.lds + 69632);
    LAS bf16_t* VN = (LAS bf16_t*)(F.lds);
    LAS float*  NS = (LAS float*)(F.lds + 104448);
    const int tid = F.tid, lane = F.lane, fr = lane & 15, fq = lane >> 4, wave = F.wave;
    const float l2g = ret_log2_gamma(h);
    const bf16_t* RQK = (const bf16_t*)(F.ws + WS_RQK); const bf16_t* RV = (const bf16_t*)(F.ws + WS_RV);
    const bf16_t* SP = (const bf16_t*)(F.ws + WS_KV) + (size_t)idx2 * 32768;
#define SB() __builtin_amdgcn_sched_barrier(0)
    u32x4 kreg[4];
    {
        u32x4 sreg[8];
#pragma unroll
        for (int i = 0; i < 8; ++i) { const int p = tid + i * 512; sreg[i] = *(const u32x4*)((const unsigned char*)SP + (unsigned)(p * 16)); }
#pragma unroll
        for (int i = 0; i < 4; ++i) { const int p = tid + i * 512, c = p >> 4, d0 = (p & 15) * 8; *(LAS u32x4*)(QN + c * 136 + d0) = P.q[i]; kreg[i] = P.k[i]; }
#pragma unroll
        for (int i = 0; i < 8; ++i) { const int p = tid + i * 512, r = p >> 4, d0 = (p & 15) * 8; *(LAS u32x4*)(SPn + r * 136 + d0) = sreg[i]; }
    }
    LBAR();
    const int wi = wave >> 1, wd = wave & 1;
    f32x4 a1[8][2];
#pragma unroll
    for (int d = 0; d < 8; ++d) { a1[d][0] = (f32x4){0.f, 0.f, 0.f, 0.f}; a1[d][1] = a1[d][0]; }
    {
        const float qd0 = exp2f(l2g * (float)((2 * wi) * 16 + fr + 1)), qd1 = exp2f(l2g * (float)((2 * wi + 1) * 16 + fr + 1));
        bf16x8 xa[8], qa[2];
#define LD0(x, q, ks) do { _Pragma("unroll") for (int _d = 0; _d < 8; ++_d) x[_d] = lfrag(SPn, 136, (wd * 8 + _d) * 16, (ks) * 32, fr, fq); \
        q[0] = lfrag(QN, 136, (2 * wi) * 16, (ks) * 32, fr, fq); q[1] = lfrag(QN, 136, (2 * wi + 1) * 16, (ks) * 32, fr, fq); } while (0)
#define MM0(x, q) do { const bf16x8 _q0 = scale_frag(q[0], qd0), _q1 = scale_frag(q[1], qd1); _Pragma("unroll") for (int _d = 0; _d < 8; ++_d) { a1[_d][0] = mma16(x[_d], _q0, a1[_d][0]); a1[_d][1] = mma16(x[_d], _q1, a1[_d][1]); } } while (0)
        LD0(xa, qa, 0); SB(); MM0(xa, qa); SB(); LD0(xa, qa, 1); SB(); MM0(xa, qa); SB(); LD0(xa, qa, 2); SB(); MM0(xa, qa); SB(); LD0(xa, qa, 3); SB(); MM0(xa, qa); SB();
#undef LD0
#undef MM0
    }
    LBAR();
    u32x4 vreg[8];
#pragma unroll
    for (int i = 0; i < 8; ++i) { const int p = tid + i * 512, c = p >> 5, d0 = (p & 31) * 8; vreg[i] = *(const u32x4*)((const unsigned char*)RV + (unsigned)(((tok0 + c) * 1024 + h * 256 + d0) * 2)); }
#pragma unroll
    for (int i = 0; i < 4; ++i) { const int p = tid + i * 512, c = p >> 4, d0 = (p & 15) * 8; *(LAS u32x4*)(KN + c * 136 + d0) = kreg[i]; }
    LBAR();
    {
        bf16x8 yq[4];
#pragma unroll
        for (int ks = 0; ks < 4; ++ks) yq[ks] = lfrag(QN, 136, wave * 16, ks * 32, fr, fq);
        const int i = wave * 16 + fr;
        bf16x8 ka[4], kb[4];
#define LD1(k, jt) do { _Pragma("unroll") for (int _s = 0; _s < 4; ++_s) k[_s] = lfrag(KN, 136, (jt) * 16, _s * 32, fr, fq); } while (0)
#define MM1(k, jt) do { f32x4 acc = {0.f, 0.f, 0.f, 0.f}; _Pragma("unroll") for (int _s = 0; _s < 4; ++_s) acc = mma16(k[_s], yq[_s], acc); \
        float o[4]; _Pragma("unroll") for (int r = 0; r < 4; ++r) { const int j = (jt) * 16 + 4 * fq + r; o[r] = (j <= i) ? acc[r] * exp2f(l2g * (float)(i - j)) : 0.f; } \
        u32x2 w; w.x = pk2(o[0], o[1]); w.y = pk2(o[2], o[3]); *(LAS u32x2*)(PM + i * 136 + (jt) * 16 + 4 * fq) = w; } while (0)
        LD1(ka, 0); SB();
#pragma unroll
        for (int jt = 0; jt < 8; jt += 2) { LD1(kb, jt + 1); SB(); MM1(ka, jt); SB(); if (jt + 2 < 8) { LD1(ka, jt + 2); } SB(); MM1(kb, jt + 1); SB(); }
#undef LD1
#undef MM1
    }
    LBAR();
#pragma unroll
    for (int i = 0; i < 8; ++i) { const int p = tid + i * 512, c = p >> 5, d0 = (p & 31) * 8; *(LAS u32x4*)(VN + c * 264 + d0) = vreg[i]; }
    LBAR();
    const bf16_t* RG = (const bf16_t*)(F.ws + WS_RG);
    u32x2 gt[2][8];
    {
        bf16x8 xa[8], pa[2];
#define LD2(x, p, ks) do { _Pragma("unroll") for (int _d = 0; _d < 8; ++_d) x[_d] = tfrag(VN, 264, (ks) * 32, (wd * 8 + _d) * 16, lane); \
        p[0] = lfrag(PM, 136, (2 * wi) * 16, (ks) * 32, fr, fq); p[1] = lfrag(PM, 136, (2 * wi + 1) * 16, (ks) * 32, fr, fq); } while (0)
#define MM2(x, p) do { _Pragma("unroll") for (int _d = 0; _d < 8; ++_d) { a1[_d][0] = mma16(x[_d], p[0], a1[_d][0]); a1[_d][1] = mma16(x[_d], p[1], a1[_d][1]); } } while (0)
        LD2(xa, pa, 0); SB(); MM2(xa, pa); SB(); LD2(xa, pa, 1); SB(); MM2(xa, pa); SB(); LD2(xa, pa, 2); SB(); MM2(xa, pa); SB(); LD2(xa, pa, 3); SB(); MM2(xa, pa); SB();
#undef LD2
#undef MM2
    }
#undef SB
#define LDGATE(t) do { _Pragma("unroll") for (int d = 0; d < 8; ++d) gt[t][d] = *(const u32x2*)((const unsigned char*)RG + (unsigned)(((tok0 + (2 * wi + (t)) * 16 + fr) * 1024 + h * 256 + (wd * 8 + d) * 16 + 4 * fq) * 2)); } while (0)
    LDGATE(0);
    ret_out_fetch(F, idx_next >= 0 ? idx_next : idx2, P);
#pragma unroll
    for (int t = 0; t < 2; ++t) {
        const int i = (2 * wi + t) * 16 + fr;
        float s = 0.f;
#pragma unroll
        for (int d = 0; d < 8; ++d) { const f32x4 v = a1[d][t]; s += (v[0] * v[0] + v[1] * v[1]) + (v[2] * v[2] + v[3] * v[3]); }
        s += __shfl_xor(s, 16); s += __shfl_xor(s, 32);
        if (fq == 0) NS[i * 2 + wd] = s;
    }
    LBAR();
    bf16_t* YB = (bf16_t*)(F.ws + WS_YB);
#pragma unroll
    for (int t = 0; t < 2; ++t) {
        const int i = (2 * wi + t) * 16 + fr;
        const float rstd = rsqrtf_((NS[i * 2] + NS[i * 2 + 1]) * (1.0f / 256.0f) + EPS);
        if (t == 0) { LDGATE(1); }
#pragma unroll
        for (int d = 0; d < 8; ++d) {
            const int dv = (wd * 8 + d) * 16 + 4 * fq;
            const f32x4 v = a1[d][t] * rstd;
            u32x2 w; w.x = pk2(v[0] * siluf_(bflo(gt[t][d].x)), v[1] * siluf_(bfhi(gt[t][d].x))); w.y = pk2(v[2] * siluf_(bflo(gt[t][d].y)), v[3] * siluf_(bfhi(gt[t][d].y)));
            *(u32x2*)(YB + (size_t)(tok0 + i) * 1024 + h * 256 + dv) = w;
        }
    }
#undef LDGATE
    LBAR();
}

__device__ __forceinline__ void gdn_normgate_row(Frame& F, int m) {
    const int lane = F.lane;
    const u32x4 ow = *(const u32x4*)((const bf16_t*)(F.ws + WS_OGDN) + (size_t)m * 512 + lane * 8);
    const u32x4 z = *(const u32x4*)((const bf16_t*)(F.ws + WS_GZ) + (size_t)m * 512 + lane * 8);
    float o[8] = {bflo(ow.x), bfhi(ow.x), bflo(ow.y), bfhi(ow.y), bflo(ow.z), bfhi(ow.z), bflo(ow.w), bfhi(ow.w)};
    float ss = 0.f;
#pragma unroll
    for (int e = 0; e < 8; ++e) ss += o[e] * o[e];
    ss = row16_sum(ss);
    const float rstd = rsqrtf_(ss * (1.0f / 128.0f) + EPS);
    const float* nw = F.in[I_GNW] + (lane & 15) * 8;
    const f32x4 w0 = *(const f32x4*)nw, w1 = *(const f32x4*)(nw + 4);
    u32x4 y;
    y.x = pk2(o[0] * rstd * w0[0] * siluf_(bflo(z.x)), o[1] * rstd * w0[1] * siluf_(bfhi(z.x)));
    y.y = pk2(o[2] * rstd * w0[2] * siluf_(bflo(z.y)), o[3] * rstd * w0[3] * siluf_(bfhi(z.y)));
    y.z = pk2(o[4] * rstd * w1[0] * siluf_(bflo(z.z)), o[5] * rstd * w1[1] * siluf_(bfhi(z.z)));
    y.w = pk2(o[6] * rstd * w1[2] * siluf_(bflo(z.w)), o[7] * rstd * w1[3] * siluf_(bfhi(z.w)));
    *(u32x4*)((bf16_t*)(F.ws + WS_YA) + (size_t)m * 512 + lane * 8) = y;
}

struct EpiUp1 {
    static constexpr bool PERM = true;
    unsigned char* ws;
    __device__ __forceinline__ void operator()(const f32x4 (&acc)[2][2][4][2], const pg8::Unit& u, int wr, int wc, int fr, int fq) const {
        const int row0 = u.pm * 256 + wr * 64 + fr, col0 = u.pn * 256 + wc * 32 + 8 * fq;
        const bf16_t* MAB = (const bf16_t*)(ws + WS_MAB); float* TMP = (float*)(ws + WS_TMP);
#pragma unroll
        for (int ai = 0; ai < 2; ++ai)
#pragma unroll
            for (int m = 0; m < 4; ++m) { const int row = row0 + ai * 128 + m * 16;
#pragma unroll
                for (int bj = 0; bj < 2; ++bj) {
                    const int col = col0 + bj * 128;
                    const u32x4 g = *(const u32x4*)(MAB + (size_t)row * 2048 + col);
                    const f32x4 v0 = acc[ai][bj][m][0], v1 = acc[ai][bj][m][1];
                    f32x4 o0, o1;
                    o0[0] = v0[0] * sigmoidf_(bflo(g.x)); o0[1] = v0[1] * sigmoidf_(bfhi(g.x)); o0[2] = v0[2] * sigmoidf_(bflo(g.y)); o0[3] = v0[3] * sigmoidf_(bfhi(g.y));
                    o1[0] = v1[0] * sigmoidf_(bflo(g.z)); o1[1] = v1[1] * sigmoidf_(bfhi(g.z)); o1[2] = v1[2] * sigmoidf_(bflo(g.w)); o1[3] = v1[3] * sigmoidf_(bfhi(g.w));
                    float* p = TMP + (size_t)row * 1024 + col;
                    *(f32x4*)p = o0; *(f32x4*)(p + 4) = o1;
                } }
    }
};
struct EpiUp1R {
    static constexpr bool PERM = true;
    unsigned char* ws;
    __device__ __forceinline__ void operator()(f32x4 (&acc)[2][2][4][2], const pg8::Unit& u, int wr, int wc, int fr, int fq) const {
        const int row0 = u.pm * 256 + wr * 64 + fr, col0 = u.pn * 256 + wc * 32 + 8 * fq;
        const bf16_t* MAB = (const bf16_t*)(ws + WS_MAB);
#pragma unroll
        for (int ai = 0; ai < 2; ++ai)
#pragma unroll
            for (int m = 0; m < 4; ++m) { const int row = row0 + ai * 128 + m * 16;
#pragma unroll
                for (int bj = 0; bj < 2; ++bj) {
                    const int col = col0 + bj * 128;
                    const u32x4 ga = *(const u32x4*)(MAB + (size_t)row * 2048 + col), gb = *(const u32x4*)(MAB + (size_t)row * 2048 + 1024 + col);
                    const unsigned gaw[4] = {ga.x, ga.y, ga.z, ga.w}, gbw[4] = {gb.x, gb.y, gb.z, gb.w};
#pragma unroll
                    for (int q = 0; q < 4; ++q) {
                        const float a0 = bflo(gaw[q]), a1 = bfhi(gaw[q]), b0 = fmaxf(bflo(gbw[q]), -80.f), b1 = fmaxf(bfhi(gbw[q]), -80.f);
                        const float r0 = (1.0f + __builtin_amdgcn_exp2f(-1.4426950408889634f * b0)) * sigmoidf_(a0);
                        const float r1 = (1.0f + __builtin_amdgcn_exp2f(-1.4426950408889634f * b1)) * sigmoidf_(a1);
                        acc[ai][bj][m][q >> 1][(q & 1) * 2] *= r0; acc[ai][bj][m][q >> 1][(q & 1) * 2 + 1] *= r1;
                    }
                    asm volatile("" : "+v"(acc[ai][bj][m][0]), "+v"(acc[ai][bj][m][1]) :: "memory");
                } }
    }
};
struct EpiUp2R {
    static constexpr bool PERM = true;
    unsigned char* ws;
    __device__ __forceinline__ void operator()(const f32x4 (&acc)[2][2][4][2], const pg8::Unit& u, int wr, int wc, int fr, int fq) const {
        const int row0 = u.pm * 256 + wr * 64 + fr, col0 = u.pn * 256 + wc * 32 + 8 * fq;
        const bf16_t* MAB = (const bf16_t*)(ws + WS_MAB); bf16_t* MG = (bf16_t*)(ws + WS_MERGED);
#pragma unroll
        for (int ai = 0; ai < 2; ++ai)
#pragma unroll
            for (int m = 0; m < 4; ++m) { const int row = row0 + ai * 128 + m * 16;
#pragma unroll
                for (int bj = 0; bj < 2; ++bj) {
                    const int col = col0 + bj * 128;
                    const u32x4 g = *(const u32x4*)(MAB + (size_t)row * 2048 + 1024 + col);
                    const f32x4 v0 = acc[ai][bj][m][0], v1 = acc[ai][bj][m][1];
                    u32x4 w;
                    w.x = pk2(v0[0] * sigmoidf_(fmaxf(bflo(g.x), -80.f)), v0[1] * sigmoidf_(fmaxf(bfhi(g.x), -80.f)));
                    w.y = pk2(v0[2] * sigmoidf_(fmaxf(bflo(g.y), -80.f)), v0[3] * sigmoidf_(fmaxf(bfhi(g.y), -80.f)));
                    w.z = pk2(v1[0] * sigmoidf_(fmaxf(bflo(g.z), -80.f)), v1[1] * sigmoidf_(fmaxf(bfhi(g.z), -80.f)));
                    w.w = pk2(v1[2] * sigmoidf_(fmaxf(bflo(g.w), -80.f)), v1[3] * sigmoidf_(fmaxf(bfhi(g.w), -80.f)));
                    __builtin_nontemporal_store(w, (u32x4*)(MG + (size_t)row * 1024 + col));
                } }
    }
};
struct EpiUp2 {
    static constexpr bool PERM = true;
    unsigned char* ws;
    __device__ __forceinline__ void operator()(const f32x4 (&acc)[2][2][4][2], const pg8::Unit& u, int wr, int wc, int fr, int fq) const {
        const int row0 = u.pm * 256 + wr * 64 + fr, col0 = u.pn * 256 + wc * 32 + 8 * fq;
        const bf16_t* MAB = (const bf16_t*)(ws + WS_MAB); const float* TMP = (const float*)(ws + WS_TMP); bf16_t* MG = (bf16_t*)(ws + WS_MERGED);
#pragma unroll
        for (int ai = 0; ai < 2; ++ai)
#pragma unroll
            for (int m = 0; m < 4; ++m) { const int row = row0 + ai * 128 + m * 16;
#pragma unroll
                for (int bj = 0; bj < 2; ++bj) {
                    const int col = col0 + bj * 128;
                    const u32x4 g = *(const u32x4*)(MAB + (size_t)row * 2048 + 1024 + col);
                    const float* p = TMP + (size_t)row * 1024 + col;
                    const f32x4 t0 = *(const f32x4*)p, t1 = *(const f32x4*)(p + 4);
                    const f32x4 v0 = acc[ai][bj][m][0], v1 = acc[ai][bj][m][1];
                    u32x4 w;
                    w.x = pk2(t0[0] + v0[0] * sigmoidf_(bflo(g.x)), t0[1] + v0[1] * sigmoidf_(bfhi(g.x)));
                    w.y = pk2(t0[2] + v0[2] * sigmoidf_(bflo(g.y)), t0[3] + v0[3] * sigmoidf_(bfhi(g.y)));
                    w.z = pk2(t1[0] + v1[0] * sigmoidf_(bflo(g.z)), t1[1] + v1[1] * sigmoidf_(bfhi(g.z)));
                    w.w = pk2(t1[2] + v1[2] * sigmoidf_(bflo(g.w)), t1[3] + v1[3] * sigmoidf_(bfhi(g.w)));
                    *(u32x4*)(MG + (size_t)row * 1024 + col) = w;
                } }
    }
};
struct EpiOut {
    static constexpr bool PERM = false;
    const float* x; float* h;
    __device__ __forceinline__ void operator()(const f32x4 (&acc)[2][2][4][2], const pg8::Unit& u, int wr, int wc, int fr, int fq) const {
        const int row0 = u.pm * 256 + wr * 64 + fr, col0 = u.pn * 256 + wc * 32 + 4 * fq;
#pragma unroll
        for (int ai = 0; ai < 2; ++ai)
#pragma unroll
            for (int m = 0; m < 4; ++m) { const size_t off = (size_t)(row0 + ai * 128 + m * 16) * 1024 + col0;
#pragma unroll
                for (int bj = 0; bj < 2; ++bj)
#pragma unroll
                    for (int n = 0; n < 2; ++n) *(f32x4*)(h + off + bj * 128 + n * 16) = __builtin_nontemporal_load((const f32x4*)(x + off + bj * 128 + n * 16)) + acc[ai][bj][m][n]; }
    }
};

__device__ __forceinline__ void router_wave16(Frame& F, int t, bool commit) {
    const int lane = F.lane, fr = lane & 15, fq = lane >> 4, tok0 = t * 16;
    LAS float* PLw = (LAS float*)(F.lds + F.wave * 16384);
    LAS float* RSw = PLw + 16 * 49;
    const float* hb = (const float*)F.out; const float* wrt = (const float*)(F.ws + WS_WRT);
    f32x4 acc[3];
#pragma unroll
    for (int ct = 0; ct < 3; ++ct) acc[ct] = (f32x4){0.f, 0.f, 0.f, 0.f};
    float ssq = 0.f;
    const float* hp = hb + (size_t)(tok0 + fr) * DM + 4 * fq;
    const float* wp = wrt + (size_t)fr * DM + 4 * fq;
#pragma unroll 4
    for (int g = 0; g < 64; ++g) {
        const f32x4 xv = *(const f32x4*)(hp + 16 * g);
        ssq += (xv.x * xv.x + xv.y * xv.y) + (xv.z * xv.z + xv.w * xv.w);
#pragma unroll
        for (int ct = 0; ct < 3; ++ct) {
            const f32x4 wv = *(const f32x4*)(wp + ct * 16 * DM + 16 * g);
#pragma unroll
            for (int e = 0; e < 4; ++e) acc[ct] = __builtin_amdgcn_mfma_f32_16x16x4f32(wv[e], xv[e], acc[ct], 0, 0, 0);
        }
    }
    ssq += __shfl_xor(ssq, 16); ssq += __shfl_xor(ssq, 32);
    const float rstd = rsqrtf_(ssq * (1.f / DM) + EPS);
#pragma unroll
    for (int ct = 0; ct < 3; ++ct)
#pragma unroll
        for (int r = 0; r < 4; ++r) PLw[fr * 49 + ct * 16 + 4 * fq + r] = acc[ct][r] * rstd;
    if (fq == 0) RSw[fr] = rstd;
    asm volatile("s_waitcnt lgkmcnt(0)" ::: "memory");
    if (lane < 16) {
        const int m = tok0 + lane;
        const LAS float* p0 = PLw + lane * 49;
        float gl[4];
#pragma unroll
        for (int j = 0; j < 4; ++j) gl[j] = p0[j] + F.in[I_BGRP][j];
        int gi = 0; float gm = gl[0];
        if (gl[1] > gm) { gm = gl[1]; gi = 1; } if (gl[2] > gm) { gm = gl[2]; gi = 2; } if (gl[3] > gm) { gm = gl[3]; gi = 3; }
        const float gp = 1.0f / (__expf(gl[0] - gm) + __expf(gl[1] - gm) + __expf(gl[2] - gm) + __expf(gl[3] - gm));
        int i0 = 0, i1 = 0; float v0 = -3.0e38f, v1 = -3.0e38f;
#pragma unroll
        for (int i = 0; i < 8; ++i) {
            const float ev = p0[4 + gi * 8 + i] + F.in[I_BEXP][gi * 8 + i];
            if (ev > v0) { v1 = v0; i1 = i0; v0 = ev; i0 = i; } else if (ev > v1) { v1 = ev; i1 = i; }
        }
        const float w0 = gp / (1.0f + __expf(v1 - v0)), w1 = gp / (1.0f + __expf(v0 - v1));
        if (commit) {
            int* LTOK = (int*)(F.ws + WS_LTOK); int* LDST = (int*)(F.ws + WS_LDST); float* LW = (float*)(F.ws + WS_LW);
            unsigned* cnt = (unsigned*)(F.ws + WS_CTL) + CW_CNT;
            const int e0 = gi * 8 + i0, e1 = gi * 8 + i1;
            const unsigned q0 = __hip_atomic_fetch_add(cnt + e0, 1u, __ATOMIC_RELAXED, __HIP_MEMORY_SCOPE_AGENT);
            LTOK[e0 * 16384 + q0] = m; LDST[e0 * 16384 + q0] = 2 * m; LW[e0 * 16384 + q0] = w0;
            const unsigned q1 = __hip_atomic_fetch_add(cnt + e1, 1u, __ATOMIC_RELAXED, __HIP_MEMORY_SCOPE_AGENT);
            LTOK[e1 * 16384 + q1] = m; LDST[e1 * 16384 + q1] = 2 * m + 1; LW[e1 * 16384 + q1] = w1;
        }
    }
    f32x4 wn[4];
#pragma unroll
    for (int q = 0; q < 4; ++q) wn[q] = *(const f32x4*)(F.in[I_NFW] + 16 * lane + 4 * q);
#pragma unroll 2
    for (int j = 0; j < 16; ++j) {
        const float rs = RSw[j];
        const float* hr = hb + (size_t)(tok0 + j) * DM + 16 * lane;
        f32x4 a[4];
#pragma unroll
        for (int q = 0; q < 4; ++q) a[q] = *(const f32x4*)(hr + 4 * q);
        u32x4 o0, o1;
        o0.x = pk2(a[0].x * rs * wn[0].x, a[0].y * rs * wn[0].y); o0.y = pk2(a[0].z * rs * wn[0].z, a[0].w * rs * wn[0].w);
        o0.z = pk2(a[1].x * rs * wn[1].x, a[1].y * rs * wn[1].y); o0.w = pk2(a[1].z * rs * wn[1].z, a[1].w * rs * wn[1].w);
        o1.x = pk2(a[2].x * rs * wn[2].x, a[2].y * rs * wn[2].y); o1.y = pk2(a[2].z * rs * wn[2].z, a[2].w * rs * wn[2].w);
        o1.z = pk2(a[3].x * rs * wn[3].x, a[3].y * rs * wn[3].y); o1.w = pk2(a[3].z * rs * wn[3].z, a[3].w * rs * wn[3].w);
        bf16_t* xo = (bf16_t*)(F.ws + WS_XN) + (size_t)(tok0 + j) * DM + 16 * lane;
        *(u32x4*)xo = o0; *(u32x4*)(xo + 8) = o1;
    }
    asm volatile("s_waitcnt lgkmcnt(0)" ::: "memory");
}
constexpr int CW_CONV = 320;
__device__ __forceinline__ void p7_router(Frame& F, bool commit) {
    const int gw = F.vcu * NWAVES + F.wave, NGW = F.G * NWAVES;
    for (int t = F.vcu + F.G * F.wave; t < M / 16; t += F.G * NWAVES) router_wave16(F, t, commit);
    (void)gw; (void)NGW;
    LAS float* scr = (LAS float*)(F.lds + F.wave * 16384);
    constexpr int IG = 16 * 16, ID = 8 * 32, IPE = 2 * IG + ID;
    const float* wg = F.in[I_WGATE]; const float* wu = F.in[I_WUP]; const float* wdn = F.in[I_WDOWN]; unsigned char* ws = F.ws;
    auto dec = [=](int it) -> TrItem {
        const int e = it / IPE; int r = it % IPE; TrItem t;
        if (r < 2 * IG) { const int up = r >= IG; if (up) r -= IG; const int nb = r % 16, kb = r / 16, n0 = nb * 32;
            t.W = (up ? wu : wg) + (size_t)e * 1024 * 512; t.ldw = 512; t.col0 = n0; t.WT = (bf16_t*)(ws + WS_WGU) + (size_t)e * 1024 * 1024; t.K = 1024;
            t.row0 = (n0 >> 7) * 256 + (up ? 128 : 0) + (n0 & 127); t.k0 = kb * 64; return t; }
        r -= 2 * IG; const int nb = r % 32, kb = r / 32;
        t.W = wdn + (size_t)e * 512 * 1024; t.ldw = 1024; t.col0 = nb * 32; t.WT = (bf16_t*)(ws + WS_WD) + (size_t)e * 1024 * 512; t.K = 512; t.row0 = nb * 32; t.k0 = kb * 64; return t;
    };
    {
        const int NIT = NE * IPE, per = (NIT + F.G - 1) / F.G, base = F.vcu * per, lim = (base + per < NIT) ? base + per : NIT; const int lane = F.lane;
        volatile LAS unsigned* qc = F.MISC + 16;
        auto grab = [&]() -> int { unsigned v = 0; if (lane == 0) v = __hip_atomic_fetch_add((LAS unsigned*)qc, 1u, __ATOMIC_RELAXED, __HIP_MEMORY_SCOPE_WORKGROUP); return base + __builtin_amdgcn_readfirstlane((int)v); };
        f32x4 la[8], lb[8];
        int ia = grab(), ib;
        TrItem ta, tb;
        if (ia < lim) { ta = dec(ia); tr_load(ta, lane, la); }
        while (ia < lim) {
            ib = grab();
            if (ib < lim) { tb = dec(ib); tr_load(tb, lane, lb); }
            tr_store(ta, lane, la, scr);
            if (ib >= lim) break;
            ia = grab();
            if (ia < lim) { ta = dec(ia); tr_load(ta, lane, la); }
            tr_store(tb, lane, lb, scr);
        }
    }
}

constexpr int TOFF_OFF = MISC_OFF + 512;
constexpr int MYU_OFF = MISC_OFF + 768;
constexpr int CW_TILE = 8192;
struct MoeProb {
    const LAS int* toff; const unsigned* cnt; const int* ltok; unsigned* tilecnt;
    const bf16_t* A; const bf16_t* Bt; int K; int G, c; int total;
    __device__ __forceinline__ void unit_of(int L, pg8::Unit& u) const {
        const int tile = L >> 2; int e = 0;
#pragma unroll 1
        for (int s = 16; s > 0; s >>= 1) if (toff[e + s] <= tile) e += s;
        u.e = e; u.pm = tile - toff[e]; u.pn = L & 3; u.base = tile * 256;
        const int c_e = (int)cnt[e]; const int rem = c_e - u.pm * 256; u.rows = rem < 256 ? rem : 256;
    }
    __device__ __forceinline__ bool next(int i, pg8::Unit& u) const { const int L = i * G + c; if (L >= total) return false; unit_of(L, u); return true; }
    __device__ __forceinline__ int a_row(const pg8::Unit& u, int r) const { return ltok[u.e * 16384 + u.pm * 256 + (r < u.rows ? r : 0)]; }
    __device__ __forceinline__ const char* a_ptr(const pg8::Unit& u) const { return (const char*)A; }
    __device__ __forceinline__ const char* a_ptr_rows(const pg8::Unit& u) const { return (const char*)A + (size_t)u.base * K * 2; }
    __device__ __forceinline__ const char* b_ptr(const pg8::Unit& u) const { return (const char*)Bt + ((size_t)u.e * 1024 + u.pn * 256) * K * 2; }
    __device__ __forceinline__ void a_ready(const pg8::Unit&) const {}
    __device__ __forceinline__ void done(const pg8::Unit& u) const {
        asm volatile("s_waitcnt vmcnt(0)" ::: "memory");
        if ((threadIdx.x & 63) == 0) __hip_atomic_fetch_add(tilecnt + 64 * (u.base >> 8), 1u, __ATOMIC_RELAXED, __HIP_MEMORY_SCOPE_AGENT);
    }
};
struct MoeProbD : MoeProb {
    const LAS int* myu;
    __device__ __forceinline__ const char* a_ptr(const pg8::Unit& u) const { return a_ptr_rows(u); }
    __device__ __forceinline__ bool next(int i, pg8::Unit& u) const { if (i >= myu[0]) return false; unit_of(myu[1 + i], u); return true; }
    __device__ __forceinline__ void done(const pg8::Unit&) const {}
    __device__ __forceinline__ void a_ready(const pg8::Unit& u) const {
        if (threadIdx.x < 64) {
            const unsigned* w = tilecnt + 64 * (u.base >> 8); unsigned polls = 0;
            while ((unsigned)__builtin_amdgcn_readfirstlane(__hip_atomic_load(w, __ATOMIC_RELAXED, __HIP_MEMORY_SCOPE_AGENT)) < 32u) {
                __builtin_amdgcn_s_sleep(2);
                if (++polls > (1u << 20)) break;
            }
            __builtin_amdgcn_fence(__ATOMIC_ACQUIRE, "agent");
            asm volatile("s_waitcnt vmcnt(0)" ::: "memory");
        }
        asm volatile("" ::: "memory"); __builtin_amdgcn_s_barrier(); asm volatile("" ::: "memory");
    }
};
struct EpiGU {
    static constexpr bool PERM = true;
    bf16_t* hid;
    __device__ __forceinline__ void operator()(const f32x4 (&acc)[2][2][4][2], const pg8::Unit& u, int wr, int wc, int fr, int fq) const {
        const int col0 = u.pn * 128 + wc * 32 + 8 * fq;
#pragma unroll
        for (int ai = 0; ai < 2; ++ai)
#pragma unroll
            for (int m = 0; m < 4; ++m) { const int r = ai * 128 + wr * 64 + m * 16 + fr;
                const f32x4 g0 = acc[ai][0][m][0], g1 = acc[ai][0][m][1], u0 = acc[ai][1][m][0], u1 = acc[ai][1][m][1];
                u32x4 w;
                w.x = pk2(siluf_(g0[0]) * u0[0], siluf_(g0[1]) * u0[1]); w.y = pk2(siluf_(g0[2]) * u0[2], siluf_(g0[3]) * u0[3]);
                w.z = pk2(siluf_(g1[0]) * u1[0], siluf_(g1[1]) * u1[1]); w.w = pk2(siluf_(g1[2]) * u1[2], siluf_(g1[3]) * u1[3]);
                { bf16_t* p = hid + (size_t)(u.base + r) * 512 + col0; asm volatile("global_store_dwordx4 %0, %1, off sc1\n\ts_nop 1" :: "v"(p), "v"(w) : "memory"); } }
    }
};
struct EpiDown {
    static constexpr bool PERM = true;
    bf16_t* y2; const int* ldst; const float* lw;
    __device__ __forceinline__ void operator()(const f32x4 (&acc)[2][2][4][2], const pg8::Unit& u, int wr, int wc, int fr, int fq) const {
        const int col0 = u.pn * 256 + wc * 32 + 8 * fq;
#pragma unroll
        for (int ai = 0; ai < 2; ++ai)
#pragma unroll
            for (int m = 0; m < 4; ++m) { const int r = ai * 128 + wr * 64 + m * 16 + fr;
                if (r < u.rows) {
                    const int li = u.e * 16384 + u.pm * 256 + r; const int dst = ldst[li]; const float cw = lw[li];
#pragma unroll
                    for (int bj = 0; bj < 2; ++bj) { const f32x4 v0 = acc[ai][bj][m][0] * cw, v1 = acc[ai][bj][m][1] * cw;
                        u32x4 w; w.x = pk2(v0[0], v0[1]); w.y = pk2(v0[2], v0[3]); w.z = pk2(v1[0], v1[1]); w.w = pk2(v1[2], v1[3]);
                        __builtin_nontemporal_store(w, (u32x4*)(y2 + (size_t)dst * 1024 + col0 + bj * 128)); }
                } }
    }
};
__device__ __forceinline__ void moe_toff(Frame& F) {
    LAS int* toff = (LAS int*)(F.lds + TOFF_OFF);
    __syncthreads();
    if (F.tid == 0) { const unsigned* cnt = (const unsigned*)(F.ws + WS_CTL) + CW_CNT; int a = 0;
        for (int e = 0; e < NE; ++e) { toff[e] = a; a += ((int)cnt[e] + 255) >> 8; } toff[NE] = a; }
    __syncthreads();
}

__device__ __forceinline__ void moe_down_list(Frame& F, int U, int c) {
    LAS int* myu = (LAS int*)(F.lds + MYU_OFF);
    if (F.tid == 0) {
        const int G = F.G, A = U % G, k = U / G;
        int tH = 5 * (k + 1), tL = 5 * k, rem = U, j0 = 0, n = 0;
        while (rem > 0 && n < 30) {
            const bool heavy = (A > 0) && (tH < tL);
            const int gsz = heavy ? A : (G - A), rank = heavy ? c : (c - A);
            const int cntr = rem < gsz ? rem : gsz;
            if ((heavy ? (c < A) : (c >= A)) && rank < cntr) { myu[1 + n] = j0 + rank; ++n; }
            if (heavy) tH += 3; else tL += 3;
            j0 += cntr; rem -= cntr;
        }
        myu[0] = n;
    }
    __syncthreads();
}

struct FinPre { f32x4 h[4]; u32x2 a[4], b[4]; };
__device__ __forceinline__ void final_fetch(Frame& F, int m, FinPre& P) {
    const int lane = F.lane;
    const float* hr = F.out + (size_t)m * DM;
    const bf16_t* y0 = (const bf16_t*)(F.ws + WS_Y2) + (size_t)(2 * m) * DM; const bf16_t* y1 = y0 + DM;
#pragma unroll
    for (int j = 0; j < 4; ++j) {
        P.h[j] = __builtin_nontemporal_load((const f32x4*)(hr + 4 * lane + 256 * j));
        P.a[j] = __builtin_nontemporal_load((const u32x2*)(y0 + 4 * lane + 256 * j)); P.b[j] = __builtin_nontemporal_load((const u32x2*)(y1 + 4 * lane + 256 * j));
    }
}
__device__ __forceinline__ void final_row(Frame& F, int m, float* dstbase, const FinPre& P) {
    const int lane = F.lane;
    f32x4 v[4]; float s = 0.f;
#pragma unroll
    for (int j = 0; j < 4; ++j) {
        v[j] = P.h[j];
        const u32x2 a = P.a[j], b = P.b[j];
        v[j][0] += bflo(a.x) + bflo(b.x); v[j][1] += bfhi(a.x) + bfhi(b.x); v[j][2] += bflo(a.y) + bflo(b.y); v[j][3] += bfhi(a.y) + bfhi(b.y);
        s += (v[j].x * v[j].x + v[j].y * v[j].y) + (v[j].z * v[j].z + v[j].w * v[j].w);
    }
    const float rstd = 1.0f / sqrtf(wave_sum(s) * (1.f / DM) + EPS);
#pragma unroll
    for (int j = 0; j < 4; ++j) { const f32x4 w = *(const f32x4*)(F.in[I_NFINW] + 4 * lane + 256 * j); __builtin_nontemporal_store(v[j] * rstd * w, (f32x4*)(dstbase + (size_t)m * DM + 4 * lane + 256 * j)); }
}

__device__ __forceinline__ void ph1_body(Frame& F) {
    pg8::Dense P; P.init((const bf16_t*)(F.ws + WS_U), (const bf16_t*)(F.ws + WS_WINT), M, NP, DM, F.G, (int)blockIdx.x);
    EpiProj E{F.ws};
    pg8::gemm_phase<EpiProj, pg8::Dense, false, true, true>(F.lds, P, E);
}
__device__ __forceinline__ void ph5_body(Frame& F) {
    if (F.G * 1 >= (M / 256) * (DM / 256)) {
        f32x4 xacc[2][2][4][2];
        { pg8::Dense P; P.init((const bf16_t*)(F.ws + WS_YA), (const bf16_t*)(F.ws + WS_WUPA), M, DM, 512, F.G, (int)blockIdx.x);
          EpiUp1R E{F.ws}; pg8::gemm_phase<EpiUp1R, pg8::Dense, false, false, true, 1>(F.lds, P, E, xacc); }
        { pg8::Dense P; P.init((const bf16_t*)(F.ws + WS_YB), (const bf16_t*)(F.ws + WS_WUPR), M, DM, 1024, F.G, (int)blockIdx.x);
          EpiUp2R E{F.ws}; pg8::gemm_phase<EpiUp2R, pg8::Dense, false, false, true, 2>(F.lds, P, E, xacc); }
    } else {
        { pg8::Dense P; P.init((const bf16_t*)(F.ws + WS_YA), (const bf16_t*)(F.ws + WS_WUPA), M, DM, 512, F.G, (int)blockIdx.x);
          EpiUp1 E{F.ws}; pg8::gemm_phase<EpiUp1, pg8::Dense, false, false, true>(F.lds, P, E); }
        { pg8::Dense P; P.init((const bf16_t*)(F.ws + WS_YB), (const bf16_t*)(F.ws + WS_WUPR), M, DM, 1024, F.G, (int)blockIdx.x);
          EpiUp2 E{F.ws}; pg8::gemm_phase<EpiUp2, pg8::Dense, false, false, true>(F.lds, P, E); }
    }
}

struct Args { const float* in[19]; float* out; unsigned char* ws; int ph_lo, ph_hi; };
__global__ void __launch_bounds__(NTHR, 2) hgrh_fwd(Args args) {
    extern __shared__ __attribute__((aligned(16))) unsigned char lds_raw[];
    Frame F;
    F.lds = (LAS unsigned char*)lds_raw;
    F.MISC = (volatile LAS unsigned*)(F.lds + MISC_OFF);
    F.tid = threadIdx.x; F.lane = F.tid & 63; F.wave = __builtin_amdgcn_readfirstlane(F.tid >> 6);
    F.G = gridDim.x; { const int bx = blockIdx.x; F.vcu = (F.G % 8 == 0) ? (bx % 8) * (F.G / 8) + bx / 8 : bx; }
#pragma unroll
    for (int i = 0; i < 19; ++i) F.in[i] = args.in[i];
    F.out = args.out; F.ws = args.ws;
    F.ctl = (GAS unsigned*)(args.ws + WS_CTL);
    for (int u = F.tid; u < (LDS_BYTES - MISC_OFF) / 4; u += NTHR) ((LAS unsigned*)(F.lds + MISC_OFF))[u] = 0u;
    __syncthreads();
    const int lo = args.ph_lo, hi = args.ph_hi;
    XcdBarrier bar; bar.bar = (unsigned*)(args.ws + WS_CTL) + CW_BAR; bar.x = 0; bar.st = nullptr;
    if (hi - lo > 1) bar = xcd_barrier_post((unsigned*)(args.ws + WS_CTL) + CW_BAR, F.MISC + 8);
#ifndef PH_MASK
#define PH_MASK 0xFFFF
#endif
#define IN(k) (((PH_MASK >> (k)) & 1) && lo <= (k) && (k) < hi)
#define SEAM(k) do { if (IN(k) && IN((k) + 1)) { xcd_barrier(bar); if (REPS(13) == 2) xcd_barrier(bar); } } while (0)
    const int gw = F.vcu * NWAVES + F.wave, NGW = F.G * NWAVES;

    if (IN(0)) { for (int rep = 0; rep < REPS(0); ++rep) p0_prologue(F); }
    SEAM(0);
    if (IN(1)) {
        ph1_body(F);
        if (REPS(1) == 2) ph1_body(F);
    }
    SEAM(1);
    if (IN(2)) {
        u32x4 pxw[2][7]; float pg = 0.f, pb = 0.f;
        for (int rep = 0; rep < REPS(2); ++rep) {
#ifdef PREP_PROBE
        if (F.vcu < 1024) gdn_prep_fetch(F, F.vcu, pxw, pg, pb);
        for (int it = F.vcu; it < 1024; it += F.G) gdn_prep_item<PREP_PROBE>(F, it, it + F.G < 1024 ? it + F.G : -1, pxw, pg, pb);
#endif
        if (F.vcu < 1024) gdn_prep_fetch(F, F.vcu, pxw, pg, pb);
        for (int it = F.vcu; it < 1024; it += F.G) gdn_prep_item<0>(F, it, it + F.G < 1024 ? it + F.G : -1, pxw, pg, pb);
        for (int it = F.vcu; it < 512; it += F.G) ret_kv_item(F, it);
        }
        if (REPS(11) == 2) { if (F.vcu < 1024) gdn_prep_fetch(F, F.vcu, pxw, pg, pb); for (int it = F.vcu; it < 1024; it += F.G) gdn_prep_item<0>(F, it, it + F.G < 1024 ? it + F.G : -1, pxw, pg, pb); }
        if (REPS(12) == 2) for (int it = F.vcu + 1024; it < 1024 + 512; it += F.G) ret_kv_item(F, it - 1024);
    }
    SEAM(2);
    if (IN(3)) {
        if (F.vcu < 64) {
#ifdef SCAN_PROBE
            gdn_scan_block<SCAN_PROBE>(F, F.vcu);
#endif
            for (int rep = 0; rep < REPS(3); ++rep) gdn_scan_block<0>(F, F.vcu); }
        else {
            const int NB = F.G - 64, ob = F.vcu - 64;
            for (int t = ob * NWAVES + F.wave; t < 2048; t += NB * NWAVES) ret_prefix_task(F, t);
            asm volatile("s_waitcnt vmcnt(0)" ::: "memory");
            __syncthreads();
            if (F.tid == 0) {
                unsigned* pc = (unsigned*)(F.ws + WS_CTL) + CW_PFX;
                __builtin_amdgcn_fence(__ATOMIC_RELEASE, "agent");
                asm volatile("s_waitcnt vmcnt(0)" ::: "memory");
                xb_add(pc, 1u);
                unsigned sp = 0;
                while (xb_ld(pc) < (unsigned)NB) { __builtin_amdgcn_s_sleep(2); if (++sp > (1u << 22)) break; }
                __builtin_amdgcn_fence(__ATOMIC_ACQUIRE, "agent");
                asm volatile("s_waitcnt vmcnt(0)" ::: "memory");
            }
            __syncthreads();
            for (int rep = 0; rep < REPS(4); ++rep) {
                RetPre RP;
                ret_out_fetch(F, ob < 512 ? ob : 0, RP);
                for (int it = ob; it < 512; it += NB) ret_out_item(F, it, it + NB < 512 ? it + NB : -1, RP);
            }
        }
    }
    SEAM(3);
    if (IN(4)) {
        for (int rep = 0; rep < REPS(14); ++rep)
        for (int m = gw; m < M; m += NGW) gdn_normgate_row(F, m);
    }
    SEAM(4);
    if (IN(5)) {
        ph5_body(F);
        if (REPS(5) == 2) ph5_body(F);
    }
    SEAM(5);
    if (IN(6)) {
        for (int rep = 0; rep < REPS(6); ++rep) {
        pg8::Dense P; P.init((const bf16_t*)(F.ws + WS_MERGED), (const bf16_t*)(F.ws + WS_WOUT), M, DM, DM, F.G, (int)blockIdx.x);
        EpiOut E{F.in[I_X], F.out}; pg8::gemm_phase<EpiOut, pg8::Dense, false, false, true>(F.lds, P, E);
        }
    }
    SEAM(6);
    if (IN(7)) { for (int rep = 0; rep < REPS(7); ++rep) { __syncthreads(); if (F.tid == 0) F.MISC[16] = 0u; __syncthreads(); p7_router(F, rep == REPS(7) - 1); } }
    SEAM(7);
    if (IN(8)) {
        moe_toff(F);
        MoeProb P; P.toff = (const LAS int*)(F.lds + TOFF_OFF); P.cnt = (const unsigned*)(F.ws + WS_CTL) + CW_CNT; P.ltok = (const int*)(F.ws + WS_LTOK); P.tilecnt = (unsigned*)(F.ws + WS_CTL) + CW_TILE;
        P.A = (const bf16_t*)(F.ws + WS_XN); P.Bt = (const bf16_t*)(F.ws + WS_WGU); P.K = 1024; P.G = F.G; P.c = F.vcu; P.total = 4 * P.toff[NE];
        moe_down_list(F, P.total, F.vcu);
        EpiGU E{(bf16_t*)(F.ws + WS_HID)};
        pg8::gemm_phase<EpiGU, MoeProb, true, true, true>(F.lds, P, E);
        MoeProbD Q; Q.toff = P.toff; Q.cnt = P.cnt; Q.ltok = P.ltok; Q.tilecnt = P.tilecnt; Q.myu = (const LAS int*)(F.lds + MYU_OFF);
        Q.A = (const bf16_t*)(F.ws + WS_HID); Q.Bt = (const bf16_t*)(F.ws + WS_WD); Q.K = 512; Q.G = F.G; Q.c = F.vcu; Q.total = P.total;
        EpiDown E2{(bf16_t*)(F.ws + WS_Y2), (const int*)(F.ws + WS_LDST), (const float*)(F.ws + WS_LW)};
        pg8::gemm_phase<EpiDown, MoeProbD, false, true, true>(F.lds, Q, E2);
    }
    SEAM(8);
    if (IN(10)) { for (int rep = 0; rep < REPS(10); ++rep) { float* dst = (rep == REPS(10) - 1) ? F.out : (float*)(F.ws + WS_MAB); FinPre fa, fb; final_fetch(F, gw < M ? gw : 0, fa); for (int m = gw; m < M; m += 2 * NGW) { const int m1 = m + NGW, m2 = m + 2 * NGW; if (m1 < M) final_fetch(F, m1, fb); final_row(F, m, dst, fa); if (m2 < M) final_fetch(F, m2, fa); if (m1 < M) final_row(F, m1, dst, fb); } } }
#undef IN
#undef SEAM
}

extern "C" void kernel_launch(void* const* d_in, const int* in_sizes, int n_in, void* d_out, int out_size, void* d_ws, size_t ws_size, hipStream_t stream) {
    static int grid = 0;
    if (grid == 0) {
        if (n_in != 19 || in_sizes[0] != M * DM || out_size != M * DM || ws_size < WS_END) {
            fprintf(stderr, "kernel_launch: unexpected problem (n_in %d, in0 %d, out %d, ws %zu < %zu); nothing launched\n", n_in, n_in > 0 ? in_sizes[0] : -1, out_size, ws_size, (size_t)WS_END); grid = -1; return; }
        int dev = 0, cus = 0;
        if (hipGetDevice(&dev) != hipSuccess || hipDeviceGetAttribute(&cus, hipDeviceAttributeMultiprocessorCount, dev) != hipSuccess) { grid = -1; return; }
        if (hipFuncSetAttribute((const void*)hgrh_fwd, hipFuncAttributeMaxDynamicSharedMemorySize, LDS_BYTES) != hipSuccess) { fprintf(stderr, "kernel_launch: hipFuncSetAttribute failed\n"); grid = -1; return; }
        int per_cu = 0;
        if (hipOccupancyMaxActiveBlocksPerMultiprocessor(&per_cu, (const void*)hgrh_fwd, NTHR, LDS_BYTES) != hipSuccess || per_cu < 1)
            fprintf(stderr, "kernel_launch: occupancy query reports %d workgroups per CU\n", per_cu);
        (void)hipGetLastError();
        grid = cus;
    }
    if (grid < 0) return;
    (void)hipMemsetAsync((char*)d_ws + WS_CTL, 0, CTL_ZERO_BYTES, stream);
    Args a{};
    for (int i = 0; i < 19; ++i) a.in[i] = (const float*)d_in[i];
    a.out = (float*)d_out; a.ws = (unsigned char*)d_ws;
#if MK_N_LAUNCHES == 1
    a.ph_lo = 0; a.ph_hi = NPH;
    hipLaunchKernelGGL(hgrh_fwd, dim3(grid), dim3(NTHR), LDS_BYTES, stream, a);
#else
    for (int p = 0; p < NPH; ++p) { a.ph_lo = p; a.ph_hi = p + 1; hipLaunchKernelGGL(hgrh_fwd, dim3(grid), dim3(NTHR), LDS_BYTES, stream, a); }
#endif
}
```

```cpp
#include <hip/hip_runtime.h>
#include <cstdio>
#include <cstdint>

#ifndef MK_N_LAUNCHES
#define MK_N_LAUNCHES 1
#endif

#ifndef REP_MASK
#define REP_MASK 0
#endif
#define REPS(k) (((REP_MASK >> (k)) & 1) ? 2 : 1)
#define LAS __attribute__((address_space(3)))
#define GAS __attribute__((address_space(1)))
typedef unsigned short bf16_t;
typedef short bf16x8 __attribute__((ext_vector_type(8)));
typedef short bf16x4 __attribute__((ext_vector_type(4)));
typedef float f32x4 __attribute__((ext_vector_type(4)));
typedef float f32x2 __attribute__((ext_vector_type(2)));
typedef unsigned u32x4 __attribute__((ext_vector_type(4)));
typedef unsigned u32x2 __attribute__((ext_vector_type(2)));

constexpr int BATCH = 8, SEQ = 2048, DM = 1024, M = BATCH * SEQ;
constexpr int D_IN = 7176, NP = 7168;
constexpr int NE = 32, DE = 512;
constexpr float EPS = 1e-6f;
constexpr int NWAVES = 8, NTHR = 512;
constexpr int NPH = 11;

constexpr size_t MiB = 1u << 20;
constexpr size_t WS_CTL = 0, CTL_ZERO_BYTES = 128 * 1024;
constexpr size_t WS_LTOK = 1 * MiB, WS_LDST = 3 * MiB, WS_LW = 5 * MiB;
constexpr size_t WS_ROPE = 7 * MiB;
constexpr size_t WS_G = 8 * MiB, WS_BETA = 8 * MiB + 256 * 1024;
constexpr size_t WS_WUPA = 9 * MiB, WS_WUPR = 10 * MiB, WS_WOUT = 12 * MiB;
constexpr size_t WS_WRT = 14 * MiB;
constexpr size_t WS_SSQ = 15 * MiB;
constexpr size_t WS_GQKV = 18 * MiB;
constexpr size_t WS_OGDN = 18 * MiB;
constexpr size_t WS_YB = 34 * MiB;
constexpr size_t WS_YA = 274 * MiB;
constexpr size_t WS_XN = 18 * MiB;
constexpr size_t WS_Y2 = 218 * MiB;
constexpr size_t WS_GZ = 66 * MiB;
constexpr size_t WS_RQK = 82 * MiB;
constexpr size_t WS_RV = 114 * MiB;
constexpr size_t WS_TMP = 82 * MiB;
constexpr size_t WS_WGU = 82 * MiB;
constexpr size_t WS_RG = 146 * MiB;
constexpr size_t WS_WD = 146 * MiB;
constexpr size_t WS_MAB = 178 * MiB;
constexpr size_t WS_HID = 178 * MiB;
constexpr size_t WS_U = 242 * MiB;
constexpr size_t WS_KV = 242 * MiB;
constexpr size_t WS_MERGED = 242 * MiB;
constexpr size_t WS_WINT = 274 * MiB;
constexpr size_t WS_UT = 274 * MiB;
constexpr size_t WS_END = 290 * MiB;
constexpr size_t GP_BYTES = 57344;
constexpr int GP_W = 0, GP_Q = 8192, GP_K = 16384, GP_A = 24576;
constexpr size_t DO_YA = 0, DO_YB = 16 * MiB;

constexpr int CW_TMO = 0;
constexpr int CW_CNT = 64;
constexpr int CW_PFX = 256;
constexpr int CW_BAR = 4096;

constexpr int RING_BYTES = 131072;
constexpr int MISC_OFF = RING_BYTES;
constexpr int LDS_BYTES = 147456;

#define LDS_WAIT() asm volatile("s_waitcnt lgkmcnt(0)" ::: "memory")
#define VM_WAIT() asm volatile("s_waitcnt vmcnt(0)" ::: "memory")
#define LBAR() do { asm volatile("s_waitcnt lgkmcnt(0)" ::: "memory"); __builtin_amdgcn_s_barrier(); asm volatile("" ::: "memory"); } while (0)
__device__ __forceinline__ unsigned f2bf(float f) { unsigned u = __builtin_bit_cast(unsigned, f); return (u + 0x7fffu + ((u >> 16) & 1u)) >> 16; }
typedef __bf16 bf16v2_t __attribute__((ext_vector_type(2)));
__device__ __forceinline__ unsigned pk2(float lo, float hi) { return __builtin_bit_cast(unsigned, __builtin_convertvector((f32x2){lo, hi}, bf16v2_t)); }
__device__ __forceinline__ float bf2f(unsigned short h) { return __builtin_bit_cast(float, (unsigned)h << 16); }
__device__ __forceinline__ float bflo(unsigned w) { return __builtin_bit_cast(float, w << 16); }
__device__ __forceinline__ float bfhi(unsigned w) { return __builtin_bit_cast(float, w & 0xffff0000u); }
template <int CTRL> __device__ __forceinline__ float dpp_f(float v) { return __builtin_bit_cast(float, __builtin_amdgcn_update_dpp(0, __builtin_bit_cast(int, v), CTRL, 0xf, 0xf, true)); }
__device__ __forceinline__ float row16_sum(float v) {
    v += dpp_f<0xB1>(v);
    v += dpp_f<0x4E>(v);
    v += dpp_f<0x141>(v);
    v += dpp_f<0x140>(v);
    return v;
}
__device__ __forceinline__ float rdlane(float v, int l) { return __builtin_bit_cast(float, __builtin_amdgcn_readlane(__builtin_bit_cast(int, v), l)); }
__device__ __forceinline__ float wave_sum(float v) {
    v = row16_sum(v);
    return (rdlane(v, 0) + rdlane(v, 16)) + (rdlane(v, 32) + rdlane(v, 48));
}
__device__ __forceinline__ float sigmoidf_(float x) { return __builtin_amdgcn_rcpf(1.0f + __builtin_amdgcn_exp2f(-1.4426950408889634f * x)); }
__device__ __forceinline__ float siluf_(float x) { return x * sigmoidf_(x); }
__device__ __forceinline__ float rsqrtf_(float x) { return __builtin_amdgcn_rsqf(x); }

#define XB_TMO      128
#define XB_XCNT(j)  (256  + 64 * (j))
#define XB_XSUB(j)  (1280 + 64 * (j))
#define XB_XGEN(j)  (2304 + 64 * (j))
#define XB_TOP      3328
#define XB_TOPGEN   3392
#define XCD_BAR_WORDS 3456
#define XB_SPIN_CAP (1u << 18)
__device__ __forceinline__ unsigned xb_ld(unsigned* p)              { return __hip_atomic_load(p, __ATOMIC_RELAXED, __HIP_MEMORY_SCOPE_AGENT); }
__device__ __forceinline__ unsigned xb_add(unsigned* p, unsigned v) { return __hip_atomic_fetch_add(p, v, __ATOMIC_RELAXED, __HIP_MEMORY_SCOPE_AGENT); }
__device__ __forceinline__ unsigned xb_xcc_id() { return (unsigned)__builtin_amdgcn_s_getreg((3 << 11) | 20) & 0xFu; }
#define XB_SPIN(cond, bar) do { unsigned _sp = 0; while (cond) { __builtin_amdgcn_s_sleep(1); \
    if ((++_sp & 255u) == 0u) { if (xb_ld(&(bar)[XB_TMO])) break; if (_sp > XB_SPIN_CAP) { atomicAdd(&(bar)[XB_TMO], 1u); break; } } } } while (0)
struct XcdBarrier { unsigned* bar; unsigned x; volatile LAS unsigned* st; };
__device__ __forceinline__ XcdBarrier xcd_barrier_post(unsigned* bar, volatile LAS unsigned* st) {
    XcdBarrier b; b.bar = bar; b.x = xb_xcc_id(); b.st = st;
    if (threadIdx.x == 0) (void)xb_add(&bar[XB_XCNT(b.x)], 1u);
    return b;
}
__device__ __forceinline__ void xcd_barrier_complete(unsigned* bar, unsigned x, unsigned& nloc, unsigned& nx) {
    const unsigned G = gridDim.x * gridDim.y * gridDim.z;
    unsigned sum, cnt, mine, sp = 0u;
    for (;;) {
        sum = 0u; cnt = 0u; mine = 0u;
#pragma unroll
        for (unsigned j = 0; j < 16; ++j) { const unsigned c = xb_ld(&bar[XB_XCNT(j)]); sum += c; cnt += (c > 0u) ? 1u : 0u; mine = (j == x) ? c : mine; }
        if (sum == G) break;
        __builtin_amdgcn_s_sleep(1);
        if ((++sp & 255u) == 0u) { if (xb_ld(&bar[XB_TMO])) break; if (sp > XB_SPIN_CAP) { atomicAdd(&bar[XB_TMO], 1u); break; } }
    }
    nloc = mine > 0u ? mine : 1u; nx = cnt > 0u ? cnt : 1u;
}
__device__ __forceinline__ void xcd_barrier(const XcdBarrier& b) {
    asm volatile("s_waitcnt vmcnt(0)" ::: "memory");
    __syncthreads();
    if (threadIdx.x == 0) {
        unsigned* bar = b.bar;
        __builtin_amdgcn_s_waitcnt(0);
        unsigned nloc = b.st[0], nx = b.st[1];
        if (nloc == 0u) { xcd_barrier_complete(bar, b.x, nloc, nx); b.st[0] = nloc; b.st[1] = nx; }
        const unsigned old = xb_add(&bar[XB_XSUB(b.x)], 1u);
        const unsigned gen = old / nloc;
        if (old + 1u == (gen + 1u) * nloc) {
            __builtin_amdgcn_fence(__ATOMIC_RELEASE, "agent");
            asm volatile("s_waitcnt vmcnt(0)" ::: "memory");
            const unsigned og = xb_add(&bar[XB_TOP], 1u);
            const unsigned tg = og / nx;
            if (og + 1u == (tg + 1u) * nx) xb_add(&bar[XB_TOPGEN], 1u);
            else XB_SPIN(xb_ld(&bar[XB_TOPGEN]) == tg, bar);
            __builtin_amdgcn_fence(__ATOMIC_ACQUIRE, "agent");
            xb_add(&bar[XB_XGEN(b.x)], 1u);
            asm volatile("s_waitcnt vmcnt(0)" ::: "memory");
        } else {
            XB_SPIN(xb_ld(&bar[XB_XGEN(b.x)]) == gen, bar);
            __builtin_amdgcn_fence(__ATOMIC_ACQUIRE, "agent");
            asm volatile("s_waitcnt vmcnt(0)" ::: "memory");
        }
    }
    __syncthreads();
}

namespace pg8 {
constexpr int BM = 256, BK = 64, HALF = 128, HTB = HALF * BK * 2, STAGE_BYTES = 8 * HTB, NXCD = 8, WGM = 8;
__host__ __device__ __forceinline__ int lds_byte(int r, int c) { const int st = (r >> 4) * 2 + (c >> 5), rr = r & 15, cc = c & 31, ob = rr * 64 + cc * 2; return st * 1024 + (ob ^ (((ob >> 9) & 1) << 5)); }
__host__ __device__ __forceinline__ void stage_rc(int b, int& R, int& C) { const int st = b / 1024, sb = b % 1024, swz = sb ^ (((sb >> 9) & 1) << 5); R = (st >> 1) * 16 + swz / 64; C = (st & 1) * 32 + (swz % 64) / 2; }
__host__ __device__ __forceinline__ int perm32(int rho) { const int n = rho >> 4, i = rho & 15; return 8 * (i >> 2) + 4 * n + (i & 3); }

struct Unit { int pm, pn, e, rows, base; };

__device__ __forceinline__ unsigned cvt_pk_bf16(float lo, float hi) { return pk2(lo, hi); }

struct Dense {
    const bf16_t* A; const bf16_t* Bt; int K; int nM, nN, nwg, G, c;
    __device__ void init(const bf16_t* A_, const bf16_t* Bt_, int M_, int N_, int K_, int G_, int c_) { A = A_; Bt = Bt_; K = K_; nM = M_ / BM; nN = N_ / BM; nwg = nM * nN; G = G_; c = c_; }
    __device__ __forceinline__ bool next(int i, Unit& u) const {
        const long L = (long)i * G + c; if (L >= nwg) return false;
        int wgid = (int)L; { const int q = nwg / NXCD, r = nwg % NXCD, xcd = wgid % NXCD, off = wgid / NXCD; wgid = (xcd < r ? xcd * (q + 1) : r * (q + 1) + (xcd - r) * q) + off; }
        const int nig = WGM * nN, gid = wgid / nig, fm = gid * WGM, gsz = (nM - fm) < WGM ? (nM - fm) : WGM;
        u.pm = fm + ((wgid % nig) % gsz); u.pn = (wgid % nig) / gsz; u.e = 0; u.rows = 256; u.base = 0; return true;
    }
    __device__ __forceinline__ const char* a_ptr(const Unit& u) const { return (const char*)A + (size_t)u.pm * (size_t)(2 * HALF) * K * 2; }
    __device__ __forceinline__ const char* b_ptr(const Unit& u) const { return (const char*)Bt + (size_t)u.pn * (size_t)(2 * HALF) * K * 2; }
    __device__ __forceinline__ void a_ready(const Unit&) const {}
    __device__ __forceinline__ void done(const Unit&) const {}
};

template <class Epi, class Prob, bool GATHER, bool ALIGN_EPI, bool SP2, int ACCMODE = 0>
__device__ __forceinline__ void gemm_phase(LAS unsigned char* lds, const Prob& S, const Epi& E, f32x4 (*xacc)[2][4][2] = nullptr) {
    const int tid = threadIdx.x, wid = __builtin_amdgcn_readfirstlane(tid >> 6), lane = tid & 63, wr = wid >> 2, wc = wid & 3, fr = lane & 15, fq = lane >> 4;
    const int K = S.K, nt = K / BK;
    unsigned voffB[2]; int RA[2], CA[2];
    unsigned cvo[2][2], nvo[2][2];
#pragma unroll
    for (int i = 0; i < 2; ++i) { int R, C; stage_rc(tid * 16 + i * 8192, R, C); const int Rb = Epi::PERM ? ((R & ~31) + perm32(R & 31)) : R;
        RA[i] = R; CA[i] = C; voffB[i] = (unsigned)(Rb * K + C) * 2u; }
    const size_t kstep = (size_t)(BK * 2);
    const size_t hstep = (size_t)HALF * K * 2;
    const unsigned ldsw = (unsigned)wid * 1024u;
    const int aoff = lds_byte(wr * 64 + fr, fq * 8), boff = lds_byte(wc * 32 + fr, fq * 8);
#define PG8_SA(b, h) (((b) * 2 + (h)) * HTB)
#define PG8_SB(b, h) ((4 + (b) * 2 + (h)) * HTB)
#define PG8_STAGE(bufoff, gbase, voff) do { _Pragma("unroll") for (int _i = 0; _i < 2; ++_i) \
        __builtin_amdgcn_global_load_lds((const unsigned*)((const char*)(gbase) + (voff)[_i]), (LAS unsigned*)(lds + (bufoff) + ldsw + _i * 8192), 16, 0, 0); } while (0)
#define PG8_LDA(dst, b, h) do { _Pragma("unroll") for (int m = 0; m < 4; ++m) _Pragma("unroll") for (int k = 0; k < 2; ++k) dst[m][k] = *(const LAS bf16x8*)(lds + PG8_SA(b, h) + aoff + m * 2048 + k * 1024); } while (0)
#define PG8_LDB(dst, b, h) do { _Pragma("unroll") for (int n = 0; n < 2; ++n) _Pragma("unroll") for (int k = 0; k < 2; ++k) dst[n][k] = *(const LAS bf16x8*)(lds + PG8_SB(b, h) + boff + n * 2048 + k * 1024); } while (0)
#define PG8_MMA(ai, bj, At, Bt) do { __builtin_amdgcn_s_setprio(1); _Pragma("unroll") for (int m = 0; m < 4; ++m) _Pragma("unroll") for (int n = 0; n < 2; ++n) _Pragma("unroll") for (int k = 0; k < 2; ++k) \
        acc[ai][bj][m][n] = __builtin_amdgcn_mfma_f32_16x16x32_bf16(Bt[n][k], At[m][k], acc[ai][bj][m][n], 0, 0, 0); __builtin_amdgcn_s_setprio(0); } while (0)
#define PG8_WAIT_V(n) asm volatile("s_waitcnt vmcnt(" #n ")" ::: "memory")
#define PG8_WAIT_L(n) asm volatile("s_waitcnt lgkmcnt(" #n ")" ::: "memory")
#define PG8_BAR __builtin_amdgcn_s_barrier()
#define PG8_SCHED __builtin_amdgcn_sched_barrier(0)
    Unit cur, nxt; int ui = 0;
    if (!S.next(0, cur)) return;
    f32x4 acc_local[2][2][4][2];
    f32x4 (&acc)[2][2][4][2] = (ACCMODE == 0) ? acc_local : *(f32x4 (*)[2][2][4][2])xacc;
    if constexpr (ACCMODE != 2) {
#pragma unroll
    for (int a = 0; a < 2; ++a)
#pragma unroll
        for (int b = 0; b < 2; ++b)
#pragma unroll
            for (int m = 0; m < 4; ++m)
#pragma unroll
                for (int n = 0; n < 2; ++n) acc[a][b][m][n] = (f32x4){0.f, 0.f, 0.f, 0.f};
    }
    bf16x8 At[4][2], B0[2][2], B1[2][2];
    S.a_ready(cur);
    const char* cA = S.a_ptr(cur); const char* cB = S.b_ptr(cur);
#pragma unroll
    for (int h = 0; h < 2; ++h)
#pragma unroll
        for (int i = 0; i < 2; ++i) {
            if constexpr (GATHER) cvo[h][i] = (unsigned)(((size_t)S.a_row(cur, h * HALF + RA[i]) * K + CA[i]) * 2u);
            else cvo[h][i] = (unsigned)((RA[i] * K + CA[i]) * 2u + h * hstep);
            nvo[h][i] = cvo[h][i];
        }
    if constexpr (SP2) {
        PG8_STAGE(PG8_SB(0, 0), cB, voffB); PG8_STAGE(PG8_SB(0, 1), cB + hstep, voffB); PG8_STAGE(PG8_SA(0, 0), cA, cvo[0]); PG8_STAGE(PG8_SA(0, 1), cA, cvo[1]);
        if (wr == 1) PG8_BAR;
        PG8_WAIT_V(2); PG8_BAR;
        PG8_STAGE(PG8_SB(1, 0), cB + kstep, voffB); PG8_STAGE(PG8_SA(1, 0), cA + kstep, cvo[0]); PG8_STAGE(PG8_SB(1, 1), cB + hstep + kstep, voffB);
        PG8_WAIT_V(6); PG8_BAR;
    } else {
        PG8_STAGE(PG8_SB(0, 0), cB, voffB); PG8_STAGE(PG8_SA(0, 0), cA, cvo[0]); PG8_STAGE(PG8_SB(0, 1), cB + hstep, voffB); PG8_STAGE(PG8_SA(0, 1), cA, cvo[1]);
        if (wr == 1) PG8_BAR;
        PG8_WAIT_V(4); PG8_BAR;
        PG8_STAGE(PG8_SB(1, 0), cB + kstep, voffB); PG8_STAGE(PG8_SA(1, 0), cA + kstep, cvo[0]); PG8_STAGE(PG8_SB(1, 1), cB + hstep + kstep, voffB);
        PG8_WAIT_V(6); PG8_BAR;
    }
    for (;;) {
        const bool has_next = (ACCMODE == 0) ? S.next(ui + 1, nxt) : false;
        const char* nA = has_next ? S.a_ptr(nxt) : cA; const char* nB = has_next ? S.b_ptr(nxt) : cB;
        if constexpr (GATHER) {
#pragma unroll
            for (int h = 0; h < 2; ++h)
#pragma unroll
                for (int i = 0; i < 2; ++i) nvo[h][i] = has_next ? (unsigned)(((size_t)S.a_row(nxt, h * HALF + RA[i]) * K + CA[i]) * 2u) : cvo[h][i];
        }
        for (int t = 0; t < nt; t += 2) {
            const bool last = (t == nt - 2);
            if (last && has_next) S.a_ready(nxt);
            const char* a1 = cA + (size_t)(t + 1) * kstep;
            const char* a2 = last ? nA : cA + (size_t)(t + 2) * kstep; const char* b2 = last ? nB : cB + (size_t)(t + 2) * kstep;
            const char* a3 = a2 + kstep; const char* b3 = b2 + kstep;
            unsigned v2[2][2];
#pragma unroll
            for (int h = 0; h < 2; ++h)
#pragma unroll
                for (int i = 0; i < 2; ++i) v2[h][i] = (GATHER && last) ? nvo[h][i] : cvo[h][i];
            if constexpr (SP2) {
            PG8_LDB(B0, 0, 0); PG8_LDB(B1, 0, 1); PG8_SCHED; PG8_LDA(At, 0, 0); PG8_STAGE(PG8_SA(1, 1), a1, cvo[1]);
            PG8_WAIT_V(8); PG8_WAIT_L(0); PG8_BAR; PG8_MMA(0, 0, At, B0); PG8_MMA(0, 1, At, B1); PG8_BAR; PG8_SCHED;
            PG8_LDA(At, 0, 1); PG8_STAGE(PG8_SB(0, 0), b2, voffB); PG8_STAGE(PG8_SB(0, 1), b2 + hstep, voffB); PG8_STAGE(PG8_SA(0, 0), a2, v2[0]);
            PG8_WAIT_V(8); PG8_WAIT_L(0); PG8_BAR; PG8_MMA(1, 0, At, B0); PG8_MMA(1, 1, At, B1); PG8_BAR; PG8_SCHED;
            PG8_LDB(B0, 1, 0); PG8_LDB(B1, 1, 1); PG8_SCHED; PG8_LDA(At, 1, 0); PG8_STAGE(PG8_SA(0, 1), a2, v2[1]);
            PG8_WAIT_V(8); PG8_WAIT_L(0); PG8_BAR; PG8_MMA(0, 0, At, B0); PG8_MMA(0, 1, At, B1); PG8_BAR; PG8_SCHED;
            PG8_LDA(At, 1, 1); PG8_STAGE(PG8_SB(1, 0), b3, voffB); PG8_STAGE(PG8_SB(1, 1), b3 + hstep, voffB); PG8_STAGE(PG8_SA(1, 0), a3, v2[0]);
            PG8_WAIT_V(8); PG8_WAIT_L(0); PG8_BAR; PG8_MMA(1, 0, At, B0); PG8_MMA(1, 1, At, B1); PG8_BAR; PG8_SCHED;
            } else {
            PG8_LDB(B0, 0, 0); PG8_SCHED; PG8_LDA(At, 0, 0); PG8_STAGE(PG8_SA(1, 1), a1, cvo[1]);
            PG8_WAIT_L(8); PG8_BAR; PG8_WAIT_L(0); PG8_MMA(0, 0, At, B0); PG8_BAR; PG8_SCHED;
            PG8_LDB(B1, 0, 1); PG8_STAGE(PG8_SB(0, 0), b2, voffB);
            PG8_BAR; PG8_WAIT_L(0); PG8_MMA(0, 1, At, B1); PG8_BAR;
            PG8_LDA(At, 0, 1); PG8_STAGE(PG8_SA(0, 0), a2, v2[0]);
            PG8_BAR; PG8_WAIT_L(0); PG8_MMA(1, 0, At, B0); PG8_BAR; PG8_SCHED;
            PG8_STAGE(PG8_SB(0, 1), b2 + hstep, voffB);
            PG8_WAIT_V(6); PG8_BAR; PG8_MMA(1, 1, At, B1); PG8_BAR;
            PG8_LDB(B0, 1, 0); PG8_SCHED; PG8_LDA(At, 1, 0); PG8_STAGE(PG8_SA(0, 1), a2, v2[1]);
            PG8_WAIT_L(8); PG8_BAR; PG8_WAIT_L(0); PG8_MMA(0, 0, At, B0); PG8_BAR; PG8_SCHED;
            PG8_LDB(B1, 1, 1); PG8_STAGE(PG8_SB(1, 0), b3, voffB);
            PG8_BAR; PG8_WAIT_L(0); PG8_MMA(0, 1, At, B1); PG8_BAR;
            PG8_LDA(At, 1, 1); PG8_STAGE(PG8_SA(1, 0), a3, v2[0]);
            PG8_BAR; PG8_WAIT_L(0); PG8_MMA(1, 0, At, B0); PG8_BAR; PG8_SCHED;
            PG8_STAGE(PG8_SB(1, 1), b3 + hstep, voffB);
            PG8_WAIT_V(6); PG8_BAR; PG8_MMA(1, 1, At, B1); PG8_BAR;
            }
        }
        if constexpr (ALIGN_EPI) { if (wr == 0) PG8_BAR; }
        E(acc, cur, wr, wc, fr, fq);
        S.done(cur);
        if (!has_next) break;
#pragma unroll
        for (int a = 0; a < 2; ++a)
#pragma unroll
            for (int b = 0; b < 2; ++b)
#pragma unroll
                for (int m = 0; m < 4; ++m)
#pragma unroll
                    for (int n = 0; n < 2; ++n) acc[a][b][m][n] = (f32x4){0.f, 0.f, 0.f, 0.f};
        cur = nxt; cA = nA; cB = nB; ++ui;
#pragma unroll
        for (int h = 0; h < 2; ++h)
#pragma unroll
            for (int i = 0; i < 2; ++i) cvo[h][i] = nvo[h][i];
        if constexpr (ALIGN_EPI) { if (wr == 1) PG8_BAR; }
    }
    PG8_WAIT_V(0);
    if constexpr (!ALIGN_EPI) { if (wr == 0) PG8_BAR; }
    PG8_BAR;
#undef PG8_SA
#undef PG8_SB
#undef PG8_STAGE
#undef PG8_LDA
#undef PG8_LDB
#undef PG8_MMA
#undef PG8_WAIT_V
#undef PG8_WAIT_L
#undef PG8_BAR
#undef PG8_SCHED
}
}

struct Frame {
    LAS unsigned char* lds;
    volatile LAS unsigned* MISC;
    GAS unsigned* ctl;
    int tid, lane, wave;
    int vcu, G;
    const float* in[19];
    float* out; unsigned char* ws;
};
enum { I_X = 0, I_NMW, I_WIN, I_CONVW, I_ALOG, I_DTB, I_GNW, I_WUPG, I_WUPR, I_WOUT, I_NFW, I_WGRP, I_BGRP, I_WEXP, I_BEXP, I_WGATE, I_WUP, I_WDOWN, I_NFINW };

struct TrItem { const float* W; bf16_t* WT; int ldw, col0, K, row0, k0; };
__device__ __forceinline__ void tr_load(const TrItem& t, int lane, f32x4 (&ld)[8]) {
#pragma unroll
    for (int i = 0; i < 8; ++i) ld[i] = __builtin_nontemporal_load((const f32x4*)(t.W + (size_t)(t.k0 + i * 8 + (lane >> 3)) * t.ldw + t.col0 + (lane & 7) * 4));
}
__device__ __forceinline__ void tr_store(const TrItem& t, int lane, const f32x4 (&ld)[8], LAS float* scr) {
#pragma unroll
    for (int i = 0; i < 8; ++i) { LAS float* d = scr + (i * 8 + (lane >> 3)) * 33 + (lane & 7) * 4; d[0] = ld[i].x; d[1] = ld[i].y; d[2] = ld[i].z; d[3] = ld[i].w; }
    LDS_WAIT(); asm volatile("" ::: "memory");
    const int c = lane & 7;
#pragma unroll
    for (int j = 0; j < 4; ++j) { const int n = (lane >> 3) + 8 * j; const LAS float* sp = scr + (8 * c) * 33 + n;
        u32x4 o; o.x = pk2(sp[0 * 33], sp[1 * 33]); o.y = pk2(sp[2 * 33], sp[3 * 33]); o.z = pk2(sp[4 * 33], sp[5 * 33]); o.w = pk2(sp[6 * 33], sp[7 * 33]);
        *(GAS u32x4*)(t.WT + (size_t)(t.row0 + n) * t.K + t.k0 + 8 * c) = o; }
    LDS_WAIT(); asm volatile("" ::: "memory");
}
template <class Dec> __device__ __forceinline__ void tr_run(const Dec& dec, int first, int count, int stride, int lane, LAS float* scr) {
    if (first >= count) return;
    f32x4 la[8], lb[8];
    TrItem ta = dec(first), tb = ta;
    tr_load(ta, lane, la);
    for (int it = first; it < count; it += 2 * stride) {
        const bool hb = it + stride < count;
        if (hb) { tb = dec(it + stride); tr_load(tb, lane, lb); }
        tr_store(ta, lane, la, scr);
        const bool ha = it + 2 * stride < count;
        if (ha) { ta = dec(it + 2 * stride); tr_load(ta, lane, la); }
        if (hb) tr_store(tb, lane, lb, scr);
    }
}

__device__ __forceinline__ void p0_prologue(Frame& F) {
    LAS float* scr = (LAS float*)(F.lds + F.wave * 16384);
    const int gw = F.vcu * NWAVES + F.wave, NGW = F.G * NWAVES;
    unsigned char* ws = F.ws;
    {
        constexpr int I_IN = (DM / 64) * (NP / 32);
        constexpr int I_UA = (512 / 64) * (DM / 32);
        constexpr int I_UR = (1024 / 64) * (DM / 32);
        constexpr int I_WO = (1024 / 64) * (DM / 32);
        constexpr int NIT = I_IN + I_UA + I_UR + I_WO;
        const float* win = F.in[I_WIN]; const float* wua = F.in[I_WUPG]; const float* wur = F.in[I_WUPR]; const float* wo = F.in[I_WOUT];
        auto dec = [=](int it) -> TrItem {
            int r = it; TrItem t;
            if (r < I_IN) { const int nb = r % (NP / 32), kb = r / (NP / 32); const int n0 = nb * 32;
                t.W = win; t.ldw = D_IN; t.col0 = n0 + (n0 >= 1536 ? 8 : 0); t.WT = (bf16_t*)(ws + WS_WINT); t.K = DM; t.row0 = n0; t.k0 = kb * 64; return t; }
            r -= I_IN;
            if (r < I_UA) { const int nb = r % 32, kb = r / 32; t.W = wua; t.ldw = DM; t.col0 = nb * 32; t.WT = (bf16_t*)(ws + WS_WUPA); t.K = 512; t.row0 = nb * 32; t.k0 = kb * 64; return t; }
            r -= I_UA;
            if (r < I_UR) { const int nb = r % 32, kb = r / 32; t.W = wur; t.ldw = DM; t.col0 = nb * 32; t.WT = (bf16_t*)(ws + WS_WUPR); t.K = 1024; t.row0 = nb * 32; t.k0 = kb * 64; return t; }
            r -= I_UR;
            { const int nb = r % 32, kb = r / 32; t.W = wo; t.ldw = DM; t.col0 = nb * 32; t.WT = (bf16_t*)(ws + WS_WOUT); t.K = 1024; t.row0 = nb * 32; t.k0 = kb * 64; return t; }
        };
        tr_run(dec, gw, NIT, NGW, F.lane, scr);
    }
    {
        GAS f32x2* tab = (GAS f32x2*)(ws + WS_ROPE);
        const int gt = (F.vcu * NTHR + F.tid), NGT = F.G * NTHR;
        for (int i = gt; i < SEQ * 64; i += NGT) {
            const int t = i >> 6, p = i & 63;
            const float invf = 1.0f / powf(10000.0f, (float)p * (1.0f / 63.0f));
            const float ang = (float)t * invf;
            float s, c; sincosf(ang, &s, &c);
            tab[i] = (f32x2){c, s};
        }
    }
    {
        GAS float* wrt = (GAS float*)(ws + WS_WRT);
        const int gt = (F.vcu * NTHR + F.tid), NGT = F.G * NTHR;
        for (int i = gt; i < 48 * DM; i += NGT) {
            const int j = i / DM, k = i % DM;
            const float nf = F.in[I_NFW][k];
            wrt[i] = j < 4 ? F.in[I_WGRP][k * 4 + j] * nf : (j < 36 ? F.in[I_WEXP][k * 32 + (j - 4)] * nf : 0.f);
        }
    }
    {
        __syncthreads();
        LAS float* wab2 = (LAS float*)F.lds;
        for (int idx = F.tid; idx < 8192; idx += NTHR) { const int k = idx >> 3, q = idx & 7; const int j = k >> 8, l_ = (k & 255) >> 2, e = k & 3;
            wab2[((j * 4 + e) * 64 + l_) * 8 + q] = F.in[I_WIN][(size_t)k * D_IN + 1536 + q]; }
        __syncthreads();
        const float* nw = F.in[I_NMW];
        f32x4 wv[4];
#pragma unroll
        for (int j = 0; j < 4; ++j) wv[j] = *(const f32x4*)(nw + 4 * F.lane + 256 * j);
        float alog = 0.f, dtb = 0.f;
        if (F.lane < 4) { alog = F.in[I_ALOG][F.lane]; dtb = F.in[I_DTB][F.lane]; }
        f32x4 vn[4];
#pragma unroll
        for (int j = 0; j < 4; ++j) vn[j] = __builtin_nontemporal_load((const f32x4*)(F.in[I_X] + (size_t)(gw < M ? gw : 0) * DM) + F.lane + 64 * j);
        for (int m = gw; m < M; m += NGW) {
            f32x4 v[4]; float s = 0.f;
#pragma unroll
            for (int j = 0; j < 4; ++j) { v[j] = vn[j]; s += (v[j].x * v[j].x + v[j].y * v[j].y) + (v[j].z * v[j].z + v[j].w * v[j].w); }
            { const int mn = (m + NGW < M) ? m + NGW : m;
#pragma unroll
              for (int j = 0; j < 4; ++j) vn[j] = __builtin_nontemporal_load((const f32x4*)(F.in[I_X] + (size_t)mn * DM) + F.lane + 64 * j); }
            const float rstd = 1.0f / sqrtf(wave_sum(s) * (1.f / DM) + EPS);
            float ab[8];
#pragma unroll
            for (int q = 0; q < 8; ++q) ab[q] = 0.f;
            GAS unsigned long long* o8 = (GAS unsigned long long*)((bf16_t*)(ws + WS_U) + (size_t)m * DM) + F.lane;
#pragma unroll
            for (int j = 0; j < 4; ++j) {
                v[j] = v[j] * rstd * wv[j];
                o8[64 * j] = (unsigned long long)pk2(v[j].x, v[j].y) | ((unsigned long long)pk2(v[j].z, v[j].w) << 32);
#pragma unroll
                for (int e = 0; e < 4; ++e) {
                    const LAS f32x4* wp = (const LAS f32x4*)(wab2 + ((j * 4 + e) * 64 + F.lane) * 8);
                    const f32x4 w0 = wp[0], w1 = wp[1];
                    const float xv = v[j][e];
                    ab[0] += xv * w0.x; ab[1] += xv * w0.y; ab[2] += xv * w0.z; ab[3] += xv * w0.w;
                    ab[4] += xv * w1.x; ab[5] += xv * w1.y; ab[6] += xv * w1.z; ab[7] += xv * w1.w;
                }
            }
#pragma unroll
            for (int q = 0; q < 8; ++q) ab[q] = wave_sum(ab[q]);
            if (F.lane < 4) {
                const float a = F.lane == 0 ? ab[0] : F.lane == 1 ? ab[1] : F.lane == 2 ? ab[2] : ab[3];
                const float b = F.lane == 0 ? ab[4] : F.lane == 1 ? ab[5] : F.lane == 2 ? ab[6] : ab[7];
                const float z = a + dtb;
                const float sp = z > 20.f ? z : log1pf(__expf(z));
                ((GAS float*)(ws + WS_G))[(size_t)m * 4 + F.lane] = -__expf(alog) * sp;
                ((GAS float*)(ws + WS_BETA))[(size_t)m * 4 + F.lane] = 1.0f / (1.0f + __expf(-b));
            }
        }
    }
}

struct EpiProj {
    static constexpr bool PERM = true;
    unsigned char* ws;
    __device__ __forceinline__ void operator()(const f32x4 (&acc)[2][2][4][2], const pg8::Unit& u, int wr, int wc, int fr, int fq) const {
        const int pn = u.pn; bf16_t* base; int ldc, colt, mode = 0;
        if (pn < 6) { base = (bf16_t*)(ws + WS_GQKV); ldc = 1536; colt = 256 * pn; }
        else if (pn < 8) { base = (bf16_t*)(ws + WS_GZ); ldc = 512; colt = 256 * (pn - 6); }
        else if (pn < 12) { base = (bf16_t*)(ws + WS_RQK); ldc = 1024; colt = 256 * (pn - 8); mode = pn < 10 ? 1 : 2; }
        else if (pn < 16) { base = (bf16_t*)(ws + WS_RV); ldc = 1024; colt = 256 * (pn - 12); }
        else if (pn < 20) { base = (bf16_t*)(ws + WS_RG); ldc = 1024; colt = 256 * (pn - 16); }
        else { base = (bf16_t*)(ws + WS_MAB); ldc = 2048; colt = 256 * (pn - 20); }
        const int row0 = u.pm * 256 + wr * 64 + fr, col0 = colt + wc * 32 + 8 * fq;
        const float sc = mode == 2 ? 0.08838834764831845f : 1.0f;
        const GAS f32x4* tab = (const GAS f32x4*)(ws + WS_ROPE);
#pragma unroll
        for (int ai = 0; ai < 2; ++ai)
#pragma unroll
            for (int m = 0; m < 4; ++m) {
                const int row = row0 + ai * 128 + m * 16;
                bf16_t* rowp = base + (size_t)row * ldc + col0;
                f32x4 cs0 = {1.f, 0.f, 1.f, 0.f}, cs1 = cs0;
                if (mode) { const GAS f32x4* tp = tab + ((size_t)(row & (SEQ - 1)) * 64 + wc * 16 + 4 * fq) / 2; cs0 = tp[0]; cs1 = tp[1]; }
#pragma unroll
                for (int bj = 0; bj < 2; ++bj) {
                    f32x4 v0 = acc[ai][bj][m][0], v1 = acc[ai][bj][m][1];
                    if (mode) {
                        f32x4 r0, r1;
                        r0[0] = v0[0] * cs0[0] - v0[1] * cs0[1]; r0[1] = v0[1] * cs0[0] + v0[0] * cs0[1];
                        r0[2] = v0[2] * cs0[2] - v0[3] * cs0[3]; r0[3] = v0[3] * cs0[2] + v0[2] * cs0[3];
                        r1[0] = v1[0] * cs1[0] - v1[1] * cs1[1]; r1[1] = v1[1] * cs1[0] + v1[0] * cs1[1];
                        r1[2] = v1[2] * cs1[2] - v1[3] * cs1[3]; r1[3] = v1[3] * cs1[2] + v1[2] * cs1[3];
                        v0 = r0 * sc; v1 = r1 * sc;
                    }
                    u32x4 w; w.x = pg8::cvt_pk_bf16(v0[0], v0[1]); w.y = pg8::cvt_pk_bf16(v0[2], v0[3]); w.z = pg8::cvt_pk_bf16(v1[0], v1[1]); w.w = pg8::cvt_pk_bf16(v1[2], v1[3]);
                    __builtin_nontemporal_store(w, (u32x4*)(rowp + bj * 128));
                }
            }
    }
};

__device__ __forceinline__ f32x4 mma16(bf16x8 x, bf16x8 y, f32x4 c) { return __builtin_amdgcn_mfma_f32_16x16x32_bf16(x, y, c, 0, 0, 0); }
__device__ __forceinline__ bf16x8 lfrag(const LAS bf16_t* base, int ld, int row0, int k0, int fr, int fq) { return *(const LAS bf16x8*)(base + (row0 + fr) * ld + k0 + 8 * fq); }
__device__ __forceinline__ bf16x8 gfrag(const bf16_t* base, int ld, int row0, int k0, int fr, int fq) { return *(const bf16x8*)(base + (size_t)(row0 + fr) * ld + k0 + 8 * fq); }
__device__ __forceinline__ bf16x8 tfrag(const LAS bf16_t* base, int ld, int k0, int n0, int lane) {
    const int g = lane >> 4, q = (lane & 15) >> 2, p = lane & 3;
    const LAS bf16_t* a = base + (k0 + 8 * g + q) * ld + n0 + 4 * p;
    const bf16x4 v0 = __builtin_amdgcn_ds_read_tr16_b64_v4i16((LAS bf16x4*)a);
    const bf16x4 v1 = __builtin_amdgcn_ds_read_tr16_b64_v4i16((LAS bf16x4*)(a + 4 * ld));
    return (bf16x8){v0[0], v0[1], v0[2], v0[3], v1[0], v1[1], v1[2], v1[3]};
}
__device__ __forceinline__ bf16x8 pack_acc(f32x4 a, f32x4 b) {
    u32x4 w; w.x = pk2(a[0], a[1]); w.y = pk2(a[2], a[3]); w.z = pk2(b[0], b[1]); w.w = pk2(b[2], b[3]);
    return __builtin_bit_cast(bf16x8, w);
}
__device__ __forceinline__ int ppos(int kap) { return 8 * ((kap & 15) >> 2) + 4 * (kap >> 4) + (kap & 3); }
__device__ __forceinline__ int foff(int row, int col, int kc32) { const int p = ppos(col & 31); return ((row >> 4) * kc32 + (col >> 5)) * 512 + ((row & 15) + 16 * (p >> 3)) * 8 + (p & 7); }

constexpr size_t WS_GL = 8 * MiB + 512 * 1024;

__device__ __forceinline__ void gdn_prep_fetch(Frame& F, int idx, u32x4 (&xw)[2][7], float& gpre, float& bpre) {
    const int bh = idx >> 5, n = idx & 31, b = bh >> 2, h = bh & 3, tok0 = b * SEQ + n * 64, tid = F.tid;
    const bf16_t* GQKV = (const bf16_t*)(F.ws + WS_GQKV);
    if (F.wave == 0) { gpre = ((const float*)(F.ws + WS_G))[(size_t)(tok0 + F.lane) * 4 + h]; bpre = ((const float*)(F.ws + WS_BETA))[(size_t)(tok0 + F.lane) * 4 + h]; }
#pragma unroll
    for (int q = 0; q < 2; ++q) {
        const int task = tid + q * NTHR;
        const int cg = task % 48, tr = task / 48, part = cg >> 4, cl = (cg & 15) * 8, gcol = part * 512 + h * 128 + cl;
#pragma unroll
        for (int r = 0; r < 7; ++r) {
            const int tt = tr * 4 - 3 + r;
            xw[q][r] = (u32x4){0u, 0u, 0u, 0u};
            if (task < 768 && n * 64 + tt >= 0) xw[q][r] = *(const u32x4*)((const unsigned char*)GQKV + (unsigned)(((tok0 + tt) * 1536 + gcol) * 2));
        }
    }
}
template <int PM> __device__ __forceinline__ void gdn_prep_item(Frame& F, int idx, int idx_next, u32x4 (&xw)[2][7], float& gpre, float& bpre) {
    const int bh = idx >> 5, n = idx & 31, b = bh >> 2, h = bh & 3;
    const int tok0 = b * SEQ + n * 64;
    LAS bf16_t* QN = (LAS bf16_t*)(F.lds);
    LAS bf16_t* KN = (LAS bf16_t*)(F.lds + 17408);
    LAS bf16_t* KT = (LAS bf16_t*)(F.lds + 34816);
    LAS bf16_t* VT = (LAS bf16_t*)(F.lds + 53248);
    LAS float*  LM = (LAS float*)(F.lds + 71680);
    LAS bf16_t* T1 = (LAS bf16_t*)(F.lds + 89088);
    LAS bf16_t* T2 = (LAS bf16_t*)(F.lds + 98304);
    LAS float*  SC = (LAS float*)(F.lds + 107520);
    LAS float*  SSQ = (LAS float*)(F.lds + 108544);
    const int tid = F.tid, lane = F.lane, fr = lane & 15, fq = lane >> 4, wave = F.wave;
    const bf16_t* GQKV = (const bf16_t*)(F.ws + WS_GQKV);
    if (!(PM & 1)) {
#pragma unroll
        for (int q = 0; q < 2; ++q) {
            const int task = tid + q * NTHR;
            if (task < 768) {
                const int cg = task % 48, tr = task / 48, part = cg >> 4, cl = (cg & 15) * 8, gcol = part * 512 + h * 128 + cl;
                unsigned nat[4][4];
                float ssq[4];
#pragma unroll
                for (int t = 0; t < 4; ++t) ssq[t] = 0.f;
#pragma unroll
                for (int e2 = 0; e2 < 4; ++e2) {
                    float c0[4], c1[4];
#pragma unroll
                    for (int k = 0; k < 4; ++k) { const f32x2 cc = *(const f32x2*)(F.in[I_CONVW] + k * 1536 + gcol + 2 * e2); c0[k] = cc.x; c1[k] = cc.y; }
                    float xa[7], xb[7];
#pragma unroll
                    for (int r = 0; r < 7; ++r) { const unsigned w = xw[q][r][e2]; xa[r] = bflo(w); xb[r] = bfhi(w); }
                    float ya[4], yb[4];
#pragma unroll
                    for (int t = 0; t < 4; ++t) {
                        ya[t] = siluf_(c0[0] * xa[t] + c0[1] * xa[t + 1] + c0[2] * xa[t + 2] + c0[3] * xa[t + 3]);
                        yb[t] = siluf_(c1[0] * xb[t] + c1[1] * xb[t + 1] + c1[2] * xb[t + 2] + c1[3] * xb[t + 3]);
                        ssq[t] += ya[t] * ya[t] + yb[t] * yb[t];
                        nat[t][e2] = pk2(ya[t], yb[t]);
                    }
                    if (part >= 1) {
                        LAS bf16_t* Tt = part == 1 ? KT : VT;
                        u32x2 w; w.x = pk2(ya[0], ya[1]); w.y = pk2(ya[2], ya[3]);
                        *(LAS u32x2*)(Tt + (cl + 2 * e2) * 72 + tr * 4) = w;
                        w.x = pk2(yb[0], yb[1]); w.y = pk2(yb[2], yb[3]);
                        *(LAS u32x2*)(Tt + (cl + 2 * e2 + 1) * 72 + tr * 4) = w;
                    }
                }
                if (part < 2) {
                    LAS bf16_t* N = part == 0 ? QN : KN;
#pragma unroll
                    for (int t = 0; t < 4; ++t) {
                        SSQ[(part * 64 + tr * 4 + t) * 16 + (cg & 15)] = ssq[t];
                        *(LAS u32x4*)(N + (tr * 4 + t) * 136 + cl) = (u32x4){nat[t][0], nat[t][1], nat[t][2], nat[t][3]};
                    }
                }
            }
        }
    }
    LBAR();
    if (wave == 0) {
        const int c = lane;
        float sq = 0.f, sk = 0.f;
#pragma unroll
        for (int j = 0; j < 16; ++j) { sq += SSQ[c * 16 + j]; sk += SSQ[(64 + c) * 16 + j]; }
        const float rq = 1.0f / sqrtf(sq + EPS), rk = 1.0f / sqrtf(sk + EPS);
        const float g = gpre, be = bpre;
        float gc = g;
#pragma unroll
        for (int o = 1; o < 64; o <<= 1) { const float t = __shfl_up(gc, o); if (lane >= o) gc += t; }
        SC[c] = rq; SC[64 + c] = rk; SC[128 + c] = gc; SC[192 + c] = be;
        if (c == 63) ((float*)(F.ws + WS_GL))[idx] = gc;
    }
    LBAR();
    if (!(PM & 4)) {
        bf16_t* ATT = (bf16_t*)((unsigned char*)F.out + (size_t)idx * GP_BYTES) + GP_A;
#pragma unroll 1
        for (int job = wave * 4; job < wave * 4 + 4; ++job) {
            const int which = job >> 4, it = (job >> 2) & 3, jt = job & 3;
            f32x4 acc = {0.f, 0.f, 0.f, 0.f};
            const LAS bf16_t* Y = which ? QN : KN;
            bf16x8 fx[4], fy[4];
#pragma unroll
            for (int ks = 0; ks < 4; ++ks) { fx[ks] = lfrag(KN, 136, jt * 16, ks * 32, fr, fq); fy[ks] = lfrag(Y, 136, it * 16, ks * 32, fr, fq); }
            __builtin_amdgcn_sched_barrier(0);
#pragma unroll
            for (int ks = 0; ks < 4; ++ks) acc = mma16(fx[ks], fy[ks], acc);
            const int i = it * 16 + fr, j0 = jt * 16 + 4 * fq;
            const float gci = SC[128 + i];
            if (which == 0) {
                const float fi = SC[192 + i] * SC[64 + i];
                f32x4 o;
#pragma unroll
                for (int r = 0; r < 4; ++r) { const int j = j0 + r; o[r] = (j < i) ? fi * SC[64 + j] * acc[r] * __expf(gci - SC[128 + j]) : 0.f; }
                *(LAS f32x4*)(LM + i * 68 + j0) = o;
            } else {
                const float fi = SC[i] * 0.08838834764831845f;
                float o[4];
#pragma unroll
                for (int r = 0; r < 4; ++r) { const int j = j0 + r; o[r] = (j <= i) ? fi * SC[64 + j] * acc[r] * __expf(gci - SC[128 + j]) : 0.f; }
                u32x2 w; w.x = pk2(o[0], o[1]); w.y = pk2(o[2], o[3]);
                *(u32x2*)(ATT + foff(i, j0, 2)) = w;
            }
        }
    }
    LBAR();
    if (idx_next >= 0) gdn_prep_fetch(F, idx_next, xw, gpre, bpre);
    LAS float* TD = (LAS float*)(F.lds + 116736);
    LAS float* PS = (LAS float*)(F.lds + 124928);
    if (wave == 0) { if (!(PM & 2)) {
        const int blk = lane >> 5, c = lane & 31;
        const LAS float* Lb = LM + (blk * 32) * 68 + blk * 32;
        LAS float* Tw = TD + blk * 1024 + c;
        float t[32];
        f32x4 la[8], lb[8];
#define INV_LD(dst, i) do { _Pragma("unroll") for (int _j = 0; _j < ((i) + 3) / 4; ++_j) dst[_j] = *(const LAS f32x4*)(Lb + (i) * 68 + 4 * _j); } while (0)
#define INV_ROW(src, i) do { float ps[4] = {((i) == c) ? 1.f : 0.f, 0.f, 0.f, 0.f}; _Pragma("unroll") for (int _j = 0; _j < ((i) + 3) / 4; ++_j) { _Pragma("unroll") for (int _e = 0; _e < 4; ++_e) if (4 * _j + _e < (i)) ps[_e] -= src[_j][_e] * t[4 * _j + _e]; } \
        t[i] = (ps[0] + ps[1]) + (ps[2] + ps[3]); Tw[(i) * 32] = t[i]; } while (0)
        INV_LD(la, 1);
#pragma unroll
        for (int i = 0; i < 32; i += 2) {
            if (i + 1 < 32) { INV_LD(lb, i + 1); }
            __builtin_amdgcn_sched_barrier(0);
            INV_ROW(la, i);
            if (i + 2 < 32) { INV_LD(la, i + 2); }
            __builtin_amdgcn_sched_barrier(0);
            INV_ROW(lb, i + 1);
        }
#undef INV_LD
#undef INV_ROW
    } } else {
        bf16_t* QGo = (bf16_t*)((unsigned char*)F.out + (size_t)idx * GP_BYTES) + GP_Q;
        bf16_t* KDo = (bf16_t*)((unsigned char*)F.out + (size_t)idx * GP_BYTES) + GP_K;
        const float gl = SC[128 + 63];
        for (int task = tid - 64; task < 2048; task += 448) {
            if (task < 1024) {
                const int c = task >> 4, d0 = (task & 15) * 8;
                const float f = SC[c] * 0.08838834764831845f * __expf(SC[128 + c]);
                const u32x4 w = *(const LAS u32x4*)(QN + c * 136 + d0);
                u32x2 o0, o1; o0.x = pk2(bflo(w.x) * f, bfhi(w.x) * f); o0.y = pk2(bflo(w.y) * f, bfhi(w.y) * f); o1.x = pk2(bflo(w.z) * f, bfhi(w.z) * f); o1.y = pk2(bflo(w.w) * f, bfhi(w.w) * f);
                *(u32x2*)(QGo + foff(c, d0, 4)) = o0; *(u32x2*)(QGo + foff(c, d0 + 4, 4)) = o1;
            } else {
                const int tk = task - 1024, d = tk >> 3, c0 = (tk & 7) * 8;
                const u32x4 w = *(const LAS u32x4*)(KT + d * 72 + c0);
                float f[8];
#pragma unroll
                for (int e = 0; e < 8; ++e) f[e] = SC[64 + c0 + e] * __expf(gl - SC[128 + c0 + e]);
                u32x2 o0, o1; o0.x = pk2(bflo(w.x) * f[0], bfhi(w.x) * f[1]); o0.y = pk2(bflo(w.y) * f[2], bfhi(w.y) * f[3]); o1.x = pk2(bflo(w.z) * f[4], bfhi(w.z) * f[5]); o1.y = pk2(bflo(w.w) * f[6], bfhi(w.w) * f[7]);
                *(u32x2*)(KDo + foff(d, c0, 2)) = o0; *(u32x2*)(KDo + foff(d, c0 + 4, 2)) = o1;
            }
        }
    }
    LBAR();
    if (wave < 4 && !(PM & 2)) {
        const int ti = wave >> 1, tj = wave & 1;
        f32x4 acc = {0.f, 0.f, 0.f, 0.f};
#pragma unroll
        for (int ks = 0; ks < 8; ++ks) acc = __builtin_amdgcn_mfma_f32_16x16x4f32(LM[(32 + 16 * ti + fr) * 68 + 4 * ks + fq], TD[(4 * ks + fq) * 32 + 16 * tj + fr], acc, 0, 0, 0);
#pragma unroll
        for (int r = 0; r < 4; ++r) PS[(16 * ti + 4 * fq + r) * 33 + 16 * tj + fr] = acc[r];
    }
    LBAR();
    if (wave < 4 && !(PM & 2)) {
        const int ti = wave >> 1, tj = wave & 1;
        f32x4 acc = {0.f, 0.f, 0.f, 0.f};
#pragma unroll
        for (int ks = 0; ks < 8; ++ks) acc = __builtin_amdgcn_mfma_f32_16x16x4f32(TD[1024 + (16 * ti + fr) * 32 + 4 * ks + fq], PS[(4 * ks + fq) * 33 + 16 * tj + fr], acc, 0, 0, 0);
#pragma unroll
        for (int r = 0; r < 4; ++r) LM[(32 + 16 * ti + 4 * fq + r) * 68 + 16 * tj + fr] = -acc[r];
    }
    LBAR();
    if (!(PM & 2)) {
#pragma unroll
        for (int q = 0; q < 2; ++q) {
            const int task = tid + q * NTHR, i = task >> 4, j0 = (task & 15) * 4;
            f32x4 tv = {0.f, 0.f, 0.f, 0.f};
            if (i < 32) { if (j0 < 32) tv = *(const LAS f32x4*)(TD + i * 32 + j0); }
            else if (j0 < 32) { tv = *(const LAS f32x4*)(LM + i * 68 + j0); }
            else { tv = *(const LAS f32x4*)(TD + 1024 + (i - 32) * 32 + (j0 - 32)); }
            float b1[4], b2[4];
#pragma unroll
            for (int e = 0; e < 4; ++e) { b1[e] = SC[192 + j0 + e]; b2[e] = b1[e] * SC[64 + j0 + e] * __expf(SC[128 + j0 + e]); }
            u32x2 w1, w2; w1.x = pk2(tv[0] * b1[0], tv[1] * b1[1]); w1.y = pk2(tv[2] * b1[2], tv[3] * b1[3]); w2.x = pk2(tv[0] * b2[0], tv[1] * b2[1]); w2.y = pk2(tv[2] * b2[2], tv[3] * b2[3]);
            *(LAS u32x2*)(T1 + i * 72 + j0) = w1; *(LAS u32x2*)(T2 + i * 72 + j0) = w2;
        }
    }
    LBAR();
    if (!(PM & 4)) {
        bf16_t* UTo = (bf16_t*)(F.ws + WS_UT) + (size_t)idx * 8192;
        bf16_t* WNo = (bf16_t*)((unsigned char*)F.out + (size_t)idx * GP_BYTES) + GP_W;
#pragma unroll 1
        for (int job = wave * 8; job < wave * 8 + 8; ++job) {
            f32x4 acc = {0.f, 0.f, 0.f, 0.f};
            if (job < 32) {
                const int it = job >> 3, dvt = job & 7;
#pragma unroll
                for (int ks = 0; ks < 2; ++ks) acc = mma16(lfrag(T1, 72, it * 16, ks * 32, fr, fq), lfrag(VT, 72, dvt * 16, ks * 32, fr, fq), acc);
                u32x2 w; w.x = pk2(acc[0], acc[1]); w.y = pk2(acc[2], acc[3]);
                *(u32x2*)(UTo + (dvt * 16 + fr) * 64 + it * 16 + 4 * fq) = w;
            } else {
                const int dkt = (job - 32) >> 2, it = (job - 32) & 3;
#pragma unroll
                for (int ks = 0; ks < 2; ++ks) acc = mma16(lfrag(KT, 72, dkt * 16, ks * 32, fr, fq), lfrag(T2, 72, it * 16, ks * 32, fr, fq), acc);
                u32x2 w; w.x = pk2(-acc[0], -acc[1]); w.y = pk2(-acc[2], -acc[3]);
                const int d0 = dkt * 16 + 4 * fq;
                *(u32x2*)(WNo + foff(it * 16 + fr, d0, 4)) = w;
            }
        }
    }
    LBAR();
}

__device__ __forceinline__ float ret_log2_gamma(int h) { return log2f(1.0f - exp2f(-5.0f - (float)h)); }
__device__ __forceinline__ void ret_kv_item(Frame& F, int idx2) {
    const int bh = idx2 >> 4, n = idx2 & 15, b = bh >> 2, h = bh & 3;
    const int tok0 = b * SEQ + n * 128;
    LAS bf16_t* KS = (LAS bf16_t*)(F.lds);
    LAS bf16_t* VN = (LAS bf16_t*)(F.lds + 34816);
    const int tid = F.tid, lane = F.lane, fr = lane & 15, fq = lane >> 4, wave = F.wave;
    const float l2g = ret_log2_gamma(h);
    const bf16_t* RQK = (const bf16_t*)(F.ws + WS_RQK); const bf16_t* RV = (const bf16_t*)(F.ws + WS_RV);
#pragma unroll
    for (int i = 0; i < 4; ++i) { const int p = tid + i * 512, c = p >> 4, d0 = (p & 15) * 8;
        const u32x4 w = *(const u32x4*)(RQK + (size_t)(tok0 + c) * 1024 + 512 + h * 128 + d0);
        const float f = exp2f(l2g * (float)(127 - c));
        u32x4 o; o.x = pk2(bflo(w.x) * f, bfhi(w.x) * f); o.y = pk2(bflo(w.y) * f, bfhi(w.y) * f); o.z = pk2(bflo(w.z) * f, bfhi(w.z) * f); o.w = pk2(bflo(w.w) * f, bfhi(w.w) * f);
        *(LAS u32x4*)(KS + c * 136 + d0) = o; }
#pragma unroll
    for (int i = 0; i < 8; ++i) { const int p = tid + i * 512, c = p >> 5, d0 = (p & 31) * 8;
        *(LAS u32x4*)(VN + c * 264 + d0) = *(const u32x4*)(RV + (size_t)(tok0 + c) * 1024 + h * 256 + d0); }
    LBAR();
    f32x4 acc[8][2];
#pragma unroll
    for (int a = 0; a < 8; ++a) { acc[a][0] = (f32x4){0.f, 0.f, 0.f, 0.f}; acc[a][1] = acc[a][0]; }
#pragma unroll
    for (int ks = 0; ks < 4; ++ks) {
        const bf16x8 y0 = tfrag(VN, 264, ks * 32, (2 * wave) * 16, lane), y1 = tfrag(VN, 264, ks * 32, (2 * wave + 1) * 16, lane);
#pragma unroll
        for (int dkt = 0; dkt < 8; ++dkt) { const bf16x8 x = tfrag(KS, 136, ks * 32, dkt * 16, lane); acc[dkt][0] = mma16(x, y0, acc[dkt][0]); acc[dkt][1] = mma16(x, y1, acc[dkt][1]); }
    }
    bf16_t* KVo = (bf16_t*)(F.ws + WS_KV) + (size_t)idx2 * 32768;
#pragma unroll
    for (int dkt = 0; dkt < 8; ++dkt)
#pragma unroll
        for (int q = 0; q < 2; ++q) { u32x2 w; w.x = pk2(acc[dkt][q][0], acc[dkt][q][1]); w.y = pk2(acc[dkt][q][2], acc[dkt][q][3]);
            *(u32x2*)(KVo + ((2 * wave + q) * 16 + fr) * 128 + dkt * 16 + 4 * fq) = w; }
    LBAR();
}

template <int MODE> __device__ __forceinline__ void gdn_scan_block(Frame& F, int cu) {
    const int bh = cu >> 1, b = bh >> 2, h = bh & 3;
    const int lane = F.lane, wave = F.wave, fr = lane & 15, fq = lane >> 4;
    const unsigned char* GPb = (const unsigned char*)F.out + (size_t)(bh * 32) * GP_BYTES;
    const unsigned char* UTb = (const unsigned char*)(F.ws + WS_UT) + (size_t)(bh * 32) * 16384 + (cu & 1) * 8192;
    constexpr int BUFB = 65536;
    int wpa[8], wpb[8]; int wsum = 0;
#pragma unroll
    for (int i = 0; i < 8; ++i) { wpa[i] = 0; wpb[i] = 0; }
#define SCAN_DMA(nn, lw) do { const unsigned char* _g = GPb + (size_t)(nn) * GP_BYTES; const unsigned char* _u = UTb + (size_t)(nn) * 16384; LAS unsigned char* _d = F.lds + ((nn) & 1) * BUFB; \
        _Pragma("unroll") for (int _i = 0; _i < 16; ++_i) { const int piece = (lw) + 4 * _i; const unsigned char* src = piece < 56 ? _g + piece * 1024 : _u + (piece - 56) * 1024; \
            __builtin_amdgcn_global_load_lds((const unsigned*)(src + lane * 16), (LAS unsigned*)(_d + piece * 1024), 16, 0, 0); } } while (0)
#define SCAN_WARM(wp, nn) do { const unsigned char* _g = GPb + (size_t)(nn) * GP_BYTES; const unsigned char* _u = UTb + (size_t)(nn) * 16384; \
        _Pragma("unroll") for (int _k = 0; _k < 2; ++_k) { const int _L = (2 * wave + _k) * 64 + lane; wsum ^= wp[_k]; wp[_k] = *(const int*)(_L < 448 ? _g + _L * 128 : _u + (_L - 448) * 128); } } while (0)
    if (wave >= 4) { SCAN_DMA(0, wave - 4); asm volatile("s_waitcnt vmcnt(0)" ::: "memory"); }
    else { SCAN_WARM(wpa, 1); SCAN_WARM(wpb, 2); }
    float glall = 0.f;
    if (wave < 4 && lane < 32) glall = ((const float*)(F.ws + WS_GL))[bh * 32 + lane];
    LBAR();
    const int sl = (cu & 1) * 4 + (wave & 3);
    bf16_t* OG = (bf16_t*)(F.ws + WS_OGDN);
    f32x4 S[8];
#pragma unroll
    for (int d = 0; d < 8; ++d) S[d] = (f32x4){0.f, 0.f, 0.f, 0.f};
#pragma unroll 1
    for (int n = 0; n < 32; ++n) {
        if (wave >= 4) {
            if (MODE != 1 && n + 1 < 32) { SCAN_DMA(n + 1, wave - 4); asm volatile("s_waitcnt vmcnt(0)" ::: "memory"); }
        } else if (MODE != 2) {
            if (n + 3 < 32) { if (n & 1) SCAN_WARM(wpb, n + 3); else SCAN_WARM(wpa, n + 3); }
            const LAS unsigned char* buf = F.lds + (n & 1) * BUFB;
            const LAS bf16x8* Bf = (const LAS bf16x8*)buf + lane;
            const float egl = __expf(rdlane(glall, n));
            f32x4 av[4], ao[4];
#pragma unroll
            for (int ct = 0; ct < 4; ++ct) {
                const u32x2 un = *(const LAS u32x2*)(buf + GP_BYTES + (((wave & 3) * 16 + fr) * 64 + ct * 16 + 4 * fq) * 2);
                av[ct] = (f32x4){bflo(un.x), bfhi(un.x), bflo(un.y), bfhi(un.y)}; ao[ct] = (f32x4){0.f, 0.f, 0.f, 0.f};
            }
#define LDG(dst, blk0) do { _Pragma("unroll") for (int _j = 0; _j < 8; ++_j) dst[_j] = Bf[((blk0) + _j) * 64]; } while (0)
#define SB() __builtin_amdgcn_sched_barrier(0)
            bf16x8 ga[8], gb[8], gc[8];
            LDG(ga, 0); LDG(gb, 8); LDG(gc, 16); SB();
            bf16x8 Sf[4];
#pragma unroll
            for (int ks = 0; ks < 4; ++ks) Sf[ks] = pack_acc(S[2 * ks], S[2 * ks + 1]);
            SB();
#pragma unroll
            for (int jj = 0; jj < 8; ++jj) { const int j = (jj >> 1) + 4 * (jj & 1); av[j >> 2] = mma16(ga[j], Sf[j & 3], av[j >> 2]); }
            SB(); LDG(ga, 24); SB();
#pragma unroll
            for (int jj = 0; jj < 8; ++jj) { const int j = (jj >> 1) + 4 * (jj & 1); av[2 + (j >> 2)] = mma16(gb[j], Sf[j & 3], av[2 + (j >> 2)]); }
            SB(); LDG(gb, 48); SB();
#pragma unroll
            for (int jj = 0; jj < 8; ++jj) { const int j = (jj >> 1) + 4 * (jj & 1); ao[j >> 2] = mma16(gc[j], Sf[j & 3], ao[j >> 2]); }
            SB(); LDG(gc, 32); SB();
            bf16x8 Vf[2];
            Vf[0] = pack_acc(av[0], av[1]); Vf[1] = pack_acc(av[2], av[3]);
#pragma unroll
            for (int dt = 0; dt < 8; ++dt) S[dt] = S[dt] * egl;
            SB();
#pragma unroll
            for (int jj = 0; jj < 8; ++jj) { const int j = (jj >> 1) + 4 * (jj & 1); ao[2 + (j >> 2)] = mma16(ga[j], Sf[j & 3], ao[2 + (j >> 2)]); }
            SB(); LDG(ga, 40); SB();
#pragma unroll
            for (int jj = 0; jj < 8; ++jj) { const int j = 2 * (jj & 3) + (jj >> 2); ao[j >> 1] = mma16(gb[j], Vf[j & 1], ao[j >> 1]); }
            SB();
#pragma unroll
            for (int jj = 0; jj < 8; ++jj) { const int j = 2 * (jj & 3) + (jj >> 2); S[j >> 1] = mma16(gc[j], Vf[j & 1], S[j >> 1]); }
            SB();
#pragma unroll
            for (int jj = 0; jj < 8; ++jj) { const int j = 2 * (jj & 3) + (jj >> 2); S[4 + (j >> 1)] = mma16(ga[j], Vf[j & 1], S[4 + (j >> 1)]); }
            SB();
#undef LDG
#undef SB
            const int tok0 = b * SEQ + n * 64;
#pragma unroll
            for (int ct = 0; ct < 4; ++ct)
#pragma unroll
                for (int r = 0; r < 4; ++r) {
                    const int c = ct * 16 + 4 * fq + r;
                    if (MODE != 3) OG[(size_t)(tok0 + c) * 512 + h * 128 + sl * 16 + fr] = (bf16_t)pk2(ao[ct][r], 0.f);
                }
        }
        LBAR();
    }
#undef SCAN_DMA
#undef SCAN_WARM
#pragma unroll
    for (int i = 0; i < 8; ++i) wsum ^= wpa[i] ^ wpb[i];
    if (wsum == 0x5a17c0de) ((unsigned*)(F.ws + WS_CTL))[CW_TMO + 16] = 1u;
}

__device__ __forceinline__ void ret_prefix_task(Frame& F, int task) {
    const int bh = task >> 6, part = task & 63, h = bh & 3;
    const float cd = exp2f(ret_log2_gamma(h) * 128.0f);
    bf16_t* base = (bf16_t*)(F.ws + WS_KV) + (size_t)bh * 16 * 32768 + part * 512 + F.lane * 8;
    float st[8];
#pragma unroll
    for (int e = 0; e < 8; ++e) st[e] = 0.f;
#pragma unroll 4
    for (int n = 0; n < 16; ++n) {
        u32x4* p = (u32x4*)(base + (size_t)n * 32768);
        const u32x4 w = *p;
        u32x4 o; o.x = pk2(st[0], st[1]); o.y = pk2(st[2], st[3]); o.z = pk2(st[4], st[5]); o.w = pk2(st[6], st[7]);
        *p = o;
        st[0] = st[0] * cd + bflo(w.x); st[1] = st[1] * cd + bfhi(w.x); st[2] = st[2] * cd + bflo(w.y); st[3] = st[3] * cd + bfhi(w.y);
        st[4] = st[4] * cd + bflo(w.z); st[5] = st[5] * cd + bfhi(w.z); st[6] = st[6] * cd + bflo(w.w); st[7] = st[7] * cd + bfhi(w.w);
    }
}

__device__ __forceinline__ bf16x8 scale_frag(bf16x8 q, float f) {
    u32x4 w = __builtin_bit_cast(u32x4, q);
    w.x = pk2(bflo(w.x) * f, bfhi(w.x) * f); w.y = pk2(bflo(w.y) * f, bfhi(w.y) * f); w.z = pk2(bflo(w.z) * f, bfhi(w.z) * f); w.w = pk2(bflo(w.w) * f, bfhi(w.w) * f);
    return __builtin_bit_cast(bf16x8, w);
}
struct RetPre { u32x4 q[4], k[4]; };
__device__ __forceinline__ void ret_out_fetch(Frame& F, int idx2, RetPre& P) {
    const int bh = idx2 >> 4, n = idx2 & 15, b = bh >> 2, h = bh & 3, tok0 = b * SEQ + n * 128, tid = F.tid;
    const bf16_t* RQK = (const bf16_t*)(F.ws + WS_RQK);
#pragma unroll
    for (int i = 0; i < 4; ++i) { const int p = tid + i * 512, c = p >> 4, d0 = (p & 15) * 8; P.q[i] = *(const u32x4*)((const unsigned char*)RQK + (unsigned)(((tok0 + c) * 1024 + h * 128 + d0) * 2)); }
#pragma unroll
    for (int i = 0; i < 4; ++i) { const int p = tid + i * 512, c = p >> 4, d0 = (p & 15) * 8; P.k[i] = *(const u32x4*)((const unsigned char*)RQK + (unsigned)(((tok0 + c) * 1024 + 512 + h * 128 + d0) * 2)); }
}
__device__ __forceinline__ void ret_out_item(Frame& F, int idx2, int idx_next, RetPre& P) {
    const int bh = idx2 >> 4, n = idx2 & 15, b = bh >> 2, h = bh & 3;
    const int tok0 = b * SEQ + n * 128;
    LAS bf16_t* QN = (LAS bf16_t*)(F.lds);
    LAS bf16_t* SPn = (LAS bf16_t*)(F.lds + 34816);
    LAS bf16_t* KN = (LAS bf16_t*)(F.lds + 34816);
    LAS bf16_t* PM = (LAS bf16_t*)(F.lds + 69632);
    LAS bf16_t* VN = (LAS bf16_t*)(F.lds);
    LAS float*  NS = (LAS float*)(F.lds + 104448);
    const int tid = F.tid, lane = F.lane, fr = lane & 15, fq = lane >> 4, wave = F.wave;
    const float l2g = ret_log2_gamma(h);
    const bf16_t* RQK = (const bf16_t*)(F.ws + WS_RQK); const bf16_t* RV = (const bf16_t*)(F.ws + WS_RV);
    const bf16_t* SP = (const bf16_t*)(F.ws + WS_KV) + (size_t)idx2 * 32768;
#define SB() __builtin_amdgcn_sched_barrier(0)
    u32x4 kreg[4];
    {
        u32x4 sreg[8];
#pragma unroll
        for (int i = 0; i < 8; ++i) { const int p = tid + i * 512; sreg[i] = *(const u32x4*)((const unsigned char*)SP + (unsigned)(p * 16)); }
#pragma unroll
        for (int i = 0; i < 4; ++i) { const int p = tid + i * 512, c = p >> 4, d0 = (p & 15) * 8; *(LAS u32x4*)(QN + c * 136 + d0) = P.q[i]; kreg[i] = P.k[i]; }
#pragma unroll
        for (int i = 0; i < 8; ++i) { const int p = tid + i * 512, r = p >> 4, d0 = (p & 15) * 8; *(LAS u32x4*)(SPn + r * 136 + d0) = sreg[i]; }
    }
    LBAR();
    const int wi = wave >> 1, wd = wave & 1;
    f32x4 a1[8][2];
#pragma unroll
    for (int d = 0; d < 8; ++d) { a1[d][0] = (f32x4){0.f, 0.f, 0.f, 0.f}; a1[d][1] = a1[d][0]; }
    {
        const float qd0 = exp2f(l2g * (float)((2 * wi) * 16 + fr + 1)), qd1 = exp2f(l2g * (float)((2 * wi + 1) * 16 + fr + 1));
        bf16x8 xa[8], qa[2];
#define LD0(x, q, ks) do { _Pragma("unroll") for (int _d = 0; _d < 8; ++_d) x[_d] = lfrag(SPn, 136, (wd * 8 + _d) * 16, (ks) * 32, fr, fq); \
        q[0] = lfrag(QN, 136, (2 * wi) * 16, (ks) * 32, fr, fq); q[1] = lfrag(QN, 136, (2 * wi + 1) * 16, (ks) * 32, fr, fq); } while (0)
#define MM0(x, q) do { const bf16x8 _q0 = scale_frag(q[0], qd0), _q1 = scale_frag(q[1], qd1); _Pragma("unroll") for (int _d = 0; _d < 8; ++_d) { a1[_d][0] = mma16(x[_d], _q0, a1[_d][0]); a1[_d][1] = mma16(x[_d], _q1, a1[_d][1]); } } while (0)
        LD0(xa, qa, 0); SB(); MM0(xa, qa); SB(); LD0(xa, qa, 1); SB(); MM0(xa, qa); SB(); LD0(xa, qa, 2); SB(); MM0(xa, qa); SB(); LD0(xa, qa, 3); SB(); MM0(xa, qa); SB();
#undef LD0
#undef MM0
    }
    LBAR();
    u32x4 vreg[8];
#pragma unroll
    for (int i = 0; i < 8; ++i) { const int p = tid + i * 512, c = p >> 5, d0 = (p & 31) * 8; vreg[i] = *(const u32x4*)((const unsigned char*)RV + (unsigned)(((tok0 + c) * 1024 + h * 256 + d0) * 2)); }
#pragma unroll
    for (int i = 0; i < 4; ++i) { const int p = tid + i * 512, c = p >> 4, d0 = (p & 15) * 8; *(LAS u32x4*)(KN + c * 136 + d0) = kreg[i]; }
    LBAR();
    {
        bf16x8 yq[4];
#pragma unroll
        for (int ks = 0; ks < 4; ++ks) yq[ks] = lfrag(QN, 136, wave * 16, ks * 32, fr, fq);
        const int i = wave * 16 + fr;
        bf16x8 ka[4], kb[4];
#define LD1(k, jt) do { _Pragma("unroll") for (int _s = 0; _s < 4; ++_s) k[_s] = lfrag(KN, 136, (jt) * 16, _s * 32, fr, fq); } while (0)
#define MM1(k, jt) do { f32x4 acc = {0.f, 0.f, 0.f, 0.f}; _Pragma("unroll") for (int _s = 0; _s < 4; ++_s) acc = mma16(k[_s], yq[_s], acc); \
        float o[4]; _Pragma("unroll") for (int r = 0; r < 4; ++r) { const int j = (jt) * 16 + 4 * fq + r; o[r] = (j <= i) ? acc[r] * exp2f(l2g * (float)(i - j)) : 0.f; } \
        u32x2 w; w.x = pk2(o[0], o[1]); w.y = pk2(o[2], o[3]); *(LAS u32x2*)(PM + i * 136 + (jt) * 16 + 4 * fq) = w; } while (0)
        LD1(ka, 0); SB();
#pragma unroll
        for (int jt = 0; jt < 8; jt += 2) { LD1(kb, jt + 1); SB(); MM1(ka, jt); SB(); if (jt + 2 < 8) { LD1(ka, jt + 2); } SB(); MM1(kb, jt + 1); SB(); }
#undef LD1
#undef MM1
    }
    LBAR();
#pragma unroll
    for (int i = 0; i < 8; ++i) { const int p = tid + i * 512, c = p >> 5, d0 = (p & 31) * 8; *(LAS u32x4*)(VN + c * 264 + d0) = vreg[i]; }
    LBAR();
    const bf16_t* RG = (const bf16_t*)(F.ws + WS_RG);
    {
        bf16x8 xa[8], pa[2];
#define LD2(x, p, ks) do { _Pragma("unroll") for (int _d = 0; _d < 8; ++_d) x[_d] = tfrag(VN, 264, (ks) * 32, (wd * 8 + _d) * 16, lane); \
        p[0] = lfrag(PM, 136, (2 * wi) * 16, (ks) * 32, fr, fq); p[1] = lfrag(PM, 136, (2 * wi + 1) * 16, (ks) * 32, fr, fq); } while (0)
#define MM2(x, p) do { _Pragma("unroll") for (int _d = 0; _d < 8; ++_d) { a1[_d][0] = mma16(x[_d], p[0], a1[_d][0]); a1[_d][1] = mma16(x[_d], p[1], a1[_d][1]); } } while (0)
        LD2(xa, pa, 0); SB(); MM2(xa, pa); SB(); LD2(xa, pa, 1); SB(); MM2(xa, pa); SB(); LD2(xa, pa, 2); SB(); MM2(xa, pa); SB(); LD2(xa, pa, 3); SB(); MM2(xa, pa); SB();
#undef LD2
#undef MM2
    }
#undef SB
    u32x4 gr[8];
    {
        const int half = tid >> 5, ch = tid & 31;
#pragma unroll
        for (int k = 0; k < 8; ++k) gr[k] = *(const u32x4*)((const unsigned char*)RG + (unsigned)(((tok0 + k * 16 + half) * 1024 + h * 256 + ch * 8) * 2));
    }
    ret_out_fetch(F, idx_next >= 0 ? idx_next : idx2, P);
    LBAR();
    LAS bf16_t* ON = VN;
#pragma unroll
    for (int t = 0; t < 2; ++t) {
        const int i = (2 * wi + t) * 16 + fr;
#pragma unroll
        for (int d = 0; d < 8; ++d) { const f32x4 v = a1[d][t]; u32x2 w; w.x = pk2(v[0], v[1]); w.y = pk2(v[2], v[3]); *(LAS u32x2*)(ON + i * 264 + (wd * 8 + d) * 16 + 4 * fq) = w; }
    }
    LBAR();
    {
        bf16_t* YB = (bf16_t*)(F.ws + WS_YB);
        const int half = tid >> 5, ch = tid & 31;
#pragma unroll
        for (int k = 0; k < 8; ++k) {
            const int i = k * 16 + half;
            const u32x4 ow = *(const LAS u32x4*)(ON + i * 264 + ch * 8);
            float o[8] = {bflo(ow.x), bfhi(ow.x), bflo(ow.y), bfhi(ow.y), bflo(ow.z), bfhi(ow.z), bflo(ow.w), bfhi(ow.w)};
            float ss = 0.f;
#pragma unroll
            for (int e = 0; e < 8; ++e) ss += o[e] * o[e];
            ss = row16_sum(ss); ss += __shfl_xor(ss, 16);
            const float rstd = rsqrtf_(ss * (1.0f / 256.0f) + EPS);
            const u32x4 g = gr[k];
            u32x4 y;
            y.x = pk2(o[0] * rstd * siluf_(bflo(g.x)), o[1] * rstd * siluf_(bfhi(g.x))); y.y = pk2(o[2] * rstd * siluf_(bflo(g.y)), o[3] * rstd * siluf_(bfhi(g.y)));
            y.z = pk2(o[4] * rstd * siluf_(bflo(g.z)), o[5] * rstd * siluf_(bfhi(g.z))); y.w = pk2(o[6] * rstd * siluf_(bflo(g.w)), o[7] * rstd * siluf_(bfhi(g.w)));
            *(u32x4*)(YB + (size_t)(tok0 + i) * 1024 + h * 256 + ch * 8) = y;
        }
    }
    LBAR();
}

__device__ __forceinline__ void gdn_normgate_row(Frame& F, int m) {
    const int lane = F.lane;
    const u32x4 ow = *(const u32x4*)((const bf16_t*)(F.ws + WS_OGDN) + (size_t)m * 512 + lane * 8);
    const u32x4 z = *(const u32x4*)((const bf16_t*)(F.ws + WS_GZ) + (size_t)m * 512 + lane * 8);
    float o[8] = {bflo(ow.x), bfhi(ow.x), bflo(ow.y), bfhi(ow.y), bflo(ow.z), bfhi(ow.z), bflo(ow.w), bfhi(ow.w)};
    float ss = 0.f;
#pragma unroll
    for (int e = 0; e < 8; ++e) ss += o[e] * o[e];
    ss = row16_sum(ss);
    const float rstd = rsqrtf_(ss * (1.0f / 128.0f) + EPS);
    const float* nw = F.in[I_GNW] + (lane & 15) * 8;
    const f32x4 w0 = *(const f32x4*)nw, w1 = *(const f32x4*)(nw + 4);
    u32x4 y;
    y.x = pk2(o[0] * rstd * w0[0] * siluf_(bflo(z.x)), o[1] * rstd * w0[1] * siluf_(bfhi(z.x)));
    y.y = pk2(o[2] * rstd * w0[2] * siluf_(bflo(z.y)), o[3] * rstd * w0[3] * siluf_(bfhi(z.y)));
    y.z = pk2(o[4] * rstd * w1[0] * siluf_(bflo(z.z)), o[5] * rstd * w1[1] * siluf_(bfhi(z.z)));
    y.w = pk2(o[6] * rstd * w1[2] * siluf_(bflo(z.w)), o[7] * rstd * w1[3] * siluf_(bfhi(z.w)));
    *(u32x4*)((bf16_t*)(F.ws + WS_YA) + (size_t)m * 512 + lane * 8) = y;
}

struct EpiUp1 {
    static constexpr bool PERM = true;
    unsigned char* ws;
    __device__ __forceinline__ void operator()(const f32x4 (&acc)[2][2][4][2], const pg8::Unit& u, int wr, int wc, int fr, int fq) const {
        const int row0 = u.pm * 256 + wr * 64 + fr, col0 = u.pn * 256 + wc * 32 + 8 * fq;
        const bf16_t* MAB = (const bf16_t*)(ws + WS_MAB); float* TMP = (float*)(ws + WS_TMP);
#pragma unroll
        for (int ai = 0; ai < 2; ++ai)
#pragma unroll
            for (int m = 0; m < 4; ++m) { const int row = row0 + ai * 128 + m * 16;
#pragma unroll
                for (int bj = 0; bj < 2; ++bj) {
                    const int col = col0 + bj * 128;
                    const u32x4 g = *(const u32x4*)(MAB + (size_t)row * 2048 + col);
                    const f32x4 v0 = acc[ai][bj][m][0], v1 = acc[ai][bj][m][1];
                    f32x4 o0, o1;
                    o0[0] = v0[0] * sigmoidf_(bflo(g.x)); o0[1] = v0[1] * sigmoidf_(bfhi(g.x)); o0[2] = v0[2] * sigmoidf_(bflo(g.y)); o0[3] = v0[3] * sigmoidf_(bfhi(g.y));
                    o1[0] = v1[0] * sigmoidf_(bflo(g.z)); o1[1] = v1[1] * sigmoidf_(bfhi(g.z)); o1[2] = v1[2] * sigmoidf_(bflo(g.w)); o1[3] = v1[3] * sigmoidf_(bfhi(g.w));
                    float* p = TMP + (size_t)row * 1024 + col;
                    *(f32x4*)p = o0; *(f32x4*)(p + 4) = o1;
                } }
    }
};
struct EpiUp1R {
    static constexpr bool PERM = true;
    unsigned char* ws;
    __device__ __forceinline__ void operator()(f32x4 (&acc)[2][2][4][2], const pg8::Unit& u, int wr, int wc, int fr, int fq) const {
        const int row0 = u.pm * 256 + wr * 64 + fr, col0 = u.pn * 256 + wc * 32 + 8 * fq;
        const bf16_t* MAB = (const bf16_t*)(ws + WS_MAB);
#pragma unroll
        for (int ai = 0; ai < 2; ++ai)
#pragma unroll
            for (int m = 0; m < 4; ++m) { const int row = row0 + ai * 128 + m * 16;
#pragma unroll
                for (int bj = 0; bj < 2; ++bj) {
                    const int col = col0 + bj * 128;
                    const u32x4 ga = *(const u32x4*)(MAB + (size_t)row * 2048 + col), gb = *(const u32x4*)(MAB + (size_t)row * 2048 + 1024 + col);
                    const unsigned gaw[4] = {ga.x, ga.y, ga.z, ga.w}, gbw[4] = {gb.x, gb.y, gb.z, gb.w};
#pragma unroll
                    for (int q = 0; q < 4; ++q) {
                        const float a0 = bflo(gaw[q]), a1 = bfhi(gaw[q]), b0 = fmaxf(bflo(gbw[q]), -80.f), b1 = fmaxf(bfhi(gbw[q]), -80.f);
                        const float r0 = (1.0f + __builtin_amdgcn_exp2f(-1.4426950408889634f * b0)) * sigmoidf_(a0);
                        const float r1 = (1.0f + __builtin_amdgcn_exp2f(-1.4426950408889634f * b1)) * sigmoidf_(a1);
                        acc[ai][bj][m][q >> 1][(q & 1) * 2] *= r0; acc[ai][bj][m][q >> 1][(q & 1) * 2 + 1] *= r1;
                    }
                    asm volatile("" : "+v"(acc[ai][bj][m][0]), "+v"(acc[ai][bj][m][1]) :: "memory");
                } }
    }
};
struct EpiUp2R {
    static constexpr bool PERM = true;
    unsigned char* ws;
    __device__ __forceinline__ void operator()(const f32x4 (&acc)[2][2][4][2], const pg8::Unit& u, int wr, int wc, int fr, int fq) const {
        const int row0 = u.pm * 256 + wr * 64 + fr, col0 = u.pn * 256 + wc * 32 + 8 * fq;
        const bf16_t* MAB = (const bf16_t*)(ws + WS_MAB); bf16_t* MG = (bf16_t*)(ws + WS_MERGED);
#pragma unroll
        for (int ai = 0; ai < 2; ++ai)
#pragma unroll
            for (int m = 0; m < 4; ++m) { const int row = row0 + ai * 128 + m * 16;
#pragma unroll
                for (int bj = 0; bj < 2; ++bj) {
                    const int col = col0 + bj * 128;
                    const u32x4 g = *(const u32x4*)(MAB + (size_t)row * 2048 + 1024 + col);
                    const f32x4 v0 = acc[ai][bj][m][0], v1 = acc[ai][bj][m][1];
                    u32x4 w;
                    w.x = pk2(v0[0] * sigmoidf_(fmaxf(bflo(g.x), -80.f)), v0[1] * sigmoidf_(fmaxf(bfhi(g.x), -80.f)));
                    w.y = pk2(v0[2] * sigmoidf_(fmaxf(bflo(g.y), -80.f)), v0[3] * sigmoidf_(fmaxf(bfhi(g.y), -80.f)));
                    w.z = pk2(v1[0] * sigmoidf_(fmaxf(bflo(g.z), -80.f)), v1[1] * sigmoidf_(fmaxf(bfhi(g.z), -80.f)));
                    w.w = pk2(v1[2] * sigmoidf_(fmaxf(bflo(g.w), -80.f)), v1[3] * sigmoidf_(fmaxf(bfhi(g.w), -80.f)));
                    __builtin_nontemporal_store(w, (u32x4*)(MG + (size_t)row * 1024 + col));
                } }
    }
};
struct EpiUp2 {
    static constexpr bool PERM = true;
    unsigned char* ws;
    __device__ __forceinline__ void operator()(const f32x4 (&acc)[2][2][4][2], const pg8::Unit& u, int wr, int wc, int fr, int fq) const {
        const int row0 = u.pm * 256 + wr * 64 + fr, col0 = u.pn * 256 + wc * 32 + 8 * fq;
        const bf16_t* MAB = (const bf16_t*)(ws + WS_MAB); const float* TMP = (const float*)(ws + WS_TMP); bf16_t* MG = (bf16_t*)(ws + WS_MERGED);
#pragma unroll
        for (int ai = 0; ai < 2; ++ai)
#pragma unroll
            for (int m = 0; m < 4; ++m) { const int row = row0 + ai * 128 + m * 16;
#pragma unroll
                for (int bj = 0; bj < 2; ++bj) {
                    const int col = col0 + bj * 128;
                    const u32x4 g = *(const u32x4*)(MAB + (size_t)row * 2048 + 1024 + col);
                    const float* p = TMP + (size_t)row * 1024 + col;
                    const f32x4 t0 = *(const f32x4*)p, t1 = *(const f32x4*)(p + 4);
                    const f32x4 v0 = acc[ai][bj][m][0], v1 = acc[ai][bj][m][1];
                    u32x4 w;
                    w.x = pk2(t0[0] + v0[0] * sigmoidf_(bflo(g.x)), t0[1] + v0[1] * sigmoidf_(bfhi(g.x)));
                    w.y = pk2(t0[2] + v0[2] * sigmoidf_(bflo(g.y)), t0[3] + v0[3] * sigmoidf_(bfhi(g.y)));
                    w.z = pk2(t1[0] + v1[0] * sigmoidf_(bflo(g.z)), t1[1] + v1[1] * sigmoidf_(bfhi(g.z)));
                    w.w = pk2(t1[2] + v1[2] * sigmoidf_(bflo(g.w)), t1[3] + v1[3] * sigmoidf_(bfhi(g.w)));
                    *(u32x4*)(MG + (size_t)row * 1024 + col) = w;
                } }
    }
};
struct EpiOut {
    static constexpr bool PERM = false;
    const float* x; float* h;
    __device__ __forceinline__ void operator()(const f32x4 (&acc)[2][2][4][2], const pg8::Unit& u, int wr, int wc, int fr, int fq) const {
        const int row0 = u.pm * 256 + wr * 64 + fr, col0 = u.pn * 256 + wc * 32 + 4 * fq;
#pragma unroll
        for (int ai = 0; ai < 2; ++ai)
#pragma unroll
            for (int m = 0; m < 4; ++m) { const size_t off = (size_t)(row0 + ai * 128 + m * 16) * 1024 + col0;
#pragma unroll
                for (int bj = 0; bj < 2; ++bj)
#pragma unroll
                    for (int n = 0; n < 2; ++n) *(f32x4*)(h + off + bj * 128 + n * 16) = __builtin_nontemporal_load((const f32x4*)(x + off + bj * 128 + n * 16)) + acc[ai][bj][m][n]; }
    }
};

__device__ __forceinline__ void router_wave16(Frame& F, int t, bool commit) {
    const int lane = F.lane, fr = lane & 15, fq = lane >> 4, tok0 = t * 16;
    LAS float* PLw = (LAS float*)(F.lds + F.wave * 16384);
    LAS float* RSw = PLw + 16 * 49;
    const float* hb = (const float*)F.out; const float* wrt = (const float*)(F.ws + WS_WRT);
    f32x4 acc[3];
#pragma unroll
    for (int ct = 0; ct < 3; ++ct) acc[ct] = (f32x4){0.f, 0.f, 0.f, 0.f};
    float ssq = 0.f;
    const float* hp = hb + (size_t)(tok0 + fr) * DM + 4 * fq;
    const float* wp = wrt + (size_t)fr * DM + 4 * fq;
#pragma unroll 4
    for (int g = 0; g < 64; ++g) {
        const f32x4 xv = *(const f32x4*)(hp + 16 * g);
        ssq += (xv.x * xv.x + xv.y * xv.y) + (xv.z * xv.z + xv.w * xv.w);
#pragma unroll
        for (int ct = 0; ct < 3; ++ct) {
            const f32x4 wv = *(const f32x4*)(wp + ct * 16 * DM + 16 * g);
#pragma unroll
            for (int e = 0; e < 4; ++e) acc[ct] = __builtin_amdgcn_mfma_f32_16x16x4f32(wv[e], xv[e], acc[ct], 0, 0, 0);
        }
    }
    ssq += __shfl_xor(ssq, 16); ssq += __shfl_xor(ssq, 32);
    const float rstd = rsqrtf_(ssq * (1.f / DM) + EPS);
#pragma unroll
    for (int ct = 0; ct < 3; ++ct)
#pragma unroll
        for (int r = 0; r < 4; ++r) PLw[fr * 49 + ct * 16 + 4 * fq + r] = acc[ct][r] * rstd;
    if (fq == 0) RSw[fr] = rstd;
    asm volatile("s_waitcnt lgkmcnt(0)" ::: "memory");
    if (lane < 16) {
        const int m = tok0 + lane;
        const LAS float* p0 = PLw + lane * 49;
        float gl[4];
#pragma unroll
        for (int j = 0; j < 4; ++j) gl[j] = p0[j] + F.in[I_BGRP][j];
        int gi = 0; float gm = gl[0];
        if (gl[1] > gm) { gm = gl[1]; gi = 1; } if (gl[2] > gm) { gm = gl[2]; gi = 2; } if (gl[3] > gm) { gm = gl[3]; gi = 3; }
        const float gp = 1.0f / (__expf(gl[0] - gm) + __expf(gl[1] - gm) + __expf(gl[2] - gm) + __expf(gl[3] - gm));
        int i0 = 0, i1 = 0; float v0 = -3.0e38f, v1 = -3.0e38f;
#pragma unroll
        for (int i = 0; i < 8; ++i) {
            const float ev = p0[4 + gi * 8 + i] + F.in[I_BEXP][gi * 8 + i];
            if (ev > v0) { v1 = v0; i1 = i0; v0 = ev; i0 = i; } else if (ev > v1) { v1 = ev; i1 = i; }
        }
        const float w0 = gp / (1.0f + __expf(v1 - v0)), w1 = gp / (1.0f + __expf(v0 - v1));
        if (commit) {
            int* LTOK = (int*)(F.ws + WS_LTOK); int* LDST = (int*)(F.ws + WS_LDST); float* LW = (float*)(F.ws + WS_LW);
            unsigned* cnt = (unsigned*)(F.ws + WS_CTL) + CW_CNT;
            const int e0 = gi * 8 + i0, e1 = gi * 8 + i1;
            const unsigned q0 = __hip_atomic_fetch_add(cnt + e0, 1u, __ATOMIC_RELAXED, __HIP_MEMORY_SCOPE_AGENT);
            LTOK[e0 * 16384 + q0] = m; LDST[e0 * 16384 + q0] = 2 * m; LW[e0 * 16384 + q0] = w0;
            const unsigned q1 = __hip_atomic_fetch_add(cnt + e1, 1u, __ATOMIC_RELAXED, __HIP_MEMORY_SCOPE_AGENT);
            LTOK[e1 * 16384 + q1] = m; LDST[e1 * 16384 + q1] = 2 * m + 1; LW[e1 * 16384 + q1] = w1;
        }
    }
    f32x4 wn[4];
#pragma unroll
    for (int q = 0; q < 4; ++q) wn[q] = *(const f32x4*)(F.in[I_NFW] + 16 * lane + 4 * q);
#pragma unroll 2
    for (int j = 0; j < 16; ++j) {
        const float rs = RSw[j];
        const float* hr = hb + (size_t)(tok0 + j) * DM + 16 * lane;
        f32x4 a[4];
#pragma unroll
        for (int q = 0; q < 4; ++q) a[q] = *(const f32x4*)(hr + 4 * q);
        u32x4 o0, o1;
        o0.x = pk2(a[0].x * rs * wn[0].x, a[0].y * rs * wn[0].y); o0.y = pk2(a[0].z * rs * wn[0].z, a[0].w * rs * wn[0].w);
        o0.z = pk2(a[1].x * rs * wn[1].x, a[1].y * rs * wn[1].y); o0.w = pk2(a[1].z * rs * wn[1].z, a[1].w * rs * wn[1].w);
        o1.x = pk2(a[2].x * rs * wn[2].x, a[2].y * rs * wn[2].y); o1.y = pk2(a[2].z * rs * wn[2].z, a[2].w * rs * wn[2].w);
        o1.z = pk2(a[3].x * rs * wn[3].x, a[3].y * rs * wn[3].y); o1.w = pk2(a[3].z * rs * wn[3].z, a[3].w * rs * wn[3].w);
        bf16_t* xo = (bf16_t*)(F.ws + WS_XN) + (size_t)(tok0 + j) * DM + 16 * lane;
        *(u32x4*)xo = o0; *(u32x4*)(xo + 8) = o1;
    }
    asm volatile("s_waitcnt lgkmcnt(0)" ::: "memory");
}
constexpr int CW_CONV = 320;
__device__ __forceinline__ void p7_router(Frame& F, bool commit) {
    const int gw = F.vcu * NWAVES + F.wave, NGW = F.G * NWAVES;
    for (int t = F.vcu + F.G * F.wave; t < M / 16; t += F.G * NWAVES) router_wave16(F, t, commit);
    (void)gw; (void)NGW;
    LAS float* scr = (LAS float*)(F.lds + F.wave * 16384);
    constexpr int IG = 16 * 16, ID = 8 * 32, IPE = 2 * IG + ID;
    const float* wg = F.in[I_WGATE]; const float* wu = F.in[I_WUP]; const float* wdn = F.in[I_WDOWN]; unsigned char* ws = F.ws;
    auto dec = [=](int it) -> TrItem {
        const int e = it / IPE; int r = it % IPE; TrItem t;
        if (r < 2 * IG) { const int up = r >= IG; if (up) r -= IG; const int nb = r % 16, kb = r / 16, n0 = nb * 32;
            t.W = (up ? wu : wg) + (size_t)e * 1024 * 512; t.ldw = 512; t.col0 = n0; t.WT = (bf16_t*)(ws + WS_WGU) + (size_t)e * 1024 * 1024; t.K = 1024;
            t.row0 = (n0 >> 7) * 256 + (up ? 128 : 0) + (n0 & 127); t.k0 = kb * 64; return t; }
        r -= 2 * IG; const int nb = r % 32, kb = r / 32;
        t.W = wdn + (size_t)e * 512 * 1024; t.ldw = 1024; t.col0 = nb * 32; t.WT = (bf16_t*)(ws + WS_WD) + (size_t)e * 1024 * 512; t.K = 512; t.row0 = nb * 32; t.k0 = kb * 64; return t;
    };
    {
        const int NIT = NE * IPE, per = (NIT + F.G - 1) / F.G, base = F.vcu * per, lim = (base + per < NIT) ? base + per : NIT; const int lane = F.lane;
        volatile LAS unsigned* qc = F.MISC + 16;
        auto grab = [&]() -> int { unsigned v = 0; if (lane == 0) v = __hip_atomic_fetch_add((LAS unsigned*)qc, 1u, __ATOMIC_RELAXED, __HIP_MEMORY_SCOPE_WORKGROUP); return base + __builtin_amdgcn_readfirstlane((int)v); };
        f32x4 la[8], lb[8];
        int ia = grab(), ib;
        TrItem ta, tb;
        if (ia < lim) { ta = dec(ia); tr_load(ta, lane, la); }
        while (ia < lim) {
            ib = grab();
            if (ib < lim) { tb = dec(ib); tr_load(tb, lane, lb); }
            tr_store(ta, lane, la, scr);
            if (ib >= lim) break;
            ia = grab();
            if (ia < lim) { ta = dec(ia); tr_load(ta, lane, la); }
            tr_store(tb, lane, lb, scr);
        }
    }
}

constexpr int TOFF_OFF = MISC_OFF + 512;
constexpr int MYU_OFF = MISC_OFF + 768;
constexpr int CW_TILE = 8192;
struct MoeProb {
    const LAS int* toff; const unsigned* cnt; const int* ltok; unsigned* tilecnt;
    const bf16_t* A; const bf16_t* Bt; int K; int G, c; int total;
    __device__ __forceinline__ void unit_of(int L, pg8::Unit& u) const {
        const int tile = L >> 2; int e = 0;
#pragma unroll 1
        for (int s = 16; s > 0; s >>= 1) if (toff[e + s] <= tile) e += s;
        u.e = e; u.pm = tile - toff[e]; u.pn = L & 3; u.base = tile * 256;
        const int c_e = (int)cnt[e]; const int rem = c_e - u.pm * 256; u.rows = rem < 256 ? rem : 256;
    }
    __device__ __forceinline__ bool next(int i, pg8::Unit& u) const { const int L = i * G + c; if (L >= total) return false; unit_of(L, u); return true; }
    __device__ __forceinline__ int a_row(const pg8::Unit& u, int r) const { return ltok[u.e * 16384 + u.pm * 256 + (r < u.rows ? r : 0)]; }
    __device__ __forceinline__ const char* a_ptr(const pg8::Unit& u) const { return (const char*)A; }
    __device__ __forceinline__ const char* a_ptr_rows(const pg8::Unit& u) const { return (const char*)A + (size_t)u.base * K * 2; }
    __device__ __forceinline__ const char* b_ptr(const pg8::Unit& u) const { return (const char*)Bt + ((size_t)u.e * 1024 + u.pn * 256) * K * 2; }
    __device__ __forceinline__ void a_ready(const pg8::Unit&) const {}
    __device__ __forceinline__ void done(const pg8::Unit& u) const {
        asm volatile("s_waitcnt vmcnt(0)" ::: "memory");
        if ((threadIdx.x & 63) == 0) __hip_atomic_fetch_add(tilecnt + 64 * (u.base >> 8), 1u, __ATOMIC_RELAXED, __HIP_MEMORY_SCOPE_AGENT);
    }
};
struct MoeProbD : MoeProb {
    const LAS int* myu;
    __device__ __forceinline__ const char* a_ptr(const pg8::Unit& u) const { return a_ptr_rows(u); }
    __device__ __forceinline__ bool next(int i, pg8::Unit& u) const { if (i >= myu[0]) return false; unit_of(myu[1 + i], u); return true; }
    __device__ __forceinline__ void done(const pg8::Unit&) const {}
    __device__ __forceinline__ void a_ready(const pg8::Unit& u) const {
        if (threadIdx.x < 64) {
            const unsigned* w = tilecnt + 64 * (u.base >> 8); unsigned polls = 0;
            while ((unsigned)__builtin_amdgcn_readfirstlane(__hip_atomic_load(w, __ATOMIC_RELAXED, __HIP_MEMORY_SCOPE_AGENT)) < 32u) {
                __builtin_amdgcn_s_sleep(2);
                if (++polls > (1u << 20)) break;
            }
            __builtin_amdgcn_fence(__ATOMIC_ACQUIRE, "agent");
            asm volatile("s_waitcnt vmcnt(0)" ::: "memory");
        }
        asm volatile("" ::: "memory"); __builtin_amdgcn_s_barrier(); asm volatile("" ::: "memory");
    }
};
struct EpiGU {
    static constexpr bool PERM = true;
    bf16_t* hid;
    __device__ __forceinline__ void operator()(const f32x4 (&acc)[2][2][4][2], const pg8::Unit& u, int wr, int wc, int fr, int fq) const {
        const int col0 = u.pn * 128 + wc * 32 + 8 * fq;
#pragma unroll
        for (int ai = 0; ai < 2; ++ai)
#pragma unroll
            for (int m = 0; m < 4; ++m) { const int r = ai * 128 + wr * 64 + m * 16 + fr;
                const f32x4 g0 = acc[ai][0][m][0], g1 = acc[ai][0][m][1], u0 = acc[ai][1][m][0], u1 = acc[ai][1][m][1];
                u32x4 w;
                w.x = pk2(siluf_(g0[0]) * u0[0], siluf_(g0[1]) * u0[1]); w.y = pk2(siluf_(g0[2]) * u0[2], siluf_(g0[3]) * u0[3]);
                w.z = pk2(siluf_(g1[0]) * u1[0], siluf_(g1[1]) * u1[1]); w.w = pk2(siluf_(g1[2]) * u1[2], siluf_(g1[3]) * u1[3]);
                { bf16_t* p = hid + (size_t)(u.base + r) * 512 + col0; asm volatile("global_store_dwordx4 %0, %1, off sc1\n\ts_nop 1" :: "v"(p), "v"(w) : "memory"); } }
    }
};
struct EpiDown {
    static constexpr bool PERM = true;
    bf16_t* y2; const int* ldst; const float* lw;
    __device__ __forceinline__ void operator()(const f32x4 (&acc)[2][2][4][2], const pg8::Unit& u, int wr, int wc, int fr, int fq) const {
        const int col0 = u.pn * 256 + wc * 32 + 8 * fq;
#pragma unroll
        for (int ai = 0; ai < 2; ++ai)
#pragma unroll
            for (int m = 0; m < 4; ++m) { const int r = ai * 128 + wr * 64 + m * 16 + fr;
                if (r < u.rows) {
                    const int li = u.e * 16384 + u.pm * 256 + r; const int dst = ldst[li]; const float cw = lw[li];
#pragma unroll
                    for (int bj = 0; bj < 2; ++bj) { const f32x4 v0 = acc[ai][bj][m][0] * cw, v1 = acc[ai][bj][m][1] * cw;
                        u32x4 w; w.x = pk2(v0[0], v0[1]); w.y = pk2(v0[2], v0[3]); w.z = pk2(v1[0], v1[1]); w.w = pk2(v1[2], v1[3]);
                        __builtin_nontemporal_store(w, (u32x4*)(y2 + (size_t)dst * 1024 + col0 + bj * 128)); }
                } }
    }
};
__device__ __forceinline__ void moe_toff(Frame& F) {
    LAS int* toff = (LAS int*)(F.lds + TOFF_OFF);
    __syncthreads();
    if (F.tid == 0) { const unsigned* cnt = (const unsigned*)(F.ws + WS_CTL) + CW_CNT; int a = 0;
        for (int e = 0; e < NE; ++e) { toff[e] = a; a += ((int)cnt[e] + 255) >> 8; } toff[NE] = a; }
    __syncthreads();
}

__device__ __forceinline__ void moe_down_list(Frame& F, int U, int c) {
    LAS int* myu = (LAS int*)(F.lds + MYU_OFF);
    if (F.tid == 0) {
        const int G = F.G, A = U % G, k = U / G;
        int tH = 5 * (k + 1), tL = 5 * k, rem = U, j0 = 0, n = 0;
        while (rem > 0 && n < 30) {
            const bool heavy = (A > 0) && (tH < tL);
            const int gsz = heavy ? A : (G - A), rank = heavy ? c : (c - A);
            const int cntr = rem < gsz ? rem : gsz;
            if ((heavy ? (c < A) : (c >= A)) && rank < cntr) { myu[1 + n] = j0 + rank; ++n; }
            if (heavy) tH += 3; else tL += 3;
            j0 += cntr; rem -= cntr;
        }
        myu[0] = n;
    }
    __syncthreads();
}

struct FinPre { f32x4 h[4]; u32x2 a[4], b[4]; };
__device__ __forceinline__ void final_fetch(Frame& F, int m, FinPre& P) {
    const int lane = F.lane;
    const float* hr = F.out + (size_t)m * DM;
    const bf16_t* y0 = (const bf16_t*)(F.ws + WS_Y2) + (size_t)(2 * m) * DM; const bf16_t* y1 = y0 + DM;
#pragma unroll
    for (int j = 0; j < 4; ++j) {
        P.h[j] = __builtin_nontemporal_load((const f32x4*)(hr + 4 * lane + 256 * j));
        P.a[j] = __builtin_nontemporal_load((const u32x2*)(y0 + 4 * lane + 256 * j)); P.b[j] = __builtin_nontemporal_load((const u32x2*)(y1 + 4 * lane + 256 * j));
    }
}
__device__ __forceinline__ void final_row(Frame& F, int m, float* dstbase, const FinPre& P) {
    const int lane = F.lane;
    f32x4 v[4]; float s = 0.f;
#pragma unroll
    for (int j = 0; j < 4; ++j) {
        v[j] = P.h[j];
        const u32x2 a = P.a[j], b = P.b[j];
        v[j][0] += bflo(a.x) + bflo(b.x); v[j][1] += bfhi(a.x) + bfhi(b.x); v[j][2] += bflo(a.y) + bflo(b.y); v[j][3] += bfhi(a.y) + bfhi(b.y);
        s += (v[j].x * v[j].x + v[j].y * v[j].y) + (v[j].z * v[j].z + v[j].w * v[j].w);
    }
    const float rstd = 1.0f / sqrtf(wave_sum(s) * (1.f / DM) + EPS);
#pragma unroll
    for (int j = 0; j < 4; ++j) { const f32x4 w = *(const f32x4*)(F.in[I_NFINW] + 4 * lane + 256 * j); __builtin_nontemporal_store(v[j] * rstd * w, (f32x4*)(dstbase + (size_t)m * DM + 4 * lane + 256 * j)); }
}

__device__ __forceinline__ void ph1_body(Frame& F) {
    pg8::Dense P; P.init((const bf16_t*)(F.ws + WS_U), (const bf16_t*)(F.ws + WS_WINT), M, NP, DM, F.G, (int)blockIdx.x);
    EpiProj E{F.ws};
    pg8::gemm_phase<EpiProj, pg8::Dense, false, true, true>(F.lds, P, E);
}
__device__ __forceinline__ void ph5_body(Frame& F) {
    if (F.G * 1 >= (M / 256) * (DM / 256)) {
        f32x4 xacc[2][2][4][2];
        { pg8::Dense P; P.init((const bf16_t*)(F.ws + WS_YA), (const bf16_t*)(F.ws + WS_WUPA), M, DM, 512, F.G, (int)blockIdx.x);
          EpiUp1R E{F.ws}; pg8::gemm_phase<EpiUp1R, pg8::Dense, false, false, true, 1>(F.lds, P, E, xacc); }
        { pg8::Dense P; P.init((const bf16_t*)(F.ws + WS_YB), (const bf16_t*)(F.ws + WS_WUPR), M, DM, 1024, F.G, (int)blockIdx.x);
          EpiUp2R E{F.ws}; pg8::gemm_phase<EpiUp2R, pg8::Dense, false, false, true, 2>(F.lds, P, E, xacc); }
    } else {
        { pg8::Dense P; P.init((const bf16_t*)(F.ws + WS_YA), (const bf16_t*)(F.ws + WS_WUPA), M, DM, 512, F.G, (int)blockIdx.x);
          EpiUp1 E{F.ws}; pg8::gemm_phase<EpiUp1, pg8::Dense, false, false, true>(F.lds, P, E); }
        { pg8::Dense P; P.init((const bf16_t*)(F.ws + WS_YB), (const bf16_t*)(F.ws + WS_WUPR), M, DM, 1024, F.G, (int)blockIdx.x);
          EpiUp2 E{F.ws}; pg8::gemm_phase<EpiUp2, pg8::Dense, false, false, true>(F.lds, P, E); }
    }
}

struct Args { const float* in[19]; float* out; unsigned char* ws; int ph_lo, ph_hi; };
__global__ void __launch_bounds__(NTHR, 2) hgrh_fwd(Args args) {
    extern __shared__ __attribute__((aligned(16))) unsigned char lds_raw[];
    Frame F;
    F.lds = (LAS unsigned char*)lds_raw;
    F.MISC = (volatile LAS unsigned*)(F.lds + MISC_OFF);
    F.tid = threadIdx.x; F.lane = F.tid & 63; F.wave = __builtin_amdgcn_readfirstlane(F.tid >> 6);
    F.G = gridDim.x; { const int bx = blockIdx.x; F.vcu = (F.G % 8 == 0) ? (bx % 8) * (F.G / 8) + bx / 8 : bx; }
#pragma unroll
    for (int i = 0; i < 19; ++i) F.in[i] = args.in[i];
    F.out = args.out; F.ws = args.ws;
    F.ctl = (GAS unsigned*)(args.ws + WS_CTL);
    for (int u = F.tid; u < (LDS_BYTES - MISC_OFF) / 4; u += NTHR) ((LAS unsigned*)(F.lds + MISC_OFF))[u] = 0u;
    __syncthreads();
    const int lo = args.ph_lo, hi = args.ph_hi;
    XcdBarrier bar; bar.bar = (unsigned*)(args.ws + WS_CTL) + CW_BAR; bar.x = 0; bar.st = nullptr;
    if (hi - lo > 1) bar = xcd_barrier_post((unsigned*)(args.ws + WS_CTL) + CW_BAR, F.MISC + 8);
#ifndef PH_MASK
#define PH_MASK 0xFFFF
#endif
#define IN(k) (((PH_MASK >> (k)) & 1) && lo <= (k) && (k) < hi)
#define SEAM(k) do { if (IN(k) && IN((k) + 1)) { xcd_barrier(bar); if (REPS(13) == 2) xcd_barrier(bar); } } while (0)
    const int gw = F.vcu * NWAVES + F.wave, NGW = F.G * NWAVES;

    if (IN(0)) { for (int rep = 0; rep < REPS(0); ++rep) p0_prologue(F); }
    SEAM(0);
    if (IN(1)) {
        ph1_body(F);
        if (REPS(1) == 2) ph1_body(F);
    }
    SEAM(1);
    if (IN(2)) {
        u32x4 pxw[2][7]; float pg = 0.f, pb = 0.f;
        for (int rep = 0; rep < REPS(2); ++rep) {
#ifdef PREP_PROBE
        if (F.vcu < 1024) gdn_prep_fetch(F, F.vcu, pxw, pg, pb);
        for (int it = F.vcu; it < 1024; it += F.G) gdn_prep_item<PREP_PROBE>(F, it, it + F.G < 1024 ? it + F.G : -1, pxw, pg, pb);
#endif
        if (F.vcu < 1024) gdn_prep_fetch(F, F.vcu, pxw, pg, pb);
        for (int it = F.vcu; it < 1024; it += F.G) gdn_prep_item<0>(F, it, it + F.G < 1024 ? it + F.G : -1, pxw, pg, pb);
        for (int it = F.vcu; it < 512; it += F.G) ret_kv_item(F, it);
        }
        if (REPS(11) == 2) { if (F.vcu < 1024) gdn_prep_fetch(F, F.vcu, pxw, pg, pb); for (int it = F.vcu; it < 1024; it += F.G) gdn_prep_item<0>(F, it, it + F.G < 1024 ? it + F.G : -1, pxw, pg, pb); }
        if (REPS(12) == 2) for (int it = F.vcu + 1024; it < 1024 + 512; it += F.G) ret_kv_item(F, it - 1024);
    }
    SEAM(2);
    if (IN(3)) {
        if (F.vcu < 64) {
#ifdef SCAN_PROBE
            gdn_scan_block<SCAN_PROBE>(F, F.vcu);
#endif
            for (int rep = 0; rep < REPS(3); ++rep) gdn_scan_block<0>(F, F.vcu); }
        else {
            const int NB = F.G - 64, ob = F.vcu - 64;
            for (int t = ob * NWAVES + F.wave; t < 2048; t += NB * NWAVES) ret_prefix_task(F, t);
            asm volatile("s_waitcnt vmcnt(0)" ::: "memory");
            __syncthreads();
            if (F.tid == 0) {
                unsigned* pc = (unsigned*)(F.ws + WS_CTL) + CW_PFX;
                __builtin_amdgcn_fence(__ATOMIC_RELEASE, "agent");
                asm volatile("s_waitcnt vmcnt(0)" ::: "memory");
                xb_add(pc, 1u);
                unsigned sp = 0;
                while (xb_ld(pc) < (unsigned)NB) { __builtin_amdgcn_s_sleep(2); if (++sp > (1u << 22)) break; }
                __builtin_amdgcn_fence(__ATOMIC_ACQUIRE, "agent");
                asm volatile("s_waitcnt vmcnt(0)" ::: "memory");
            }
            __syncthreads();
            for (int rep = 0; rep < REPS(4); ++rep) {
                RetPre RP;
                ret_out_fetch(F, ob < 512 ? ob : 0, RP);
                for (int it = ob; it < 512; it += NB) ret_out_item(F, it, it + NB < 512 ? it + NB : -1, RP);
            }
        }
    }
    SEAM(3);
    if (IN(4)) {
        for (int rep = 0; rep < REPS(14); ++rep)
        for (int m = gw; m < M; m += NGW) gdn_normgate_row(F, m);
    }
    SEAM(4);
    if (IN(5)) {
        ph5_body(F);
        if (REPS(5) == 2) ph5_body(F);
    }
    SEAM(5);
    if (IN(6)) {
        for (int rep = 0; rep < REPS(6); ++rep) {
        pg8::Dense P; P.init((const bf16_t*)(F.ws + WS_MERGED), (const bf16_t*)(F.ws + WS_WOUT), M, DM, DM, F.G, (int)blockIdx.x);
        EpiOut E{F.in[I_X], F.out}; pg8::gemm_phase<EpiOut, pg8::Dense, false, false, true>(F.lds, P, E);
        }
    }
    SEAM(6);
    if (IN(7)) { for (int rep = 0; rep < REPS(7); ++rep) { __syncthreads(); if (F.tid == 0) F.MISC[16] = 0u; __syncthreads(); p7_router(F, rep == REPS(7) - 1); } }
    SEAM(7);
    if (IN(8)) {
        moe_toff(F);
        MoeProb P; P.toff = (const LAS int*)(F.lds + TOFF_OFF); P.cnt = (const unsigned*)(F.ws + WS_CTL) + CW_CNT; P.ltok = (const int*)(F.ws + WS_LTOK); P.tilecnt = (unsigned*)(F.ws + WS_CTL) + CW_TILE;
        P.A = (const bf16_t*)(F.ws + WS_XN); P.Bt = (const bf16_t*)(F.ws + WS_WGU); P.K = 1024; P.G = F.G; P.c = F.vcu; P.total = 4 * P.toff[NE];
        moe_down_list(F, P.total, F.vcu);
        EpiGU E{(bf16_t*)(F.ws + WS_HID)};
        pg8::gemm_phase<EpiGU, MoeProb, true, true, true>(F.lds, P, E);
        MoeProbD Q; Q.toff = P.toff; Q.cnt = P.cnt; Q.ltok = P.ltok; Q.tilecnt = P.tilecnt; Q.myu = (const LAS int*)(F.lds + MYU_OFF);
        Q.A = (const bf16_t*)(F.ws + WS_HID); Q.Bt = (const bf16_t*)(F.ws + WS_WD); Q.K = 512; Q.G = F.G; Q.c = F.vcu; Q.total = P.total;
        EpiDown E2{(bf16_t*)(F.ws + WS_Y2), (const int*)(F.ws + WS_LDST), (const float*)(F.ws + WS_LW)};
        pg8::gemm_phase<EpiDown, MoeProbD, false, true, true>(F.lds, Q, E2);
    }
    SEAM(8);
    if (IN(10)) { for (int rep = 0; rep < REPS(10); ++rep) { float* dst = (rep == REPS(10) - 1) ? F.out : (float*)(F.ws + WS_MAB); FinPre fa, fb; final_fetch(F, gw < M ? gw : 0, fa); for (int m = gw; m < M; m += 2 * NGW) { const int m1 = m + NGW, m2 = m + 2 * NGW; if (m1 < M) final_fetch(F, m1, fb); final_row(F, m, dst, fa); if (m2 < M) final_fetch(F, m2, fa); if (m1 < M) final_row(F, m1, dst, fb); } } }
#undef IN
#undef SEAM
}

extern "C" void kernel_launch(void* const* d_in, const int* in_sizes, int n_in, void* d_out, int out_size, void* d_ws, size_t ws_size, hipStream_t stream) {
    static int grid = 0;
    if (grid == 0) {
        if (n_in != 19 || in_sizes[0] != M * DM || out_size != M * DM || ws_size < WS_END) {
            fprintf(stderr, "kernel_launch: unexpected problem (n_in %d, in0 %d, out %d, ws %zu < %zu); nothing launched\n", n_in, n_in > 0 ? in_sizes[0] : -1, out_size, ws_size, (size_t)WS_END); grid = -1; return; }
        int dev = 0, cus = 0;
        if (hipGetDevice(&dev) != hipSuccess || hipDeviceGetAttribute(&cus, hipDeviceAttributeMultiprocessorCount, dev) != hipSuccess) { grid = -1; return; }
        if (hipFuncSetAttribute((const void*)hgrh_fwd, hipFuncAttributeMaxDynamicSharedMemorySize, LDS_BYTES) != hipSuccess) { fprintf(stderr, "kernel_launch: hipFuncSetAttribute failed\n"); grid = -1; return; }
        int per_cu = 0;
        if (hipOccupancyMaxActiveBlocksPerMultiprocessor(&per_cu, (const void*)hgrh_fwd, NTHR, LDS_BYTES) != hipSuccess || per_cu < 1)
            fprintf(stderr, "kernel_launch: occupancy query reports %d workgroups per CU\n", per_cu);
        (void)hipGetLastError();
        grid = cus;
    }
    if (grid < 0) return;
    (void)hipMemsetAsync((char*)d_ws + WS_CTL, 0, CTL_ZERO_BYTES, stream);
    Args a{};
    for (int i = 0; i < 19; ++i) a.in[i] = (const float*)d_in[i];
    a.out = (float*)d_out; a.ws = (unsigned char*)d_ws;
#if MK_N_LAUNCHES == 1
    a.ph_lo = 0; a.ph_hi = NPH;
    hipLaunchKernelGGL(hgrh_fwd, dim3(grid), dim3(NTHR), LDS_BYTES, stream, a);
#else
    for (int p = 0; p < NPH; ++p) { a.ph_lo = p; a.ph_hi = p + 1; hipLaunchKernelGGL(hgrh_fwd, dim3(grid), dim3(NTHR), LDS_BYTES, stream, a); }
#endif
}
```
